# Optimizing an MI355X kernel written in HIP

```python
import jax, jax.numpy as jnp
from jax import lax
import numpy as np

D_MODEL = 1024
BATCH = 8
SEQ = 2048
DEPTH = 2
DEC_BATCH = 128
DEC_SEQ = 8
PAST_LEN = 16384
PAGE_SIZE = 128

N_EVEN = (DEPTH + 1) // 2
N_ODD = DEPTH // 2
A_WIDTH = D_MODEL // 2
B_WIDTH = D_MODEL // 2
RWKV_HEAD = 64
RWKV_HEADS = B_WIDTH // RWKV_HEAD
LORA_W = 64
LORA_A = 64
LORA_G = 128
B_PROJ = 3 * B_WIDTH + LORA_W + LORA_A + LORA_G
IN_PROJ = 2 * A_WIDTH + B_PROJ
CONV_W = 31
CONV_BUF = CONV_W - 1
POOL_WINDOWS = (2, 4, 8, 16)
POOL_GROUPS = 4
POOL_GW = D_MODEL // POOL_GROUPS
POOL_BUF = max(POOL_WINDOWS) - 1
D_FF = ((8 * D_MODEL + 3 * 256 - 1) // (3 * 256)) * 256
ALPHA = (2 * DEPTH) ** 0.25
BETA = (8 * DEPTH) ** -0.25
LN_EPS = 1e-5
GN_EPS = 64e-5

kernel_name = 'hybrid_conv_rwkv7_pool_deepnorm_step'


def layer_norm(x, g, b, eps=LN_EPS):
    xf = x.astype(jnp.float32)
    mu = jnp.mean(xf, axis=-1, keepdims=True)
    var = jnp.mean(jnp.square(xf - mu), axis=-1, keepdims=True)
    y = (xf - mu) * lax.rsqrt(var + eps) * g.astype(jnp.float32) + b.astype(jnp.float32)
    return y.astype(x.dtype)


def conformer_conv(val, gate, conv_prev, w, b, g, bb):
    u = val * jax.nn.sigmoid(gate)
    ext = jnp.concatenate([conv_prev.astype(u.dtype), u], axis=1)
    y = lax.conv_general_dilated(ext, w[:, None, :].astype(u.dtype), window_strides=(1,), padding='VALID',
                                 dimension_numbers=('NWC', 'WIO', 'NWC'), feature_group_count=A_WIDTH) + b
    y = jax.nn.silu(layer_norm(y, g, bb))
    return y, ext[:, -CONV_BUF:]


def rwkv_scan(r, k, v, w, a, b, s0):
    def step(S, inp):
        r_t, k_t, v_t, w_t, a_t, b_t = inp
        sa = jnp.einsum('nhvk,nhk->nhv', S, a_t)
        S = S * w_t[:, :, None, :] + sa[..., None] * b_t[:, :, None, :] + v_t[..., None] * k_t[:, :, None, :]
        o = jnp.einsum('nhvk,nhk->nhv', S, r_t)
        return S, o
    xs = tuple(jnp.moveaxis(t.astype(jnp.float32), 1, 0) for t in (r, k, v, w, a, b))
    S, o = lax.scan(step, s0.astype(jnp.float32), xs)
    return jnp.moveaxis(o, 0, 1), S


def rwkv_mix(proj, shift_prev, wkv_prev, mu, w0, w2, a0, a2, g2, k_k, k_a, r_k, lnx_g, lnx_b):
    N, L, _ = proj.shape
    prev = jnp.concatenate([shift_prev[:, None, :].astype(proj.dtype), proj[:, :-1]], axis=1)
    xm = proj + mu * (prev - proj)
    s1, s2, s3 = B_WIDTH, 2 * B_WIDTH, 3 * B_WIDTH
    r, k, v = xm[..., :s1], xm[..., s1:s2], xm[..., s2:s3]
    dw = xm[..., s3:s3 + LORA_W]
    da = xm[..., s3 + LORA_W:s3 + LORA_W + LORA_A]
    dg = xm[..., s3 + LORA_W + LORA_A:]
    wlog = -jax.nn.softplus(-(w0 + jnp.tanh(dw) @ w2)) - 0.5
    decay = jnp.exp(-jnp.exp(wlog.astype(jnp.float32)))
    a = jax.nn.sigmoid((a0 + da @ a2).astype(jnp.float32))
    g = jax.nn.sigmoid(dg) @ g2
    hs = (N, L, RWKV_HEADS, RWKV_HEAD)
    rf = r.astype(jnp.float32).reshape(hs)
    kf = k.astype(jnp.float32)
    vf = v.astype(jnp.float32).reshape(hs)
    kk = (kf * k_k.astype(jnp.float32)).reshape(hs)
    kk = kk / jnp.maximum(jnp.sqrt(jnp.sum(kk * kk, axis=-1, keepdims=True)), 1e-12)
    kf = (kf * (1.0 + (a - 1.0) * k_a.astype(jnp.float32))).reshape(hs)
    ah = a.reshape(hs)
    o, S = rwkv_scan(rf, kf, vf, decay.reshape(hs), -kk, kk * ah, wkv_prev)
    om = jnp.mean(o, axis=-1, keepdims=True)
    ov = jnp.mean(jnp.square(o - om), axis=-1, keepdims=True)
    o = ((o - om) * lax.rsqrt(ov + GN_EPS)).reshape(N, L, B_WIDTH) * lnx_g.astype(jnp.float32) + lnx_b.astype(jnp.float32)
    bonus = jnp.sum(rf * kf * r_k.astype(jnp.float32), axis=-1, keepdims=True) * vf
    o = (o + bonus.reshape(N, L, B_WIDTH)) * g.astype(jnp.float32)
    return o.astype(proj.dtype), proj[:, -1], S.astype(wkv_prev.dtype)


def pool_mix(x, pool_prev, start, w, scale):
    N, L, D = x.shape
    ext = jnp.concatenate([pool_prev.astype(x.dtype), x], axis=1)
    cs = jnp.cumsum(ext.astype(jnp.float32), axis=1)
    cs0 = jnp.concatenate([jnp.zeros((N, 1, D), jnp.float32), cs], axis=1)
    pos = start + jnp.arange(L)
    outs = []
    for gi, wdw in enumerate(POOL_WINDOWS):
        lo, hi = gi * POOL_GW, (gi + 1) * POOL_GW
        ssum = cs0[:, POOL_BUF + 1:, lo:hi] - cs0[:, POOL_BUF + 1 - wdw:POOL_BUF + 1 - wdw + L, lo:hi]
        cnt = jnp.minimum(wdw, pos + 1).astype(jnp.float32)
        outs.append(ssum / cnt[None, :, None])
    pooled = jnp.concatenate(outs, axis=-1) - x.astype(jnp.float32)
    y = jnp.einsum('nlgc,gcd->nlgd', pooled.reshape(N, L, POOL_GROUPS, POOL_GW), w.astype(jnp.float32))
    y = y.reshape(N, L, D) * scale.astype(jnp.float32)
    return y.astype(x.dtype), ext[:, -POOL_BUF:]


def swiglu(x, wg, wu, wd):
    return (jax.nn.silu(x @ wg) * (x @ wu)) @ wd


def trunk(x, conv_prev, shift_prev, wkv_prev, pool_prev, start, p):
    new_conv, new_shift, new_wkv, new_pool = [], [], [], []
    for i in range(DEPTH):
        if i % 2 == 0:
            e = i // 2
            proj = x @ p['w_in'][e]
            a_out, c_new = conformer_conv(proj[..., :A_WIDTH], proj[..., A_WIDTH:2 * A_WIDTH], conv_prev[e],
                                          p['conv_w'][e], p['conv_b'][e], p['conv_ln_g'][e], p['conv_ln_b'][e])
            b_out, sh_new, s_new = rwkv_mix(proj[..., 2 * A_WIDTH:], shift_prev[e], wkv_prev[e],
                                            p['rwkv_mu'][e], p['rwkv_w0'][e], p['rwkv_w2'][e], p['rwkv_a0'][e],
                                            p['rwkv_a2'][e], p['rwkv_g2'][e], p['rwkv_kk'][e], p['rwkv_ka'][e],
                                            p['rwkv_rk'][e], p['rwkv_lnx_g'][e], p['rwkv_lnx_b'][e])
            mix = jnp.concatenate([a_out, b_out], axis=-1) @ p['w_out'][e]
            new_conv.append(c_new)
            new_shift.append(sh_new)
            new_wkv.append(s_new)
        else:
            o = i // 2
            mix, pl_new = pool_mix(x, pool_prev[o], start, p['pool_w'][o], p['pool_scale'][o])
            new_pool.append(pl_new)
        x = layer_norm(ALPHA * x + mix, p['ln_mix_g'][i], p['ln_mix_b'][i])
        x = layer_norm(ALPHA * x + swiglu(x, p['ffn_gate'][i], p['ffn_up'][i], p['ffn_down'][i]),
                       p['ln_ffn_g'][i], p['ln_ffn_b'][i])
    return x, jnp.stack(new_conv), jnp.stack(new_shift), jnp.stack(new_wkv), jnp.stack(new_pool)


def setup_inputs(seed: int = 0) -> dict:
    key = jax.random.key(seed)
    ks = jax.random.split(key, 40)
    nrm = jax.random.normal
    f = jnp.float32
    d = {}
    d['x_prompt'] = nrm(ks[0], (BATCH, SEQ, D_MODEL), f)
    d['x_sample'] = nrm(ks[1], (DEC_BATCH, DEC_SEQ, D_MODEL), f)
    d['state_conv'] = 0.5 * nrm(ks[2], (N_EVEN, DEC_BATCH, CONV_BUF, A_WIDTH), f)
    d['state_shift'] = nrm(ks[3], (N_EVEN, DEC_BATCH, B_PROJ), f)
    d['state_wkv'] = 0.5 * nrm(ks[4], (N_EVEN, DEC_BATCH, RWKV_HEADS, RWKV_HEAD, RWKV_HEAD), f)
    d['state_pool'] = nrm(ks[5], (N_ODD, DEC_BATCH, POOL_BUF, D_MODEL), f)
    d['w_in'] = nrm(ks[6], (N_EVEN, D_MODEL, IN_PROJ), f) * D_MODEL ** -0.5
    d['conv_w'] = nrm(ks[7], (N_EVEN, CONV_W, A_WIDTH), f) * CONV_W ** -0.5
    d['conv_b'] = 0.01 * nrm(ks[8], (N_EVEN, A_WIDTH), f)
    d['conv_ln_g'] = 1.0 + 0.02 * nrm(ks[9], (N_EVEN, A_WIDTH), f)
    d['conv_ln_b'] = 0.01 * nrm(ks[10], (N_EVEN, A_WIDTH), f)
    d['rwkv_mu'] = jax.random.uniform(ks[11], (N_EVEN, B_PROJ), f)
    d['rwkv_w0'] = jax.random.uniform(ks[12], (N_EVEN, B_WIDTH), f, -6.0, 1.0)
    d['rwkv_w2'] = 0.1 * nrm(ks[13], (N_EVEN, LORA_W, B_WIDTH), f) * LORA_W ** -0.5
    d['rwkv_a0'] = 0.1 * nrm(ks[14], (N_EVEN, B_WIDTH), f)
    d['rwkv_a2'] = 0.1 * nrm(ks[15], (N_EVEN, LORA_A, B_WIDTH), f) * LORA_A ** -0.5
    d['rwkv_g2'] = nrm(ks[16], (N_EVEN, LORA_G, B_WIDTH), f) * LORA_G ** -0.5
    d['rwkv_kk'] = 0.85 + 0.05 * nrm(ks[17], (N_EVEN, B_WIDTH), f)
    d['rwkv_ka'] = 1.0 + 0.05 * nrm(ks[18], (N_EVEN, B_WIDTH), f)
    d['rwkv_rk'] = 0.1 * nrm(ks[19], (N_EVEN, RWKV_HEADS, RWKV_HEAD), f)
    d['rwkv_lnx_g'] = 1.0 + 0.02 * nrm(ks[20], (N_EVEN, B_WIDTH), f)
    d['rwkv_lnx_b'] = 0.01 * nrm(ks[21], (N_EVEN, B_WIDTH), f)
    d['w_out'] = nrm(ks[22], (N_EVEN, A_WIDTH + B_WIDTH, D_MODEL), f) * (A_WIDTH + B_WIDTH) ** -0.5 * BETA
    d['pool_w'] = nrm(ks[23], (N_ODD, POOL_GROUPS, POOL_GW, POOL_GW), f) * POOL_GW ** -0.5 * BETA
    d['pool_scale'] = 1.0 + 0.02 * nrm(ks[24], (N_ODD, D_MODEL), f)
    d['ln_mix_g'] = 1.0 + 0.02 * nrm(ks[25], (DEPTH, D_MODEL), f)
    d['ln_mix_b'] = 0.01 * nrm(ks[26], (DEPTH, D_MODEL), f)
    d['ffn_gate'] = nrm(ks[27], (DEPTH, D_MODEL, D_FF), f) * D_MODEL ** -0.5
    d['ffn_up'] = nrm(ks[28], (DEPTH, D_MODEL, D_FF), f) * D_MODEL ** -0.5
    d['ffn_down'] = nrm(ks[29], (DEPTH, D_FF, D_MODEL), f) * D_FF ** -0.5 * BETA
    d['ln_ffn_g'] = 1.0 + 0.02 * nrm(ks[30], (DEPTH, D_MODEL), f)
    d['ln_ffn_b'] = 0.01 * nrm(ks[31], (DEPTH, D_MODEL), f)
    return d


def reference(x_prompt, x_sample, state_conv, state_shift, state_wkv, state_pool,
              w_in, conv_w, conv_b, conv_ln_g, conv_ln_b,
              rwkv_mu, rwkv_w0, rwkv_w2, rwkv_a0, rwkv_a2, rwkv_g2, rwkv_kk, rwkv_ka, rwkv_rk,
              rwkv_lnx_g, rwkv_lnx_b, w_out, pool_w, pool_scale,
              ln_mix_g, ln_mix_b, ffn_gate, ffn_up, ffn_down, ln_ffn_g, ln_ffn_b):
    p = dict(w_in=w_in, conv_w=conv_w, conv_b=conv_b, conv_ln_g=conv_ln_g, conv_ln_b=conv_ln_b,
             rwkv_mu=rwkv_mu, rwkv_w0=rwkv_w0, rwkv_w2=rwkv_w2, rwkv_a0=rwkv_a0, rwkv_a2=rwkv_a2,
             rwkv_g2=rwkv_g2, rwkv_kk=rwkv_kk, rwkv_ka=rwkv_ka, rwkv_rk=rwkv_rk,
             rwkv_lnx_g=rwkv_lnx_g, rwkv_lnx_b=rwkv_lnx_b, w_out=w_out, pool_w=pool_w, pool_scale=pool_scale,
             ln_mix_g=ln_mix_g, ln_mix_b=ln_mix_b, ffn_gate=ffn_gate, ffn_up=ffn_up, ffn_down=ffn_down,
             ln_ffn_g=ln_ffn_g, ln_ffn_b=ln_ffn_b)
    dt = x_prompt.dtype
    z_conv = jnp.zeros((N_EVEN, BATCH, CONV_BUF, A_WIDTH), dt)
    z_shift = jnp.zeros((N_EVEN, BATCH, B_PROJ), dt)
    z_wkv = jnp.zeros((N_EVEN, BATCH, RWKV_HEADS, RWKV_HEAD, RWKV_HEAD), state_wkv.dtype)
    z_pool = jnp.zeros((N_ODD, BATCH, POOL_BUF, D_MODEL), dt)
    y_prompt, p_conv, p_shift, p_wkv, p_pool = trunk(x_prompt, z_conv, z_shift, z_wkv, z_pool, 0, p)
    y_sample, s_conv, s_shift, s_wkv, s_pool = trunk(x_sample, state_conv, state_shift, state_wkv, state_pool,
                                                     PAST_LEN, p)
    return (y_prompt, y_sample, p_conv, p_shift, p_wkv, p_pool, s_conv, s_shift, s_wkv, s_pool)
```

```cpp
#include <hip/hip_runtime.h>
#include <hip/hip_cooperative_groups.h>
#include <cstdio>
#include <cstdint>
namespace cg = cooperative_groups;
namespace pg8 {
#define PG8_LAS __attribute__((address_space(3)))
typedef unsigned short bf16_t;
typedef short bf16x8 __attribute__((ext_vector_type(8)));
typedef float f32x4 __attribute__((ext_vector_type(4)));
typedef unsigned u32x4 __attribute__((ext_vector_type(4)));
constexpr int BM = 256, BK = 64, HALF = 128, HTB = HALF * BK * 2  , STAGE_BYTES = 8 * HTB, NXCD = 8, WGM = 8;

__host__ __device__ __forceinline__ int lds_byte(int r, int c) { const int st = (r >> 4) * 2 + (c >> 5), rr = r & 15, cc = c & 31, ob = rr * 64 + cc * 2; return st * 1024 + (ob ^ (((ob >> 9) & 1) << 5)); }
__host__ __device__ __forceinline__ void stage_rc(int b, int& R, int& C) { const int st = b / 1024, sb = b % 1024, swz = sb ^ (((sb >> 9) & 1) << 5); R = (st >> 1) * 16 + swz / 64; C = (st & 1) * 32 + (swz % 64) / 2; }
__host__ __device__ __forceinline__ int perm32(int rho) { const int n = rho >> 4, i = rho & 15; return 8 * (i >> 2) + 4 * n + (i & 3); }

struct Unit { int pm, pn; };
struct Gemm { const bf16_t* A; const bf16_t* Bt; int M, N, K, lda, ldb, acol; };

struct StaticOrder {
    int nM, nN, nwg, G, c;
    __host__ __device__ void init(int M, int N, int G_, int c_) { nM = M / BM; nN = N / BM; nwg = nM * nN; G = G_; c = c_; }
    __host__ __device__ bool next(int i, Unit& u) const {
        const long L = (long)i * G + c; if (L >= nwg) return false;
        int wgid = (int)L; { const int q = nwg / NXCD, r = nwg % NXCD, xcd = wgid % NXCD, off = wgid / NXCD; wgid = (xcd < r ? xcd * (q + 1) : r * (q + 1) + (xcd - r) * q) + off; }
        const int nig = WGM * nN, gid = wgid / nig, fm = gid * WGM, gsz = (nM - fm) < WGM ? (nM - fm) : WGM;
        u.pm = fm + ((wgid % nig) % gsz); u.pn = (wgid % nig) / gsz; return true;
    }
    __device__ __forceinline__ void a_ready(const Unit&) const {}
    __device__ __forceinline__ void done(const Unit&) const {}
};

__device__ __forceinline__ unsigned cvt_pk_bf16(float lo, float hi) { unsigned r; asm volatile("v_cvt_pk_bf16_f32 %0, %1, %2" : "=v"(r) : "v"(lo), "v"(hi)); return r; }
template <class Epi, class Sched, bool ALIGN_EPI = false, bool SP2 = false>
__device__ __forceinline__ void gemm_phase(PG8_LAS unsigned char* lds, const Gemm g, const Sched& S, const Epi& E) {
    const int tid = threadIdx.x, wid = __builtin_amdgcn_readfirstlane(tid >> 6), lane = tid & 63, wr = wid >> 2, wc = wid & 3, fr = lane & 15, fq = lane >> 4;
    const int K = g.K, nt = K / BK;
    unsigned voffA[2], voffB[2];
#pragma unroll
    for (int i = 0; i < 2; ++i) { int R, C; stage_rc(tid * 16 + i * 8192, R, C); const int Rb = Epi::PERM ? ((R & ~31) + perm32(R & 31)) : R;
        voffA[i] = (unsigned)(R * g.lda + C) * 2u; voffB[i] = (unsigned)(Rb * g.ldb + C) * 2u; }
    const size_t kstep = (size_t)(BK * 2);
    const size_t hstepA = (size_t)HALF * g.lda * 2, hstepB = (size_t)HALF * g.ldb * 2;
    const size_t tstepA = 2 * hstepA, tstepB = 2 * hstepB; const size_t acolB = (size_t)g.acol * 2;
    const unsigned ldsw = (unsigned)wid * 1024u;
    const int aoff = lds_byte(wr * 64 + fr, fq * 8), boff = lds_byte(wc * 32 + fr, fq * 8);
#define PG8_SA(b, h) (((b) * 2 + (h)) * HTB)
#define PG8_SB(b, h) ((4 + (b) * 2 + (h)) * HTB)
#define PG8_STAGE(bufoff, gbase, voff) do { _Pragma("unroll") for (int _i = 0; _i < 2; ++_i) \
        __builtin_amdgcn_global_load_lds((const unsigned*)((const char*)(gbase) + (voff)[_i]), (PG8_LAS unsigned*)(lds + (bufoff) + ldsw + _i * 8192), 16, 0, 0); } while (0)
#define PG8_LDA(dst, b, h) do { _Pragma("unroll") for (int m = 0; m < 4; ++m) _Pragma("unroll") for (int k = 0; k < 2; ++k) dst[m][k] = *(const PG8_LAS bf16x8*)(lds + PG8_SA(b, h) + aoff + m * 2048 + k * 1024); } while (0)
#define PG8_LDB(dst, b, h) do { _Pragma("unroll") for (int n = 0; n < 2; ++n) _Pragma("unroll") for (int k = 0; k < 2; ++k) dst[n][k] = *(const PG8_LAS bf16x8*)(lds + PG8_SB(b, h) + boff + n * 2048 + k * 1024); } while (0)
#define PG8_MMA(ai, bj, At, Bt) do { __builtin_amdgcn_s_setprio(1); _Pragma("unroll") for (int m = 0; m < 4; ++m) _Pragma("unroll") for (int n = 0; n < 2; ++n) _Pragma("unroll") for (int k = 0; k < 2; ++k) \
        acc[ai][bj][m][n] = __builtin_amdgcn_mfma_f32_16x16x32_bf16(Bt[n][k], At[m][k], acc[ai][bj][m][n], 0, 0, 0); __builtin_amdgcn_s_setprio(0); } while (0)
#define PG8_WAIT_V(n) asm volatile("s_waitcnt vmcnt(" #n ")" ::: "memory")
#define PG8_WAIT_L(n) asm volatile("s_waitcnt lgkmcnt(" #n ")" ::: "memory")
#define PG8_BAR __builtin_amdgcn_s_barrier()
#define PG8_SCHED __builtin_amdgcn_sched_barrier(0)
    Unit cur, nxt; int ui = 0;
    if (!S.next(0, cur)) return;
    f32x4 acc[2][2][4][2];
#pragma unroll
    for (int a = 0; a < 2; ++a)
#pragma unroll
        for (int b = 0; b < 2; ++b)
#pragma unroll
            for (int m = 0; m < 4; ++m)
#pragma unroll
                for (int n = 0; n < 2; ++n) acc[a][b][m][n] = (f32x4){0.f, 0.f, 0.f, 0.f};
    bf16x8 At[4][2], B0[2][2], B1[2][2];
    const char* cA = (const char*)g.A + (size_t)cur.pm * tstepA + (size_t)cur.pn * acolB; const char* cB = (const char*)g.Bt + (size_t)cur.pn * tstepB;
    S.a_ready(cur);
    if constexpr (SP2) {
        PG8_STAGE(PG8_SB(0, 0), cB, voffB); PG8_STAGE(PG8_SB(0, 1), cB + hstepB, voffB); PG8_STAGE(PG8_SA(0, 0), cA, voffA); PG8_STAGE(PG8_SA(0, 1), cA + hstepA, voffA);
        if (wr == 1) PG8_BAR;
        PG8_WAIT_V(2); PG8_BAR;
        PG8_STAGE(PG8_SB(1, 0), cB + kstep, voffB); PG8_STAGE(PG8_SA(1, 0), cA + kstep, voffA); PG8_STAGE(PG8_SB(1, 1), cB + hstepB + kstep, voffB);
        PG8_WAIT_V(6); PG8_BAR;
    } else {
        PG8_STAGE(PG8_SB(0, 0), cB, voffB); PG8_STAGE(PG8_SA(0, 0), cA, voffA); PG8_STAGE(PG8_SB(0, 1), cB + hstepB, voffB); PG8_STAGE(PG8_SA(0, 1), cA + hstepA, voffA);
        if (wr == 1) PG8_BAR;
        PG8_WAIT_V(4); PG8_BAR;
        PG8_STAGE(PG8_SB(1, 0), cB + kstep, voffB); PG8_STAGE(PG8_SA(1, 0), cA + kstep, voffA); PG8_STAGE(PG8_SB(1, 1), cB + hstepB + kstep, voffB);
        PG8_WAIT_V(6); PG8_BAR;
    }
    for (;;) {
        const bool has_next = S.next(ui + 1, nxt);
        const char* nA = has_next ? (const char*)g.A + (size_t)nxt.pm * tstepA + (size_t)nxt.pn * acolB : cA; const char* nB = has_next ? (const char*)g.Bt + (size_t)nxt.pn * tstepB : cB;
        _Pragma("unroll 1") for (int t = 0; t < nt; t += 2) {
            const bool last = (t == nt - 2);
            const char* a1 = cA + (size_t)(t + 1) * kstep;
            const char* a2 = last ? nA : cA + (size_t)(t + 2) * kstep; const char* b2 = last ? nB : cB + (size_t)(t + 2) * kstep;
            const char* a3 = a2 + kstep; const char* b3 = b2 + kstep;
            if (last && has_next) S.a_ready(nxt);
            if constexpr (SP2) {
            PG8_LDB(B0, 0, 0); PG8_LDB(B1, 0, 1); PG8_SCHED; PG8_LDA(At, 0, 0); PG8_STAGE(PG8_SA(1, 1), a1 + hstepA, voffA);
            PG8_WAIT_V(8); PG8_WAIT_L(0); PG8_BAR; PG8_MMA(0, 0, At, B0); PG8_MMA(0, 1, At, B1); PG8_BAR; PG8_SCHED;
            PG8_LDA(At, 0, 1); PG8_STAGE(PG8_SB(0, 0), b2, voffB); PG8_STAGE(PG8_SB(0, 1), b2 + hstepB, voffB); PG8_STAGE(PG8_SA(0, 0), a2, voffA);
            PG8_WAIT_V(8); PG8_WAIT_L(0); PG8_BAR; PG8_MMA(1, 0, At, B0); PG8_MMA(1, 1, At, B1); PG8_BAR; PG8_SCHED;
            PG8_LDB(B0, 1, 0); PG8_LDB(B1, 1, 1); PG8_SCHED; PG8_LDA(At, 1, 0); PG8_STAGE(PG8_SA(0, 1), a2 + hstepA, voffA);
            PG8_WAIT_V(8); PG8_WAIT_L(0); PG8_BAR; PG8_MMA(0, 0, At, B0); PG8_MMA(0, 1, At, B1); PG8_BAR; PG8_SCHED;
            PG8_LDA(At, 1, 1); PG8_STAGE(PG8_SB(1, 0), b3, voffB); PG8_STAGE(PG8_SB(1, 1), b3 + hstepB, voffB); PG8_STAGE(PG8_SA(1, 0), a3, voffA);
            PG8_WAIT_V(8); PG8_WAIT_L(0); PG8_BAR; PG8_MMA(1, 0, At, B0); PG8_MMA(1, 1, At, B1); PG8_BAR; PG8_SCHED;
            } else {
            PG8_LDB(B0, 0, 0); PG8_SCHED; PG8_LDA(At, 0, 0); PG8_STAGE(PG8_SA(1, 1), a1 + hstepA, voffA);
            PG8_WAIT_L(8); PG8_BAR; PG8_WAIT_L(0); PG8_MMA(0, 0, At, B0); PG8_BAR; PG8_SCHED;
            PG8_LDB(B1, 0, 1); PG8_STAGE(PG8_SB(0, 0), b2, voffB);
            PG8_BAR; PG8_WAIT_L(0); PG8_MMA(0, 1, At, B1); PG8_BAR;
            PG8_LDA(At, 0, 1); PG8_STAGE(PG8_SA(0, 0), a2, voffA);
            PG8_BAR; PG8_WAIT_L(0); PG8_MMA(1, 0, At, B0); PG8_BAR; PG8_SCHED;
            PG8_STAGE(PG8_SB(0, 1), b2 + hstepB, voffB);
            PG8_WAIT_V(6); PG8_BAR; PG8_MMA(1, 1, At, B1); PG8_BAR;
            PG8_LDB(B0, 1, 0); PG8_SCHED; PG8_LDA(At, 1, 0); PG8_STAGE(PG8_SA(0, 1), a2 + hstepA, voffA);
            PG8_WAIT_L(8); PG8_BAR; PG8_WAIT_L(0); PG8_MMA(0, 0, At, B0); PG8_BAR; PG8_SCHED;
            PG8_LDB(B1, 1, 1); PG8_STAGE(PG8_SB(1, 0), b3, voffB);
            PG8_BAR; PG8_WAIT_L(0); PG8_MMA(0, 1, At, B1); PG8_BAR;
            PG8_LDA(At, 1, 1); PG8_STAGE(PG8_SA(1, 0), a3, voffA);
            PG8_BAR; PG8_WAIT_L(0); PG8_MMA(1, 0, At, B0); PG8_BAR; PG8_SCHED;
            PG8_STAGE(PG8_SB(1, 1), b3 + hstepB, voffB);
            PG8_WAIT_V(6); PG8_BAR; PG8_MMA(1, 1, At, B1); PG8_BAR;
            }
        }
        if constexpr (ALIGN_EPI) { if (wr == 0) PG8_BAR; }
        if constexpr (!Epi::AFTER_DRAIN) { E(acc, cur, wr, wc, fr, fq); S.done(cur); }
        if (!has_next) break;
#pragma unroll
        for (int a = 0; a < 2; ++a)
#pragma unroll
            for (int b = 0; b < 2; ++b)
#pragma unroll
                for (int m = 0; m < 4; ++m)
#pragma unroll
                    for (int n = 0; n < 2; ++n) acc[a][b][m][n] = (f32x4){0.f, 0.f, 0.f, 0.f};
        cur = nxt; cA = nA; cB = nB; ++ui;
        if constexpr (ALIGN_EPI) { if (wr == 1) PG8_BAR; }
    }
    PG8_WAIT_V(0);
    if constexpr (!ALIGN_EPI) { if (wr == 0) PG8_BAR; }
    PG8_BAR;
    if constexpr (Epi::AFTER_DRAIN) { E.fused(acc, cur, wr, wc, fr, fq, lds, wid, lane); S.done(cur); }
#undef PG8_SA
#undef PG8_SB
#undef PG8_STAGE
#undef PG8_LDA
#undef PG8_LDB
#undef PG8_MMA
#undef PG8_WAIT_V
#undef PG8_WAIT_L
#undef PG8_BAR
#undef PG8_SCHED
}
}

#define GAS __attribute__((address_space(1)))
#define LAS __attribute__((address_space(3)))
typedef unsigned short bf16;
typedef unsigned v4u __attribute__((ext_vector_type(4)));
typedef unsigned v2u __attribute__((ext_vector_type(2)));
typedef float f32x4 __attribute__((ext_vector_type(4)));
typedef _Float16 h16;
typedef _Float16 h16x2 __attribute__((ext_vector_type(2)));

#ifndef MK_SINGLE
#define MK_SINGLE 1
#endif

constexpr int NWAVES = 8, NTHREADS = NWAVES * 64;
constexpr int D = 1024, TP = 16384, TS = 1024, T = TP + TS, LP = 2048, LS = 8, NPB = 8, NSB = 128;
constexpr int INP = 2816, BP = 1792, FF = 2816, HW = 512;
constexpr float ALPHA = 1.41421356237309515f, LN_EPS = 1e-5f, GN_EPS = 64e-5f;
constexpr int NPHASE = 18;

constexpr size_t MiB = 1u << 20;
constexpr size_t WS_WIN = 1 * MiB, WS_WOUT = WS_WIN + 5632 * 1024, WS_WGU0 = WS_WOUT + 2 * MiB, WS_WGU1 = WS_WGU0 + 11 * MiB, WS_WD0 = WS_WGU1 + 11 * MiB, WS_WD1 = WS_WD0 + 5632 * 1024,
                 WS_POOLT = WS_WD1 + 5632 * 1024, WS_LORAT = WS_POOLT + 512 * 1024;
constexpr size_t WS_XB = 43 * MiB;
constexpr size_t WS_SCW = 43 * MiB, WS_G = 60 * MiB;
constexpr size_t WS_PROJA = 77 * MiB;
constexpr size_t WS_PROJB = 111 * MiB;
constexpr size_t WS_CAT = 111 * MiB, WS_SCB = 145 * MiB, WS_O = 162 * MiB;
constexpr size_t WS_LA = 170 * MiB + 512 * 1024;
constexpr size_t WS_SCR = 179 * MiB, WS_SCV = 196 * MiB, WS_SCK = 213 * MiB, WS_SCKK = 230 * MiB;
constexpr size_t WS_Z = 188 * MiB;
constexpr size_t WS_H = 77 * MiB;
constexpr size_t WS_PL = 77 * MiB;
constexpr size_t WS_END = 256 * MiB;
static_assert(WS_LORAT + 1536 * 256 * 2 <= WS_XB, "weights");
static_assert(WS_PROJB + (size_t)T * BP * 2 <= WS_LA, "projb");
static_assert(WS_H + (size_t)T * FF * 2 <= WS_Z, "h");
static_assert(WS_Z + (size_t)T * D * 4 <= WS_END, "z");

constexpr size_t O_Y = 0, O_CONV_P = 17825792, O_SHIFT_P = 17948672, O_WKV_P = 17963008, O_POOL_P = 18225152,
                 O_CONV_S = 18348032, O_SHIFT_S = 20314112, O_WKV_S = 20543488, O_POOL_S = 24737792, O_TOTAL = 26703872;

constexpr int LDS_BYTES = 147456;

struct Frame {
    LAS unsigned char* lds;
    int tid, lane, wave, vcu, G;
    const float* const* in;
    float* out; unsigned char* ws;
};

__device__ __forceinline__ float bf2f(unsigned b) { return __uint_as_float(b << 16); }
__device__ __forceinline__ unsigned pkbf(float lo, float hi) { return pg8::cvt_pk_bf16(lo, hi); }
__device__ __forceinline__ unsigned pkh(float lo, float hi) { const unsigned short a = __builtin_bit_cast(unsigned short, (h16)lo), b = __builtin_bit_cast(unsigned short, (h16)hi); return (unsigned)a | ((unsigned)b << 16); }
__device__ __forceinline__ float hlo(unsigned u) { return (float)__builtin_bit_cast(h16, (unsigned short)(u & 0xffffu)); }
__device__ __forceinline__ float hhi(unsigned u) { return (float)__builtin_bit_cast(h16, (unsigned short)(u >> 16)); }
__device__ __forceinline__ void unpack_bf8(v4u w, float (&f)[8]) { const unsigned u0 = w.x, u1 = w.y, u2 = w.z, u3 = w.w;
    f[0] = __uint_as_float(u0 << 16); f[1] = __uint_as_float(u0 & 0xffff0000u); f[2] = __uint_as_float(u1 << 16); f[3] = __uint_as_float(u1 & 0xffff0000u);
    f[4] = __uint_as_float(u2 << 16); f[5] = __uint_as_float(u2 & 0xffff0000u); f[6] = __uint_as_float(u3 << 16); f[7] = __uint_as_float(u3 & 0xffff0000u); }
__device__ __forceinline__ void unpack_h8(v4u w, float (&f)[8]) { const unsigned u0 = w.x, u1 = w.y, u2 = w.z, u3 = w.w; f[0] = hlo(u0); f[1] = hhi(u0); f[2] = hlo(u1); f[3] = hhi(u1); f[4] = hlo(u2); f[5] = hhi(u2); f[6] = hlo(u3); f[7] = hhi(u3); }
__device__ __forceinline__ v4u pack_bf8(const float (&f)[8]) { v4u w; w.x = pkbf(f[0], f[1]); w.y = pkbf(f[2], f[3]); w.z = pkbf(f[4], f[5]); w.w = pkbf(f[6], f[7]); return w; }
__device__ __forceinline__ v4u pack_h8(const float (&f)[8]) { v4u w; w.x = pkh(f[0], f[1]); w.y = pkh(f[2], f[3]); w.z = pkh(f[4], f[5]); w.w = pkh(f[6], f[7]); return w; }
__device__ __forceinline__ void load_f8(const float* p, float (&f)[8]) { const f32x4 a = *(const f32x4*)p, b = *(const f32x4*)(p + 4); f[0] = a.x; f[1] = a.y; f[2] = a.z; f[3] = a.w; f[4] = b.x; f[5] = b.y; f[6] = b.z; f[7] = b.w; }
__device__ __forceinline__ void store_f8(float* p, const float (&f)[8]) { *(f32x4*)p = (f32x4){f[0], f[1], f[2], f[3]}; *(f32x4*)(p + 4) = (f32x4){f[4], f[5], f[6], f[7]}; }
__device__ __forceinline__ float sigmoid_(float x) { return __builtin_amdgcn_rcpf(1.f + __expf(-x)); }
__device__ __forceinline__ float silu_(float x) { return x * sigmoid_(x); }
__device__ __forceinline__ float wave_sum(float v) {
#pragma unroll
    for (int o = 1; o < 64; o <<= 1) v += __shfl_xor(v, o);
    return v;
}
__device__ __forceinline__ float sum8(float v) { v += __shfl_xor(v, 1); v += __shfl_xor(v, 2); v += __shfl_xor(v, 4); return v; }
template <int CTRL> __device__ __forceinline__ float dppf(float x) { return __builtin_bit_cast(float, __builtin_amdgcn_update_dpp(0, __builtin_bit_cast(int, x), CTRL, 0xF, 0xF, true)); }
__device__ __forceinline__ float dpp_sum16(float x) {
    x += dppf<0xB1>(x);
    x += dppf<0x4E>(x);
    x += dppf<0x141>(x);
    x += dppf<0x140>(x);
    return x;
}
__device__ __forceinline__ void h4(v2u x, float (&f)[4]) { const unsigned u0 = x.x, u1 = x.y; f[0] = hlo(u0); f[1] = hhi(u0); f[2] = hlo(u1); f[3] = hhi(u1); }
__device__ __forceinline__ const float* xrow_ptr(const Frame& F, int m) { return m < TP ? F.in[0] + (size_t)m * D : F.in[1] + (size_t)(m - TP) * D; }

using pg8::Unit; using pg8::HALF; using pg8::BM;
typedef pg8::u32x4 u32x4;
struct EpiProj {
    static constexpr bool PERM = true, AFTER_DRAIN = false;
    bf16* PA; bf16* PB;
    __device__ __forceinline__ void operator()(const pg8::f32x4 (&acc)[2][2][4][2], const Unit& u, int wr, int wc, int fr, int fq) const {
        const int row0 = u.pm * BM + wr * 64 + fr;
        bf16* base; int ldc, colt;
        if (u.pn < 4) { base = PA; ldc = 1024; colt = u.pn * BM; } else { base = PB; ldc = BP; colt = (u.pn - 4) * BM; }
        const int col0 = colt + wc * 32 + 8 * fq;
#pragma unroll
        for (int ai = 0; ai < 2; ++ai)
#pragma unroll
            for (int m = 0; m < 4; ++m) { bf16* rowp = base + (size_t)(row0 + ai * HALF + m * 16) * ldc + col0;
#pragma unroll
                for (int bj = 0; bj < 2; ++bj) { const pg8::f32x4 v0 = acc[ai][bj][m][0], v1 = acc[ai][bj][m][1];
                    u32x4 w; w.x = pkbf(v0[0], v0[1]); w.y = pkbf(v0[2], v0[3]); w.z = pkbf(v1[0], v1[1]); w.w = pkbf(v1[2], v1[3]);
                    *(u32x4*)(rowp + bj * HALF) = w; } }
    }
};
struct EpiLora {
    static constexpr bool PERM = true, AFTER_DRAIN = false;
    const float* w0; const float* a0; const float* ka;
    h16* SCW; h16* SCK; h16* SCKK; h16* SCB; h16* G;
    __device__ __forceinline__ void operator()(const pg8::f32x4 (&acc)[2][2][4][2], const Unit& u, int wr, int wc, int fr, int fq) const {
        const int row0 = u.pm * BM + wr * 64 + fr; const int sec = u.pn >> 1;
        const int c0 = (u.pn & 1) * BM + wc * 32 + 8 * fq;
#pragma unroll
        for (int bj = 0; bj < 2; ++bj)
#pragma unroll
            for (int n = 0; n < 2; ++n) {
                const int c = c0 + bj * HALF + 4 * n;
                f32x4 p0 = {0.f, 0.f, 0.f, 0.f}, p1 = {0.f, 0.f, 0.f, 0.f};
                if (sec == 0) p0 = *(const f32x4*)(w0 + c); else if (sec == 1) { p0 = *(const f32x4*)(a0 + c); p1 = *(const f32x4*)(ka + c); }
#pragma unroll
                for (int ai = 0; ai < 2; ++ai)
#pragma unroll
                    for (int m = 0; m < 4; ++m) {
                        const size_t off = (size_t)(row0 + ai * HALF + m * 16) * HW + c;
                        const pg8::f32x4 v = acc[ai][bj][m][n];
                        if (sec == 0) {
                            float o[4];
#pragma unroll
                            for (int i = 0; i < 4; ++i) { const float e = 0.60653065971f * sigmoid_(p0[i] + v[i]); o[i] = 1.f - __expf(-e); }
                            v2u w; w.x = pkh(o[0], o[1]); w.y = pkh(o[2], o[3]); *(v2u*)(SCW + off) = w;
                        } else if (sec == 1) {
                            float kx[4], kk[4], ko[4], bo[4];
                            h4(*(const v2u*)(SCK + off), kx); h4(*(const v2u*)(SCKK + off), kk);
#pragma unroll
                            for (int i = 0; i < 4; ++i) { const float a = sigmoid_(p0[i] + v[i]); ko[i] = kx[i] * (1.f + (a - 1.f) * p1[i]); bo[i] = kk[i] * a; }
                            v2u w; w.x = pkh(ko[0], ko[1]); w.y = pkh(ko[2], ko[3]); *(v2u*)(SCK + off) = w;
                            v2u x; x.x = pkh(bo[0], bo[1]); x.y = pkh(bo[2], bo[3]); *(v2u*)(SCB + off) = x;
                        } else {
                            v2u w; w.x = pkh(v[0], v[1]); w.y = pkh(v[2], v[3]); *(v2u*)(G + off) = w;
                        }
                        asm volatile("" ::: "memory");
                    }
            }
    }
};
struct EpiGateUp {
    static constexpr bool PERM = true, AFTER_DRAIN = false;
    bf16* H;
    __device__ __forceinline__ void operator()(const pg8::f32x4 (&acc)[2][2][4][2], const Unit& u, int wr, int wc, int fr, int fq) const {
        const int row0 = u.pm * BM + wr * 64 + fr; const int col0 = u.pn * HALF + wc * 32 + 8 * fq;
#pragma unroll
        for (int ai = 0; ai < 2; ++ai)
#pragma unroll
            for (int m = 0; m < 4; ++m) {
                const pg8::f32x4 g0 = acc[ai][0][m][0], g1 = acc[ai][0][m][1], u0 = acc[ai][1][m][0], u1 = acc[ai][1][m][1];
                u32x4 w; w.x = pkbf(silu_(g0[0]) * u0[0], silu_(g0[1]) * u0[1]); w.y = pkbf(silu_(g0[2]) * u0[2], silu_(g0[3]) * u0[3]);
                w.z = pkbf(silu_(g1[0]) * u1[0], silu_(g1[1]) * u1[1]); w.w = pkbf(silu_(g1[2]) * u1[2], silu_(g1[3]) * u1[3]);
                *(u32x4*)(H + (size_t)(row0 + ai * HALF + m * 16) * FF + col0) = w;
            }
    }
};
struct EpiResid {
    static constexpr bool PERM = false, AFTER_DRAIN = false;
    const float* xp; const float* xs; float* Z; const float* scale;
    __device__ __forceinline__ void operator()(const pg8::f32x4 (&acc)[2][2][4][2], const Unit& u, int wr, int wc, int fr, int fq) const {
        const int col0 = u.pn * BM + wc * 32 + 4 * fq;
#pragma unroll
        for (int ai = 0; ai < 2; ++ai)
#pragma unroll
            for (int m = 0; m < 4; ++m) {
                const int row = u.pm * BM + ai * HALF + wr * 64 + m * 16 + fr;
                float* zr = Z + (size_t)row * D + col0;
                const float* br = xp ? ((row < TP ? xp + (size_t)row * D : xs + (size_t)(row - TP) * D) + col0) : zr;
#pragma unroll
                for (int bj = 0; bj < 2; ++bj)
#pragma unroll
                    for (int n = 0; n < 2; ++n) {
                        const int o = bj * HALF + n * 16;
                        pg8::f32x4 a = acc[ai][bj][m][n];
                        if (scale) a = a * *(const pg8::f32x4*)(scale + col0 + o);
                        const pg8::f32x4 b = *(const pg8::f32x4*)(br + o);
                        *(pg8::f32x4*)(zr + o) = b * ALPHA + a;
                    }
            }
    }
};

__device__ __forceinline__ void transpose_item(const float* W, int K, int N, bf16* WT, int mode, LAS float* scr, int item, int lane) {
    const int nblk = N / 32, kb = item / nblk, nb = item % nblk, k0 = 64 * kb, n0 = 32 * nb;
    const int drow0 = mode == 0 ? n0 : ((n0 >> 7) * 256 + (mode == 2 ? 128 : 0) + (n0 & 127));
#pragma unroll 8
    for (int i = 0; i < 32; ++i) { const int kk = 2 * i + (lane >> 5); scr[kk * 33 + (lane & 31)] = W[(size_t)(k0 + kk) * N + n0 + (lane & 31)]; }
    asm volatile("s_waitcnt lgkmcnt(0)" ::: "memory");
    const int c = lane & 7;
#pragma unroll
    for (int j = 0; j < 4; ++j) { const int n = (lane >> 3) + 8 * j; const LAS float* s = scr + (8 * c) * 33 + n;
        v4u o; o.x = pkbf(s[0 * 33], s[1 * 33]); o.y = pkbf(s[2 * 33], s[3 * 33]); o.z = pkbf(s[4 * 33], s[5 * 33]); o.w = pkbf(s[6 * 33], s[7 * 33]);
        *(v4u*)(WT + (size_t)(drow0 + n) * K + k0 + 8 * c) = o; }
    asm volatile("s_waitcnt lgkmcnt(0)" ::: "memory");
}
__device__ __forceinline__ void p0_prologue(Frame& F) {
    LAS float* scr = (LAS float*)(F.lds + F.wave * 16384);
    const int gw = F.vcu * NWAVES + F.wave, NGW = F.G * NWAVES;
    unsigned char* ws = F.ws;
    constexpr int I_IN = 16 * 88, I_OUT = 16 * 32, I_GU = 16 * 88, I_DN = 44 * 32, I_PL = 4 * 8;
    constexpr int NITEMS = I_IN + I_OUT + 2 * (2 * I_GU + I_DN) + 4 * I_PL;
    for (int it = gw; it < NITEMS; it += NGW) {
        int r = it;
        if (r < I_IN) { transpose_item(F.in[6], D, INP, (bf16*)(ws + WS_WIN), 0, scr, r, F.lane); continue; } r -= I_IN;
        if (r < I_OUT) { transpose_item(F.in[22], D, D, (bf16*)(ws + WS_WOUT), 0, scr, r, F.lane); continue; } r -= I_OUT;
        constexpr int I_LAYER = 2 * I_GU + I_DN;
        if (r < 2 * I_LAYER) {
            const int l = r / I_LAYER; int q = r % I_LAYER;
            bf16* gu = (bf16*)(ws + (l ? WS_WGU1 : WS_WGU0)); bf16* dn = (bf16*)(ws + (l ? WS_WD1 : WS_WD0));
            if (q < I_GU) { transpose_item(F.in[27] + (size_t)l * D * FF, D, FF, gu, 1, scr, q, F.lane); continue; } q -= I_GU;
            if (q < I_GU) { transpose_item(F.in[28] + (size_t)l * D * FF, D, FF, gu, 2, scr, q, F.lane); continue; } q -= I_GU;
            transpose_item(F.in[29] + (size_t)l * FF * D, FF, D, dn, 0, scr, q, F.lane); continue;
        }
        r -= 2 * I_LAYER;
        { const int g = r / I_PL, ri = r % I_PL; transpose_item(F.in[23] + (size_t)g * 65536, 256, 256, (bf16*)(ws + WS_POOLT) + (size_t)g * 65536, 0, scr, ri, F.lane); }
    }
    const int gt = F.vcu * NTHREADS + F.tid, NGT = F.G * NTHREADS;
    bf16* XB = (bf16*)(ws + WS_XB);
    for (int i = gt; i < T * D / 8; i += NGT) { const int m = i >> 7, c8 = (i & 127) * 8; float f[8]; load_f8(xrow_ptr(F, m) + c8, f); *(v4u*)(XB + (size_t)m * D + c8) = pack_bf8(f); }
    bf16* LT = (bf16*)(ws + WS_LORAT);
    for (int i = gt; i < 1536 * 256 / 2; i += NGT) { const int j = i >> 7, k = (i & 127) * 2; float v[2];
#pragma unroll
        for (int e = 0; e < 2; ++e) { const int kk = k + e; float x = 0.f;
            if (j < 512) { if (kk < 64) x = F.in[13][(size_t)kk * 512 + j]; }
            else if (j < 1024) { if (kk >= 64 && kk < 128) x = F.in[15][(size_t)(kk - 64) * 512 + (j - 512)]; }
            else { if (kk >= 128) x = F.in[16][(size_t)(kk - 128) * 512 + (j - 1024)]; }
            v[e] = x; }
        *(unsigned*)(LT + (size_t)j * 256 + k) = pkbf(v[0], v[1]); }
}

__device__ __forceinline__ void p2_rows(Frame& F) {
    const int gw = F.vcu * NWAVES + F.wave, NGW = F.G * NWAVES, lane = F.lane;
    unsigned char* ws = F.ws;
    const bf16* PB = (const bf16*)(ws + WS_PROJB);
    h16* SCR = (h16*)(ws + WS_SCR); h16* SCK = (h16*)(ws + WS_SCK); h16* SCV = (h16*)(ws + WS_SCV); h16* SCKK = (h16*)(ws + WS_SCKK);
    bf16* LA = (bf16*)(ws + WS_LA);
    const float* mu = F.in[11]; const float* kkw = F.in[17]; const float* sshift = F.in[3];
    for (int m = gw; m < T; m += NGW) {
        const bool sample = m >= TP; const int seq = sample ? (m - TP) >> 3 : m >> 11, t = sample ? (m - TP) & 7 : m & 2047, L = sample ? LS : LP;
        const bf16* pb = PB + (size_t)m * BP;
        float* oshift = F.out + (sample ? O_SHIFT_S : O_SHIFT_P) + (size_t)seq * BP;
        const bool last = (t == L - 1);
#pragma unroll
        for (int sec = 0; sec < 4; ++sec) {
            if (sec == 3 && lane >= 32) break;
            const int col = sec * 512 + lane * 8;
            float p[8], pv[8], mv[8], xm[8];
            unpack_bf8(*(const v4u*)(pb + col), p);
            if (t > 0) unpack_bf8(*(const v4u*)(pb - BP + col), pv);
            else if (sample) load_f8(sshift + (size_t)seq * BP + col, pv);
            else {
#pragma unroll
                for (int i = 0; i < 8; ++i) pv[i] = 0.f; }
            load_f8(mu + col, mv);
#pragma unroll
            for (int i = 0; i < 8; ++i) xm[i] = p[i] + mv[i] * (pv[i] - p[i]);
            if (last) store_f8(oshift + col, p);
            const size_t off = (size_t)m * HW + lane * 8;
            if (sec == 0) *(v4u*)(SCR + off) = pack_h8(xm);
            else if (sec == 1) {
                *(v4u*)(SCK + off) = pack_h8(xm);
                float kw[8], kx[8]; load_f8(kkw + lane * 8, kw); float ss = 0.f;
#pragma unroll
                for (int i = 0; i < 8; ++i) { kx[i] = xm[i] * kw[i]; ss += kx[i] * kx[i]; }
                ss = sum8(ss);
                const float inv = 1.f / fmaxf(sqrtf(ss), 1e-12f);
#pragma unroll
                for (int i = 0; i < 8; ++i) kx[i] *= inv;
                *(v4u*)(SCKK + off) = pack_h8(kx);
            } else if (sec == 2) *(v4u*)(SCV + off) = pack_h8(xm);
            else {
                float o[8];
#pragma unroll
                for (int i = 0; i < 8; ++i) {
                    if (lane < 8) { const float e = __expf(2.f * xm[i]); o[i] = 1.f - 2.f * __builtin_amdgcn_rcpf(e + 1.f); }
                    else if (lane < 16) o[i] = xm[i];
                    else o[i] = sigmoid_(xm[i]);
                }
                *(v4u*)(LA + (size_t)m * 256 + lane * 8) = pack_bf8(o);
            }
        }
    }
}

template <int TT> __device__ __forceinline__ void conv_tile(Frame& F, int m0, int t0, int seq, bool sample) {
    const int c = F.tid;
    unsigned char* ws = F.ws;
    const bf16* PA = (const bf16*)(ws + WS_PROJA); bf16* CAT = (bf16*)(ws + WS_CAT);
    const float* cw = F.in[7]; const float* sconv = F.in[2];
    LAS float* ylds = (LAS float*)F.lds;
    float w[31];
#pragma unroll
    for (int j = 0; j < 31; ++j) w[j] = cw[j * 512 + c];
    float y[TT]; const float bias = F.in[8][c];
#pragma unroll
    for (int t = 0; t < TT; ++t) y[t] = bias;
    const bool lastp = (!sample) && (t0 + TT == LP);
    float* oconv = F.out + (sample ? O_CONV_S : O_CONV_P) + (size_t)seq * 30 * 512 + c;
    const bf16* pp = PA + ((size_t)m0 - 30) * 1024 + c; const float* scp = sconv + ((size_t)seq * 30 + t0) * 512 + c;
#pragma unroll
    for (int s = -30; s < TT; ++s) {
        float u;
        asm volatile("" : "+v"(pp), "+v"(scp));
        if (t0 + s >= 0) { const float val = bf2f(pp[0]), gate = bf2f(pp[512]); u = val * sigmoid_(gate); }
        else u = sample ? *scp : 0.f;
        pp += 1024; scp += 512;
#pragma unroll
        for (int t = 0; t < TT; ++t) { const int j = s - t + 30; if (j >= 0 && j <= 30) y[t] += u * w[j]; }
        if (sample) { if (s + 22 >= 0) oconv[(size_t)(s + 22) * 512] = u; }
        else if (lastp && s >= TT - 30) oconv[(size_t)(s - (TT - 30)) * 512] = u;
    }
#pragma unroll
    for (int t = 0; t < TT; ++t) ylds[t * 512 + c] = y[t];
    __syncthreads();
    const float* lg = F.in[9]; const float* lb = F.in[10];
    for (int t = F.wave; t < TT; t += NWAVES) {
        const LAS float* yr = ylds + t * 512 + F.lane * 8;
        float v[8];
        { const f32x4 a = *(const LAS f32x4*)yr, b = *(const LAS f32x4*)(yr + 4); v[0] = a.x; v[1] = a.y; v[2] = a.z; v[3] = a.w; v[4] = b.x; v[5] = b.y; v[6] = b.z; v[7] = b.w; }
        float s = 0.f;
#pragma unroll
        for (int i = 0; i < 8; ++i) s += v[i];
        const float mean = wave_sum(s) * (1.f / 512.f); float q = 0.f;
#pragma unroll
        for (int i = 0; i < 8; ++i) { v[i] -= mean; q += v[i] * v[i]; }
        const float rstd = rsqrtf(wave_sum(q) * (1.f / 512.f) + LN_EPS);
        float g8[8], b8[8], o[8]; load_f8(lg + F.lane * 8, g8); load_f8(lb + F.lane * 8, b8);
#pragma unroll
        for (int i = 0; i < 8; ++i) o[i] = silu_(v[i] * rstd * g8[i] + b8[i]);
        *(v4u*)(CAT + (size_t)(m0 + t) * 1024 + F.lane * 8) = pack_bf8(o);
    }
    __syncthreads();
}
__device__ __forceinline__ void conv_phase(Frame& F) {
    for (int it = F.vcu; it < 512 + 128; it += F.G) {
        if (it < 512) { const int m0 = it * 32; conv_tile<32>(F, m0, m0 & 2047, m0 >> 11, false); }
        else { const int seq = it - 512; conv_tile<8>(F, TP + seq * 8, 0, seq, true); }
    }
}

constexpr int SU = 8;
struct ScanPtrs { const h16* R; const h16* K; const h16* V; const h16* KK; const h16* B; const h16* W; h16* O; };
struct ScanBuf { v2u r[SU], k[SU], kk[SU], b[SU], w[SU]; unsigned short v[SU]; };
__device__ __forceinline__ void scan_load(ScanBuf& Bf, const ScanPtrs& P, size_t off, int ks, int row) {
#pragma unroll
    for (int i = 0; i < SU; ++i) { const size_t o = off + (size_t)i * HW;
        Bf.r[i] = *(const v2u*)(P.R + o + ks); Bf.k[i] = *(const v2u*)(P.K + o + ks); Bf.kk[i] = *(const v2u*)(P.KK + o + ks);
        Bf.b[i] = *(const v2u*)(P.B + o + ks); Bf.w[i] = *(const v2u*)(P.W + o + ks); Bf.v[i] = *(const unsigned short*)(P.V + o + row); }
}
__device__ __forceinline__ void scan_compute(const ScanBuf& Bf, float (&S)[4], const ScanPtrs& P, size_t off, int row, bool writer) {
#pragma unroll
    for (int i = 0; i < SU; ++i) {
        float r[4], k[4], kk[4], b[4], w[4]; h4(Bf.r[i], r); h4(Bf.k[i], k); h4(Bf.kk[i], kk); h4(Bf.b[i], b); h4(Bf.w[i], w);
        const float v = (float)__builtin_bit_cast(h16, Bf.v[i]);
        float d = (S[0] * kk[0] + S[1] * kk[1]) + (S[2] * kk[2] + S[3] * kk[3]);
        float pj[4];
#pragma unroll
        for (int j = 0; j < 4; ++j) pj[j] = fmaf(v, k[j], fmaf(-S[j], w[j], S[j]));
        d = dpp_sum16(d);
#pragma unroll
        for (int j = 0; j < 4; ++j) S[j] = fmaf(-d, b[j], pj[j]);
        float o = (S[0] * r[0] + S[1] * r[1]) + (S[2] * r[2] + S[3] * r[3]);
        o = dpp_sum16(o);
        if (writer) P.O[off + (size_t)i * HW + row] = (h16)o;
    }
}
template <int L> __device__ __forceinline__ void scan_task(const ScanPtrs& P, int mbase, int h, int v0, const float* s_in, float* s_out, int lane) {
    const int rl = lane >> 4, ks = (lane & 15) * 4, row = v0 + rl; const bool writer = (lane & 15) == 0;
    float S[4] = {0.f, 0.f, 0.f, 0.f};
    if (s_in) { const f32x4 s = *(const f32x4*)(s_in + (size_t)row * 64 + ks); S[0] = s.x; S[1] = s.y; S[2] = s.z; S[3] = s.w; }
    size_t off = (size_t)mbase * HW + h * 64;
    ScanBuf A;
    scan_load(A, P, off, ks, row);
    if constexpr (L == SU) { scan_compute(A, S, P, off, row, writer); }
    else {
        ScanBuf Bf;
        for (int t = 0; t < L; t += 2 * SU) {
            scan_load(Bf, P, off + (size_t)SU * HW, ks, row);
            scan_compute(A, S, P, off, row, writer);
            if (t + 2 * SU < L) scan_load(A, P, off + (size_t)2 * SU * HW, ks, row);
            scan_compute(Bf, S, P, off + (size_t)SU * HW, row, writer);
            off += (size_t)2 * SU * HW;
        }
    }
    *(f32x4*)(s_out + (size_t)row * 64 + ks) = (f32x4){S[0], S[1], S[2], S[3]};
}
__device__ __forceinline__ void scan_phase(Frame& F) {
    unsigned char* ws = F.ws;
    ScanPtrs P{(const h16*)(ws + WS_SCR), (const h16*)(ws + WS_SCK), (const h16*)(ws + WS_SCV), (const h16*)(ws + WS_SCKK), (const h16*)(ws + WS_SCB), (const h16*)(ws + WS_SCW), (h16*)(ws + WS_O)};
    if (F.wave < 4) {
        for (int task = F.vcu; task < 256; task += F.G) {
            const int pair = task >> 2, q = task & 3, n = pair >> 3, h = pair & 7, v0 = q * 16 + F.wave * 4;
            scan_task<LP>(P, n * LP, h, v0, nullptr, F.out + O_WKV_P + (size_t)pair * 4096, F.lane);
        }
    } else {
        for (int pair = F.vcu * 4 + (F.wave - 4); pair < NSB * 8; pair += F.G * 4) {
            const int n = pair >> 3, h = pair & 7;
            for (int rg = 0; rg < 16; ++rg)
                scan_task<LS>(P, TP + n * LS, h, rg * 4, F.in[4] + (size_t)pair * 4096, F.out + O_WKV_S + (size_t)pair * 4096, F.lane);
        }
    }
}

__device__ __forceinline__ void p6_rows(Frame& F) {
    const int gw = F.vcu * NWAVES + F.wave, NGW = F.G * NWAVES, lane = F.lane;
    unsigned char* ws = F.ws;
    const h16* O = (const h16*)(ws + WS_O); const h16* SCR = (const h16*)(ws + WS_SCR); const h16* SCK = (const h16*)(ws + WS_SCK); const h16* SCV = (const h16*)(ws + WS_SCV); const h16* G = (const h16*)(ws + WS_G);
    bf16* CAT = (bf16*)(ws + WS_CAT);
    float rk[8], lg[8], lb[8]; load_f8(F.in[19] + lane * 8, rk); load_f8(F.in[20] + lane * 8, lg); load_f8(F.in[21] + lane * 8, lb);
    for (int m = gw; m < T; m += NGW) {
        const size_t off = (size_t)m * HW + lane * 8;
        float o[8], r[8], k[8], v[8], g[8];
        unpack_h8(*(const v4u*)(O + off), o); unpack_h8(*(const v4u*)(SCR + off), r); unpack_h8(*(const v4u*)(SCK + off), k); unpack_h8(*(const v4u*)(SCV + off), v); unpack_h8(*(const v4u*)(G + off), g);
        float s = 0.f, bs = 0.f;
#pragma unroll
        for (int i = 0; i < 8; ++i) { s += o[i]; bs += r[i] * k[i] * rk[i]; }
        const float mean = sum8(s) * (1.f / 64.f); bs = sum8(bs); float q = 0.f;
#pragma unroll
        for (int i = 0; i < 8; ++i) { o[i] -= mean; q += o[i] * o[i]; }
        const float rstd = rsqrtf(sum8(q) * (1.f / 64.f) + GN_EPS);
        float res[8];
#pragma unroll
        for (int i = 0; i < 8; ++i) res[i] = (o[i] * rstd * lg[i] + lb[i] + bs * v[i]) * g[i];
        *(v4u*)(CAT + (size_t)m * 1024 + 512 + lane * 8) = pack_bf8(res);
    }
}

template <int MODE> __device__ __forceinline__ void ln_rows(Frame& F, const float* g, const float* b) {
    const int gw = F.vcu * NWAVES + F.wave, NGW = F.G * NWAVES, lane = F.lane;
    float* Z = (float*)(F.ws + WS_Z); bf16* XB = (bf16*)(F.ws + WS_XB);
    f32x4 gv[4], bv[4];
#pragma unroll
    for (int j = 0; j < 4; ++j) { gv[j] = *(const f32x4*)(g + 4 * (lane + 64 * j)); bv[j] = *(const f32x4*)(b + 4 * (lane + 64 * j)); }
    for (int m = gw; m < T; m += NGW) {
        float* zr = Z + (size_t)m * D;
        f32x4 v[4]; float s = 0.f;
#pragma unroll
        for (int j = 0; j < 4; ++j) { v[j] = *(const f32x4*)(zr + 4 * (lane + 64 * j)); s += (v[j].x + v[j].y) + (v[j].z + v[j].w); }
        const float mean = wave_sum(s) * (1.f / D); float s2 = 0.f;
#pragma unroll
        for (int j = 0; j < 4; ++j) { v[j] = v[j] - mean; s2 += (v[j].x * v[j].x + v[j].y * v[j].y) + (v[j].z * v[j].z + v[j].w * v[j].w); }
        const float rstd = rsqrtf(wave_sum(s2) * (1.f / D) + LN_EPS);
#pragma unroll
        for (int j = 0; j < 4; ++j) v[j] = v[j] * rstd * gv[j] + bv[j];
        if (MODE == 2) {
#pragma unroll
            for (int j = 0; j < 4; ++j) *(f32x4*)(F.out + O_Y + (size_t)m * D + 4 * (lane + 64 * j)) = v[j];
        } else {
#pragma unroll
            for (int j = 0; j < 4; ++j) *(f32x4*)(zr + 4 * (lane + 64 * j)) = v[j];
        }
        if (MODE == 0) {
#pragma unroll
            for (int j = 0; j < 4; ++j) { v2u w; w.x = pkbf(v[j].x, v[j].y); w.y = pkbf(v[j].z, v[j].w); *(v2u*)(XB + (size_t)m * D + 4 * (lane + 64 * j)) = w; }
        }
        if (MODE == 1) {
            const bool sample = m >= TP; const int seq = sample ? (m - TP) >> 3 : m >> 11, t = sample ? (m - TP) & 7 : m & 2047;
            if (sample) {
                float* op = F.out + O_POOL_S + ((size_t)seq * 15 + 7 + t) * D;
#pragma unroll
                for (int j = 0; j < 4; ++j) *(f32x4*)(op + 4 * (lane + 64 * j)) = v[j];
                if (t == 0) { const float* sp = F.in[5] + ((size_t)seq * 15 + 8) * D; float* o0 = F.out + O_POOL_S + (size_t)seq * 15 * D;
                    for (int i = lane; i < 7 * D / 4; i += 64) *(f32x4*)(o0 + 4 * i) = *(const f32x4*)(sp + 4 * i); }
            } else if (t >= LP - 15) {
                float* op = F.out + O_POOL_P + ((size_t)seq * 15 + (t - (LP - 15))) * D;
#pragma unroll
                for (int j = 0; j < 4; ++j) *(f32x4*)(op + 4 * (lane + 64 * j)) = v[j];
            }
        }
    }
}

template <int TT> __device__ __forceinline__ void pool_tile(Frame& F, int m0, int t0, int seq, bool sample) {
    const float* Z = (const float*)(F.ws + WS_Z); bf16* PL = (bf16*)(F.ws + WS_PL); const float* spool = F.in[5];
#pragma unroll 1
    for (int half = 0; half < 2; ++half) {
        const int c = F.tid + 512 * half, g = c >> 8;
        float xs[TT + 15];
        const float* zp = Z + ((size_t)m0 - 15) * D + c; const float* sp = spool + ((size_t)seq * 15 + t0) * D + c;
#pragma unroll
        for (int s = -15; s < TT; ++s) {
            asm volatile("" : "+v"(zp), "+v"(sp));
            if (t0 + s >= 0) xs[s + 15] = *zp;
            else xs[s + 15] = sample ? *sp : 0.f;
            zp += D; sp += D;
        }
        const int wdw = 2 << g;
#pragma unroll
        for (int t = 0; t < TT; ++t) {
            const float x0 = xs[t + 15];
            const float s2 = x0 + xs[t + 14];
            const float s4 = s2 + (xs[t + 13] + xs[t + 12]);
            const float s8 = s4 + ((xs[t + 11] + xs[t + 10]) + (xs[t + 9] + xs[t + 8]));
            const float s16 = s8 + (((xs[t + 7] + xs[t + 6]) + (xs[t + 5] + xs[t + 4])) + ((xs[t + 3] + xs[t + 2]) + (xs[t + 1] + xs[t + 0])));
            const float sum = g == 0 ? s2 : (g == 1 ? s4 : (g == 2 ? s8 : s16));
            const int cnt = sample ? wdw : min(wdw, t0 + t + 1);
            const float pooled = sum / (float)cnt - x0;
            PL[(size_t)(m0 + t) * D + c] = (bf16)(pkbf(pooled, 0.f) & 0xffffu);
        }
    }
}
__device__ __forceinline__ void pool_phase(Frame& F) {
    for (int it = F.vcu; it < 512 + 128; it += F.G) {
        if (it < 512) { const int m0 = it * 32; pool_tile<32>(F, m0, m0 & 2047, m0 >> 11, false); }
        else { const int seq = it - 512; pool_tile<8>(F, TP + seq * 8, 0, seq, true); }
    }
}


#ifndef DIAG_AT
#define DIAG_AT -1
#endif
__device__ __forceinline__ bool dbad(float got, float want) { return !(fabsf(got - want) <= 0.03f * fabsf(want) + 0.02f); }
__device__ __forceinline__ float h2f(h16 x) { return (float)x; }
__device__ __forceinline__ void diag_checks(Frame& F, int at) {
    if (blockIdx.x != 0 || F.wave != 0) return;
    const int lane = F.lane; unsigned char* ws = F.ws;
    unsigned mask = 0;
    const bf16* PA = (const bf16*)(ws + WS_PROJA); const bf16* PB = (const bf16*)(ws + WS_PROJB);
    const h16* SCR = (const h16*)(ws + WS_SCR); const h16* SCK = (const h16*)(ws + WS_SCK); const h16* SCV = (const h16*)(ws + WS_SCV); const h16* SCKK = (const h16*)(ws + WS_SCKK);
    const h16* SCB = (const h16*)(ws + WS_SCB); const h16* SCW = (const h16*)(ws + WS_SCW);
    const int m = 1 + (lane * 131 + 7) % 9000;
    const int t = m & 2047;
    if (at == 3) {
        const int c = (lane * 29 + 5) % 512, h0 = c & ~63;
        auto xm = [&](int col) { const float p = bf2f(PB[(size_t)m * BP + col]); const float pv = t > 0 ? bf2f(PB[(size_t)(m - 1) * BP + col]) : 0.f; return p + F.in[11][col] * (pv - p); };
        float ss = 0.f; for (int j = 0; j < 64; ++j) { const float kx = xm(512 + h0 + j) * F.in[17][h0 + j]; ss += kx * kx; }
        const float kkn = xm(512 + c) * F.in[17][c] / fmaxf(sqrtf(ss), 1e-12f);
        float al = F.in[14][c]; for (int j = 0; j < 64; ++j) al += xm(1600 + j) * F.in[15][(size_t)j * 512 + c];
        const float a = 1.f / (1.f + expf(-al)); const float f = (1.f + (a - 1.f) * F.in[18][c]); const float k0 = xm(512 + c); const float b = kkn * a;
        const float gotk = h2f(SCK[(size_t)m * HW + c]);
        if (__ballot(dbad(gotk, k0 * f))) mask |= 1;
        if (__ballot(dbad(h2f(SCB[(size_t)m * HW + c]) * 10.f, b * 10.f))) mask |= 2;
        { const bf16* LA = (const bf16*)(ws + WS_LA); bool bad = false; for (int j = 0; j < 64; ++j) bad = bad || dbad(bf2f(LA[(size_t)m * 256 + 64 + j]), xm(1600 + j)); if (__ballot(bad)) mask |= 4; }
        { float g = 0.f; for (int j = 0; j < 128; ++j) g += (1.f / (1.f + expf(-xm(1664 + j)))) * F.in[16][(size_t)j * 512 + c];
          const h16* G = (const h16*)(ws + WS_G); if (__ballot(dbad(h2f(G[(size_t)m * HW + c]), g))) mask |= 8; }
        if (__ballot(dbad(gotk, k0 * f * f))) mask |= 16;
        if (__ballot(dbad(gotk, k0))) mask |= 32;
    }
    if (lane == 0) *(unsigned*)(ws + 0) = mask;
}
__device__ __forceinline__ void diag_fill(Frame& F) {
    const unsigned mask = *(const unsigned*)(F.ws + 0);
    const float C = sqrtf(exp2f(1.f + (float)mask));
    const int gt = blockIdx.x * NTHREADS + F.tid, NGT = F.G * NTHREADS;
    for (int i = gt; i < TS * D; i += NGT) F.out[O_Y + (size_t)TP * D + i] = C;
}

struct Args { const float* in[32]; float* out; unsigned char* ws; int ph_lo, ph_hi, coop, pad; };

__global__ void __launch_bounds__(NTHREADS, 2) mk_fwd(Args args) {
    extern __shared__ __attribute__((aligned(16))) unsigned char lds_raw[];
    Frame F;
    F.lds = (LAS unsigned char*)lds_raw;
    F.tid = threadIdx.x; F.lane = F.tid & 63; F.wave = __builtin_amdgcn_readfirstlane(F.tid >> 6);
    F.G = gridDim.x; { const int bx = blockIdx.x; F.vcu = (F.G % 8 == 0) ? (bx % 8) * (F.G / 8) + bx / 8 : bx; }
    F.in = args.in;
    F.out = args.out; F.ws = args.ws;
    unsigned char* ws = args.ws;
    const int lo = args.ph_lo, hi = args.ph_hi;
    cg::grid_group grid = cg::this_grid();
#ifndef PHMASK
#define PHMASK 0x3ffff
#endif
#define IN(k) ((((PHMASK) >> (k)) & 1) && lo <= (k) && (k) < hi)
#define SEAM(k) do { if (IN(k) && IN((k) + 1)) { __threadfence(); grid.sync(); } } while (0)
    typedef pg8::bf16_t gb;

    if (IN(0)) { p0_prologue(F); } SEAM(0);
    if (IN(1)) {
        pg8::Gemm g{(const gb*)(ws + WS_XB), (const gb*)(ws + WS_WIN), T, INP, D, D, D, 0}; pg8::StaticOrder S; S.init(T, INP, F.G, (int)blockIdx.x);
        EpiProj E{(bf16*)(ws + WS_PROJA), (bf16*)(ws + WS_PROJB)};
        pg8::gemm_phase<EpiProj, pg8::StaticOrder, true, true>(F.lds, g, S, E);
    } SEAM(1);
    if (IN(2)) { p2_rows(F); } SEAM(2);
    if (IN(3)) {
        pg8::Gemm g{(const gb*)(ws + WS_LA), (const gb*)(ws + WS_LORAT), T, 1536, 256, 256, 256, 0}; pg8::StaticOrder S; S.init(T, 1536, F.G, (int)blockIdx.x);
        EpiLora E{F.in[12], F.in[14], F.in[18], (h16*)(ws + WS_SCW), (h16*)(ws + WS_SCK), (h16*)(ws + WS_SCKK), (h16*)(ws + WS_SCB), (h16*)(ws + WS_G)};
        pg8::gemm_phase<EpiLora, pg8::StaticOrder, true, true>(F.lds, g, S, E);
    } SEAM(3);
    if (IN(4)) { conv_phase(F); }
    if (IN(5)) { scan_phase(F); } SEAM(5);
    if (IN(6)) { p6_rows(F); } SEAM(6);
    if (IN(7)) {
        pg8::Gemm g{(const gb*)(ws + WS_CAT), (const gb*)(ws + WS_WOUT), T, D, D, D, D, 0}; pg8::StaticOrder S; S.init(T, D, F.G, (int)blockIdx.x);
        EpiResid E{F.in[0], F.in[1], (float*)(ws + WS_Z), nullptr};
        pg8::gemm_phase<EpiResid, pg8::StaticOrder, true, true>(F.lds, g, S, E);
    } SEAM(7);
    if (IN(8)) { ln_rows<0>(F, F.in[25], F.in[26]); } SEAM(8);
#define FFN_PHASES(layer, pgu, pdn) \
    if (IN(pgu)) { \
        pg8::Gemm g{(const gb*)(ws + WS_XB), (const gb*)(ws + ((layer) ? WS_WGU1 : WS_WGU0)), T, 2 * FF, D, D, D, 0}; pg8::StaticOrder S; S.init(T, 2 * FF, F.G, (int)blockIdx.x); \
        EpiGateUp E{(bf16*)(ws + WS_H)}; \
        pg8::gemm_phase<EpiGateUp, pg8::StaticOrder, true, true>(F.lds, g, S, E); \
    } SEAM(pgu); \
    if (IN(pdn)) { \
        pg8::Gemm g{(const gb*)(ws + WS_H), (const gb*)(ws + ((layer) ? WS_WD1 : WS_WD0)), T, D, FF, FF, FF, 0}; pg8::StaticOrder S; S.init(T, D, F.G, (int)blockIdx.x); \
        EpiResid E{nullptr, nullptr, (float*)(ws + WS_Z), nullptr}; \
        pg8::gemm_phase<EpiResid, pg8::StaticOrder, true, true>(F.lds, g, S, E); \
    } SEAM(pdn);
    FFN_PHASES(0, 9, 10)
    if (IN(11)) { ln_rows<1>(F, F.in[30], F.in[31]); } SEAM(11);
    if (IN(12)) { pool_phase(F); } SEAM(12);
    if (IN(13)) {
        pg8::Gemm g{(const gb*)(ws + WS_PL), (const gb*)(ws + WS_POOLT), T, D, 256, D, 256, 256}; pg8::StaticOrder S; S.init(T, D, F.G, (int)blockIdx.x);
        EpiResid E{nullptr, nullptr, (float*)(ws + WS_Z), F.in[24]};
        pg8::gemm_phase<EpiResid, pg8::StaticOrder, true, true>(F.lds, g, S, E);
    } SEAM(13);
    if (IN(14)) { ln_rows<0>(F, F.in[25] + D, F.in[26] + D); } SEAM(14);
    FFN_PHASES(1, 15, 16)
    if (IN(17)) { ln_rows<2>(F, F.in[30] + D, F.in[31] + D); }
    if (lo == 100) diag_checks(F, args.pad);
    if (lo == 101) diag_fill(F);
#undef IN
#undef SEAM
}

extern "C" void kernel_launch(void* const* d_in, const int* in_sizes, int n_in, void* d_out, int out_size, void* d_ws, size_t ws_size, hipStream_t stream) {
    static int grid = 0;
    if (grid == 0) {
        if (n_in != 32 || out_size != (int)O_TOTAL || ws_size < WS_END) { fprintf(stderr, "kernel_launch: unexpected shapes: n_in %d out %d ws %zu\n", n_in, out_size, ws_size); grid = -1; return; }
        int dev = 0, cus = 0, per_cu = 0;
        if (hipGetDevice(&dev) != hipSuccess || hipDeviceGetAttribute(&cus, hipDeviceAttributeMultiprocessorCount, dev) != hipSuccess) { grid = -1; return; }
        if (hipFuncSetAttribute((const void*)mk_fwd, hipFuncAttributeMaxDynamicSharedMemorySize, LDS_BYTES) != hipSuccess) { fprintf(stderr, "kernel_launch: hipFuncSetAttribute failed\n"); grid = -1; return; }
        if (hipOccupancyMaxActiveBlocksPerMultiprocessor(&per_cu, (const void*)mk_fwd, NTHREADS, LDS_BYTES) != hipSuccess || per_cu < 1) { fprintf(stderr, "kernel_launch: occupancy query says %d\n", per_cu); (void)hipGetLastError(); per_cu = 1; }
        grid = cus * 1;
        if (per_cu < 1) grid = -1;
    }
    if (grid < 0) return;
    Args a{};
    for (int i = 0; i < 32; ++i) a.in[i] = (const float*)d_in[i];
    a.out = (float*)d_out; a.ws = (unsigned char*)d_ws;
#if MK_SINGLE
    a.ph_lo = 0; a.ph_hi = NPHASE; a.coop = 1;
    void* params[] = {&a};
    hipError_t e = hipLaunchCooperativeKernel((const void*)mk_fwd, dim3(grid), dim3(NTHREADS), params, LDS_BYTES, stream);
    if (e != hipSuccess) fprintf(stderr, "kernel_launch: cooperative launch failed: %s (grid %d)\n", hipGetErrorString(e), grid);
#else
    for (int p = 0; p < NPHASE; ++p) {
        if (DIAG_AT >= 0 && p > DIAG_AT) break;
        a.ph_lo = p; a.ph_hi = p + 1; a.coop = 0;
        hipLaunchKernelGGL(mk_fwd, dim3(grid), dim3(NTHREADS), LDS_BYTES, stream, a);
    }
    if (DIAG_AT >= 0) { a.pad = DIAG_AT; a.ph_lo = 100; a.ph_hi = 101; hipLaunchKernelGGL(mk_fwd, dim3(grid), dim3(NTHREADS), LDS_BYTES, stream, a);
                        a.ph_lo = 101; a.ph_hi = 102; hipLaunchKernelGGL(mk_fwd, dim3(grid), dim3(NTHREADS), LDS_BYTES, stream, a); }
#endif
}
```

```cpp
#include <hip/hip_runtime.h>
#include <hip/hip_cooperative_groups.h>
#include <cstdio>
#include <cstdint>
namespace cg = cooperative_groups;
namespace pg8 {
#define PG8_LAS __attribute__((address_space(3)))
typedef unsigned short bf16_t;
typedef short bf16x8 __attribute__((ext_vector_type(8)));
typedef float f32x4 __attribute__((ext_vector_type(4)));
typedef unsigned u32x4 __attribute__((ext_vector_type(4)));
constexpr int BM = 256, BK = 64, HALF = 128, HTB = HALF * BK * 2  , STAGE_BYTES = 8 * HTB, NXCD = 8, WGM = 8;

__host__ __device__ __forceinline__ int lds_byte(int r, int c) { const int st = (r >> 4) * 2 + (c >> 5), rr = r & 15, cc = c & 31, ob = rr * 64 + cc * 2; return st * 1024 + (ob ^ (((ob >> 9) & 1) << 5)); }
__host__ __device__ __forceinline__ void stage_rc(int b, int& R, int& C) { const int st = b / 1024, sb = b % 1024, swz = sb ^ (((sb >> 9) & 1) << 5); R = (st >> 1) * 16 + swz / 64; C = (st & 1) * 32 + (swz % 64) / 2; }
__host__ __device__ __forceinline__ int perm32(int rho) { const int n = rho >> 4, i = rho & 15; return 8 * (i >> 2) + 4 * n + (i & 3); }

struct Unit { int pm, pn; };
struct Gemm { const bf16_t* A; const bf16_t* Bt; int M, N, K, lda, ldb, acol; };

struct StaticOrder {
    int nM, nN, nwg, G, c;
    __host__ __device__ void init(int M, int N, int G_, int c_) { nM = M / BM; nN = N / BM; nwg = nM * nN; G = G_; c = c_; }
    __host__ __device__ bool next(int i, Unit& u) const {
        const long L = (long)i * G + c; if (L >= nwg) return false;
        int wgid = (int)L; { const int q = nwg / NXCD, r = nwg % NXCD, xcd = wgid % NXCD, off = wgid / NXCD; wgid = (xcd < r ? xcd * (q + 1) : r * (q + 1) + (xcd - r) * q) + off; }
        const int nig = WGM * nN, gid = wgid / nig, fm = gid * WGM, gsz = (nM - fm) < WGM ? (nM - fm) : WGM;
        u.pm = fm + ((wgid % nig) % gsz); u.pn = (wgid % nig) / gsz; return true;
    }
    __device__ __forceinline__ void a_ready(const Unit&) const {}
    __device__ __forceinline__ void done(const Unit&) const {}
};

__device__ __forceinline__ unsigned cvt_pk_bf16(float lo, float hi) { unsigned r; asm volatile("v_cvt_pk_bf16_f32 %0, %1, %2" : "=v"(r) : "v"(lo), "v"(hi)); return r; }
template <class Epi, class Sched, bool ALIGN_EPI = false, bool SP2 = false>
__device__ __forceinline__ void gemm_phase(PG8_LAS unsigned char* lds, const Gemm g, const Sched& S, const Epi& E) {
    const int tid = threadIdx.x, wid = __builtin_amdgcn_readfirstlane(tid >> 6), lane = tid & 63, wr = wid >> 2, wc = wid & 3, fr = lane & 15, fq = lane >> 4;
    const int K = g.K, nt = K / BK;
    unsigned voffA[2], voffB[2];
#pragma unroll
    for (int i = 0; i < 2; ++i) { int R, C; stage_rc(tid * 16 + i * 8192, R, C); const int Rb = Epi::PERM ? ((R & ~31) + perm32(R & 31)) : R;
        voffA[i] = (unsigned)(R * g.lda + C) * 2u; voffB[i] = (unsigned)(Rb * g.ldb + C) * 2u; }
    const size_t kstep = (size_t)(BK * 2);
    const size_t hstepA = (size_t)HALF * g.lda * 2, hstepB = (size_t)HALF * g.ldb * 2;
    const size_t tstepA = 2 * hstepA, tstepB = 2 * hstepB; const size_t acolB = (size_t)g.acol * 2;
    const unsigned ldsw = (unsigned)wid * 1024u;
    const int aoff = lds_byte(wr * 64 + fr, fq * 8), boff = lds_byte(wc * 32 + fr, fq * 8);
#define PG8_SA(b, h) (((b) * 2 + (h)) * HTB)
#define PG8_SB(b, h) ((4 + (b) * 2 + (h)) * HTB)
#define PG8_STAGE(bufoff, gbase, voff) do { _Pragma("unroll") for (int _i = 0; _i < 2; ++_i) \
        __builtin_amdgcn_global_load_lds((const unsigned*)((const char*)(gbase) + (voff)[_i]), (PG8_LAS unsigned*)(lds + (bufoff) + ldsw + _i * 8192), 16, 0, 0); } while (0)
#define PG8_LDA(dst, b, h) do { _Pragma("unroll") for (int m = 0; m < 4; ++m) _Pragma("unroll") for (int k = 0; k < 2; ++k) dst[m][k] = *(const PG8_LAS bf16x8*)(lds + PG8_SA(b, h) + aoff + m * 2048 + k * 1024); } while (0)
#define PG8_LDB(dst, b, h) do { _Pragma("unroll") for (int n = 0; n < 2; ++n) _Pragma("unroll") for (int k = 0; k < 2; ++k) dst[n][k] = *(const PG8_LAS bf16x8*)(lds + PG8_SB(b, h) + boff + n * 2048 + k * 1024); } while (0)
#define PG8_MMA(ai, bj, At, Bt) do { __builtin_amdgcn_s_setprio(1); _Pragma("unroll") for (int m = 0; m < 4; ++m) _Pragma("unroll") for (int n = 0; n < 2; ++n) _Pragma("unroll") for (int k = 0; k < 2; ++k) \
        acc[ai][bj][m][n] = __builtin_amdgcn_mfma_f32_16x16x32_bf16(Bt[n][k], At[m][k], acc[ai][bj][m][n], 0, 0, 0); __builtin_amdgcn_s_setprio(0); } while (0)
#define PG8_WAIT_V(n) asm volatile("s_waitcnt vmcnt(" #n ")" ::: "memory")
#define PG8_WAIT_L(n) asm volatile("s_waitcnt lgkmcnt(" #n ")" ::: "memory")
#define PG8_BAR __builtin_amdgcn_s_barrier()
#define PG8_SCHED __builtin_amdgcn_sched_barrier(0)
    Unit cur, nxt; int ui = 0;
    if (!S.next(0, cur)) return;
    f32x4 acc[2][2][4][2];
#pragma unroll
    for (int a = 0; a < 2; ++a)
#pragma unroll
        for (int b = 0; b < 2; ++b)
#pragma unroll
            for (int m = 0; m < 4; ++m)
#pragma unroll
                for (int n = 0; n < 2; ++n) acc[a][b][m][n] = (f32x4){0.f, 0.f, 0.f, 0.f};
    bf16x8 At[4][2], B0[2][2], B1[2][2];
    const char* cA = (const char*)g.A + (size_t)cur.pm * tstepA + (size_t)cur.pn * acolB; const char* cB = (const char*)g.Bt + (size_t)cur.pn * tstepB;
    S.a_ready(cur);
    if constexpr (SP2) {
        PG8_STAGE(PG8_SB(0, 0), cB, voffB); PG8_STAGE(PG8_SB(0, 1), cB + hstepB, voffB); PG8_STAGE(PG8_SA(0, 0), cA, voffA); PG8_STAGE(PG8_SA(0, 1), cA + hstepA, voffA);
        if (wr == 1) PG8_BAR;
        PG8_WAIT_V(2); PG8_BAR;
        PG8_STAGE(PG8_SB(1, 0), cB + kstep, voffB); PG8_STAGE(PG8_SA(1, 0), cA + kstep, voffA); PG8_STAGE(PG8_SB(1, 1), cB + hstepB + kstep, voffB);
        PG8_WAIT_V(6); PG8_BAR;
    } else {
        PG8_STAGE(PG8_SB(0, 0), cB, voffB); PG8_STAGE(PG8_SA(0, 0), cA, voffA); PG8_STAGE(PG8_SB(0, 1), cB + hstepB, voffB); PG8_STAGE(PG8_SA(0, 1), cA + hstepA, voffA);
        if (wr == 1) PG8_BAR;
        PG8_WAIT_V(4); PG8_BAR;
        PG8_STAGE(PG8_SB(1, 0), cB + kstep, voffB); PG8_STAGE(PG8_SA(1, 0), cA + kstep, voffA); PG8_STAGE(PG8_SB(1, 1), cB + hstepB + kstep, voffB);
        PG8_WAIT_V(6); PG8_BAR;
    }
    for (;;) {
        const bool has_next = S.next(ui + 1, nxt);
        const char* nA = has_next ? (const char*)g.A + (size_t)nxt.pm * tstepA + (size_t)nxt.pn * acolB : cA; const char* nB = has_next ? (const char*)g.Bt + (size_t)nxt.pn * tstepB : cB;
        _Pragma("unroll 1") for (int t = 0; t < nt; t += 2) {
            const bool last = (t == nt - 2);
            const char* a1 = cA + (size_t)(t + 1) * kstep;
            const char* a2 = last ? nA : cA + (size_t)(t + 2) * kstep; const char* b2 = last ? nB : cB + (size_t)(t + 2) * kstep;
            const char* a3 = a2 + kstep; const char* b3 = b2 + kstep;
            if (last && has_next) S.a_ready(nxt);
            if constexpr (SP2) {
            PG8_LDB(B0, 0, 0); PG8_LDB(B1, 0, 1); PG8_SCHED; PG8_LDA(At, 0, 0); PG8_STAGE(PG8_SA(1, 1), a1 + hstepA, voffA);
            PG8_WAIT_V(8); PG8_WAIT_L(0); PG8_BAR; PG8_MMA(0, 0, At, B0); PG8_MMA(0, 1, At, B1); PG8_BAR; PG8_SCHED;
            PG8_LDA(At, 0, 1); PG8_STAGE(PG8_SB(0, 0), b2, voffB); PG8_STAGE(PG8_SB(0, 1), b2 + hstepB, voffB); PG8_STAGE(PG8_SA(0, 0), a2, voffA);
            PG8_WAIT_V(8); PG8_WAIT_L(0); PG8_BAR; PG8_MMA(1, 0, At, B0); PG8_MMA(1, 1, At, B1); PG8_BAR; PG8_SCHED;
            PG8_LDB(B0, 1, 0); PG8_LDB(B1, 1, 1); PG8_SCHED; PG8_LDA(At, 1, 0); PG8_STAGE(PG8_SA(0, 1), a2 + hstepA, voffA);
            PG8_WAIT_V(8); PG8_WAIT_L(0); PG8_BAR; PG8_MMA(0, 0, At, B0); PG8_MMA(0, 1, At, B1); PG8_BAR; PG8_SCHED;
            PG8_LDA(At, 1, 1); PG8_STAGE(PG8_SB(1, 0), b3, voffB); PG8_STAGE(PG8_SB(1, 1), b3 + hstepB, voffB); PG8_STAGE(PG8_SA(1, 0), a3, voffA);
            PG8_WAIT_V(8); PG8_WAIT_L(0); PG8_BAR; PG8_MMA(1, 0, At, B0); PG8_MMA(1, 1, At, B1); PG8_BAR; PG8_SCHED;
            } else {
            PG8_LDB(B0, 0, 0); PG8_SCHED; PG8_LDA(At, 0, 0); PG8_STAGE(PG8_SA(1, 1), a1 + hstepA, voffA);
            PG8_WAIT_L(8); PG8_BAR; PG8_WAIT_L(0); PG8_MMA(0, 0, At, B0); PG8_BAR; PG8_SCHED;
            PG8_LDB(B1, 0, 1); PG8_STAGE(PG8_SB(0, 0), b2, voffB);
            PG8_BAR; PG8_WAIT_L(0); PG8_MMA(0, 1, At, B1); PG8_BAR;
            PG8_LDA(At, 0, 1); PG8_STAGE(PG8_SA(0, 0), a2, voffA);
            PG8_BAR; PG8_WAIT_L(0); PG8_MMA(1, 0, At, B0); PG8_BAR; PG8_SCHED;
            PG8_STAGE(PG8_SB(0, 1), b2 + hstepB, voffB);
            PG8_WAIT_V(6); PG8_BAR; PG8_MMA(1, 1, At, B1); PG8_BAR;
            PG8_LDB(B0, 1, 0); PG8_SCHED; PG8_LDA(At, 1, 0); PG8_STAGE(PG8_SA(0, 1), a2 + hstepA, voffA);
            PG8_WAIT_L(8); PG8_BAR; PG8_WAIT_L(0); PG8_MMA(0, 0, At, B0); PG8_BAR; PG8_SCHED;
            PG8_LDB(B1, 1, 1); PG8_STAGE(PG8_SB(1, 0), b3, voffB);
            PG8_BAR; PG8_WAIT_L(0); PG8_MMA(0, 1, At, B1); PG8_BAR;
            PG8_LDA(At, 1, 1); PG8_STAGE(PG8_SA(1, 0), a3, voffA);
            PG8_BAR; PG8_WAIT_L(0); PG8_MMA(1, 0, At, B0); PG8_BAR; PG8_SCHED;
            PG8_STAGE(PG8_SB(1, 1), b3 + hstepB, voffB);
            PG8_WAIT_V(6); PG8_BAR; PG8_MMA(1, 1, At, B1); PG8_BAR;
            }
        }
        if constexpr (ALIGN_EPI) { if (wr == 0) PG8_BAR; }
        if constexpr (!Epi::AFTER_DRAIN) { E(acc, cur, wr, wc, fr, fq); S.done(cur); }
        if (!has_next) break;
#pragma unroll
        for (int a = 0; a < 2; ++a)
#pragma unroll
            for (int b = 0; b < 2; ++b)
#pragma unroll
                for (int m = 0; m < 4; ++m)
#pragma unroll
                    for (int n = 0; n < 2; ++n) acc[a][b][m][n] = (f32x4){0.f, 0.f, 0.f, 0.f};
        cur = nxt; cA = nA; cB = nB; ++ui;
        if constexpr (ALIGN_EPI) { if (wr == 1) PG8_BAR; }
    }
    PG8_WAIT_V(0);
    if constexpr (!ALIGN_EPI) { if (wr == 0) PG8_BAR; }
    PG8_BAR;
    if constexpr (Epi::AFTER_DRAIN) { E.fused(acc, cur, wr, wc, fr, fq, lds, wid, lane); S.done(cur); }
#undef PG8_SA
#undef PG8_SB
#undef PG8_STAGE
#undef PG8_LDA
#undef PG8_LDB
#undef PG8_MMA
#undef PG8_WAIT_V
#undef PG8_WAIT_L
#undef PG8_BAR
#undef PG8_SCHED
}
}

#define GAS __attribute__((address_space(1)))
#define LAS __attribute__((address_space(3)))
typedef unsigned short bf16;
typedef unsigned v4u __attribute__((ext_vector_type(4)));
typedef unsigned v2u __attribute__((ext_vector_type(2)));
typedef float f32x4 __attribute__((ext_vector_type(4)));
typedef _Float16 h16;
typedef _Float16 h16x2 __attribute__((ext_vector_type(2)));

#ifndef MK_SINGLE
#define MK_SINGLE 1
#endif

constexpr int NWAVES = 8, NTHREADS = NWAVES * 64;
constexpr int D = 1024, TP = 16384, TS = 1024, T = TP + TS, LP = 2048, LS = 8, NPB = 8, NSB = 128;
constexpr int INP = 2816, BP = 1792, FF = 2816, HW = 512;
constexpr float ALPHA = 1.41421356237309515f, LN_EPS = 1e-5f, GN_EPS = 64e-5f;
constexpr int NPHASE = 18;

constexpr size_t MiB = 1u << 20;
constexpr size_t WS_WIN = 1 * MiB, WS_WOUT = WS_WIN + 5632 * 1024, WS_WGU0 = WS_WOUT + 2 * MiB, WS_WGU1 = WS_WGU0 + 11 * MiB, WS_WD0 = WS_WGU1 + 11 * MiB, WS_WD1 = WS_WD0 + 5632 * 1024,
                 WS_POOLT = WS_WD1 + 5632 * 1024, WS_LORAT = WS_POOLT + 512 * 1024;
constexpr size_t WS_XB = 43 * MiB;
constexpr size_t WS_SCW = 43 * MiB, WS_G = 60 * MiB;
constexpr size_t WS_PROJA = 77 * MiB;
constexpr size_t WS_PROJB = 111 * MiB;
constexpr size_t WS_CAT = 111 * MiB, WS_SCB = 145 * MiB, WS_O = 162 * MiB;
constexpr size_t WS_LA = 170 * MiB + 512 * 1024;
constexpr size_t WS_SCR = 179 * MiB, WS_SCV = 196 * MiB, WS_SCK = 213 * MiB, WS_SCKK = 230 * MiB;
constexpr size_t WS_Z = 188 * MiB;
constexpr size_t WS_H = 77 * MiB;
constexpr size_t WS_PL = 77 * MiB;
constexpr size_t WS_END = 256 * MiB;
static_assert(WS_LORAT + 1536 * 256 * 2 <= WS_XB, "weights");
static_assert(WS_PROJB + (size_t)T * BP * 2 <= WS_LA, "projb");
static_assert(WS_H + (size_t)T * FF * 2 <= WS_Z, "h");
static_assert(WS_Z + (size_t)T * D * 4 <= WS_END, "z");

constexpr size_t O_Y = 0, O_CONV_P = 17825792, O_SHIFT_P = 17948672, O_WKV_P = 17963008, O_POOL_P = 18225152,
                 O_CONV_S = 18348032, O_SHIFT_S = 20314112, O_WKV_S = 20543488, O_POOL_S = 24737792, O_TOTAL = 26703872;

constexpr int LDS_BYTES = 147456;

struct Frame {
    LAS unsigned char* lds;
    int tid, lane, wave, vcu, G;
    const float* const* in;
    float* out; unsigned char* ws;
};

__device__ __forceinline__ float bf2f(unsigned b) { return __uint_as_float(b << 16); }
__device__ __forceinline__ unsigned pkbf(float lo, float hi) { return pg8::cvt_pk_bf16(lo, hi); }
__device__ __forceinline__ unsigned pkh(float lo, float hi) { const unsigned short a = __builtin_bit_cast(unsigned short, (h16)lo), b = __builtin_bit_cast(unsigned short, (h16)hi); return (unsigned)a | ((unsigned)b << 16); }
__device__ __forceinline__ float hlo(unsigned u) { return (float)__builtin_bit_cast(h16, (unsigned short)(u & 0xffffu)); }
__device__ __forceinline__ float hhi(unsigned u) { return (float)__builtin_bit_cast(h16, (unsigned short)(u >> 16)); }
__device__ __forceinline__ void unpack_bf8(v4u w, float (&f)[8]) { const unsigned u0 = w.x, u1 = w.y, u2 = w.z, u3 = w.w;
    f[0] = __uint_as_float(u0 << 16); f[1] = __uint_as_float(u0 & 0xffff0000u); f[2] = __uint_as_float(u1 << 16); f[3] = __uint_as_float(u1 & 0xffff0000u);
    f[4] = __uint_as_float(u2 << 16); f[5] = __uint_as_float(u2 & 0xffff0000u); f[6] = __uint_as_float(u3 << 16); f[7] = __uint_as_float(u3 & 0xffff0000u); }
__device__ __forceinline__ void unpack_h8(v4u w, float (&f)[8]) { const unsigned u0 = w.x, u1 = w.y, u2 = w.z, u3 = w.w; f[0] = hlo(u0); f[1] = hhi(u0); f[2] = hlo(u1); f[3] = hhi(u1); f[4] = hlo(u2); f[5] = hhi(u2); f[6] = hlo(u3); f[7] = hhi(u3); }
__device__ __forceinline__ v4u pack_bf8(const float (&f)[8]) { v4u w; w.x = pkbf(f[0], f[1]); w.y = pkbf(f[2], f[3]); w.z = pkbf(f[4], f[5]); w.w = pkbf(f[6], f[7]); return w; }
__device__ __forceinline__ v4u pack_h8(const float (&f)[8]) { v4u w; w.x = pkh(f[0], f[1]); w.y = pkh(f[2], f[3]); w.z = pkh(f[4], f[5]); w.w = pkh(f[6], f[7]); return w; }
__device__ __forceinline__ void load_f8(const float* p, float (&f)[8]) { const f32x4 a = *(const f32x4*)p, b = *(const f32x4*)(p + 4); f[0] = a.x; f[1] = a.y; f[2] = a.z; f[3] = a.w; f[4] = b.x; f[5] = b.y; f[6] = b.z; f[7] = b.w; }
__device__ __forceinline__ void store_f8(float* p, const float (&f)[8]) { *(f32x4*)p = (f32x4){f[0], f[1], f[2], f[3]}; *(f32x4*)(p + 4) = (f32x4){f[4], f[5], f[6], f[7]}; }
__device__ __forceinline__ float sigmoid_(float x) { return __builtin_amdgcn_rcpf(1.f + __expf(-x)); }
__device__ __forceinline__ float silu_(float x) { return x * sigmoid_(x); }
__device__ __forceinline__ float wave_sum(float v) {
#pragma unroll
    for (int o = 1; o < 64; o <<= 1) v += __shfl_xor(v, o);
    return v;
}
__device__ __forceinline__ float sum8(float v) { v += __shfl_xor(v, 1); v += __shfl_xor(v, 2); v += __shfl_xor(v, 4); return v; }
template <int CTRL> __device__ __forceinline__ float dppf(float x) { return __builtin_bit_cast(float, __builtin_amdgcn_update_dpp(0, __builtin_bit_cast(int, x), CTRL, 0xF, 0xF, true)); }
__device__ __forceinline__ float dpp_sum16(float x) {
    x += dppf<0xB1>(x);
    x += dppf<0x4E>(x);
    x += dppf<0x141>(x);
    x += dppf<0x140>(x);
    return x;
}
__device__ __forceinline__ void h4(v2u x, float (&f)[4]) { const unsigned u0 = x.x, u1 = x.y; f[0] = hlo(u0); f[1] = hhi(u0); f[2] = hlo(u1); f[3] = hhi(u1); }
__device__ __forceinline__ const float* xrow_ptr(const Frame& F, int m) { return m < TP ? F.in[0] + (size_t)m * D : F.in[1] + (size_t)(m - TP) * D; }

using pg8::Unit; using pg8::HALF; using pg8::BM;
typedef pg8::u32x4 u32x4;
struct EpiProj {
    static constexpr bool PERM = true, AFTER_DRAIN = false;
    bf16* PA; bf16* PB;
    __device__ __forceinline__ void operator()(const pg8::f32x4 (&acc)[2][2][4][2], const Unit& u, int wr, int wc, int fr, int fq) const {
        const int row0 = u.pm * BM + wr * 64 + fr;
        bf16* base; int ldc, colt;
        if (u.pn < 4) { base = PA; ldc = 1024; colt = u.pn * BM; } else { base = PB; ldc = BP; colt = (u.pn - 4) * BM; }
        const int col0 = colt + wc * 32 + 8 * fq;
#pragma unroll
        for (int ai = 0; ai < 2; ++ai)
#pragma unroll
            for (int m = 0; m < 4; ++m) { bf16* rowp = base + (size_t)(row0 + ai * HALF + m * 16) * ldc + col0;
#pragma unroll
                for (int bj = 0; bj < 2; ++bj) { const pg8::f32x4 v0 = acc[ai][bj][m][0], v1 = acc[ai][bj][m][1];
                    u32x4 w; w.x = pkbf(v0[0], v0[1]); w.y = pkbf(v0[2], v0[3]); w.z = pkbf(v1[0], v1[1]); w.w = pkbf(v1[2], v1[3]);
                    *(u32x4*)(rowp + bj * HALF) = w; } }
    }
};
struct EpiLora {
    static constexpr bool PERM = true, AFTER_DRAIN = false;
    const float* w0; const float* a0; const float* ka;
    h16* SCW; h16* SCK; h16* SCKK; h16* SCB; h16* G;
    __device__ __forceinline__ void operator()(const pg8::f32x4 (&acc)[2][2][4][2], const Unit& u, int wr, int wc, int fr, int fq) const {
        const int row0 = u.pm * BM + wr * 64 + fr; const int sec = u.pn >> 1;
        const int c0 = (u.pn & 1) * BM + wc * 32 + 8 * fq;
#pragma unroll
        for (int bj = 0; bj < 2; ++bj)
#pragma unroll
            for (int n = 0; n < 2; ++n) {
                const int c = c0 + bj * HALF + 4 * n;
                f32x4 p0 = {0.f, 0.f, 0.f, 0.f}, p1 = {0.f, 0.f, 0.f, 0.f};
                if (sec == 0) p0 = *(const f32x4*)(w0 + c); else if (sec == 1) { p0 = *(const f32x4*)(a0 + c); p1 = *(const f32x4*)(ka + c); }
#pragma unroll
                for (int ai = 0; ai < 2; ++ai)
#pragma unroll
                    for (int m = 0; m < 4; ++m) {
                        const size_t off = (size_t)(row0 + ai * HALF + m * 16) * HW + c;
                        const pg8::f32x4 v = acc[ai][bj][m][n];
                        if (sec == 0) {
                            float o[4];
#pragma unroll
                            for (int i = 0; i < 4; ++i) { const float e = 0.60653065971f * sigmoid_(p0[i] + v[i]); o[i] = 1.f - __expf(-e); }
                            v2u w; w.x = pkh(o[0], o[1]); w.y = pkh(o[2], o[3]); *(v2u*)(SCW + off) = w;
                        } else if (sec == 1) {
                            float kx[4], kk[4], ko[4], bo[4];
                            h4(*(const v2u*)(SCK + off), kx); h4(*(const v2u*)(SCKK + off), kk);
#pragma unroll
                            for (int i = 0; i < 4; ++i) { const float a = sigmoid_(p0[i] + v[i]); ko[i] = kx[i] * (1.f + (a - 1.f) * p1[i]); bo[i] = kk[i] * a; }
                            v2u w; w.x = pkh(ko[0], ko[1]); w.y = pkh(ko[2], ko[3]); *(v2u*)(SCK + off) = w;
                            v2u x; x.x = pkh(bo[0], bo[1]); x.y = pkh(bo[2], bo[3]); *(v2u*)(SCB + off) = x;
                        } else {
                            v2u w; w.x = pkh(v[0], v[1]); w.y = pkh(v[2], v[3]); *(v2u*)(G + off) = w;
                        }
                        asm volatile("" ::: "memory");
                    }
            }
    }
};
struct EpiGateUp {
    static constexpr bool PERM = true, AFTER_DRAIN = false;
    bf16* H;
    __device__ __forceinline__ void operator()(const pg8::f32x4 (&acc)[2][2][4][2], const Unit& u, int wr, int wc, int fr, int fq) const {
        const int row0 = u.pm * BM + wr * 64 + fr; const int col0 = u.pn * HALF + wc * 32 + 8 * fq;
#pragma unroll
        for (int ai = 0; ai < 2; ++ai)
#pragma unroll
            for (int m = 0; m < 4; ++m) {
                const pg8::f32x4 g0 = acc[ai][0][m][0], g1 = acc[ai][0][m][1], u0 = acc[ai][1][m][0], u1 = acc[ai][1][m][1];
                u32x4 w; w.x = pkbf(silu_(g0[0]) * u0[0], silu_(g0[1]) * u0[1]); w.y = pkbf(silu_(g0[2]) * u0[2], silu_(g0[3]) * u0[3]);
                w.z = pkbf(silu_(g1[0]) * u1[0], silu_(g1[1]) * u1[1]); w.w = pkbf(silu_(g1[2]) * u1[2], silu_(g1[3]) * u1[3]);
                *(u32x4*)(H + (size_t)(row0 + ai * HALF + m * 16) * FF + col0) = w;
            }
    }
};
struct EpiResid {
    static constexpr bool PERM = false, AFTER_DRAIN = false;
    const float* xp; const float* xs; float* Z; const float* scale;
    __device__ __forceinline__ void operator()(const pg8::f32x4 (&acc)[2][2][4][2], const Unit& u, int wr, int wc, int fr, int fq) const {
        const int col0 = u.pn * BM + wc * 32 + 4 * fq;
#pragma unroll
        for (int ai = 0; ai < 2; ++ai)
#pragma unroll
            for (int m = 0; m < 4; ++m) {
                const int row = u.pm * BM + ai * HALF + wr * 64 + m * 16 + fr;
                float* zr = Z + (size_t)row * D + col0;
                const float* br = xp ? ((row < TP ? xp + (size_t)row * D : xs + (size_t)(row - TP) * D) + col0) : zr;
#pragma unroll
                for (int bj = 0; bj < 2; ++bj)
#pragma unroll
                    for (int n = 0; n < 2; ++n) {
                        const int o = bj * HALF + n * 16;
                        pg8::f32x4 a = acc[ai][bj][m][n];
                        if (scale) a = a * *(const pg8::f32x4*)(scale + col0 + o);
                        const pg8::f32x4 b = *(const pg8::f32x4*)(br + o);
                        *(pg8::f32x4*)(zr + o) = b * ALPHA + a;
                    }
            }
    }
};

__device__ __forceinline__ void transpose_item(const float* W, int K, int N, bf16* WT, int mode, LAS float* scr, int item, int lane) {
    const int nblk = N / 32, kb = item / nblk, nb = item % nblk, k0 = 64 * kb, n0 = 32 * nb;
    const int drow0 = mode == 0 ? n0 : ((n0 >> 7) * 256 + (mode == 2 ? 128 : 0) + (n0 & 127));
#pragma unroll 8
    for (int i = 0; i < 32; ++i) { const int kk = 2 * i + (lane >> 5); scr[kk * 33 + (lane & 31)] = W[(size_t)(k0 + kk) * N + n0 + (lane & 31)]; }
    asm volatile("s_waitcnt lgkmcnt(0)" ::: "memory");
    const int c = lane & 7;
#pragma unroll
    for (int j = 0; j < 4; ++j) { const int n = (lane >> 3) + 8 * j; const LAS float* s = scr + (8 * c) * 33 + n;
        v4u o; o.x = pkbf(s[0 * 33], s[1 * 33]); o.y = pkbf(s[2 * 33], s[3 * 33]); o.z = pkbf(s[4 * 33], s[5 * 33]); o.w = pkbf(s[6 * 33], s[7 * 33]);
        *(v4u*)(WT + (size_t)(drow0 + n) * K + k0 + 8 * c) = o; }
    asm volatile("s_waitcnt lgkmcnt(0)" ::: "memory");
}
__device__ __forceinline__ void p0_prologue(Frame& F) {
    LAS float* scr = (LAS float*)(F.lds + F.wave * 16384);
    const int gw = F.vcu * NWAVES + F.wave, NGW = F.G * NWAVES;
    unsigned char* ws = F.ws;
    constexpr int I_IN = 16 * 88, I_OUT = 16 * 32, I_GU = 16 * 88, I_DN = 44 * 32, I_PL = 4 * 8;
    constexpr int NITEMS = I_IN + I_OUT + 2 * (2 * I_GU + I_DN) + 4 * I_PL;
    for (int it = gw; it < NITEMS; it += NGW) {
        int r = it;
        if (r < I_IN) { transpose_item(F.in[6], D, INP, (bf16*)(ws + WS_WIN), 0, scr, r, F.lane); continue; } r -= I_IN;
        if (r < I_OUT) { transpose_item(F.in[22], D, D, (bf16*)(ws + WS_WOUT), 0, scr, r, F.lane); continue; } r -= I_OUT;
        constexpr int I_LAYER = 2 * I_GU + I_DN;
        if (r < 2 * I_LAYER) {
            const int l = r / I_LAYER; int q = r % I_LAYER;
            bf16* gu = (bf16*)(ws + (l ? WS_WGU1 : WS_WGU0)); bf16* dn = (bf16*)(ws + (l ? WS_WD1 : WS_WD0));
            if (q < I_GU) { transpose_item(F.in[27] + (size_t)l * D * FF, D, FF, gu, 1, scr, q, F.lane); continue; } q -= I_GU;
            if (q < I_GU) { transpose_item(F.in[28] + (size_t)l * D * FF, D, FF, gu, 2, scr, q, F.lane); continue; } q -= I_GU;
            transpose_item(F.in[29] + (size_t)l * FF * D, FF, D, dn, 0, scr, q, F.lane); continue;
        }
        r -= 2 * I_LAYER;
        { const int g = r / I_PL, ri = r % I_PL; transpose_item(F.in[23] + (size_t)g * 65536, 256, 256, (bf16*)(ws + WS_POOLT) + (size_t)g * 65536, 0, scr, ri, F.lane); }
    }
    const int gt = F.vcu * NTHREADS + F.tid, NGT = F.G * NTHREADS;
    bf16* XB = (bf16*)(ws + WS_XB);
    for (int i = gt; i < T * D / 8; i += NGT) { const int m = i >> 7, c8 = (i & 127) * 8; float f[8]; load_f8(xrow_ptr(F, m) + c8, f); *(v4u*)(XB + (size_t)m * D + c8) = pack_bf8(f); }
    bf16* LT = (bf16*)(ws + WS_LORAT);
    for (int i = gt; i < 1536 * 256 / 2; i += NGT) { const int j = i >> 7, k = (i & 127) * 2; float v[2];
#pragma unroll
        for (int e = 0; e < 2; ++e) { const int kk = k + e; float x = 0.f;
            if (j < 512) { if (kk < 64) x = F.in[13][(size_t)kk * 512 + j]; }
            else if (j < 1024) { if (kk >= 64 && kk < 128) x = F.in[15][(size_t)(kk - 64) * 512 + (j - 512)]; }
            else { if (kk >= 128) x = F.in[16][(size_t)(kk - 128) * 512 + (j - 1024)]; }
            v[e] = x; }
        *(unsigned*)(LT + (size_t)j * 256 + k) = pkbf(v[0], v[1]); }
}

__device__ __forceinline__ void p2_rows(Frame& F) {
    const int gw = F.vcu * NWAVES + F.wave, NGW = F.G * NWAVES, lane = F.lane;
    unsigned char* ws = F.ws;
    const bf16* PB = (const bf16*)(ws + WS_PROJB);
    h16* SCR = (h16*)(ws + WS_SCR); h16* SCK = (h16*)(ws + WS_SCK); h16* SCV = (h16*)(ws + WS_SCV); h16* SCKK = (h16*)(ws + WS_SCKK);
    bf16* LA = (bf16*)(ws + WS_LA);
    const float* mu = F.in[11]; const float* kkw = F.in[17]; const float* sshift = F.in[3];
    for (int m = gw; m < T; m += NGW) {
        const bool sample = m >= TP; const int seq = sample ? (m - TP) >> 3 : m >> 11, t = sample ? (m - TP) & 7 : m & 2047, L = sample ? LS : LP;
        const bf16* pb = PB + (size_t)m * BP;
        float* oshift = F.out + (sample ? O_SHIFT_S : O_SHIFT_P) + (size_t)seq * BP;
        const bool last = (t == L - 1);
#pragma unroll
        for (int sec = 0; sec < 4; ++sec) {
            if (sec == 3 && lane >= 32) break;
            const int col = sec * 512 + lane * 8;
            float p[8], pv[8], mv[8], xm[8];
            unpack_bf8(*(const v4u*)(pb + col), p);
            if (t > 0) unpack_bf8(*(const v4u*)(pb - BP + col), pv);
            else if (sample) load_f8(sshift + (size_t)seq * BP + col, pv);
            else {
#pragma unroll
                for (int i = 0; i < 8; ++i) pv[i] = 0.f; }
            load_f8(mu + col, mv);
#pragma unroll
            for (int i = 0; i < 8; ++i) xm[i] = p[i] + mv[i] * (pv[i] - p[i]);
            if (last) store_f8(oshift + col, p);
            const size_t off = (size_t)m * HW + lane * 8;
            if (sec == 0) *(v4u*)(SCR + off) = pack_h8(xm);
            else if (sec == 1) {
                *(v4u*)(SCK + off) = pack_h8(xm);
                float kw[8], kx[8]; load_f8(kkw + lane * 8, kw); float ss = 0.f;
#pragma unroll
                for (int i = 0; i < 8; ++i) { kx[i] = xm[i] * kw[i]; ss += kx[i] * kx[i]; }
                ss = sum8(ss);
                const float inv = 1.f / fmaxf(sqrtf(ss), 1e-12f);
#pragma unroll
                for (int i = 0; i < 8; ++i) kx[i] *= inv;
                *(v4u*)(SCKK + off) = pack_h8(kx);
            } else if (sec == 2) *(v4u*)(SCV + off) = pack_h8(xm);
            else {
                float o[8];
#pragma unroll
                for (int i = 0; i < 8; ++i) {
                    if (lane < 8) { const float e = __expf(2.f * xm[i]); o[i] = 1.f - 2.f * __builtin_amdgcn_rcpf(e + 1.f); }
                    else if (lane < 16) o[i] = xm[i];
                    else o[i] = sigmoid_(xm[i]);
                }
                *(v4u*)(LA + (size_t)m * 256 + lane * 8) = pack_bf8(o);
            }
        }
    }
}

template <int TT> __device__ __forceinline__ void conv_tile(Frame& F, int m0, int t0, int seq, bool sample) {
    const int c = F.tid;
    unsigned char* ws = F.ws;
    const bf16* PA = (const bf16*)(ws + WS_PROJA); bf16* CAT = (bf16*)(ws + WS_CAT);
    const float* cw = F.in[7]; const float* sconv = F.in[2];
    LAS float* ylds = (LAS float*)F.lds;
    float w[31];
#pragma unroll
    for (int j = 0; j < 31; ++j) w[j] = cw[j * 512 + c];
    float y[TT]; const float bias = F.in[8][c];
#pragma unroll
    for (int t = 0; t < TT; ++t) y[t] = bias;
    const bool lastp = (!sample) && (t0 + TT == LP);
    float* oconv = F.out + (sample ? O_CONV_S : O_CONV_P) + (size_t)seq * 30 * 512 + c;
    const bf16* pp = PA + ((size_t)m0 - 30) * 1024 + c; const float* scp = sconv + ((size_t)seq * 30 + t0) * 512 + c;
#pragma unroll
    for (int s = -30; s < TT; ++s) {
        float u;
        asm volatile("" : "+v"(pp), "+v"(scp));
        if (t0 + s >= 0) { const float val = bf2f(pp[0]), gate = bf2f(pp[512]); u = val * sigmoid_(gate); }
        else u = sample ? *scp : 0.f;
        pp += 1024; scp += 512;
#pragma unroll
        for (int t = 0; t < TT; ++t) { const int j = s - t + 30; if (j >= 0 && j <= 30) y[t] += u * w[j]; }
        if (sample) { if (s + 22 >= 0) oconv[(size_t)(s + 22) * 512] = u; }
        else if (lastp && s >= TT - 30) oconv[(size_t)(s - (TT - 30)) * 512] = u;
    }
#pragma unroll
    for (int t = 0; t < TT; ++t) ylds[t * 512 + c] = y[t];
    __syncthreads();
    const float* lg = F.in[9]; const float* lb = F.in[10];
    for (int t = F.wave; t < TT; t += NWAVES) {
        const LAS float* yr = ylds + t * 512 + F.lane * 8;
        float v[8];
        { const f32x4 a = *(const LAS f32x4*)yr, b = *(const LAS f32x4*)(yr + 4); v[0] = a.x; v[1] = a.y; v[2] = a.z; v[3] = a.w; v[4] = b.x; v[5] = b.y; v[6] = b.z; v[7] = b.w; }
        float s = 0.f;
#pragma unroll
        for (int i = 0; i < 8; ++i) s += v[i];
        const float mean = wave_sum(s) * (1.f / 512.f); float q = 0.f;
#pragma unroll
        for (int i = 0; i < 8; ++i) { v[i] -= mean; q += v[i] * v[i]; }
        const float rstd = rsqrtf(wave_sum(q) * (1.f / 512.f) + LN_EPS);
        float g8[8], b8[8], o[8]; load_f8(lg + F.lane * 8, g8); load_f8(lb + F.lane * 8, b8);
#pragma unroll
        for (int i = 0; i < 8; ++i) o[i] = silu_(v[i] * rstd * g8[i] + b8[i]);
        *(v4u*)(CAT + (size_t)(m0 + t) * 1024 + F.lane * 8) = pack_bf8(o);
    }
    __syncthreads();
}
__device__ __forceinline__ void conv_phase(Frame& F) {
    for (int it = F.vcu; it < 512 + 128; it += F.G) {
        if (it < 512) { const int m0 = it * 32; conv_tile<32>(F, m0, m0 & 2047, m0 >> 11, false); }
        else { const int seq = it - 512; conv_tile<8>(F, TP + seq * 8, 0, seq, true); }
    }
}

constexpr int SU = 8;
struct ScanPtrs { const h16* R; const h16* K; const h16* V; const h16* KK; const h16* B; const h16* W; h16* O; };
struct ScanBuf { v2u r[SU], k[SU], kk[SU], b[SU], w[SU]; unsigned short v[SU]; };
__device__ __forceinline__ void scan_load(ScanBuf& Bf, const ScanPtrs& P, size_t off, int ks, int row) {
#pragma unroll
    for (int i = 0; i < SU; ++i) { const size_t o = off + (size_t)i * HW;
        Bf.r[i] = *(const v2u*)(P.R + o + ks); Bf.k[i] = *(const v2u*)(P.K + o + ks); Bf.kk[i] = *(const v2u*)(P.KK + o + ks);
        Bf.b[i] = *(const v2u*)(P.B + o + ks); Bf.w[i] = *(const v2u*)(P.W + o + ks); Bf.v[i] = *(const unsigned short*)(P.V + o + row); }
}
__device__ __forceinline__ void scan_compute(const ScanBuf& Bf, float (&S)[4], const ScanPtrs& P, size_t off, int row, bool writer) {
#pragma unroll
    for (int i = 0; i < SU; ++i) {
        float r[4], k[4], kk[4], b[4], w[4]; h4(Bf.r[i], r); h4(Bf.k[i], k); h4(Bf.kk[i], kk); h4(Bf.b[i], b); h4(Bf.w[i], w);
        const float v = (float)__builtin_bit_cast(h16, Bf.v[i]);
        float d = (S[0] * kk[0] + S[1] * kk[1]) + (S[2] * kk[2] + S[3] * kk[3]);
        float pj[4];
#pragma unroll
        for (int j = 0; j < 4; ++j) pj[j] = fmaf(v, k[j], fmaf(-S[j], w[j], S[j]));
        d = dpp_sum16(d);
#pragma unroll
        for (int j = 0; j < 4; ++j) S[j] = fmaf(-d, b[j], pj[j]);
        float o = (S[0] * r[0] + S[1] * r[1]) + (S[2] * r[2] + S[3] * r[3]);
        o = dpp_sum16(o);
        if (writer) P.O[off + (size_t)i * HW + row] = (h16)o;
    }
}
template <int L> __device__ __forceinline__ void scan_task(const ScanPtrs& P, int mbase, int h, int v0, const float* s_in, float* s_out, int lane) {
    const int rl = lane >> 4, ks = (lane & 15) * 4, row = v0 + rl; const bool writer = (lane & 15) == 0;
    float S[4] = {0.f, 0.f, 0.f, 0.f};
    if (s_in) { const f32x4 s = *(const f32x4*)(s_in + (size_t)row * 64 + ks); S[0] = s.x; S[1] = s.y; S[2] = s.z; S[3] = s.w; }
    size_t off = (size_t)mbase * HW + h * 64;
    ScanBuf A;
    scan_load(A, P, off, ks, row);
    if constexpr (L == SU) { scan_compute(A, S, P, off, row, writer); }
    else {
        ScanBuf Bf;
        for (int t = 0; t < L; t += 2 * SU) {
            scan_load(Bf, P, off + (size_t)SU * HW, ks, row);
            scan_compute(A, S, P, off, row, writer);
            if (t + 2 * SU < L) scan_load(A, P, off + (size_t)2 * SU * HW, ks, row);
            scan_compute(Bf, S, P, off + (size_t)SU * HW, row, writer);
            off += (size_t)2 * SU * HW;
        }
    }
    *(f32x4*)(s_out + (size_t)row * 64 + ks) = (f32x4){S[0], S[1], S[2], S[3]};
}
__device__ __forceinline__ void scan_phase(Frame& F) {
    unsigned char* ws = F.ws;
    ScanPtrs P{(const h16*)(ws + WS_SCR), (const h16*)(ws + WS_SCK), (const h16*)(ws + WS_SCV), (const h16*)(ws + WS_SCKK), (const h16*)(ws + WS_SCB), (const h16*)(ws + WS_SCW), (h16*)(ws + WS_O)};
    if (F.wave < 4) {
        for (int task = F.vcu; task < 256; task += F.G) {
            const int pair = task >> 2, q = task & 3, n = pair >> 3, h = pair & 7, v0 = q * 16 + F.wave * 4;
            scan_task<LP>(P, n * LP, h, v0, nullptr, F.out + O_WKV_P + (size_t)pair * 4096, F.lane);
        }
    } else {
        for (int pair = F.vcu * 4 + (F.wave - 4); pair < NSB * 8; pair += F.G * 4) {
            const int n = pair >> 3, h = pair & 7;
            for (int rg = 0; rg < 16; ++rg)
                scan_task<LS>(P, TP + n * LS, h, rg * 4, F.in[4] + (size_t)pair * 4096, F.out + O_WKV_S + (size_t)pair * 4096, F.lane);
        }
    }
}

__device__ __forceinline__ void p6_rows(Frame& F) {
    const int gw = F.vcu * NWAVES + F.wave, NGW = F.G * NWAVES, lane = F.lane;
    unsigned char* ws = F.ws;
    const h16* O = (const h16*)(ws + WS_O); const h16* SCR = (const h16*)(ws + WS_SCR); const h16* SCK = (const h16*)(ws + WS_SCK); const h16* SCV = (const h16*)(ws + WS_SCV); const h16* G = (const h16*)(ws + WS_G);
    bf16* CAT = (bf16*)(ws + WS_CAT);
    float rk[8], lg[8], lb[8]; load_f8(F.in[19] + lane * 8, rk); load_f8(F.in[20] + lane * 8, lg); load_f8(F.in[21] + lane * 8, lb);
    for (int m = gw; m < T; m += NGW) {
        const size_t off = (size_t)m * HW + lane * 8;
        float o[8], r[8], k[8], v[8], g[8];
        unpack_h8(*(const v4u*)(O + off), o); unpack_h8(*(const v4u*)(SCR + off), r); unpack_h8(*(const v4u*)(SCK + off), k); unpack_h8(*(const v4u*)(SCV + off), v); unpack_h8(*(const v4u*)(G + off), g);
        float s = 0.f, bs = 0.f;
#pragma unroll
        for (int i = 0; i < 8; ++i) { s += o[i]; bs += r[i] * k[i] * rk[i]; }
        const float mean = sum8(s) * (1.f / 64.f); bs = sum8(bs); float q = 0.f;
#pragma unroll
        for (int i = 0; i < 8; ++i) { o[i] -= mean; q += o[i] * o[i]; }
        const float rstd = rsqrtf(sum8(q) * (1.f / 64.f) + GN_EPS);
        float res[8];
#pragma unroll
        for (int i = 0; i < 8; ++i) res[i] = (o[i] * rstd * lg[i] + lb[i] + bs * v[i]) * g[i];
        *(v4u*)(CAT + (size_t)m * 1024 + 512 + lane * 8) = pack_bf8(res);
    }
}

template <int MODE> __device__ __forceinline__ void ln_rows(Frame& F, const float* g, const float* b) {
    const int gw = F.vcu * NWAVES + F.wave, NGW = F.G * NWAVES, lane = F.lane;
    float* Z = (float*)(F.ws + WS_Z); bf16* XB = (bf16*)(F.ws + WS_XB);
    f32x4 gv[4], bv[4];
#pragma unroll
    for (int j = 0; j < 4; ++j) { gv[j] = *(const f32x4*)(g + 4 * (lane + 64 * j)); bv[j] = *(const f32x4*)(b + 4 * (lane + 64 * j)); }
    for (int m = gw; m < T; m += NGW) {
        float* zr = Z + (size_t)m * D;
        f32x4 v[4]; float s = 0.f;
#pragma unroll
        for (int j = 0; j < 4; ++j) { v[j] = *(const f32x4*)(zr + 4 * (lane + 64 * j)); s += (v[j].x + v[j].y) + (v[j].z + v[j].w); }
        const float mean = wave_sum(s) * (1.f / D); float s2 = 0.f;
#pragma unroll
        for (int j = 0; j < 4; ++j) { v[j] = v[j] - mean; s2 += (v[j].x * v[j].x + v[j].y * v[j].y) + (v[j].z * v[j].z + v[j].w * v[j].w); }
        const float rstd = rsqrtf(wave_sum(s2) * (1.f / D) + LN_EPS);
#pragma unroll
        for (int j = 0; j < 4; ++j) v[j] = v[j] * rstd * gv[j] + bv[j];
        if (MODE == 2) {
#pragma unroll
            for (int j = 0; j < 4; ++j) *(f32x4*)(F.out + O_Y + (size_t)m * D + 4 * (lane + 64 * j)) = v[j];
        } else {
#pragma unroll
            for (int j = 0; j < 4; ++j) *(f32x4*)(zr + 4 * (lane + 64 * j)) = v[j];
        }
        if (MODE == 0) {
#pragma unroll
            for (int j = 0; j < 4; ++j) { v2u w; w.x = pkbf(v[j].x, v[j].y); w.y = pkbf(v[j].z, v[j].w); *(v2u*)(XB + (size_t)m * D + 4 * (lane + 64 * j)) = w; }
        }
        if (MODE == 1) {
            const bool sample = m >= TP; const int seq = sample ? (m - TP) >> 3 : m >> 11, t = sample ? (m - TP) & 7 : m & 2047;
            if (sample) {
                float* op = F.out + O_POOL_S + ((size_t)seq * 15 + 7 + t) * D;
#pragma unroll
                for (int j = 0; j < 4; ++j) *(f32x4*)(op + 4 * (lane + 64 * j)) = v[j];
                if (t == 0) { const float* sp = F.in[5] + ((size_t)seq * 15 + 8) * D; float* o0 = F.out + O_POOL_S + (size_t)seq * 15 * D;
                    for (int i = lane; i < 7 * D / 4; i += 64) *(f32x4*)(o0 + 4 * i) = *(const f32x4*)(sp + 4 * i); }
            } else if (t >= LP - 15) {
                float* op = F.out + O_POOL_P + ((size_t)seq * 15 + (t - (LP - 15))) * D;
#pragma unroll
                for (int j = 0; j < 4; ++j) *(f32x4*)(op + 4 * (lane + 64 * j)) = v[j];
            }
        }
    }
}

template <int TT> __device__ __forceinline__ void pool_tile(Frame& F, int m0, int t0, int seq, bool sample) {
    const float* Z = (const float*)(F.ws + WS_Z); bf16* PL = (bf16*)(F.ws + WS_PL); const float* spool = F.in[5];
#pragma unroll 1
    for (int half = 0; half < 2; ++half) {
        const int c = F.tid + 512 * half, g = c >> 8;
        float xs[TT + 15];
        const float* zp = Z + ((size_t)m0 - 15) * D + c; const float* sp = spool + ((size_t)seq * 15 + t0) * D + c;
#pragma unroll
        for (int s = -15; s < TT; ++s) {
            asm volatile("" : "+v"(zp), "+v"(sp));
            if (t0 + s >= 0) xs[s + 15] = *zp;
            else xs[s + 15] = sample ? *sp : 0.f;
            zp += D; sp += D;
        }
        const int wdw = 2 << g;
#pragma unroll
        for (int t = 0; t < TT; ++t) {
            const float x0 = xs[t + 15];
            const float s2 = x0 + xs[t + 14];
            const float s4 = s2 + (xs[t + 13] + xs[t + 12]);
            const float s8 = s4 + ((xs[t + 11] + xs[t + 10]) + (xs[t + 9] + xs[t + 8]));
            const float s16 = s8 + (((xs[t + 7] + xs[t + 6]) + (xs[t + 5] + xs[t + 4])) + ((xs[t + 3] + xs[t + 2]) + (xs[t + 1] + xs[t + 0])));
            const float sum = g == 0 ? s2 : (g == 1 ? s4 : (g == 2 ? s8 : s16));
            const int cnt = sample ? wdw : min(wdw, t0 + t + 1);
            const float pooled = sum / (float)cnt - x0;
            PL[(size_t)(m0 + t) * D + c] = (bf16)(pkbf(pooled, 0.f) & 0xffffu);
        }
    }
}
__device__ __forceinline__ void pool_phase(Frame& F) {
    for (int it = F.vcu; it < 512 + 128; it += F.G) {
        if (it < 512) { const int m0 = it * 32; pool_tile<32>(F, m0, m0 & 2047, m0 >> 11, false); }
        else { const int seq = it - 512; pool_tile<8>(F, TP + seq * 8, 0, seq, true); }
    }
}


#ifndef DIAG_AT
#define DIAG_AT -1
#endif
__device__ __forceinline__ bool dbad(float got, float want) { return !(fabsf(got - want) <= 0.03f * fabsf(want) + 0.02f); }
__device__ __forceinline__ float h2f(h16 x) { return (float)x; }
__device__ __forceinline__ void diag_checks(Frame& F, int at) {
    if (blockIdx.x != 0 || F.wave != 0) return;
    const int lane = F.lane; unsigned char* ws = F.ws;
    unsigned mask = 0;
    const bf16* PA = (const bf16*)(ws + WS_PROJA); const bf16* PB = (const bf16*)(ws + WS_PROJB);
    const h16* SCR = (const h16*)(ws + WS_SCR); const h16* SCK = (const h16*)(ws + WS_SCK); const h16* SCV = (const h16*)(ws + WS_SCV); const h16* SCKK = (const h16*)(ws + WS_SCKK);
    const h16* SCB = (const h16*)(ws + WS_SCB); const h16* SCW = (const h16*)(ws + WS_SCW);
    const int m = 1 + (lane * 131 + 7) % 9000;
    const int t = m & 2047;
    if (at == 3) {
        const int c = (lane * 29 + 5) % 512, h0 = c & ~63;
        auto xm = [&](int col) { const float p = bf2f(PB[(size_t)m * BP + col]); const float pv = t > 0 ? bf2f(PB[(size_t)(m - 1) * BP + col]) : 0.f; return p + F.in[11][col] * (pv - p); };
        float ss = 0.f; for (int j = 0; j < 64; ++j) { const float kx = xm(512 + h0 + j) * F.in[17][h0 + j]; ss += kx * kx; }
        const float kkn = xm(512 + c) * F.in[17][c] / fmaxf(sqrtf(ss), 1e-12f);
        float al = F.in[14][c]; for (int j = 0; j < 64; ++j) al += xm(1600 + j) * F.in[15][(size_t)j * 512 + c];
        const float a = 1.f / (1.f + expf(-al)); const float f = (1.f + (a - 1.f) * F.in[18][c]); const float k0 = xm(512 + c); const float b = kkn * a;
        const float gotk = h2f(SCK[(size_t)m * HW + c]);
        if (__ballot(dbad(gotk, k0 * f))) mask |= 1;
        if (__ballot(dbad(h2f(SCB[(size_t)m * HW + c]) * 10.f, b * 10.f))) mask |= 2;
        { const bf16* LA = (const bf16*)(ws + WS_LA); bool bad = false; for (int j = 0; j < 64; ++j) bad = bad || dbad(bf2f(LA[(size_t)m * 256 + 64 + j]), xm(1600 + j)); if (__ballot(bad)) mask |= 4; }
        { float g = 0.f; for (int j = 0; j < 128; ++j) g += (1.f / (1.f + expf(-xm(1664 + j)))) * F.in[16][(size_t)j * 512 + c];
          const h16* G = (const h16*)(ws + WS_G); if (__ballot(dbad(h2f(G[(size_t)m * HW + c]), g))) mask |= 8; }
        if (__ballot(dbad(gotk, k0 * f * f))) mask |= 16;
        if (__ballot(dbad(gotk, k0))) mask |= 32;
    }
    if (lane == 0) *(unsigned*)(ws + 0) = mask;
}
__device__ __forceinline__ void diag_fill(Frame& F) {
    const unsigned mask = *(const unsigned*)(F.ws + 0);
    const float C = sqrtf(exp2f(1.f + (float)mask));
    const int gt = blockIdx.x * NTHREADS + F.tid, NGT = F.G * NTHREADS;
    for (int i = gt; i < TS * D; i += NGT) F.out[O_Y + (size_t)TP * D + i] = C;
}

#define XB_TMO      128
#define XB_XCNT(j)  (256  + 64 * (j))
#define XB_XSUB(j)  (1280 + 64 * (j))
#define XB_XGEN(j)  (2304 + 64 * (j))
#define XB_TOP      3328
#define XB_TOPGEN   3392
#define XCD_BAR_WORDS 3456
#define XB_SPIN_CAP (1u << 18)

__device__ __forceinline__ unsigned xb_ld(unsigned* p)              { return __hip_atomic_load(p, __ATOMIC_RELAXED, __HIP_MEMORY_SCOPE_AGENT); }
__device__ __forceinline__ unsigned xb_add(unsigned* p, unsigned v) { return __hip_atomic_fetch_add(p, v, __ATOMIC_RELAXED, __HIP_MEMORY_SCOPE_AGENT); }
__device__ __forceinline__ unsigned xb_xcc_id() { return (unsigned)__builtin_amdgcn_s_getreg((3 << 11) | 20) & 0xFu; }
#define XB_SPIN(cond, bar) do { unsigned _sp = 0; while (cond) { __builtin_amdgcn_s_sleep(1); \
    if ((++_sp & 255u) == 0u) { if (xb_ld(&(bar)[XB_TMO])) break; if (_sp > XB_SPIN_CAP) { atomicAdd(&(bar)[XB_TMO], 1u); break; } } } } while (0)

struct XcdBarrier {
    unsigned* bar; unsigned x;
    volatile LAS unsigned* st;
};

__device__ __forceinline__ XcdBarrier xcd_barrier_post(unsigned* bar, volatile LAS unsigned* st) {
    XcdBarrier b; b.bar = bar; b.x = xb_xcc_id(); b.st = st;
    if (threadIdx.x == 0) (void)xb_add(&bar[XB_XCNT(b.x)], 1u);
    return b;
}
__device__ __forceinline__ void xcd_barrier_complete(unsigned* bar, unsigned x, unsigned& nloc, unsigned& nx) {
    const unsigned G = gridDim.x * gridDim.y * gridDim.z;
    unsigned sum, cnt, mine, sp = 0u;
    for (;;) {
        sum = 0u; cnt = 0u; mine = 0u;
#pragma unroll
        for (unsigned j = 0; j < 16; ++j) { const unsigned c = xb_ld(&bar[XB_XCNT(j)]); sum += c; cnt += (c > 0u) ? 1u : 0u; mine = (j == x) ? c : mine; }
        if (sum == G) break;
        __builtin_amdgcn_s_sleep(1);
        if ((++sp & 255u) == 0u) { if (xb_ld(&bar[XB_TMO])) break; if (sp > XB_SPIN_CAP) { atomicAdd(&bar[XB_TMO], 1u); break; } }
    }
    nloc = mine > 0u ? mine : 1u; nx = cnt > 0u ? cnt : 1u;
}

__device__ __forceinline__ void xcd_barrier(const XcdBarrier& b) {
    asm volatile("s_waitcnt vmcnt(0)" ::: "memory");
    __syncthreads();
    if (threadIdx.x == 0) {
        unsigned* bar = b.bar;
        __builtin_amdgcn_s_waitcnt(0);
        unsigned nloc = b.st[0], nx = b.st[1];
        if (nloc == 0u) { xcd_barrier_complete(bar, b.x, nloc, nx); b.st[0] = nloc; b.st[1] = nx; }
        const unsigned old = xb_add(&bar[XB_XSUB(b.x)], 1u);
        const unsigned gen = old / nloc;
        if (old + 1u == (gen + 1u) * nloc) {
            __builtin_amdgcn_fence(__ATOMIC_RELEASE, "agent");
            asm volatile("s_waitcnt vmcnt(0)" ::: "memory");
            const unsigned og = xb_add(&bar[XB_TOP], 1u);
            const unsigned tg = og / nx;
            if (og + 1u == (tg + 1u) * nx) xb_add(&bar[XB_TOPGEN], 1u);
            else XB_SPIN(xb_ld(&bar[XB_TOPGEN]) == tg, bar);
            __builtin_amdgcn_fence(__ATOMIC_ACQUIRE, "agent");
            xb_add(&bar[XB_XGEN(b.x)], 1u);
            asm volatile("s_waitcnt vmcnt(0)" ::: "memory");
        } else {
            XB_SPIN(xb_ld(&bar[XB_XGEN(b.x)]) == gen, bar);
            __builtin_amdgcn_fence(__ATOMIC_ACQUIRE, "agent");
            asm volatile("s_waitcnt vmcnt(0)" ::: "memory");
        }
    }
    __syncthreads();
}

struct Args { const float* in[32]; float* out; unsigned char* ws; int ph_lo, ph_hi, coop, pad; };

__global__ void __launch_bounds__(NTHREADS, 2) mk_fwd(Args args) {
    extern __shared__ __attribute__((aligned(16))) unsigned char lds_raw[];
    Frame F;
    F.lds = (LAS unsigned char*)lds_raw;
    F.tid = threadIdx.x; F.lane = F.tid & 63; F.wave = __builtin_amdgcn_readfirstlane(F.tid >> 6);
    F.G = gridDim.x; { const int bx = blockIdx.x; F.vcu = (F.G % 8 == 0) ? (bx % 8) * (F.G / 8) + bx / 8 : bx; }
    F.in = args.in;
    F.out = args.out; F.ws = args.ws;
    unsigned char* ws = args.ws;
    const int lo = args.ph_lo, hi = args.ph_hi;
    volatile LAS unsigned* MISC = (volatile LAS unsigned*)(F.lds + 131072 + 512);
    if (F.tid < 32) MISC[F.tid] = 0u;
    __syncthreads();
    XcdBarrier bar = xcd_barrier_post((unsigned*)ws, MISC + 8);
#ifndef PHMASK
#define PHMASK 0x3ffff
#endif
#define IN(k) ((((PHMASK) >> (k)) & 1) && lo <= (k) && (k) < hi)
#define SEAM(k) do { if (IN(k) && IN((k) + 1)) { xcd_barrier(bar); } } while (0)
    typedef pg8::bf16_t gb;

    if (IN(0)) { p0_prologue(F); } SEAM(0);
    if (IN(1)) {
        pg8::Gemm g{(const gb*)(ws + WS_XB), (const gb*)(ws + WS_WIN), T, INP, D, D, D, 0}; pg8::StaticOrder S; S.init(T, INP, F.G, (int)blockIdx.x);
        EpiProj E{(bf16*)(ws + WS_PROJA), (bf16*)(ws + WS_PROJB)};
        pg8::gemm_phase<EpiProj, pg8::StaticOrder, true, true>(F.lds, g, S, E);
    } SEAM(1);
    if (IN(2)) { p2_rows(F); } SEAM(2);
    if (IN(3)) {
        pg8::Gemm g{(const gb*)(ws + WS_LA), (const gb*)(ws + WS_LORAT), T, 1536, 256, 256, 256, 0}; pg8::StaticOrder S; S.init(T, 1536, F.G, (int)blockIdx.x);
        EpiLora E{F.in[12], F.in[14], F.in[18], (h16*)(ws + WS_SCW), (h16*)(ws + WS_SCK), (h16*)(ws + WS_SCKK), (h16*)(ws + WS_SCB), (h16*)(ws + WS_G)};
        pg8::gemm_phase<EpiLora, pg8::StaticOrder, true, true>(F.lds, g, S, E);
    } SEAM(3);
    if (IN(4)) { conv_phase(F); }
    if (IN(5)) { scan_phase(F); } SEAM(5);
    if (IN(6)) { p6_rows(F); } SEAM(6);
    if (IN(7)) {
        pg8::Gemm g{(const gb*)(ws + WS_CAT), (const gb*)(ws + WS_WOUT), T, D, D, D, D, 0}; pg8::StaticOrder S; S.init(T, D, F.G, (int)blockIdx.x);
        EpiResid E{F.in[0], F.in[1], (float*)(ws + WS_Z), nullptr};
        pg8::gemm_phase<EpiResid, pg8::StaticOrder, true, true>(F.lds, g, S, E);
    } SEAM(7);
    if (IN(8)) { ln_rows<0>(F, F.in[25], F.in[26]); } SEAM(8);
#define FFN_PHASES(layer, pgu, pdn) \
    if (IN(pgu)) { \
        pg8::Gemm g{(const gb*)(ws + WS_XB), (const gb*)(ws + ((layer) ? WS_WGU1 : WS_WGU0)), T, 2 * FF, D, D, D, 0}; pg8::StaticOrder S; S.init(T, 2 * FF, F.G, (int)blockIdx.x); \
        EpiGateUp E{(bf16*)(ws + WS_H)}; \
        pg8::gemm_phase<EpiGateUp, pg8::StaticOrder, true, true>(F.lds, g, S, E); \
    } SEAM(pgu); \
    if (IN(pdn)) { \
        pg8::Gemm g{(const gb*)(ws + WS_H), (const gb*)(ws + ((layer) ? WS_WD1 : WS_WD0)), T, D, FF, FF, FF, 0}; pg8::StaticOrder S; S.init(T, D, F.G, (int)blockIdx.x); \
        EpiResid E{nullptr, nullptr, (float*)(ws + WS_Z), nullptr}; \
        pg8::gemm_phase<EpiResid, pg8::StaticOrder, true, true>(F.lds, g, S, E); \
    } SEAM(pdn);
    FFN_PHASES(0, 9, 10)
    if (IN(11)) { ln_rows<1>(F, F.in[30], F.in[31]); } SEAM(11);
    if (IN(12)) { pool_phase(F); } SEAM(12);
    if (IN(13)) {
        pg8::Gemm g{(const gb*)(ws + WS_PL), (const gb*)(ws + WS_POOLT), T, D, 256, D, 256, 256}; pg8::StaticOrder S; S.init(T, D, F.G, (int)blockIdx.x);
        EpiResid E{nullptr, nullptr, (float*)(ws + WS_Z), F.in[24]};
        pg8::gemm_phase<EpiResid, pg8::StaticOrder, true, true>(F.lds, g, S, E);
    } SEAM(13);
    if (IN(14)) { ln_rows<0>(F, F.in[25] + D, F.in[26] + D); } SEAM(14);
    FFN_PHASES(1, 15, 16)
    if (IN(17)) { ln_rows<2>(F, F.in[30] + D, F.in[31] + D); }
    if (lo == 100) diag_checks(F, args.pad);
    if (lo == 101) diag_fill(F);
#undef IN
#undef SEAM
}

extern "C" void kernel_launch(void* const* d_in, const int* in_sizes, int n_in, void* d_out, int out_size, void* d_ws, size_t ws_size, hipStream_t stream) {
    static int grid = 0;
    if (grid == 0) {
        if (n_in != 32 || out_size != (int)O_TOTAL || ws_size < WS_END) { fprintf(stderr, "kernel_launch: unexpected shapes: n_in %d out %d ws %zu\n", n_in, out_size, ws_size); grid = -1; return; }
        int dev = 0, cus = 0, per_cu = 0;
        if (hipGetDevice(&dev) != hipSuccess || hipDeviceGetAttribute(&cus, hipDeviceAttributeMultiprocessorCount, dev) != hipSuccess) { grid = -1; return; }
        if (hipFuncSetAttribute((const void*)mk_fwd, hipFuncAttributeMaxDynamicSharedMemorySize, LDS_BYTES) != hipSuccess) { fprintf(stderr, "kernel_launch: hipFuncSetAttribute failed\n"); grid = -1; return; }
        if (hipOccupancyMaxActiveBlocksPerMultiprocessor(&per_cu, (const void*)mk_fwd, NTHREADS, LDS_BYTES) != hipSuccess || per_cu < 1) { fprintf(stderr, "kernel_launch: occupancy query says %d\n", per_cu); (void)hipGetLastError(); per_cu = 1; }
        grid = cus * 1;
        if (per_cu < 1) grid = -1;
    }
    if (grid < 0) return;
    Args a{};
    for (int i = 0; i < 32; ++i) a.in[i] = (const float*)d_in[i];
    a.out = (float*)d_out; a.ws = (unsigned char*)d_ws;
#if MK_SINGLE
    if (hipMemsetAsync(d_ws, 0, 16384, stream) != hipSuccess) { fprintf(stderr, "kernel_launch: memset failed\n"); return; }
    a.ph_lo = 0; a.ph_hi = NPHASE; a.coop = 1;
    void* params[] = {&a};
    hipError_t e = hipLaunchCooperativeKernel((const void*)mk_fwd, dim3(grid), dim3(NTHREADS), params, LDS_BYTES, stream);
    if (e != hipSuccess) fprintf(stderr, "kernel_launch: cooperative launch failed: %s (grid %d)\n", hipGetErrorString(e), grid);
#else
    for (int p = 0; p < NPHASE; ++p) {
        if (DIAG_AT >= 0 && p > DIAG_AT) break;
        a.ph_lo = p; a.ph_hi = p + 1; a.coop = 0;
        hipLaunchKernelGGL(mk_fwd, dim3(grid), dim3(NTHREADS), LDS_BYTES, stream, a);
    }
    if (DIAG_AT >= 0) { a.pad = DIAG_AT; a.ph_lo = 100; a.ph_hi = 101; hipLaunchKernelGGL(mk_fwd, dim3(grid), dim3(NTHREADS), LDS_BYTES, stream, a);
                        a.ph_lo = 101; a.ph_hi = 102; hipLaunchKernelGGL(mk_fwd, dim3(grid), dim3(NTHREADS), LDS_BYTES, stream, a); }
#endif
}
```

```cpp
#include <hip/hip_runtime.h>
#include <hip/hip_cooperative_groups.h>
#include <cstdio>
#include <cstdint>
namespace cg = cooperative_groups;
namespace pg8 {
#define PG8_LAS __attribute__((address_space(3)))
typedef unsigned short bf16_t;
typedef short bf16x8 __attribute__((ext_vector_type(8)));
typedef float f32x4 __attribute__((ext_vector_type(4)));
typedef unsigned u32x4 __attribute__((ext_vector_type(4)));
constexpr int BM = 256, BK = 64, HALF = 128, HTB = HALF * BK * 2  , STAGE_BYTES = 8 * HTB, NXCD = 8, WGM = 8;

__host__ __device__ __forceinline__ int lds_byte(int r, int c) { const int st = (r >> 4) * 2 + (c >> 5), rr = r & 15, cc = c & 31, ob = rr * 64 + cc * 2; return st * 1024 + (ob ^ (((ob >> 9) & 1) << 5)); }
__host__ __device__ __forceinline__ void stage_rc(int b, int& R, int& C) { const int st = b / 1024, sb = b % 1024, swz = sb ^ (((sb >> 9) & 1) << 5); R = (st >> 1) * 16 + swz / 64; C = (st & 1) * 32 + (swz % 64) / 2; }
__host__ __device__ __forceinline__ int perm32(int rho) { const int n = rho >> 4, i = rho & 15; return 8 * (i >> 2) + 4 * n + (i & 3); }

struct Unit { int pm, pn, kt0, nt, mode; };
struct Gemm { const bf16_t* A; const bf16_t* Bt; int M, N, K, lda, ldb, acol; };

struct StaticOrder {
    int nM, nN, nwg, G, c, ntf;
    __host__ __device__ void init(int M, int N, int G_, int c_, int K_) { nM = M / BM; nN = N / BM; nwg = nM * nN; G = G_; c = c_; ntf = K_ / BK; }
    __host__ __device__ bool next(int i, Unit& u) const {
        const long L = (long)i * G + c; if (L >= nwg) return false;
        int wgid = (int)L; { const int q = nwg / NXCD, r = nwg % NXCD, xcd = wgid % NXCD, off = wgid / NXCD; wgid = (xcd < r ? xcd * (q + 1) : r * (q + 1) + (xcd - r) * q) + off; }
        const int nig = WGM * nN, gid = wgid / nig, fm = gid * WGM, gsz = (nM - fm) < WGM ? (nM - fm) : WGM;
        u.pm = fm + ((wgid % nig) % gsz); u.pn = (wgid % nig) / gsz; u.kt0 = 0; u.nt = ntf; u.mode = 0; return true;
    }
    __device__ __forceinline__ void a_ready(const Unit&) const {}
    __device__ __forceinline__ void done(const Unit&) const {}
};

__device__ __forceinline__ unsigned cvt_pk_bf16(float lo, float hi) { unsigned r; asm volatile("v_cvt_pk_bf16_f32 %0, %1, %2" : "=v"(r) : "v"(lo), "v"(hi)); return r; }
template <class Epi, class Sched, bool ALIGN_EPI = false, bool SP2 = false>
__device__ __forceinline__ void gemm_phase(PG8_LAS unsigned char* lds, const Gemm g, const Sched& S, const Epi& E) {
    const int tid = threadIdx.x, wid = __builtin_amdgcn_readfirstlane(tid >> 6), lane = tid & 63, wr = wid >> 2, wc = wid & 3, fr = lane & 15, fq = lane >> 4;
    const int K = g.K; (void)K;
    unsigned voffA[2], voffB[2];
#pragma unroll
    for (int i = 0; i < 2; ++i) { int R, C; stage_rc(tid * 16 + i * 8192, R, C); const int Rb = Epi::PERM ? ((R & ~31) + perm32(R & 31)) : R;
        voffA[i] = (unsigned)(R * g.lda + C) * 2u; voffB[i] = (unsigned)(Rb * g.ldb + C) * 2u; }
    const size_t kstep = (size_t)(BK * 2);
    const size_t hstepA = (size_t)HALF * g.lda * 2, hstepB = (size_t)HALF * g.ldb * 2;
    const size_t tstepA = 2 * hstepA, tstepB = 2 * hstepB; const size_t acolB = (size_t)g.acol * 2;
    const unsigned ldsw = (unsigned)wid * 1024u;
    const int aoff = lds_byte(wr * 64 + fr, fq * 8), boff = lds_byte(wc * 32 + fr, fq * 8);
#define PG8_SA(b, h) (((b) * 2 + (h)) * HTB)
#define PG8_SB(b, h) ((4 + (b) * 2 + (h)) * HTB)
#define PG8_STAGE(bufoff, gbase, voff) do { _Pragma("unroll") for (int _i = 0; _i < 2; ++_i) \
        __builtin_amdgcn_global_load_lds((const unsigned*)((const char*)(gbase) + (voff)[_i]), (PG8_LAS unsigned*)(lds + (bufoff) + ldsw + _i * 8192), 16, 0, 0); } while (0)
#define PG8_LDA(dst, b, h) do { _Pragma("unroll") for (int m = 0; m < 4; ++m) _Pragma("unroll") for (int k = 0; k < 2; ++k) dst[m][k] = *(const PG8_LAS bf16x8*)(lds + PG8_SA(b, h) + aoff + m * 2048 + k * 1024); } while (0)
#define PG8_LDB(dst, b, h) do { _Pragma("unroll") for (int n = 0; n < 2; ++n) _Pragma("unroll") for (int k = 0; k < 2; ++k) dst[n][k] = *(const PG8_LAS bf16x8*)(lds + PG8_SB(b, h) + boff + n * 2048 + k * 1024); } while (0)
#define PG8_MMA(ai, bj, At, Bt) do { __builtin_amdgcn_s_setprio(1); _Pragma("unroll") for (int m = 0; m < 4; ++m) _Pragma("unroll") for (int n = 0; n < 2; ++n) _Pragma("unroll") for (int k = 0; k < 2; ++k) \
        acc[ai][bj][m][n] = __builtin_amdgcn_mfma_f32_16x16x32_bf16(Bt[n][k], At[m][k], acc[ai][bj][m][n], 0, 0, 0); __builtin_amdgcn_s_setprio(0); } while (0)
#define PG8_WAIT_V(n) asm volatile("s_waitcnt vmcnt(" #n ")" ::: "memory")
#define PG8_WAIT_L(n) asm volatile("s_waitcnt lgkmcnt(" #n ")" ::: "memory")
#define PG8_BAR __builtin_amdgcn_s_barrier()
#define PG8_SCHED __builtin_amdgcn_sched_barrier(0)
    Unit cur, nxt; int ui = 0;
    if (!S.next(0, cur)) return;
    f32x4 acc[2][2][4][2];
#pragma unroll
    for (int a = 0; a < 2; ++a)
#pragma unroll
        for (int b = 0; b < 2; ++b)
#pragma unroll
            for (int m = 0; m < 4; ++m)
#pragma unroll
                for (int n = 0; n < 2; ++n) acc[a][b][m][n] = (f32x4){0.f, 0.f, 0.f, 0.f};
    bf16x8 At[4][2], B0[2][2], B1[2][2];
    const char* cA = (const char*)g.A + (size_t)cur.pm * tstepA + (size_t)cur.pn * acolB + (size_t)cur.kt0 * kstep; const char* cB = (const char*)g.Bt + (size_t)cur.pn * tstepB + (size_t)cur.kt0 * kstep;
    S.a_ready(cur);
    if constexpr (SP2) {
        PG8_STAGE(PG8_SB(0, 0), cB, voffB); PG8_STAGE(PG8_SB(0, 1), cB + hstepB, voffB); PG8_STAGE(PG8_SA(0, 0), cA, voffA); PG8_STAGE(PG8_SA(0, 1), cA + hstepA, voffA);
        if (wr == 1) PG8_BAR;
        PG8_WAIT_V(2); PG8_BAR;
        PG8_STAGE(PG8_SB(1, 0), cB + kstep, voffB); PG8_STAGE(PG8_SA(1, 0), cA + kstep, voffA); PG8_STAGE(PG8_SB(1, 1), cB + hstepB + kstep, voffB);
        PG8_WAIT_V(6); PG8_BAR;
    } else {
        PG8_STAGE(PG8_SB(0, 0), cB, voffB); PG8_STAGE(PG8_SA(0, 0), cA, voffA); PG8_STAGE(PG8_SB(0, 1), cB + hstepB, voffB); PG8_STAGE(PG8_SA(0, 1), cA + hstepA, voffA);
        if (wr == 1) PG8_BAR;
        PG8_WAIT_V(4); PG8_BAR;
        PG8_STAGE(PG8_SB(1, 0), cB + kstep, voffB); PG8_STAGE(PG8_SA(1, 0), cA + kstep, voffA); PG8_STAGE(PG8_SB(1, 1), cB + hstepB + kstep, voffB);
        PG8_WAIT_V(6); PG8_BAR;
    }
    for (;;) {
        const bool has_next = S.next(ui + 1, nxt);
        const char* nA = has_next ? (const char*)g.A + (size_t)nxt.pm * tstepA + (size_t)nxt.pn * acolB + (size_t)nxt.kt0 * kstep : cA; const char* nB = has_next ? (const char*)g.Bt + (size_t)nxt.pn * tstepB + (size_t)nxt.kt0 * kstep : cB;
        const int nt = cur.nt;
        _Pragma("unroll 1") for (int t = 0; t < nt; t += 2) {
            const bool last = (t == nt - 2);
            const char* a1 = cA + (size_t)(t + 1) * kstep;
            const char* a2 = last ? nA : cA + (size_t)(t + 2) * kstep; const char* b2 = last ? nB : cB + (size_t)(t + 2) * kstep;
            const char* a3 = a2 + kstep; const char* b3 = b2 + kstep;
            if (last && has_next) S.a_ready(nxt);
            if constexpr (SP2) {
            PG8_LDB(B0, 0, 0); PG8_LDB(B1, 0, 1); PG8_SCHED; PG8_LDA(At, 0, 0); PG8_STAGE(PG8_SA(1, 1), a1 + hstepA, voffA);
            PG8_WAIT_V(8); PG8_WAIT_L(0); PG8_BAR; PG8_MMA(0, 0, At, B0); PG8_MMA(0, 1, At, B1); PG8_BAR; PG8_SCHED;
            PG8_LDA(At, 0, 1); PG8_STAGE(PG8_SB(0, 0), b2, voffB); PG8_STAGE(PG8_SB(0, 1), b2 + hstepB, voffB); PG8_STAGE(PG8_SA(0, 0), a2, voffA);
            PG8_WAIT_V(8); PG8_WAIT_L(0); PG8_BAR; PG8_MMA(1, 0, At, B0); PG8_MMA(1, 1, At, B1); PG8_BAR; PG8_SCHED;
            PG8_LDB(B0, 1, 0); PG8_LDB(B1, 1, 1); PG8_SCHED; PG8_LDA(At, 1, 0); PG8_STAGE(PG8_SA(0, 1), a2 + hstepA, voffA);
            PG8_WAIT_V(8); PG8_WAIT_L(0); PG8_BAR; PG8_MMA(0, 0, At, B0); PG8_MMA(0, 1, At, B1); PG8_BAR; PG8_SCHED;
            PG8_LDA(At, 1, 1); PG8_STAGE(PG8_SB(1, 0), b3, voffB); PG8_STAGE(PG8_SB(1, 1), b3 + hstepB, voffB); PG8_STAGE(PG8_SA(1, 0), a3, voffA);
            PG8_WAIT_V(8); PG8_WAIT_L(0); PG8_BAR; PG8_MMA(1, 0, At, B0); PG8_MMA(1, 1, At, B1); PG8_BAR; PG8_SCHED;
            } else {
            PG8_LDB(B0, 0, 0); PG8_SCHED; PG8_LDA(At, 0, 0); PG8_STAGE(PG8_SA(1, 1), a1 + hstepA, voffA);
            PG8_WAIT_L(8); PG8_BAR; PG8_WAIT_L(0); PG8_MMA(0, 0, At, B0); PG8_BAR; PG8_SCHED;
            PG8_LDB(B1, 0, 1); PG8_STAGE(PG8_SB(0, 0), b2, voffB);
            PG8_BAR; PG8_WAIT_L(0); PG8_MMA(0, 1, At, B1); PG8_BAR;
            PG8_LDA(At, 0, 1); PG8_STAGE(PG8_SA(0, 0), a2, voffA);
            PG8_BAR; PG8_WAIT_L(0); PG8_MMA(1, 0, At, B0); PG8_BAR; PG8_SCHED;
            PG8_STAGE(PG8_SB(0, 1), b2 + hstepB, voffB);
            PG8_WAIT_V(6); PG8_BAR; PG8_MMA(1, 1, At, B1); PG8_BAR;
            PG8_LDB(B0, 1, 0); PG8_SCHED; PG8_LDA(At, 1, 0); PG8_STAGE(PG8_SA(0, 1), a2 + hstepA, voffA);
            PG8_WAIT_L(8); PG8_BAR; PG8_WAIT_L(0); PG8_MMA(0, 0, At, B0); PG8_BAR; PG8_SCHED;
            PG8_LDB(B1, 1, 1); PG8_STAGE(PG8_SB(1, 0), b3, voffB);
            PG8_BAR; PG8_WAIT_L(0); PG8_MMA(0, 1, At, B1); PG8_BAR;
            PG8_LDA(At, 1, 1); PG8_STAGE(PG8_SA(1, 0), a3, voffA);
            PG8_BAR; PG8_WAIT_L(0); PG8_MMA(1, 0, At, B0); PG8_BAR; PG8_SCHED;
            PG8_STAGE(PG8_SB(1, 1), b3 + hstepB, voffB);
            PG8_WAIT_V(6); PG8_BAR; PG8_MMA(1, 1, At, B1); PG8_BAR;
            }
        }
        if constexpr (ALIGN_EPI) { if (wr == 0) PG8_BAR; }
        if constexpr (!Epi::AFTER_DRAIN) { E(acc, cur, wr, wc, fr, fq); S.done(cur); }
        if (!has_next) break;
#pragma unroll
        for (int a = 0; a < 2; ++a)
#pragma unroll
            for (int b = 0; b < 2; ++b)
#pragma unroll
                for (int m = 0; m < 4; ++m)
#pragma unroll
                    for (int n = 0; n < 2; ++n) acc[a][b][m][n] = (f32x4){0.f, 0.f, 0.f, 0.f};
        cur = nxt; cA = nA; cB = nB; ++ui;
        if constexpr (ALIGN_EPI) { if (wr == 1) PG8_BAR; }
    }
    PG8_WAIT_V(0);
    if constexpr (!ALIGN_EPI) { if (wr == 0) PG8_BAR; }
    PG8_BAR;
    if constexpr (Epi::AFTER_DRAIN) { E.fused(acc, cur, wr, wc, fr, fq, lds, wid, lane); S.done(cur); }
#undef PG8_SA
#undef PG8_SB
#undef PG8_STAGE
#undef PG8_LDA
#undef PG8_LDB
#undef PG8_MMA
#undef PG8_WAIT_V
#undef PG8_WAIT_L
#undef PG8_BAR
#undef PG8_SCHED
}
}

#define GAS __attribute__((address_space(1)))
#define LAS __attribute__((address_space(3)))
typedef unsigned short bf16;
typedef unsigned v4u __attribute__((ext_vector_type(4)));
typedef unsigned v2u __attribute__((ext_vector_type(2)));
typedef float f32x4 __attribute__((ext_vector_type(4)));
typedef _Float16 h16;
typedef _Float16 h16x2 __attribute__((ext_vector_type(2)));

#ifndef MK_SINGLE
#define MK_SINGLE 1
#endif

constexpr int NWAVES = 8, NTHREADS = NWAVES * 64;
constexpr int D = 1024, TP = 16384, TS = 1024, T = TP + TS, LP = 2048, LS = 8, NPB = 8, NSB = 128;
constexpr int INP = 2816, BP = 1792, FF = 2816, HW = 512;
constexpr float ALPHA = 1.41421356237309515f, LN_EPS = 1e-5f, GN_EPS = 64e-5f;
constexpr int NPHASE = 18;

constexpr size_t MiB = 1u << 20;
constexpr size_t WS_WIN = 1 * MiB, WS_WOUT = WS_WIN + 5632 * 1024, WS_WGU0 = WS_WOUT + 2 * MiB, WS_WGU1 = WS_WGU0 + 11 * MiB, WS_WD0 = WS_WGU1 + 11 * MiB, WS_WD1 = WS_WD0 + 5632 * 1024,
                 WS_POOLT = WS_WD1 + 5632 * 1024, WS_LORAT = WS_POOLT + 512 * 1024;
constexpr size_t WS_XB = 43 * MiB;
constexpr size_t WS_SCW = 43 * MiB, WS_G = 60 * MiB;
constexpr size_t WS_PROJA = 77 * MiB;
constexpr size_t WS_PROJB = 111 * MiB;
constexpr size_t WS_CAT = 111 * MiB, WS_SCB = 145 * MiB, WS_O = 162 * MiB;
constexpr size_t WS_LA = 170 * MiB + 512 * 1024;
constexpr size_t WS_SCR = 179 * MiB, WS_SCV = 196 * MiB, WS_SCK = 213 * MiB, WS_SCKK = 230 * MiB;
constexpr size_t WS_Z = 188 * MiB;
constexpr size_t WS_H = 77 * MiB;
constexpr size_t WS_PL = 77 * MiB;
constexpr size_t WS_PART7 = 145 * MiB;
constexpr size_t WS_PARTA = 43 * MiB, WS_PARTB = 170 * MiB + 512 * 1024;
constexpr size_t WS_END = 256 * MiB;
static_assert(WS_LORAT + 1536 * 256 * 2 <= WS_XB, "weights");
static_assert(WS_PROJB + (size_t)T * BP * 2 <= WS_LA, "projb");
static_assert(WS_H + (size_t)T * FF * 2 <= WS_Z, "h");
static_assert(WS_Z + (size_t)T * D * 4 <= WS_END, "z");

constexpr size_t O_Y = 0, O_CONV_P = 17825792, O_SHIFT_P = 17948672, O_WKV_P = 17963008, O_POOL_P = 18225152,
                 O_CONV_S = 18348032, O_SHIFT_S = 20314112, O_WKV_S = 20543488, O_POOL_S = 24737792, O_TOTAL = 26703872;

constexpr int LDS_BYTES = 147456;

struct Frame {
    LAS unsigned char* lds;
    int tid, lane, wave, vcu, G;
    const float* const* in;
    float* out; unsigned char* ws;
};

__device__ __forceinline__ float bf2f(unsigned b) { return __uint_as_float(b << 16); }
__device__ __forceinline__ unsigned pkbf(float lo, float hi) { return pg8::cvt_pk_bf16(lo, hi); }
__device__ __forceinline__ unsigned pkh(float lo, float hi) { const unsigned short a = __builtin_bit_cast(unsigned short, (h16)lo), b = __builtin_bit_cast(unsigned short, (h16)hi); return (unsigned)a | ((unsigned)b << 16); }
__device__ __forceinline__ float hlo(unsigned u) { return (float)__builtin_bit_cast(h16, (unsigned short)(u & 0xffffu)); }
__device__ __forceinline__ float hhi(unsigned u) { return (float)__builtin_bit_cast(h16, (unsigned short)(u >> 16)); }
__device__ __forceinline__ void unpack_bf8(v4u w, float (&f)[8]) { const unsigned u0 = w.x, u1 = w.y, u2 = w.z, u3 = w.w;
    f[0] = __uint_as_float(u0 << 16); f[1] = __uint_as_float(u0 & 0xffff0000u); f[2] = __uint_as_float(u1 << 16); f[3] = __uint_as_float(u1 & 0xffff0000u);
    f[4] = __uint_as_float(u2 << 16); f[5] = __uint_as_float(u2 & 0xffff0000u); f[6] = __uint_as_float(u3 << 16); f[7] = __uint_as_float(u3 & 0xffff0000u); }
__device__ __forceinline__ void unpack_h8(v4u w, float (&f)[8]) { const unsigned u0 = w.x, u1 = w.y, u2 = w.z, u3 = w.w; f[0] = hlo(u0); f[1] = hhi(u0); f[2] = hlo(u1); f[3] = hhi(u1); f[4] = hlo(u2); f[5] = hhi(u2); f[6] = hlo(u3); f[7] = hhi(u3); }
__device__ __forceinline__ v4u pack_bf8(const float (&f)[8]) { v4u w; w.x = pkbf(f[0], f[1]); w.y = pkbf(f[2], f[3]); w.z = pkbf(f[4], f[5]); w.w = pkbf(f[6], f[7]); return w; }
__device__ __forceinline__ v4u pack_h8(const float (&f)[8]) { v4u w; w.x = pkh(f[0], f[1]); w.y = pkh(f[2], f[3]); w.z = pkh(f[4], f[5]); w.w = pkh(f[6], f[7]); return w; }
__device__ __forceinline__ void load_f8(const float* p, float (&f)[8]) { const f32x4 a = *(const f32x4*)p, b = *(const f32x4*)(p + 4); f[0] = a.x; f[1] = a.y; f[2] = a.z; f[3] = a.w; f[4] = b.x; f[5] = b.y; f[6] = b.z; f[7] = b.w; }
__device__ __forceinline__ void store_f8(float* p, const float (&f)[8]) { *(f32x4*)p = (f32x4){f[0], f[1], f[2], f[3]}; *(f32x4*)(p + 4) = (f32x4){f[4], f[5], f[6], f[7]}; }
__device__ __forceinline__ float sigmoid_(float x) { return __builtin_amdgcn_rcpf(1.f + __expf(-x)); }
__device__ __forceinline__ float silu_(float x) { return x * sigmoid_(x); }
__device__ __forceinline__ float wave_sum(float v) {
#pragma unroll
    for (int o = 1; o < 64; o <<= 1) v += __shfl_xor(v, o);
    return v;
}
__device__ __forceinline__ float sum8(float v) { v += __shfl_xor(v, 1); v += __shfl_xor(v, 2); v += __shfl_xor(v, 4); return v; }
template <int CTRL> __device__ __forceinline__ float dppf(float x) { return __builtin_bit_cast(float, __builtin_amdgcn_update_dpp(0, __builtin_bit_cast(int, x), CTRL, 0xF, 0xF, true)); }
__device__ __forceinline__ float dpp_sum16(float x) {
    x += dppf<0xB1>(x);
    x += dppf<0x4E>(x);
    x += dppf<0x141>(x);
    x += dppf<0x140>(x);
    return x;
}
__device__ __forceinline__ void h4(v2u x, float (&f)[4]) { const unsigned u0 = x.x, u1 = x.y; f[0] = hlo(u0); f[1] = hhi(u0); f[2] = hlo(u1); f[3] = hhi(u1); }
__device__ __forceinline__ const float* xrow_ptr(const Frame& F, int m) { return m < TP ? F.in[0] + (size_t)m * D : F.in[1] + (size_t)(m - TP) * D; }

using pg8::Unit; using pg8::HALF; using pg8::BM;
typedef pg8::u32x4 u32x4;
struct EpiProj {
    static constexpr bool PERM = true, AFTER_DRAIN = false;
    bf16* PA; bf16* PB;
    __device__ __forceinline__ void operator()(const pg8::f32x4 (&acc)[2][2][4][2], const Unit& u, int wr, int wc, int fr, int fq) const {
        const int row0 = u.pm * BM + wr * 64 + fr;
        bf16* base; int ldc, colt;
        if (u.pn < 4) { base = PA; ldc = 1024; colt = u.pn * BM; } else { base = PB; ldc = BP; colt = (u.pn - 4) * BM; }
        const int col0 = colt + wc * 32 + 8 * fq;
#pragma unroll
        for (int ai = 0; ai < 2; ++ai)
#pragma unroll
            for (int m = 0; m < 4; ++m) { bf16* rowp = base + (size_t)(row0 + ai * HALF + m * 16) * ldc + col0;
#pragma unroll
                for (int bj = 0; bj < 2; ++bj) { const pg8::f32x4 v0 = acc[ai][bj][m][0], v1 = acc[ai][bj][m][1];
                    u32x4 w; w.x = pkbf(v0[0], v0[1]); w.y = pkbf(v0[2], v0[3]); w.z = pkbf(v1[0], v1[1]); w.w = pkbf(v1[2], v1[3]);
                    *(u32x4*)(rowp + bj * HALF) = w; } }
    }
};
struct EpiLora {
    static constexpr bool PERM = true, AFTER_DRAIN = false;
    const float* w0; const float* a0; const float* ka;
    h16* SCW; h16* SCK; h16* SCKK; h16* SCB; h16* G;
    __device__ __forceinline__ void operator()(const pg8::f32x4 (&acc)[2][2][4][2], const Unit& u, int wr, int wc, int fr, int fq) const {
        const int row0 = u.pm * BM + wr * 64 + fr; const int sec = u.pn >> 1;
        const int c0 = (u.pn & 1) * BM + wc * 32 + 8 * fq;
#pragma unroll
        for (int bj = 0; bj < 2; ++bj)
#pragma unroll
            for (int n = 0; n < 2; ++n) {
                const int c = c0 + bj * HALF + 4 * n;
                f32x4 p0 = {0.f, 0.f, 0.f, 0.f}, p1 = {0.f, 0.f, 0.f, 0.f};
                if (sec == 0) p0 = *(const f32x4*)(w0 + c); else if (sec == 1) { p0 = *(const f32x4*)(a0 + c); p1 = *(const f32x4*)(ka + c); }
#pragma unroll
                for (int ai = 0; ai < 2; ++ai)
#pragma unroll
                    for (int m = 0; m < 4; ++m) {
                        const size_t off = (size_t)(row0 + ai * HALF + m * 16) * HW + c;
                        const pg8::f32x4 v = acc[ai][bj][m][n];
                        if (sec == 0) {
                            float o[4];
#pragma unroll
                            for (int i = 0; i < 4; ++i) { const float e = 0.60653065971f * sigmoid_(p0[i] + v[i]); o[i] = 1.f - __expf(-e); }
                            v2u w; w.x = pkh(o[0], o[1]); w.y = pkh(o[2], o[3]); *(v2u*)(SCW + off) = w;
                        } else if (sec == 1) {
                            float kx[4], kk[4], ko[4], bo[4];
                            h4(*(const v2u*)(SCK + off), kx); h4(*(const v2u*)(SCKK + off), kk);
#pragma unroll
                            for (int i = 0; i < 4; ++i) { const float a = sigmoid_(p0[i] + v[i]); ko[i] = kx[i] * (1.f + (a - 1.f) * p1[i]); bo[i] = kk[i] * a; }
                            v2u w; w.x = pkh(ko[0], ko[1]); w.y = pkh(ko[2], ko[3]); *(v2u*)(SCK + off) = w;
                            v2u x; x.x = pkh(bo[0], bo[1]); x.y = pkh(bo[2], bo[3]); *(v2u*)(SCB + off) = x;
                        } else {
                            v2u w; w.x = pkh(v[0], v[1]); w.y = pkh(v[2], v[3]); *(v2u*)(G + off) = w;
                        }
                        asm volatile("" ::: "memory");
                    }
            }
    }
};
struct EpiGateUp {
    static constexpr bool PERM = true, AFTER_DRAIN = false;
    bf16* H;
    __device__ __forceinline__ void operator()(const pg8::f32x4 (&acc)[2][2][4][2], const Unit& u, int wr, int wc, int fr, int fq) const {
        const int row0 = u.pm * BM + wr * 64 + fr; const int col0 = u.pn * HALF + wc * 32 + 8 * fq;
#pragma unroll
        for (int ai = 0; ai < 2; ++ai)
#pragma unroll
            for (int m = 0; m < 4; ++m) {
                const pg8::f32x4 g0 = acc[ai][0][m][0], g1 = acc[ai][0][m][1], u0 = acc[ai][1][m][0], u1 = acc[ai][1][m][1];
                u32x4 w; w.x = pkbf(silu_(g0[0]) * u0[0], silu_(g0[1]) * u0[1]); w.y = pkbf(silu_(g0[2]) * u0[2], silu_(g0[3]) * u0[3]);
                w.z = pkbf(silu_(g1[0]) * u1[0], silu_(g1[1]) * u1[1]); w.w = pkbf(silu_(g1[2]) * u1[2], silu_(g1[3]) * u1[3]);
                *(u32x4*)(H + (size_t)(row0 + ai * HALF + m * 16) * FF + col0) = w;
            }
    }
};
struct EpiResid {
    static constexpr bool PERM = false, AFTER_DRAIN = false;
    const float* xp; const float* xs; float* Z; const float* scale;
    float* pa; float* pb;
    __device__ __forceinline__ void operator()(const pg8::f32x4 (&acc)[2][2][4][2], const Unit& u, int wr, int wc, int fr, int fq) const {
        const int col0 = u.pn * BM + wc * 32 + 4 * fq;
#pragma unroll
        for (int ai = 0; ai < 2; ++ai)
#pragma unroll
            for (int m = 0; m < 4; ++m) {
                const int row = u.pm * BM + ai * HALF + wr * 64 + m * 16 + fr;
                float* zr = Z + (size_t)row * D + col0;
                const float* br = xp ? ((row < TP ? xp + (size_t)row * D : xs + (size_t)(row - TP) * D) + col0) : zr;
#pragma unroll
                for (int bj = 0; bj < 2; ++bj)
#pragma unroll
                    for (int n = 0; n < 2; ++n) {
                        const int o = bj * HALF + n * 16;
                        pg8::f32x4 a = acc[ai][bj][m][n];
                        if (scale) a = a * *(const pg8::f32x4*)(scale + col0 + o);
                        if (u.mode == 1) {
                            const int sp = u.kt0 / u.nt;
                            float* pr = (sp < 8 ? pa + (size_t)sp * (1u << 20) : pb + (size_t)(sp - 8) * (1u << 20)) + (size_t)(row - TP) * D + col0;
                            *(pg8::f32x4*)(pr + o) = a;
                        } else {
                            const pg8::f32x4 b = *(const pg8::f32x4*)(br + o);
                            *(pg8::f32x4*)(zr + o) = b * ALPHA + a;
                        }
                    }
            }
    }
};

struct SplitOrder {
    pg8::StaticOrder base; int NS, ntc, c;
    __device__ void init(int N, int G, int c_, int K, int NS_) { base.init(TP, N, G, c_, K); NS = NS_; ntc = (K / pg8::BK) / NS_; c = c_; }
    __device__ bool next(int i, Unit& u) const {
        if (i == 0) return base.next(0, u);
        if (i == 1) { if (c >= 16 * NS) return false; const int unit = c / NS, sp = c % NS; u.pm = 64 + (unit >> 2); u.pn = unit & 3; u.kt0 = sp * ntc; u.nt = ntc; u.mode = 1; return true; }
        return false;
    }
    __device__ __forceinline__ void a_ready(const Unit&) const {}
    __device__ __forceinline__ void done(const Unit&) const {}
};

__device__ __forceinline__ void transpose_item(const float* W, int K, int N, bf16* WT, int mode, LAS float* scr, int item, int lane) {
    const int nblk = N / 32, kb = item / nblk, nb = item % nblk, k0 = 64 * kb, n0 = 32 * nb;
    const int drow0 = mode == 0 ? n0 : ((n0 >> 7) * 256 + (mode == 2 ? 128 : 0) + (n0 & 127));
#pragma unroll 8
    for (int i = 0; i < 32; ++i) { const int kk = 2 * i + (lane >> 5); scr[kk * 33 + (lane & 31)] = W[(size_t)(k0 + kk) * N + n0 + (lane & 31)]; }
    asm volatile("s_waitcnt lgkmcnt(0)" ::: "memory");
    const int c = lane & 7;
#pragma unroll
    for (int j = 0; j < 4; ++j) { const int n = (lane >> 3) + 8 * j; const LAS float* s = scr + (8 * c) * 33 + n;
        v4u o; o.x = pkbf(s[0 * 33], s[1 * 33]); o.y = pkbf(s[2 * 33], s[3 * 33]); o.z = pkbf(s[4 * 33], s[5 * 33]); o.w = pkbf(s[6 * 33], s[7 * 33]);
        *(v4u*)(WT + (size_t)(drow0 + n) * K + k0 + 8 * c) = o; }
    asm volatile("s_waitcnt lgkmcnt(0)" ::: "memory");
}
__device__ __forceinline__ void p0_prologue(Frame& F) {
    LAS float* scr = (LAS float*)(F.lds + F.wave * 16384);
    const int gw = F.vcu * NWAVES + F.wave, NGW = F.G * NWAVES;
    unsigned char* ws = F.ws;
    constexpr int I_IN = 16 * 88, I_OUT = 16 * 32, I_GU = 16 * 88, I_DN = 44 * 32, I_PL = 4 * 8;
    constexpr int NITEMS = I_IN + I_OUT + 2 * (2 * I_GU + I_DN) + 4 * I_PL;
    for (int it = gw; it < NITEMS; it += NGW) {
        int r = it;
        if (r < I_IN) { transpose_item(F.in[6], D, INP, (bf16*)(ws + WS_WIN), 0, scr, r, F.lane); continue; } r -= I_IN;
        if (r < I_OUT) { transpose_item(F.in[22], D, D, (bf16*)(ws + WS_WOUT), 0, scr, r, F.lane); continue; } r -= I_OUT;
        constexpr int I_LAYER = 2 * I_GU + I_DN;
        if (r < 2 * I_LAYER) {
            const int l = r / I_LAYER; int q = r % I_LAYER;
            bf16* gu = (bf16*)(ws + (l ? WS_WGU1 : WS_WGU0)); bf16* dn = (bf16*)(ws + (l ? WS_WD1 : WS_WD0));
            if (q < I_GU) { transpose_item(F.in[27] + (size_t)l * D * FF, D, FF, gu, 1, scr, q, F.lane); continue; } q -= I_GU;
            if (q < I_GU) { transpose_item(F.in[28] + (size_t)l * D * FF, D, FF, gu, 2, scr, q, F.lane); continue; } q -= I_GU;
            transpose_item(F.in[29] + (size_t)l * FF * D, FF, D, dn, 0, scr, q, F.lane); continue;
        }
        r -= 2 * I_LAYER;
        { const int g = r / I_PL, ri = r % I_PL; transpose_item(F.in[23] + (size_t)g * 65536, 256, 256, (bf16*)(ws + WS_POOLT) + (size_t)g * 65536, 0, scr, ri, F.lane); }
    }
    const int gt = F.vcu * NTHREADS + F.tid, NGT = F.G * NTHREADS;
    bf16* XB = (bf16*)(ws + WS_XB);
    float* Zp = (float*)(ws + WS_Z);
    for (int i = gt; i < T * D / 8; i += NGT) { const int m = i >> 7, c8 = (i & 127) * 8; float f[8]; load_f8(xrow_ptr(F, m) + c8, f); *(v4u*)(XB + (size_t)m * D + c8) = pack_bf8(f);
        if (m >= TP) { float z[8];
#pragma unroll
            for (int e = 0; e < 8; ++e) z[e] = ALPHA * f[e];
            store_f8(Zp + (size_t)m * D + c8, z); } }
    bf16* LT = (bf16*)(ws + WS_LORAT);
    for (int i = gt; i < 1536 * 256 / 2; i += NGT) { const int j = i >> 7, k = (i & 127) * 2; float v[2];
#pragma unroll
        for (int e = 0; e < 2; ++e) { const int kk = k + e; float x = 0.f;
            if (j < 512) { if (kk < 64) x = F.in[13][(size_t)kk * 512 + j]; }
            else if (j < 1024) { if (kk >= 64 && kk < 128) x = F.in[15][(size_t)(kk - 64) * 512 + (j - 512)]; }
            else { if (kk >= 128) x = F.in[16][(size_t)(kk - 128) * 512 + (j - 1024)]; }
            v[e] = x; }
        *(unsigned*)(LT + (size_t)j * 256 + k) = pkbf(v[0], v[1]); }
}

__device__ __forceinline__ void p2_rows(Frame& F) {
    const int gw = F.vcu * NWAVES + F.wave, NGW = F.G * NWAVES, lane = F.lane;
    unsigned char* ws = F.ws;
    const bf16* PB = (const bf16*)(ws + WS_PROJB);
    h16* SCR = (h16*)(ws + WS_SCR); h16* SCK = (h16*)(ws + WS_SCK); h16* SCV = (h16*)(ws + WS_SCV); h16* SCKK = (h16*)(ws + WS_SCKK);
    bf16* LA = (bf16*)(ws + WS_LA);
    const float* mu = F.in[11]; const float* kkw = F.in[17]; const float* sshift = F.in[3];
    for (int m = gw; m < T; m += NGW) {
        const bool sample = m >= TP; const int seq = sample ? (m - TP) >> 3 : m >> 11, t = sample ? (m - TP) & 7 : m & 2047, L = sample ? LS : LP;
        const bf16* pb = PB + (size_t)m * BP;
        float* oshift = F.out + (sample ? O_SHIFT_S : O_SHIFT_P) + (size_t)seq * BP;
        const bool last = (t == L - 1);
#pragma unroll
        for (int sec = 0; sec < 4; ++sec) {
            if (sec == 3 && lane >= 32) break;
            const int col = sec * 512 + lane * 8;
            float p[8], pv[8], mv[8], xm[8];
            unpack_bf8(*(const v4u*)(pb + col), p);
            if (t > 0) unpack_bf8(*(const v4u*)(pb - BP + col), pv);
            else if (sample) load_f8(sshift + (size_t)seq * BP + col, pv);
            else {
#pragma unroll
                for (int i = 0; i < 8; ++i) pv[i] = 0.f; }
            load_f8(mu + col, mv);
#pragma unroll
            for (int i = 0; i < 8; ++i) xm[i] = p[i] + mv[i] * (pv[i] - p[i]);
            if (last) store_f8(oshift + col, p);
            const size_t off = (size_t)m * HW + lane * 8;
            if (sec == 0) *(v4u*)(SCR + off) = pack_h8(xm);
            else if (sec == 1) {
                *(v4u*)(SCK + off) = pack_h8(xm);
                float kw[8], kx[8]; load_f8(kkw + lane * 8, kw); float ss = 0.f;
#pragma unroll
                for (int i = 0; i < 8; ++i) { kx[i] = xm[i] * kw[i]; ss += kx[i] * kx[i]; }
                ss = sum8(ss);
                const float inv = 1.f / fmaxf(sqrtf(ss), 1e-12f);
#pragma unroll
                for (int i = 0; i < 8; ++i) kx[i] *= inv;
                *(v4u*)(SCKK + off) = pack_h8(kx);
            } else if (sec == 2) *(v4u*)(SCV + off) = pack_h8(xm);
            else {
                float o[8];
#pragma unroll
                for (int i = 0; i < 8; ++i) {
                    if (lane < 8) { const float e = __expf(2.f * xm[i]); o[i] = 1.f - 2.f * __builtin_amdgcn_rcpf(e + 1.f); }
                    else if (lane < 16) o[i] = xm[i];
                    else o[i] = sigmoid_(xm[i]);
                }
                *(v4u*)(LA + (size_t)m * 256 + lane * 8) = pack_bf8(o);
            }
        }
    }
}

template <int TT> __device__ __forceinline__ void conv_tile(Frame& F, int m0, int t0, int seq, bool sample) {
    const int c = F.tid;
    unsigned char* ws = F.ws;
    const bf16* PA = (const bf16*)(ws + WS_PROJA); bf16* CAT = (bf16*)(ws + WS_CAT);
    const float* cw = F.in[7]; const float* sconv = F.in[2];
    LAS float* ylds = (LAS float*)F.lds;
    float w[31];
#pragma unroll
    for (int j = 0; j < 31; ++j) w[j] = cw[j * 512 + c];
    float y[TT]; const float bias = F.in[8][c];
#pragma unroll
    for (int t = 0; t < TT; ++t) y[t] = bias;
    const bool lastp = (!sample) && (t0 + TT == LP);
    float* oconv = F.out + (sample ? O_CONV_S : O_CONV_P) + (size_t)seq * 30 * 512 + c;
    const bf16* pp = PA + ((size_t)m0 - 30) * 1024 + c; const float* scp = sconv + ((size_t)seq * 30 + t0) * 512 + c;
#pragma unroll
    for (int s = -30; s < TT; ++s) {
        float u;
        asm volatile("" : "+v"(pp), "+v"(scp));
        if (t0 + s >= 0) { const float val = bf2f(pp[0]), gate = bf2f(pp[512]); u = val * sigmoid_(gate); }
        else u = sample ? *scp : 0.f;
        pp += 1024; scp += 512;
#pragma unroll
        for (int t = 0; t < TT; ++t) { const int j = s - t + 30; if (j >= 0 && j <= 30) y[t] += u * w[j]; }
        if (sample) { if (s + 22 >= 0) oconv[(size_t)(s + 22) * 512] = u; }
        else if (lastp && s >= TT - 30) oconv[(size_t)(s - (TT - 30)) * 512] = u;
    }
#pragma unroll
    for (int t = 0; t < TT; ++t) ylds[t * 512 + c] = y[t];
    __syncthreads();
    const float* lg = F.in[9]; const float* lb = F.in[10];
    for (int t = F.wave; t < TT; t += NWAVES) {
        const LAS float* yr = ylds + t * 512 + F.lane * 8;
        float v[8];
        { const f32x4 a = *(const LAS f32x4*)yr, b = *(const LAS f32x4*)(yr + 4); v[0] = a.x; v[1] = a.y; v[2] = a.z; v[3] = a.w; v[4] = b.x; v[5] = b.y; v[6] = b.z; v[7] = b.w; }
        float s = 0.f;
#pragma unroll
        for (int i = 0; i < 8; ++i) s += v[i];
        const float mean = wave_sum(s) * (1.f / 512.f); float q = 0.f;
#pragma unroll
        for (int i = 0; i < 8; ++i) { v[i] -= mean; q += v[i] * v[i]; }
        const float rstd = rsqrtf(wave_sum(q) * (1.f / 512.f) + LN_EPS);
        float g8[8], b8[8], o[8]; load_f8(lg + F.lane * 8, g8); load_f8(lb + F.lane * 8, b8);
#pragma unroll
        for (int i = 0; i < 8; ++i) o[i] = silu_(v[i] * rstd * g8[i] + b8[i]);
        *(v4u*)(CAT + (size_t)(m0 + t) * 1024 + F.lane * 8) = pack_bf8(o);
    }
    __syncthreads();
}
__device__ __forceinline__ void conv_phase(Frame& F) {
    for (int it = F.vcu; it < 512 + 128; it += F.G) {
        if (it < 512) { const int m0 = it * 32; conv_tile<32>(F, m0, m0 & 2047, m0 >> 11, false); }
        else { const int seq = it - 512; conv_tile<8>(F, TP + seq * 8, 0, seq, true); }
    }
}

constexpr int SU = 8;
struct ScanPtrs { const h16* R; const h16* K; const h16* V; const h16* KK; const h16* B; const h16* W; h16* O; };
struct ScanBuf { v2u r[SU], k[SU], kk[SU], b[SU], w[SU]; unsigned short v[SU]; };
__device__ __forceinline__ void scan_load(ScanBuf& Bf, const ScanPtrs& P, size_t off, int ks, int row) {
#pragma unroll
    for (int i = 0; i < SU; ++i) { const size_t o = off + (size_t)i * HW;
        Bf.r[i] = *(const v2u*)(P.R + o + ks); Bf.k[i] = *(const v2u*)(P.K + o + ks); Bf.kk[i] = *(const v2u*)(P.KK + o + ks);
        Bf.b[i] = *(const v2u*)(P.B + o + ks); Bf.w[i] = *(const v2u*)(P.W + o + ks); Bf.v[i] = *(const unsigned short*)(P.V + o + row); }
}
__device__ __forceinline__ void scan_compute(const ScanBuf& Bf, float (&S)[4], const ScanPtrs& P, size_t off, int row, bool writer) {
#pragma unroll
    for (int i = 0; i < SU; ++i) {
        float r[4], k[4], kk[4], b[4], w[4]; h4(Bf.r[i], r); h4(Bf.k[i], k); h4(Bf.kk[i], kk); h4(Bf.b[i], b); h4(Bf.w[i], w);
        const float v = (float)__builtin_bit_cast(h16, Bf.v[i]);
        float d = (S[0] * kk[0] + S[1] * kk[1]) + (S[2] * kk[2] + S[3] * kk[3]);
        float pj[4];
#pragma unroll
        for (int j = 0; j < 4; ++j) pj[j] = fmaf(v, k[j], fmaf(-S[j], w[j], S[j]));
        d = dpp_sum16(d);
#pragma unroll
        for (int j = 0; j < 4; ++j) S[j] = fmaf(-d, b[j], pj[j]);
        float o = (S[0] * r[0] + S[1] * r[1]) + (S[2] * r[2] + S[3] * r[3]);
        o = dpp_sum16(o);
        if (writer) P.O[off + (size_t)i * HW + row] = (h16)o;
    }
}
template <int L> __device__ __forceinline__ void scan_task(const ScanPtrs& P, int mbase, int h, int v0, const float* s_in, float* s_out, int lane) {
    const int rl = lane >> 4, ks = (lane & 15) * 4, row = v0 + rl; const bool writer = (lane & 15) == 0;
    float S[4] = {0.f, 0.f, 0.f, 0.f};
    if (s_in) { const f32x4 s = *(const f32x4*)(s_in + (size_t)row * 64 + ks); S[0] = s.x; S[1] = s.y; S[2] = s.z; S[3] = s.w; }
    size_t off = (size_t)mbase * HW + h * 64;
    ScanBuf A;
    scan_load(A, P, off, ks, row);
    if constexpr (L == SU) { scan_compute(A, S, P, off, row, writer); }
    else {
        ScanBuf Bf;
        for (int t = 0; t < L; t += 2 * SU) {
            scan_load(Bf, P, off + (size_t)SU * HW, ks, row);
            scan_compute(A, S, P, off, row, writer);
            if (t + 2 * SU < L) scan_load(A, P, off + (size_t)2 * SU * HW, ks, row);
            scan_compute(Bf, S, P, off + (size_t)SU * HW, row, writer);
            off += (size_t)2 * SU * HW;
        }
    }
    *(f32x4*)(s_out + (size_t)row * 64 + ks) = (f32x4){S[0], S[1], S[2], S[3]};
}
constexpr int RING_SLOTS = 64, SLOT_BYTES = 1536, FLAG_OFF = 131072 + 1024;
constexpr unsigned SPIN_CAP = 1u << 22;
struct StepF { f32x4 r, k, kk, b, w; float v; };
__device__ __forceinline__ void ld_stepf(StepF& X, const LAS unsigned char* slot, unsigned rd, unsigned vd) {
    X.r = *(const LAS f32x4*)(slot + 0 * 256 + rd); X.k = *(const LAS f32x4*)(slot + 1 * 256 + rd); X.kk = *(const LAS f32x4*)(slot + 2 * 256 + rd);
    X.b = *(const LAS f32x4*)(slot + 3 * 256 + rd); X.w = *(const LAS f32x4*)(slot + 4 * 256 + rd); X.v = *(const LAS float*)(slot + vd);
}
__device__ __forceinline__ float step_computef(const StepF& X, float (&S)[4]) {
    float d = (S[0] * X.kk[0] + S[1] * X.kk[1]) + (S[2] * X.kk[2] + S[3] * X.kk[3]);
    float pj[4];
#pragma unroll
    for (int j = 0; j < 4; ++j) pj[j] = fmaf(X.v, X.k[j], fmaf(-S[j], X.w[j], S[j]));
    d = dpp_sum16(d);
#pragma unroll
    for (int j = 0; j < 4; ++j) S[j] = fmaf(-d, X.b[j], pj[j]);
    float o = (S[0] * X.r[0] + S[1] * X.r[1]) + (S[2] * X.r[2] + S[3] * X.r[3]);
    return dpp_sum16(o);
}
__device__ __forceinline__ unsigned min4(const volatile LAS unsigned* p) { const unsigned a = p[0], b = p[1], c = p[2], d = p[3]; return min(min(a, b), min(c, d)); }
__device__ __forceinline__ void scan_prompt_consumer(Frame& F, int mbase, int h, int v0, float* s_out) {
    const int lane = F.lane, rl = lane >> 4, l16 = lane & 15, ks = l16 * 4, row = v0 + rl;
    const LAS unsigned char* ring = F.lds;
    volatile LAS unsigned* prod = (volatile LAS unsigned*)(F.lds + FLAG_OFF); volatile LAS unsigned* cons = prod + 4;
    h16* O = (h16*)(F.ws + WS_O) + (size_t)mbase * HW + h * 64 + row;
    const unsigned rd = ks * 4, vd = 5 * 256 + row * 4;
    constexpr int L = LP;
    float S[4] = {0.f, 0.f, 0.f, 0.f};
    StepF A, B;
    { unsigned sp = 0; while (min4(prod) < 2u && ++sp < SPIN_CAP) __builtin_amdgcn_s_sleep(1); }
    asm volatile("" ::: "memory");
    ld_stepf(A, ring, rd, vd);
    float okeep = 0.f;
#pragma unroll 1
    for (int tb = 0; tb < L; tb += 16) {
#pragma unroll
        for (int j = 0; j < 16; ++j) {
            const int t = tb + j;
            if ((j & 3) == 0) {
                const unsigned need = (unsigned)min(t / 4 + 2, L / 4);
                unsigned sp = 0; while (min4(prod) < need && ++sp < SPIN_CAP) __builtin_amdgcn_s_sleep(1);
                asm volatile("" ::: "memory");
            }
            float o;
            if (j & 1) { ld_stepf(A, ring + ((t + 1) & (RING_SLOTS - 1)) * SLOT_BYTES, rd, vd); o = step_computef(B, S); }
            else       { ld_stepf(B, ring + ((t + 1) & (RING_SLOTS - 1)) * SLOT_BYTES, rd, vd); o = step_computef(A, S); }
            okeep = (l16 == j) ? o : okeep;
            if ((j & 3) == 3) { asm volatile("s_waitcnt lgkmcnt(0)" ::: "memory"); if (lane == 0) cons[F.wave] = (unsigned)(t + 1); }
        }
        O[(size_t)(tb + l16) * HW] = (h16)okeep;
    }
    *(f32x4*)(s_out + (size_t)row * 64 + ks) = (f32x4){S[0], S[1], S[2], S[3]};
}
__device__ __forceinline__ void scan_prompt_loader(Frame& F, int mbase, int h) {
    const int lane = F.lane, w = F.wave - 4;
    LAS unsigned char* ring = F.lds;
    volatile LAS unsigned* prod = (volatile LAS unsigned*)(F.lds + FLAG_OFF); volatile LAS unsigned* cons = prod + 4;
    const int arr = lane < 40 ? (lane >> 3) : 5, part = lane & 7;
    const size_t abase = arr == 0 ? WS_SCR : arr == 1 ? WS_SCK : arr == 2 ? WS_SCKK : arr == 3 ? WS_SCB : arr == 4 ? WS_SCW : WS_SCV;
    const unsigned char* src = F.ws + abase + ((size_t)mbase * HW + h * 64) * 2 + part * 16;
    const bool active = lane < 48;
    const unsigned dst = arr * 256 + part * 32;
    constexpr int L = LP, PF = 8;
    v4u buf[PF];
#pragma unroll
    for (int i = 0; i < PF; ++i) { const int s0 = w + 4 * i; buf[i] = active ? *(const v4u*)(src + (size_t)s0 * 1024) : (v4u){0u, 0u, 0u, 0u}; }
#pragma unroll 1
    for (int sb = w; sb < L; sb += 4 * PF) {
#pragma unroll
        for (int i = 0; i < PF; ++i) {
            const int st = sb + 4 * i;
            if (st >= RING_SLOTS) { unsigned sp = 0; while (min4(cons) < (unsigned)(st - RING_SLOTS + 1) && ++sp < SPIN_CAP) __builtin_amdgcn_s_sleep(1); }
            asm volatile("" ::: "memory");
            float f[8]; unpack_h8(buf[i], f);
            { const int sn = st + 4 * PF; if (sn < L) buf[i] = active ? *(const v4u*)(src + (size_t)sn * 1024) : (v4u){0u, 0u, 0u, 0u}; }
            if (active) { LAS unsigned char* p = ring + (st & (RING_SLOTS - 1)) * SLOT_BYTES + dst;
                *(LAS f32x4*)p = (f32x4){f[0], f[1], f[2], f[3]}; *(LAS f32x4*)(p + 16) = (f32x4){f[4], f[5], f[6], f[7]}; }
            asm volatile("s_waitcnt lgkmcnt(0)" ::: "memory");
            if (lane == 0) prod[w] = (unsigned)(st >> 2) + 1u;
        }
    }
}
__device__ __forceinline__ void scan_phase(Frame& F) {
    unsigned char* ws = F.ws;
    ScanPtrs P{(const h16*)(ws + WS_SCR), (const h16*)(ws + WS_SCK), (const h16*)(ws + WS_SCV), (const h16*)(ws + WS_SCKK), (const h16*)(ws + WS_SCB), (const h16*)(ws + WS_SCW), (h16*)(ws + WS_O)};
    for (int task = F.vcu; task < 256; task += F.G) {
        if (F.tid < 8) ((volatile LAS unsigned*)(F.lds + FLAG_OFF))[F.tid] = 0u;
        __syncthreads();
        const int pair = task >> 2, q = task & 3, n = pair >> 3, h = pair & 7;
        if (F.wave < 4) scan_prompt_consumer(F, n * LP, h, q * 16 + F.wave * 4, F.out + O_WKV_P + (size_t)pair * 4096);
        else scan_prompt_loader(F, n * LP, h);
        __syncthreads();
    }
    {
        const int gw = F.vcu * NWAVES + F.wave, NGW = F.G * NWAVES;
        for (int task = gw; task < NSB * 8 * 16; task += NGW) {
            const int pair = task >> 4, rg = task & 15, n = pair >> 3, h = pair & 7;
            scan_task<LS>(P, TP + n * LS, h, rg * 4, F.in[4] + (size_t)pair * 4096, F.out + O_WKV_S + (size_t)pair * 4096, F.lane);
        }
    }
}

__device__ __forceinline__ void p6_rows(Frame& F) {
    const int gw = F.vcu * NWAVES + F.wave, NGW = F.G * NWAVES, lane = F.lane;
    unsigned char* ws = F.ws;
    const h16* O = (const h16*)(ws + WS_O); const h16* SCR = (const h16*)(ws + WS_SCR); const h16* SCK = (const h16*)(ws + WS_SCK); const h16* SCV = (const h16*)(ws + WS_SCV); const h16* G = (const h16*)(ws + WS_G);
    bf16* CAT = (bf16*)(ws + WS_CAT);
    float rk[8], lg[8], lb[8]; load_f8(F.in[19] + lane * 8, rk); load_f8(F.in[20] + lane * 8, lg); load_f8(F.in[21] + lane * 8, lb);
    for (int m = gw; m < T; m += NGW) {
        const size_t off = (size_t)m * HW + lane * 8;
        float o[8], r[8], k[8], v[8], g[8];
        unpack_h8(*(const v4u*)(O + off), o); unpack_h8(*(const v4u*)(SCR + off), r); unpack_h8(*(const v4u*)(SCK + off), k); unpack_h8(*(const v4u*)(SCV + off), v); unpack_h8(*(const v4u*)(G + off), g);
        float s = 0.f, bs = 0.f;
#pragma unroll
        for (int i = 0; i < 8; ++i) { s += o[i]; bs += r[i] * k[i] * rk[i]; }
        const float mean = sum8(s) * (1.f / 64.f); bs = sum8(bs); float q = 0.f;
#pragma unroll
        for (int i = 0; i < 8; ++i) { o[i] -= mean; q += o[i] * o[i]; }
        const float rstd = rsqrtf(sum8(q) * (1.f / 64.f) + GN_EPS);
        float res[8];
#pragma unroll
        for (int i = 0; i < 8; ++i) res[i] = (o[i] * rstd * lg[i] + lb[i] + bs * v[i]) * g[i];
        *(v4u*)(CAT + (size_t)m * 1024 + 512 + lane * 8) = pack_bf8(res);
    }
}

template <int MODE> __device__ __forceinline__ void ln_rows(Frame& F, const float* g, const float* b, int nparts, const float* pa, const float* pb) {
    const int gw = F.vcu * NWAVES + F.wave, NGW = F.G * NWAVES, lane = F.lane;
    float* Z = (float*)(F.ws + WS_Z); bf16* XB = (bf16*)(F.ws + WS_XB);
    f32x4 gv[4], bv[4];
#pragma unroll
    for (int j = 0; j < 4; ++j) { gv[j] = *(const f32x4*)(g + 4 * (lane + 64 * j)); bv[j] = *(const f32x4*)(b + 4 * (lane + 64 * j)); }
    for (int m = gw; m < T; m += NGW) {
        float* zr = Z + (size_t)m * D;
        f32x4 v[4]; float s = 0.f;
#pragma unroll
        for (int j = 0; j < 4; ++j) v[j] = *(const f32x4*)(zr + 4 * (lane + 64 * j));
        if (m >= TP) {
            for (int sp = 0; sp < nparts; ++sp) { const float* pr = (sp < 8 ? pa + (size_t)sp * (1u << 20) : pb + (size_t)(sp - 8) * (1u << 20)) + (size_t)(m - TP) * D;
#pragma unroll
                for (int j = 0; j < 4; ++j) v[j] = v[j] + *(const f32x4*)(pr + 4 * (lane + 64 * j)); }
        }
#pragma unroll
        for (int j = 0; j < 4; ++j) s += (v[j].x + v[j].y) + (v[j].z + v[j].w);
        const float mean = wave_sum(s) * (1.f / D); float s2 = 0.f;
#pragma unroll
        for (int j = 0; j < 4; ++j) { v[j] = v[j] - mean; s2 += (v[j].x * v[j].x + v[j].y * v[j].y) + (v[j].z * v[j].z + v[j].w * v[j].w); }
        const float rstd = rsqrtf(wave_sum(s2) * (1.f / D) + LN_EPS);
#pragma unroll
        for (int j = 0; j < 4; ++j) v[j] = v[j] * rstd * gv[j] + bv[j];
        if (MODE == 2) {
#pragma unroll
            for (int j = 0; j < 4; ++j) *(f32x4*)(F.out + O_Y + (size_t)m * D + 4 * (lane + 64 * j)) = v[j];
        } else {
            const float zs = (MODE == 0 && m >= TP) ? ALPHA : 1.f;
#pragma unroll
            for (int j = 0; j < 4; ++j) *(f32x4*)(zr + 4 * (lane + 64 * j)) = v[j] * zs;
        }
        if (MODE == 0) {
#pragma unroll
            for (int j = 0; j < 4; ++j) { v2u w; w.x = pkbf(v[j].x, v[j].y); w.y = pkbf(v[j].z, v[j].w); *(v2u*)(XB + (size_t)m * D + 4 * (lane + 64 * j)) = w; }
        }
        if (MODE == 1) {
            const bool sample = m >= TP; const int seq = sample ? (m - TP) >> 3 : m >> 11, t = sample ? (m - TP) & 7 : m & 2047;
            if (sample) {
                float* op = F.out + O_POOL_S + ((size_t)seq * 15 + 7 + t) * D;
#pragma unroll
                for (int j = 0; j < 4; ++j) *(f32x4*)(op + 4 * (lane + 64 * j)) = v[j];
                if (t == 0) { const float* sp = F.in[5] + ((size_t)seq * 15 + 8) * D; float* o0 = F.out + O_POOL_S + (size_t)seq * 15 * D;
                    for (int i = lane; i < 7 * D / 4; i += 64) *(f32x4*)(o0 + 4 * i) = *(const f32x4*)(sp + 4 * i); }
            } else if (t >= LP - 15) {
                float* op = F.out + O_POOL_P + ((size_t)seq * 15 + (t - (LP - 15))) * D;
#pragma unroll
                for (int j = 0; j < 4; ++j) *(f32x4*)(op + 4 * (lane + 64 * j)) = v[j];
            }
        }
    }
}

template <int TT> __device__ __forceinline__ void pool_tile(Frame& F, int m0, int t0, int seq, bool sample) {
    const float* Z = (const float*)(F.ws + WS_Z); bf16* PL = (bf16*)(F.ws + WS_PL); const float* spool = F.in[5];
#pragma unroll 1
    for (int half = 0; half < 2; ++half) {
        const int c = F.tid + 512 * half, g = c >> 8;
        float xs[TT + 15];
        const float* zp = Z + ((size_t)m0 - 15) * D + c; const float* sp = spool + ((size_t)seq * 15 + t0) * D + c;
#pragma unroll
        for (int s = -15; s < TT; ++s) {
            asm volatile("" : "+v"(zp), "+v"(sp));
            if (t0 + s >= 0) xs[s + 15] = *zp;
            else xs[s + 15] = sample ? *sp : 0.f;
            zp += D; sp += D;
        }
        const int wdw = 2 << g;
#pragma unroll
        for (int t = 0; t < TT; ++t) {
            const float x0 = xs[t + 15];
            const float s2 = x0 + xs[t + 14];
            const float s4 = s2 + (xs[t + 13] + xs[t + 12]);
            const float s8 = s4 + ((xs[t + 11] + xs[t + 10]) + (xs[t + 9] + xs[t + 8]));
            const float s16 = s8 + (((xs[t + 7] + xs[t + 6]) + (xs[t + 5] + xs[t + 4])) + ((xs[t + 3] + xs[t + 2]) + (xs[t + 1] + xs[t + 0])));
            const float sum = g == 0 ? s2 : (g == 1 ? s4 : (g == 2 ? s8 : s16));
            const int cnt = sample ? wdw : min(wdw, t0 + t + 1);
            const float pooled = sum / (float)cnt - x0;
            PL[(size_t)(m0 + t) * D + c] = (bf16)(pkbf(pooled, 0.f) & 0xffffu);
        }
    }
}
__device__ __forceinline__ void pool_phase(Frame& F) {
    for (int it = F.vcu; it < 512 + 128; it += F.G) {
        if (it < 512) { const int m0 = it * 32; pool_tile<32>(F, m0, m0 & 2047, m0 >> 11, false); }
        else { const int seq = it - 512; pool_tile<8>(F, TP + seq * 8, 0, seq, true); }
    }
}


#ifndef DIAG_AT
#define DIAG_AT -1
#endif
__device__ __forceinline__ bool dbad(float got, float want) { return !(fabsf(got - want) <= 0.03f * fabsf(want) + 0.02f); }
__device__ __forceinline__ float h2f(h16 x) { return (float)x; }
__device__ __forceinline__ void diag_checks(Frame& F, int at) {
    if (blockIdx.x != 0 || F.wave != 0) return;
    const int lane = F.lane; unsigned char* ws = F.ws;
    unsigned mask = 0;
    const bf16* PA = (const bf16*)(ws + WS_PROJA); const bf16* PB = (const bf16*)(ws + WS_PROJB);
    const h16* SCR = (const h16*)(ws + WS_SCR); const h16* SCK = (const h16*)(ws + WS_SCK); const h16* SCV = (const h16*)(ws + WS_SCV); const h16* SCKK = (const h16*)(ws + WS_SCKK);
    const h16* SCB = (const h16*)(ws + WS_SCB); const h16* SCW = (const h16*)(ws + WS_SCW);
    const int m = 1 + (lane * 131 + 7) % 9000;
    const int t = m & 2047;
    if (at == 3) {
        const int c = (lane * 29 + 5) % 512, h0 = c & ~63;
        auto xm = [&](int col) { const float p = bf2f(PB[(size_t)m * BP + col]); const float pv = t > 0 ? bf2f(PB[(size_t)(m - 1) * BP + col]) : 0.f; return p + F.in[11][col] * (pv - p); };
        float ss = 0.f; for (int j = 0; j < 64; ++j) { const float kx = xm(512 + h0 + j) * F.in[17][h0 + j]; ss += kx * kx; }
        const float kkn = xm(512 + c) * F.in[17][c] / fmaxf(sqrtf(ss), 1e-12f);
        float al = F.in[14][c]; for (int j = 0; j < 64; ++j) al += xm(1600 + j) * F.in[15][(size_t)j * 512 + c];
        const float a = 1.f / (1.f + expf(-al)); const float f = (1.f + (a - 1.f) * F.in[18][c]); const float k0 = xm(512 + c); const float b = kkn * a;
        const float gotk = h2f(SCK[(size_t)m * HW + c]);
        if (__ballot(dbad(gotk, k0 * f))) mask |= 1;
        if (__ballot(dbad(h2f(SCB[(size_t)m * HW + c]) * 10.f, b * 10.f))) mask |= 2;
        { const bf16* LA = (const bf16*)(ws + WS_LA); bool bad = false; for (int j = 0; j < 64; ++j) bad = bad || dbad(bf2f(LA[(size_t)m * 256 + 64 + j]), xm(1600 + j)); if (__ballot(bad)) mask |= 4; }
        { float g = 0.f; for (int j = 0; j < 128; ++j) g += (1.f / (1.f + expf(-xm(1664 + j)))) * F.in[16][(size_t)j * 512 + c];
          const h16* G = (const h16*)(ws + WS_G); if (__ballot(dbad(h2f(G[(size_t)m * HW + c]), g))) mask |= 8; }
        if (__ballot(dbad(gotk, k0 * f * f))) mask |= 16;
        if (__ballot(dbad(gotk, k0))) mask |= 32;
    }
    if (lane == 0) *(unsigned*)(ws + 0) = mask;
}
__device__ __forceinline__ void diag_fill(Frame& F) {
    const unsigned mask = *(const unsigned*)(F.ws + 0);
    const float C = sqrtf(exp2f(1.f + (float)mask));
    const int gt = blockIdx.x * NTHREADS + F.tid, NGT = F.G * NTHREADS;
    for (int i = gt; i < TS * D; i += NGT) F.out[O_Y + (size_t)TP * D + i] = C;
}

#define XB_TMO      128
#define XB_XCNT(j)  (256  + 64 * (j))
#define XB_XSUB(j)  (1280 + 64 * (j))
#define XB_XGEN(j)  (2304 + 64 * (j))
#define XB_TOP      3328
#define XB_TOPGEN   3392
#define XCD_BAR_WORDS 3456
#define XB_SPIN_CAP (1u << 18)

__device__ __forceinline__ unsigned xb_ld(unsigned* p)              { return __hip_atomic_load(p, __ATOMIC_RELAXED, __HIP_MEMORY_SCOPE_AGENT); }
__device__ __forceinline__ unsigned xb_add(unsigned* p, unsigned v) { return __hip_atomic_fetch_add(p, v, __ATOMIC_RELAXED, __HIP_MEMORY_SCOPE_AGENT); }
__device__ __forceinline__ unsigned xb_xcc_id() { return (unsigned)__builtin_amdgcn_s_getreg((3 << 11) | 20) & 0xFu; }
#define XB_SPIN(cond, bar) do { unsigned _sp = 0; while (cond) { __builtin_amdgcn_s_sleep(1); \
    if ((++_sp & 255u) == 0u) { if (xb_ld(&(bar)[XB_TMO])) break; if (_sp > XB_SPIN_CAP) { atomicAdd(&(bar)[XB_TMO], 1u); break; } } } } while (0)

struct XcdBarrier {
    unsigned* bar; unsigned x;
    volatile LAS unsigned* st;
};

__device__ __forceinline__ XcdBarrier xcd_barrier_post(unsigned* bar, volatile LAS unsigned* st) {
    XcdBarrier b; b.bar = bar; b.x = xb_xcc_id(); b.st = st;
    if (threadIdx.x == 0) (void)xb_add(&bar[XB_XCNT(b.x)], 1u);
    return b;
}
__device__ __forceinline__ void xcd_barrier_complete(unsigned* bar, unsigned x, unsigned& nloc, unsigned& nx) {
    const unsigned G = gridDim.x * gridDim.y * gridDim.z;
    unsigned sum, cnt, mine, sp = 0u;
    for (;;) {
        sum = 0u; cnt = 0u; mine = 0u;
#pragma unroll
        for (unsigned j = 0; j < 16; ++j) { const unsigned c = xb_ld(&bar[XB_XCNT(j)]); sum += c; cnt += (c > 0u) ? 1u : 0u; mine = (j == x) ? c : mine; }
        if (sum == G) break;
        __builtin_amdgcn_s_sleep(1);
        if ((++sp & 255u) == 0u) { if (xb_ld(&bar[XB_TMO])) break; if (sp > XB_SPIN_CAP) { atomicAdd(&bar[XB_TMO], 1u); break; } }
    }
    nloc = mine > 0u ? mine : 1u; nx = cnt > 0u ? cnt : 1u;
}

__device__ __forceinline__ void xcd_barrier(const XcdBarrier& b) {
    asm volatile("s_waitcnt vmcnt(0)" ::: "memory");
    __syncthreads();
    if (threadIdx.x == 0) {
        unsigned* bar = b.bar;
        __builtin_amdgcn_s_waitcnt(0);
        unsigned nloc = b.st[0], nx = b.st[1];
        if (nloc == 0u) { xcd_barrier_complete(bar, b.x, nloc, nx); b.st[0] = nloc; b.st[1] = nx; }
        const unsigned old = xb_add(&bar[XB_XSUB(b.x)], 1u);
        const unsigned gen = old / nloc;
        if (old + 1u == (gen + 1u) * nloc) {
            __builtin_amdgcn_fence(__ATOMIC_RELEASE, "agent");
            asm volatile("s_waitcnt vmcnt(0)" ::: "memory");
            const unsigned og = xb_add(&bar[XB_TOP], 1u);
            const unsigned tg = og / nx;
            if (og + 1u == (tg + 1u) * nx) xb_add(&bar[XB_TOPGEN], 1u);
            else XB_SPIN(xb_ld(&bar[XB_TOPGEN]) == tg, bar);
            __builtin_amdgcn_fence(__ATOMIC_ACQUIRE, "agent");
            xb_add(&bar[XB_XGEN(b.x)], 1u);
            asm volatile("s_waitcnt vmcnt(0)" ::: "memory");
        } else {
            XB_SPIN(xb_ld(&bar[XB_XGEN(b.x)]) == gen, bar);
            __builtin_amdgcn_fence(__ATOMIC_ACQUIRE, "agent");
            asm volatile("s_waitcnt vmcnt(0)" ::: "memory");
        }
    }
    __syncthreads();
}

struct Args { const float* in[32]; float* out; unsigned char* ws; int ph_lo, ph_hi, coop, pad; };

__global__ void __launch_bounds__(NTHREADS, 2) mk_fwd(Args args) {
    extern __shared__ __attribute__((aligned(16))) unsigned char lds_raw[];
    Frame F;
    F.lds = (LAS unsigned char*)lds_raw;
    F.tid = threadIdx.x; F.lane = F.tid & 63; F.wave = __builtin_amdgcn_readfirstlane(F.tid >> 6);
    F.G = gridDim.x; { const int bx = blockIdx.x; F.vcu = (F.G % 8 == 0) ? (bx % 8) * (F.G / 8) + bx / 8 : bx; }
    F.in = args.in;
    F.out = args.out; F.ws = args.ws;
    unsigned char* ws = args.ws;
    const int lo = args.ph_lo, hi = args.ph_hi;
    volatile LAS unsigned* MISC = (volatile LAS unsigned*)(F.lds + 131072 + 512);
    if (F.tid < 32) MISC[F.tid] = 0u;
    __syncthreads();
    XcdBarrier bar = xcd_barrier_post((unsigned*)ws, MISC + 8);
#ifndef PHMASK
#define PHMASK 0x3ffff
#endif
#define IN(k) ((((PHMASK) >> (k)) & 1) && lo <= (k) && (k) < hi)
#define SEAM(k) do { if (IN(k) && IN((k) + 1)) { xcd_barrier(bar); } } while (0)
    typedef pg8::bf16_t gb;

    if (IN(0)) { p0_prologue(F); } SEAM(0);
    if (IN(1)) {
        pg8::Gemm g{(const gb*)(ws + WS_XB), (const gb*)(ws + WS_WIN), T, INP, D, D, D, 0}; pg8::StaticOrder S; S.init(T, INP, F.G, (int)blockIdx.x, D);
        EpiProj E{(bf16*)(ws + WS_PROJA), (bf16*)(ws + WS_PROJB)};
        pg8::gemm_phase<EpiProj, pg8::StaticOrder, true, true>(F.lds, g, S, E);
    } SEAM(1);
    if (IN(2)) { p2_rows(F); } SEAM(2);
    if (IN(3)) {
        pg8::Gemm g{(const gb*)(ws + WS_LA), (const gb*)(ws + WS_LORAT), T, 1536, 256, 256, 256, 0}; pg8::StaticOrder S; S.init(T, 1536, F.G, (int)blockIdx.x, 256);
        EpiLora E{F.in[12], F.in[14], F.in[18], (h16*)(ws + WS_SCW), (h16*)(ws + WS_SCK), (h16*)(ws + WS_SCKK), (h16*)(ws + WS_SCB), (h16*)(ws + WS_G)};
        pg8::gemm_phase<EpiLora, pg8::StaticOrder, true, true>(F.lds, g, S, E);
    } SEAM(3);
    if (IN(4)) { conv_phase(F); }
#ifndef DUP5
#define DUP5 0
#endif
#ifndef DUP4
#define DUP4 0
#endif
    if (DUP4) { conv_phase(F); }
    if (IN(5)) { scan_phase(F); } SEAM(5);
    if (DUP5) { scan_phase(F); xcd_barrier(bar); }
    if (IN(6)) { p6_rows(F); } SEAM(6);
    if (IN(7)) {
        pg8::Gemm g{(const gb*)(ws + WS_CAT), (const gb*)(ws + WS_WOUT), T, D, D, D, D, 0}; SplitOrder S; S.init(D, F.G, (int)blockIdx.x, D, 4);
        EpiResid E{F.in[0], F.in[1], (float*)(ws + WS_Z), nullptr, (float*)(ws + WS_PART7), nullptr};
        pg8::gemm_phase<EpiResid, SplitOrder, true, true>(F.lds, g, S, E);
    } SEAM(7);
    if (IN(8)) { ln_rows<0>(F, F.in[25], F.in[26], 4, (const float*)(ws + WS_PART7), nullptr); } SEAM(8);
#define FFN_PHASES(layer, pgu, pdn) \
    if (IN(pgu)) { \
        pg8::Gemm g{(const gb*)(ws + WS_XB), (const gb*)(ws + ((layer) ? WS_WGU1 : WS_WGU0)), T, 2 * FF, D, D, D, 0}; pg8::StaticOrder S; S.init(T, 2 * FF, F.G, (int)blockIdx.x, D); \
        EpiGateUp E{(bf16*)(ws + WS_H)}; \
        pg8::gemm_phase<EpiGateUp, pg8::StaticOrder, true, true>(F.lds, g, S, E); \
    } SEAM(pgu); \
    if (IN(pdn)) { \
        pg8::Gemm g{(const gb*)(ws + WS_H), (const gb*)(ws + ((layer) ? WS_WD1 : WS_WD0)), T, D, FF, FF, FF, 0}; SplitOrder S; S.init(D, F.G, (int)blockIdx.x, FF, 11); \
        EpiResid E{nullptr, nullptr, (float*)(ws + WS_Z), nullptr, (float*)(ws + WS_PARTA), (float*)(ws + WS_PARTB)}; \
        pg8::gemm_phase<EpiResid, SplitOrder, true, true>(F.lds, g, S, E); \
    } SEAM(pdn);
    FFN_PHASES(0, 9, 10)
    if (IN(11)) { ln_rows<1>(F, F.in[30], F.in[31], 11, (const float*)(ws + WS_PARTA), (const float*)(ws + WS_PARTB)); } SEAM(11);
    if (IN(12)) { pool_phase(F); } SEAM(12);
    if (IN(13)) {
        pg8::Gemm g{(const gb*)(ws + WS_PL), (const gb*)(ws + WS_POOLT), T, D, 256, D, 256, 256}; pg8::StaticOrder S; S.init(T, D, F.G, (int)blockIdx.x, 256);
        EpiResid E{nullptr, nullptr, (float*)(ws + WS_Z), F.in[24], nullptr, nullptr};
        pg8::gemm_phase<EpiResid, pg8::StaticOrder, true, true>(F.lds, g, S, E);
    } SEAM(13);
    if (IN(14)) { ln_rows<0>(F, F.in[25] + D, F.in[26] + D, 0, nullptr, nullptr); } SEAM(14);
    FFN_PHASES(1, 15, 16)
    if (IN(17)) { ln_rows<2>(F, F.in[30] + D, F.in[31] + D, 11, (const float*)(ws + WS_PARTA), (const float*)(ws + WS_PARTB)); }
    if (lo == 100) diag_checks(F, args.pad);
    if (lo == 101) diag_fill(F);
#undef IN
#undef SEAM
}

extern "C" void kernel_launch(void* const* d_in, const int* in_sizes, int n_in, void* d_out, int out_size, void* d_ws, size_t ws_size, hipStream_t stream) {
    static int grid = 0;
    if (grid == 0) {
        if (n_in != 32 || out_size != (int)O_TOTAL || ws_size < WS_END) { fprintf(stderr, "kernel_launch: unexpected shapes: n_in %d out %d ws %zu\n", n_in, out_size, ws_size); grid = -1; return; }
        int dev = 0, cus = 0, per_cu = 0;
        if (hipGetDevice(&dev) != hipSuccess || hipDeviceGetAttribute(&cus, hipDeviceAttributeMultiprocessorCount, dev) != hipSuccess) { grid = -1; return; }
        if (hipFuncSetAttribute((const void*)mk_fwd, hipFuncAttributeMaxDynamicSharedMemorySize, LDS_BYTES) != hipSuccess) { fprintf(stderr, "kernel_launch: hipFuncSetAttribute failed\n"); grid = -1; return; }
        if (hipOccupancyMaxActiveBlocksPerMultiprocessor(&per_cu, (const void*)mk_fwd, NTHREADS, LDS_BYTES) != hipSuccess || per_cu < 1) { fprintf(stderr, "kernel_launch: occupancy query says %d\n", per_cu); (void)hipGetLastError(); per_cu = 1; }
        grid = cus * 1;
        if (per_cu < 1) grid = -1;
    }
    if (grid < 0) return;
    Args a{};
    for (int i = 0; i < 32; ++i) a.in[i] = (const float*)d_in[i];
    a.out = (float*)d_out; a.ws = (unsigned char*)d_ws;
#if MK_SINGLE
    if (hipMemsetAsync(d_ws, 0, 16384, stream) != hipSuccess) { fprintf(stderr, "kernel_launch: memset failed\n"); return; }
    a.ph_lo = 0; a.ph_hi = NPHASE; a.coop = 1;
    void* params[] = {&a};
    hipError_t e = hipLaunchCooperativeKernel((const void*)mk_fwd, dim3(grid), dim3(NTHREADS), params, LDS_BYTES, stream);
    if (e != hipSuccess) fprintf(stderr, "kernel_launch: cooperative launch failed: %s (grid %d)\n", hipGetErrorString(e), grid);
#else
    for (int p = 0; p < NPHASE; ++p) {
        if (DIAG_AT >= 0 && p > DIAG_AT) break;
        a.ph_lo = p; a.ph_hi = p + 1; a.coop = 0;
        hipLaunchKernelGGL(mk_fwd, dim3(grid), dim3(NTHREADS), LDS_BYTES, stream, a);
    }
    if (DIAG_AT >= 0) { a.pad = DIAG_AT; a.ph_lo = 100; a.ph_hi = 101; hipLaunchKernelGGL(mk_fwd, dim3(grid), dim3(NTHREADS), LDS_BYTES, stream, a);
                        a.ph_lo = 101; a.ph_hi = 102; hipLaunchKernelGGL(mk_fwd, dim3(grid), dim3(NTHREADS), LDS_BYTES, stream, a); }
#endif
}
```

```cpp
#include <hip/hip_runtime.h>
#include <hip/hip_cooperative_groups.h>
#include <cstdio>
#include <cstdint>
namespace cg = cooperative_groups;
namespace pg8 {
#define PG8_LAS __attribute__((address_space(3)))
typedef unsigned short bf16_t;
typedef short bf16x8 __attribute__((ext_vector_type(8)));
typedef float f32x4 __attribute__((ext_vector_type(4)));
typedef unsigned u32x4 __attribute__((ext_vector_type(4)));
constexpr int BM = 256, BK = 64, HALF = 128, HTB = HALF * BK * 2  , STAGE_BYTES = 8 * HTB, NXCD = 8, WGM = 8;

__host__ __device__ __forceinline__ int lds_byte(int r, int c) { const int st = (r >> 4) * 2 + (c >> 5), rr = r & 15, cc = c & 31, ob = rr * 64 + cc * 2; return st * 1024 + (ob ^ (((ob >> 9) & 1) << 5)); }
__host__ __device__ __forceinline__ void stage_rc(int b, int& R, int& C) { const int st = b / 1024, sb = b % 1024, swz = sb ^ (((sb >> 9) & 1) << 5); R = (st >> 1) * 16 + swz / 64; C = (st & 1) * 32 + (swz % 64) / 2; }
__host__ __device__ __forceinline__ int perm32(int rho) { const int n = rho >> 4, i = rho & 15; return 8 * (i >> 2) + 4 * n + (i & 3); }

struct Unit { int pm, pn, kt0, nt, mode; };
struct Gemm { const bf16_t* A; const bf16_t* Bt; int M, N, K, lda, ldb, acol; };

struct StaticOrder {
    int nM, nN, nwg, G, c, ntf;
    __host__ __device__ void init(int M, int N, int G_, int c_, int K_) { nM = M / BM; nN = N / BM; nwg = nM * nN; G = G_; c = c_; ntf = K_ / BK; }
    __host__ __device__ bool next(int i, Unit& u) const {
        const long L = (long)i * G + c; if (L >= nwg) return false;
        int wgid = (int)L; { const int q = nwg / NXCD, r = nwg % NXCD, xcd = wgid % NXCD, off = wgid / NXCD; wgid = (xcd < r ? xcd * (q + 1) : r * (q + 1) + (xcd - r) * q) + off; }
        const int nig = WGM * nN, gid = wgid / nig, fm = gid * WGM, gsz = (nM - fm) < WGM ? (nM - fm) : WGM;
        u.pm = fm + ((wgid % nig) % gsz); u.pn = (wgid % nig) / gsz; u.kt0 = 0; u.nt = ntf; u.mode = 0; return true;
    }
    __device__ __forceinline__ void a_ready(const Unit&) const {}
    __device__ __forceinline__ void done(const Unit&) const {}
};

__device__ __forceinline__ unsigned cvt_pk_bf16(float lo, float hi) { unsigned r; asm volatile("v_cvt_pk_bf16_f32 %0, %1, %2" : "=v"(r) : "v"(lo), "v"(hi)); return r; }
template <class Epi, class Sched, bool ALIGN_EPI = false, bool SP2 = false>
__device__ __forceinline__ void gemm_phase(PG8_LAS unsigned char* lds, const Gemm g, const Sched& S, const Epi& E) {
    const int tid = threadIdx.x, wid = __builtin_amdgcn_readfirstlane(tid >> 6), lane = tid & 63, wr = wid >> 2, wc = wid & 3, fr = lane & 15, fq = lane >> 4;
    const int K = g.K; (void)K;
    unsigned voffA[2], voffB[2];
#pragma unroll
    for (int i = 0; i < 2; ++i) { int R, C; stage_rc(tid * 16 + i * 8192, R, C); const int Rb = Epi::PERM ? ((R & ~31) + perm32(R & 31)) : R;
        voffA[i] = (unsigned)(R * g.lda + C) * 2u; voffB[i] = (unsigned)(Rb * g.ldb + C) * 2u; }
    const size_t kstep = (size_t)(BK * 2);
    const size_t hstepA = (size_t)HALF * g.lda * 2, hstepB = (size_t)HALF * g.ldb * 2;
    const size_t tstepA = 2 * hstepA, tstepB = 2 * hstepB; const size_t acolB = (size_t)g.acol * 2;
    const unsigned ldsw = (unsigned)wid * 1024u;
    const int aoff = lds_byte(wr * 64 + fr, fq * 8), boff = lds_byte(wc * 32 + fr, fq * 8);
#define PG8_SA(b, h) (((b) * 2 + (h)) * HTB)
#define PG8_SB(b, h) ((4 + (b) * 2 + (h)) * HTB)
#define PG8_STAGE(bufoff, gbase, voff) do { _Pragma("unroll") for (int _i = 0; _i < 2; ++_i) \
        __builtin_amdgcn_global_load_lds((const unsigned*)((const char*)(gbase) + (voff)[_i]), (PG8_LAS unsigned*)(lds + (bufoff) + ldsw + _i * 8192), 16, 0, 0); } while (0)
#define PG8_LDA(dst, b, h) do { _Pragma("unroll") for (int m = 0; m < 4; ++m) _Pragma("unroll") for (int k = 0; k < 2; ++k) dst[m][k] = *(const PG8_LAS bf16x8*)(lds + PG8_SA(b, h) + aoff + m * 2048 + k * 1024); } while (0)
#define PG8_LDB(dst, b, h) do { _Pragma("unroll") for (int n = 0; n < 2; ++n) _Pragma("unroll") for (int k = 0; k < 2; ++k) dst[n][k] = *(const PG8_LAS bf16x8*)(lds + PG8_SB(b, h) + boff + n * 2048 + k * 1024); } while (0)
#define PG8_MMA(ai, bj, At, Bt) do { __builtin_amdgcn_s_setprio(1); _Pragma("unroll") for (int m = 0; m < 4; ++m) _Pragma("unroll") for (int n = 0; n < 2; ++n) _Pragma("unroll") for (int k = 0; k < 2; ++k) \
        acc[ai][bj][m][n] = __builtin_amdgcn_mfma_f32_16x16x32_bf16(Bt[n][k], At[m][k], acc[ai][bj][m][n], 0, 0, 0); __builtin_amdgcn_s_setprio(0); } while (0)
#define PG8_WAIT_V(n) asm volatile("s_waitcnt vmcnt(" #n ")" ::: "memory")
#define PG8_WAIT_L(n) asm volatile("s_waitcnt lgkmcnt(" #n ")" ::: "memory")
#define PG8_BAR __builtin_amdgcn_s_barrier()
#define PG8_SCHED __builtin_amdgcn_sched_barrier(0)
    Unit cur, nxt; int ui = 0;
    if (!S.next(0, cur)) return;
    f32x4 acc[2][2][4][2];
#pragma unroll
    for (int a = 0; a < 2; ++a)
#pragma unroll
        for (int b = 0; b < 2; ++b)
#pragma unroll
            for (int m = 0; m < 4; ++m)
#pragma unroll
                for (int n = 0; n < 2; ++n) acc[a][b][m][n] = (f32x4){0.f, 0.f, 0.f, 0.f};
    bf16x8 At[4][2], B0[2][2], B1[2][2];
    const char* cA = (const char*)g.A + (size_t)cur.pm * tstepA + (size_t)cur.pn * acolB + (size_t)cur.kt0 * kstep; const char* cB = (const char*)g.Bt + (size_t)cur.pn * tstepB + (size_t)cur.kt0 * kstep;
    S.a_ready(cur);
    if constexpr (SP2) {
        PG8_STAGE(PG8_SB(0, 0), cB, voffB); PG8_STAGE(PG8_SB(0, 1), cB + hstepB, voffB); PG8_STAGE(PG8_SA(0, 0), cA, voffA); PG8_STAGE(PG8_SA(0, 1), cA + hstepA, voffA);
        if (wr == 1) PG8_BAR;
        PG8_WAIT_V(2); PG8_BAR;
        PG8_STAGE(PG8_SB(1, 0), cB + kstep, voffB); PG8_STAGE(PG8_SA(1, 0), cA + kstep, voffA); PG8_STAGE(PG8_SB(1, 1), cB + hstepB + kstep, voffB);
        PG8_WAIT_V(6); PG8_BAR;
    } else {
        PG8_STAGE(PG8_SB(0, 0), cB, voffB); PG8_STAGE(PG8_SA(0, 0), cA, voffA); PG8_STAGE(PG8_SB(0, 1), cB + hstepB, voffB); PG8_STAGE(PG8_SA(0, 1), cA + hstepA, voffA);
        if (wr == 1) PG8_BAR;
        PG8_WAIT_V(4); PG8_BAR;
        PG8_STAGE(PG8_SB(1, 0), cB + kstep, voffB); PG8_STAGE(PG8_SA(1, 0), cA + kstep, voffA); PG8_STAGE(PG8_SB(1, 1), cB + hstepB + kstep, voffB);
        PG8_WAIT_V(6); PG8_BAR;
    }
    for (;;) {
        const bool has_next = S.next(ui + 1, nxt);
        const char* nA = has_next ? (const char*)g.A + (size_t)nxt.pm * tstepA + (size_t)nxt.pn * acolB + (size_t)nxt.kt0 * kstep : cA; const char* nB = has_next ? (const char*)g.Bt + (size_t)nxt.pn * tstepB + (size_t)nxt.kt0 * kstep : cB;
        const int nt = cur.nt;
        _Pragma("unroll 1") for (int t = 0; t < nt; t += 2) {
            const bool last = (t == nt - 2);
            const char* a1 = cA + (size_t)(t + 1) * kstep;
            const char* a2 = last ? nA : cA + (size_t)(t + 2) * kstep; const char* b2 = last ? nB : cB + (size_t)(t + 2) * kstep;
            const char* a3 = a2 + kstep; const char* b3 = b2 + kstep;
            if (last && has_next) S.a_ready(nxt);
            if constexpr (SP2) {
            PG8_LDB(B0, 0, 0); PG8_LDB(B1, 0, 1); PG8_SCHED; PG8_LDA(At, 0, 0); PG8_STAGE(PG8_SA(1, 1), a1 + hstepA, voffA);
            PG8_WAIT_V(8); PG8_WAIT_L(0); PG8_BAR; PG8_MMA(0, 0, At, B0); PG8_MMA(0, 1, At, B1); PG8_BAR; PG8_SCHED;
            PG8_LDA(At, 0, 1); PG8_STAGE(PG8_SB(0, 0), b2, voffB); PG8_STAGE(PG8_SB(0, 1), b2 + hstepB, voffB); PG8_STAGE(PG8_SA(0, 0), a2, voffA);
            PG8_WAIT_V(8); PG8_WAIT_L(0); PG8_BAR; PG8_MMA(1, 0, At, B0); PG8_MMA(1, 1, At, B1); PG8_BAR; PG8_SCHED;
            PG8_LDB(B0, 1, 0); PG8_LDB(B1, 1, 1); PG8_SCHED; PG8_LDA(At, 1, 0); PG8_STAGE(PG8_SA(0, 1), a2 + hstepA, voffA);
            PG8_WAIT_V(8); PG8_WAIT_L(0); PG8_BAR; PG8_MMA(0, 0, At, B0); PG8_MMA(0, 1, At, B1); PG8_BAR; PG8_SCHED;
            PG8_LDA(At, 1, 1); PG8_STAGE(PG8_SB(1, 0), b3, voffB); PG8_STAGE(PG8_SB(1, 1), b3 + hstepB, voffB); PG8_STAGE(PG8_SA(1, 0), a3, voffA);
            PG8_WAIT_V(8); PG8_WAIT_L(0); PG8_BAR; PG8_MMA(1, 0, At, B0); PG8_MMA(1, 1, At, B1); PG8_BAR; PG8_SCHED;
            } else {
            PG8_LDB(B0, 0, 0); PG8_SCHED; PG8_LDA(At, 0, 0); PG8_STAGE(PG8_SA(1, 1), a1 + hstepA, voffA);
            PG8_WAIT_L(8); PG8_BAR; PG8_WAIT_L(0); PG8_MMA(0, 0, At, B0); PG8_BAR; PG8_SCHED;
            PG8_LDB(B1, 0, 1); PG8_STAGE(PG8_SB(0, 0), b2, voffB);
            PG8_BAR; PG8_WAIT_L(0); PG8_MMA(0, 1, At, B1); PG8_BAR;
            PG8_LDA(At, 0, 1); PG8_STAGE(PG8_SA(0, 0), a2, voffA);
            PG8_BAR; PG8_WAIT_L(0); PG8_MMA(1, 0, At, B0); PG8_BAR; PG8_SCHED;
            PG8_STAGE(PG8_SB(0, 1), b2 + hstepB, voffB);
            PG8_WAIT_V(6); PG8_BAR; PG8_MMA(1, 1, At, B1); PG8_BAR;
            PG8_LDB(B0, 1, 0); PG8_SCHED; PG8_LDA(At, 1, 0); PG8_STAGE(PG8_SA(0, 1), a2 + hstepA, voffA);
            PG8_WAIT_L(8); PG8_BAR; PG8_WAIT_L(0); PG8_MMA(0, 0, At, B0); PG8_BAR; PG8_SCHED;
            PG8_LDB(B1, 1, 1); PG8_STAGE(PG8_SB(1, 0), b3, voffB);
            PG8_BAR; PG8_WAIT_L(0); PG8_MMA(0, 1, At, B1); PG8_BAR;
            PG8_LDA(At, 1, 1); PG8_STAGE(PG8_SA(1, 0), a3, voffA);
            PG8_BAR; PG8_WAIT_L(0); PG8_MMA(1, 0, At, B0); PG8_BAR; PG8_SCHED;
            PG8_STAGE(PG8_SB(1, 1), b3 + hstepB, voffB);
            PG8_WAIT_V(6); PG8_BAR; PG8_MMA(1, 1, At, B1); PG8_BAR;
            }
        }
        if constexpr (ALIGN_EPI) { if (wr == 0) PG8_BAR; }
        if constexpr (!Epi::AFTER_DRAIN) { E(acc, cur, wr, wc, fr, fq); S.done(cur); }
        if (!has_next) break;
#pragma unroll
        for (int a = 0; a < 2; ++a)
#pragma unroll
            for (int b = 0; b < 2; ++b)
#pragma unroll
                for (int m = 0; m < 4; ++m)
#pragma unroll
                    for (int n = 0; n < 2; ++n) acc[a][b][m][n] = (f32x4){0.f, 0.f, 0.f, 0.f};
        cur = nxt; cA = nA; cB = nB; ++ui;
        if constexpr (ALIGN_EPI) { if (wr == 1) PG8_BAR; }
    }
    PG8_WAIT_V(0);
    if constexpr (!ALIGN_EPI) { if (wr == 0) PG8_BAR; }
    PG8_BAR;
    if constexpr (Epi::AFTER_DRAIN) { E.fused(acc, cur, wr, wc, fr, fq, lds, wid, lane); S.done(cur); }
#undef PG8_SA
#undef PG8_SB
#undef PG8_STAGE
#undef PG8_LDA
#undef PG8_LDB
#undef PG8_MMA
#undef PG8_WAIT_V
#undef PG8_WAIT_L
#undef PG8_BAR
#undef PG8_SCHED
}
}

#define GAS __attribute__((address_space(1)))
#define LAS __attribute__((address_space(3)))
typedef unsigned short bf16;
typedef unsigned v4u __attribute__((ext_vector_type(4)));
typedef unsigned v2u __attribute__((ext_vector_type(2)));
typedef float f32x4 __attribute__((ext_vector_type(4)));
typedef _Float16 h16;
typedef _Float16 h16x2 __attribute__((ext_vector_type(2)));

#ifndef MK_SINGLE
#define MK_SINGLE 1
#endif

constexpr int NWAVES = 8, NTHREADS = NWAVES * 64;
constexpr int D = 1024, TP = 16384, TS = 1024, T = TP + TS, LP = 2048, LS = 8, NPB = 8, NSB = 128;
constexpr int INP = 2816, BP = 1792, FF = 2816, HW = 512;
constexpr float ALPHA = 1.41421356237309515f, LN_EPS = 1e-5f, GN_EPS = 64e-5f;
constexpr int NPHASE = 18;

constexpr size_t MiB = 1u << 20;
constexpr size_t WS_WIN = 1 * MiB, WS_WOUT = WS_WIN + 5632 * 1024, WS_WGU0 = WS_WOUT + 2 * MiB, WS_WGU1 = WS_WGU0 + 11 * MiB, WS_WD0 = WS_WGU1 + 11 * MiB, WS_WD1 = WS_WD0 + 5632 * 1024,
                 WS_POOLT = WS_WD1 + 5632 * 1024, WS_LORAT = WS_POOLT + 512 * 1024;
constexpr size_t WS_XB = 43 * MiB;
constexpr size_t WS_SCW = 43 * MiB, WS_G = 60 * MiB;
constexpr size_t WS_PROJA = 77 * MiB;
constexpr size_t WS_PROJB = 111 * MiB;
constexpr size_t WS_CAT = 111 * MiB, WS_SCB = 145 * MiB, WS_O = 162 * MiB;
constexpr size_t WS_LA = 170 * MiB + 512 * 1024;
constexpr size_t WS_SCR = 179 * MiB, WS_SCV = 196 * MiB, WS_SCK = 213 * MiB, WS_SCKK = 230 * MiB;
constexpr size_t WS_Z = 188 * MiB;
constexpr size_t WS_H = 77 * MiB;
constexpr size_t WS_PL = 77 * MiB;
constexpr size_t WS_PART7 = 145 * MiB;
constexpr size_t WS_PARTA = 170 * MiB + 512 * 1024, WS_PARTB = 1 * MiB;
constexpr size_t WS_XR = 43 * MiB;
constexpr size_t WS_END = 256 * MiB;
static_assert(WS_LORAT + 1536 * 256 * 2 <= WS_XB, "weights");
static_assert(WS_PROJB + (size_t)T * BP * 2 <= WS_LA, "projb");
static_assert(WS_H + (size_t)T * FF * 2 <= WS_Z, "h");
static_assert(WS_Z + (size_t)T * D * 4 <= WS_END, "z");

constexpr size_t O_Y = 0, O_CONV_P = 17825792, O_SHIFT_P = 17948672, O_WKV_P = 17963008, O_POOL_P = 18225152,
                 O_CONV_S = 18348032, O_SHIFT_S = 20314112, O_WKV_S = 20543488, O_POOL_S = 24737792, O_TOTAL = 26703872;

constexpr int LDS_BYTES = 147456;

struct Frame {
    LAS unsigned char* lds;
    int tid, lane, wave, vcu, G;
    const float* const* in;
    float* out; unsigned char* ws;
};

__device__ __forceinline__ float bf2f(unsigned b) { return __uint_as_float(b << 16); }
__device__ __forceinline__ unsigned pkbf(float lo, float hi) { return pg8::cvt_pk_bf16(lo, hi); }
__device__ __forceinline__ unsigned pkh(float lo, float hi) { const unsigned short a = __builtin_bit_cast(unsigned short, (h16)lo), b = __builtin_bit_cast(unsigned short, (h16)hi); return (unsigned)a | ((unsigned)b << 16); }
__device__ __forceinline__ float hlo(unsigned u) { return (float)__builtin_bit_cast(h16, (unsigned short)(u & 0xffffu)); }
__device__ __forceinline__ float hhi(unsigned u) { return (float)__builtin_bit_cast(h16, (unsigned short)(u >> 16)); }
__device__ __forceinline__ void unpack_bf8(v4u w, float (&f)[8]) { const unsigned u0 = w.x, u1 = w.y, u2 = w.z, u3 = w.w;
    f[0] = __uint_as_float(u0 << 16); f[1] = __uint_as_float(u0 & 0xffff0000u); f[2] = __uint_as_float(u1 << 16); f[3] = __uint_as_float(u1 & 0xffff0000u);
    f[4] = __uint_as_float(u2 << 16); f[5] = __uint_as_float(u2 & 0xffff0000u); f[6] = __uint_as_float(u3 << 16); f[7] = __uint_as_float(u3 & 0xffff0000u); }
__device__ __forceinline__ void unpack_h8(v4u w, float (&f)[8]) { const unsigned u0 = w.x, u1 = w.y, u2 = w.z, u3 = w.w; f[0] = hlo(u0); f[1] = hhi(u0); f[2] = hlo(u1); f[3] = hhi(u1); f[4] = hlo(u2); f[5] = hhi(u2); f[6] = hlo(u3); f[7] = hhi(u3); }
__device__ __forceinline__ v4u pack_bf8(const float (&f)[8]) { v4u w; w.x = pkbf(f[0], f[1]); w.y = pkbf(f[2], f[3]); w.z = pkbf(f[4], f[5]); w.w = pkbf(f[6], f[7]); return w; }
__device__ __forceinline__ v4u pack_h8(const float (&f)[8]) { v4u w; w.x = pkh(f[0], f[1]); w.y = pkh(f[2], f[3]); w.z = pkh(f[4], f[5]); w.w = pkh(f[6], f[7]); return w; }
__device__ __forceinline__ void load_f8(const float* p, float (&f)[8]) { const f32x4 a = *(const f32x4*)p, b = *(const f32x4*)(p + 4); f[0] = a.x; f[1] = a.y; f[2] = a.z; f[3] = a.w; f[4] = b.x; f[5] = b.y; f[6] = b.z; f[7] = b.w; }
__device__ __forceinline__ void store_f8(float* p, const float (&f)[8]) { *(f32x4*)p = (f32x4){f[0], f[1], f[2], f[3]}; *(f32x4*)(p + 4) = (f32x4){f[4], f[5], f[6], f[7]}; }
__device__ __forceinline__ float sigmoid_(float x) { return __builtin_amdgcn_rcpf(1.f + __expf(-x)); }
__device__ __forceinline__ float silu_(float x) { return x * sigmoid_(x); }
__device__ __forceinline__ float wave_sum(float v) {
#pragma unroll
    for (int o = 1; o < 64; o <<= 1) v += __shfl_xor(v, o);
    return v;
}
__device__ __forceinline__ float sum8(float v) { v += __shfl_xor(v, 1); v += __shfl_xor(v, 2); v += __shfl_xor(v, 4); return v; }
template <int CTRL> __device__ __forceinline__ float dppf(float x) { return __builtin_bit_cast(float, __builtin_amdgcn_update_dpp(0, __builtin_bit_cast(int, x), CTRL, 0xF, 0xF, true)); }
__device__ __forceinline__ float dpp_sum16(float x) {
    x += dppf<0xB1>(x);
    x += dppf<0x4E>(x);
    x += dppf<0x141>(x);
    x += dppf<0x140>(x);
    return x;
}
__device__ __forceinline__ void h4(v2u x, float (&f)[4]) { const unsigned u0 = x.x, u1 = x.y; f[0] = hlo(u0); f[1] = hhi(u0); f[2] = hlo(u1); f[3] = hhi(u1); }
__device__ __forceinline__ const float* xrow_ptr(const Frame& F, int m) { return m < TP ? F.in[0] + (size_t)m * D : F.in[1] + (size_t)(m - TP) * D; }

using pg8::Unit; using pg8::HALF; using pg8::BM;
typedef pg8::u32x4 u32x4;
struct EpiProj {
    static constexpr bool PERM = true, AFTER_DRAIN = false;
    bf16* PA; bf16* PB;
    __device__ __forceinline__ void operator()(const pg8::f32x4 (&acc)[2][2][4][2], const Unit& u, int wr, int wc, int fr, int fq) const {
        const int row0 = u.pm * BM + wr * 64 + fr;
        bf16* base; int ldc, colt;
        if (u.pn < 4) { base = PA; ldc = 1024; colt = u.pn * BM; } else { base = PB; ldc = BP; colt = (u.pn - 4) * BM; }
        const int col0 = colt + wc * 32 + 8 * fq;
#pragma unroll
        for (int ai = 0; ai < 2; ++ai)
#pragma unroll
            for (int m = 0; m < 4; ++m) { bf16* rowp = base + (size_t)(row0 + ai * HALF + m * 16) * ldc + col0;
#pragma unroll
                for (int bj = 0; bj < 2; ++bj) { const pg8::f32x4 v0 = acc[ai][bj][m][0], v1 = acc[ai][bj][m][1];
                    u32x4 w; w.x = pkbf(v0[0], v0[1]); w.y = pkbf(v0[2], v0[3]); w.z = pkbf(v1[0], v1[1]); w.w = pkbf(v1[2], v1[3]);
                    *(u32x4*)(rowp + bj * HALF) = w; } }
    }
};
struct EpiLora {
    static constexpr bool PERM = true, AFTER_DRAIN = false;
    const float* w0; const float* a0; const float* ka;
    h16* SCW; h16* SCK; h16* SCKK; h16* SCB; h16* G;
    __device__ __forceinline__ void operator()(const pg8::f32x4 (&acc)[2][2][4][2], const Unit& u, int wr, int wc, int fr, int fq) const {
        const int row0 = u.pm * BM + wr * 64 + fr; const int sec = u.pn >> 1;
        const int c0 = (u.pn & 1) * BM + wc * 32 + 8 * fq;
#pragma unroll
        for (int bj = 0; bj < 2; ++bj)
#pragma unroll
            for (int n = 0; n < 2; ++n) {
                const int c = c0 + bj * HALF + 4 * n;
                f32x4 p0 = {0.f, 0.f, 0.f, 0.f}, p1 = {0.f, 0.f, 0.f, 0.f};
                if (sec == 0) p0 = *(const f32x4*)(w0 + c); else if (sec == 1) { p0 = *(const f32x4*)(a0 + c); p1 = *(const f32x4*)(ka + c); }
#pragma unroll
                for (int ai = 0; ai < 2; ++ai)
#pragma unroll
                    for (int m = 0; m < 4; ++m) {
                        const size_t off = (size_t)(row0 + ai * HALF + m * 16) * HW + c;
                        const pg8::f32x4 v = acc[ai][bj][m][n];
                        if (sec == 0) {
                            float o[4];
#pragma unroll
                            for (int i = 0; i < 4; ++i) { const float e = 0.60653065971f * sigmoid_(p0[i] + v[i]); o[i] = 1.f - __expf(-e); }
                            v2u w; w.x = pkh(o[0], o[1]); w.y = pkh(o[2], o[3]); *(v2u*)(SCW + off) = w;
                        } else if (sec == 1) {
                            float kx[4], kk[4], ko[4], bo[4];
                            h4(*(const v2u*)(SCK + off), kx); h4(*(const v2u*)(SCKK + off), kk);
#pragma unroll
                            for (int i = 0; i < 4; ++i) { const float a = sigmoid_(p0[i] + v[i]); ko[i] = kx[i] * (1.f + (a - 1.f) * p1[i]); bo[i] = kk[i] * a; }
                            v2u w; w.x = pkh(ko[0], ko[1]); w.y = pkh(ko[2], ko[3]); *(v2u*)(SCK + off) = w;
                            v2u x; x.x = pkh(bo[0], bo[1]); x.y = pkh(bo[2], bo[3]); *(v2u*)(SCB + off) = x;
                        } else {
                            v2u w; w.x = pkh(v[0], v[1]); w.y = pkh(v[2], v[3]); *(v2u*)(G + off) = w;
                        }
                        asm volatile("" ::: "memory");
                    }
            }
    }
};
struct EpiGateUp {
    static constexpr bool PERM = true, AFTER_DRAIN = false;
    bf16* H;
    __device__ __forceinline__ void operator()(const pg8::f32x4 (&acc)[2][2][4][2], const Unit& u, int wr, int wc, int fr, int fq) const {
        const int row0 = u.pm * BM + wr * 64 + fr; const int col0 = u.pn * HALF + wc * 32 + 8 * fq;
#pragma unroll
        for (int ai = 0; ai < 2; ++ai)
#pragma unroll
            for (int m = 0; m < 4; ++m) {
                const pg8::f32x4 g0 = acc[ai][0][m][0], g1 = acc[ai][0][m][1], u0 = acc[ai][1][m][0], u1 = acc[ai][1][m][1];
                u32x4 w; w.x = pkbf(silu_(g0[0]) * u0[0], silu_(g0[1]) * u0[1]); w.y = pkbf(silu_(g0[2]) * u0[2], silu_(g0[3]) * u0[3]);
                w.z = pkbf(silu_(g1[0]) * u1[0], silu_(g1[1]) * u1[1]); w.w = pkbf(silu_(g1[2]) * u1[2], silu_(g1[3]) * u1[3]);
                *(u32x4*)(H + (size_t)(row0 + ai * HALF + m * 16) * FF + col0) = w;
            }
    }
};
struct EpiResid {
    static constexpr bool PERM = false, AFTER_DRAIN = false;
    const float* xp; const float* xs; float* Z; const float* scale;
    const bf16* XBr;
    h16* pa; h16* pb;
    __device__ __forceinline__ void operator()(const pg8::f32x4 (&acc)[2][2][4][2], const Unit& u, int wr, int wc, int fr, int fq) const {
        const int col0 = u.pn * BM + wc * 32 + 4 * fq;
#pragma unroll
        for (int ai = 0; ai < 2; ++ai)
#pragma unroll
            for (int m = 0; m < 4; ++m) {
                const int row = u.pm * BM + ai * HALF + wr * 64 + m * 16 + fr;
                float* zr = Z + (size_t)row * D + col0;
                const float* br = xp ? ((row < TP ? xp + (size_t)row * D : xs + (size_t)(row - TP) * D) + col0) : nullptr;
                const bf16* bb = XBr + (size_t)row * D + col0;
#pragma unroll
                for (int bj = 0; bj < 2; ++bj)
#pragma unroll
                    for (int n = 0; n < 2; ++n) {
                        const int o = bj * HALF + n * 16;
                        pg8::f32x4 a = acc[ai][bj][m][n];
                        if (scale) a = a * *(const pg8::f32x4*)(scale + col0 + o);
                        if (u.mode == 1) {
                            const int sp = u.kt0 / u.nt;
                            h16* pr = (sp < 8 ? pa + (size_t)sp * (1u << 20) : pb + (size_t)(sp - 8) * (1u << 20)) + (size_t)(row - TP) * D + col0;
                            v2u w; w.x = pkh(a[0], a[1]); w.y = pkh(a[2], a[3]); *(v2u*)(pr + o) = w;
                        } else {
                            pg8::f32x4 b;
                            if (xp) b = *(const pg8::f32x4*)(br + o);
                            else { const v2u w = *(const v2u*)(bb + o); const unsigned w0 = w.x, w1 = w.y; b = (pg8::f32x4){__uint_as_float(w0 << 16), __uint_as_float(w0 & 0xffff0000u), __uint_as_float(w1 << 16), __uint_as_float(w1 & 0xffff0000u)}; }
                            *(pg8::f32x4*)(zr + o) = b * ALPHA + a;
                        }
                    }
            }
    }
};

struct SplitOrder {
    pg8::StaticOrder base; int NS, ntc, c;
    __device__ void init(int N, int G, int c_, int K, int NS_) { base.init(TP, N, G, c_, K); NS = NS_; ntc = (K / pg8::BK) / NS_; c = c_; }
    __device__ bool next(int i, Unit& u) const {
        if (i == 0) return base.next(0, u);
        if (i == 1) { if (c >= 16 * NS) return false; const int unit = c / NS, sp = c % NS; u.pm = 64 + (unit >> 2); u.pn = unit & 3; u.kt0 = sp * ntc; u.nt = ntc; u.mode = 1; return true; }
        return false;
    }
    __device__ __forceinline__ void a_ready(const Unit&) const {}
    __device__ __forceinline__ void done(const Unit&) const {}
};

__device__ __forceinline__ void transpose_item(const float* W, int K, int N, bf16* WT, int mode, LAS float* scr, int item, int lane) {
    const int nblk = N / 32, kb = item / nblk, nb = item % nblk, k0 = 64 * kb, n0 = 32 * nb;
    const int drow0 = mode == 0 ? n0 : ((n0 >> 7) * 256 + (mode == 2 ? 128 : 0) + (n0 & 127));
#pragma unroll 8
    for (int i = 0; i < 32; ++i) { const int kk = 2 * i + (lane >> 5); scr[kk * 33 + (lane & 31)] = W[(size_t)(k0 + kk) * N + n0 + (lane & 31)]; }
    asm volatile("s_waitcnt lgkmcnt(0)" ::: "memory");
    const int c = lane & 7;
#pragma unroll
    for (int j = 0; j < 4; ++j) { const int n = (lane >> 3) + 8 * j; const LAS float* s = scr + (8 * c) * 33 + n;
        v4u o; o.x = pkbf(s[0 * 33], s[1 * 33]); o.y = pkbf(s[2 * 33], s[3 * 33]); o.z = pkbf(s[4 * 33], s[5 * 33]); o.w = pkbf(s[6 * 33], s[7 * 33]);
        *(v4u*)(WT + (size_t)(drow0 + n) * K + k0 + 8 * c) = o; }
    asm volatile("s_waitcnt lgkmcnt(0)" ::: "memory");
}
__device__ __forceinline__ void p0_prologue(Frame& F) {
    LAS float* scr = (LAS float*)(F.lds + F.wave * 16384);
    const int gw = F.vcu * NWAVES + F.wave, NGW = F.G * NWAVES;
    unsigned char* ws = F.ws;
    constexpr int I_IN = 16 * 88, I_OUT = 16 * 32, I_GU = 16 * 88, I_DN = 44 * 32, I_PL = 4 * 8;
    constexpr int NITEMS = I_IN + I_OUT + 2 * (2 * I_GU + I_DN) + 4 * I_PL;
    for (int it = gw; it < NITEMS; it += NGW) {
        int r = it;
        if (r < I_IN) { transpose_item(F.in[6], D, INP, (bf16*)(ws + WS_WIN), 0, scr, r, F.lane); continue; } r -= I_IN;
        if (r < I_OUT) { transpose_item(F.in[22], D, D, (bf16*)(ws + WS_WOUT), 0, scr, r, F.lane); continue; } r -= I_OUT;
        constexpr int I_LAYER = 2 * I_GU + I_DN;
        if (r < 2 * I_LAYER) {
            const int l = r / I_LAYER; int q = r % I_LAYER;
            bf16* gu = (bf16*)(ws + (l ? WS_WGU1 : WS_WGU0)); bf16* dn = (bf16*)(ws + (l ? WS_WD1 : WS_WD0));
            if (q < I_GU) { transpose_item(F.in[27] + (size_t)l * D * FF, D, FF, gu, 1, scr, q, F.lane); continue; } q -= I_GU;
            if (q < I_GU) { transpose_item(F.in[28] + (size_t)l * D * FF, D, FF, gu, 2, scr, q, F.lane); continue; } q -= I_GU;
            transpose_item(F.in[29] + (size_t)l * FF * D, FF, D, dn, 0, scr, q, F.lane); continue;
        }
        r -= 2 * I_LAYER;
        { const int g = r / I_PL, ri = r % I_PL; transpose_item(F.in[23] + (size_t)g * 65536, 256, 256, (bf16*)(ws + WS_POOLT) + (size_t)g * 65536, 0, scr, ri, F.lane); }
    }
    const int gt = F.vcu * NTHREADS + F.tid, NGT = F.G * NTHREADS;
    bf16* XB = (bf16*)(ws + WS_XB);
    float* Zp = (float*)(ws + WS_Z);
    for (int i = gt; i < T * D / 8; i += NGT) { const int m = i >> 7, c8 = (i & 127) * 8; float f[8]; load_f8(xrow_ptr(F, m) + c8, f); *(v4u*)(XB + (size_t)m * D + c8) = pack_bf8(f);
        if (m >= TP) { float z[8];
#pragma unroll
            for (int e = 0; e < 8; ++e) z[e] = ALPHA * f[e];
            store_f8(Zp + (size_t)m * D + c8, z); } }
    bf16* LT = (bf16*)(ws + WS_LORAT);
    for (int i = gt; i < 1536 * 256 / 2; i += NGT) { const int j = i >> 7, k = (i & 127) * 2; float v[2];
#pragma unroll
        for (int e = 0; e < 2; ++e) { const int kk = k + e; float x = 0.f;
            if (j < 512) { if (kk < 64) x = F.in[13][(size_t)kk * 512 + j]; }
            else if (j < 1024) { if (kk >= 64 && kk < 128) x = F.in[15][(size_t)(kk - 64) * 512 + (j - 512)]; }
            else { if (kk >= 128) x = F.in[16][(size_t)(kk - 128) * 512 + (j - 1024)]; }
            v[e] = x; }
        *(unsigned*)(LT + (size_t)j * 256 + k) = pkbf(v[0], v[1]); }
}

__device__ __forceinline__ void p2_rows(Frame& F) {
    const int gw = F.vcu * NWAVES + F.wave, NGW = F.G * NWAVES, lane = F.lane;
    unsigned char* ws = F.ws;
    const bf16* PB = (const bf16*)(ws + WS_PROJB);
    h16* SCR = (h16*)(ws + WS_SCR); h16* SCK = (h16*)(ws + WS_SCK); h16* SCV = (h16*)(ws + WS_SCV); h16* SCKK = (h16*)(ws + WS_SCKK);
    bf16* LA = (bf16*)(ws + WS_LA);
    const float* mu = F.in[11]; const float* kkw = F.in[17]; const float* sshift = F.in[3];
    for (int m = gw; m < T; m += NGW) {
        const bool sample = m >= TP; const int seq = sample ? (m - TP) >> 3 : m >> 11, t = sample ? (m - TP) & 7 : m & 2047, L = sample ? LS : LP;
        const bf16* pb = PB + (size_t)m * BP;
        float* oshift = F.out + (sample ? O_SHIFT_S : O_SHIFT_P) + (size_t)seq * BP;
        const bool last = (t == L - 1);
#pragma unroll
        for (int sec = 0; sec < 4; ++sec) {
            if (sec == 3 && lane >= 32) break;
            const int col = sec * 512 + lane * 8;
            float p[8], pv[8], mv[8], xm[8];
            unpack_bf8(*(const v4u*)(pb + col), p);
            if (t > 0) unpack_bf8(*(const v4u*)(pb - BP + col), pv);
            else if (sample) load_f8(sshift + (size_t)seq * BP + col, pv);
            else {
#pragma unroll
                for (int i = 0; i < 8; ++i) pv[i] = 0.f; }
            load_f8(mu + col, mv);
#pragma unroll
            for (int i = 0; i < 8; ++i) xm[i] = p[i] + mv[i] * (pv[i] - p[i]);
            if (last) store_f8(oshift + col, p);
            const size_t off = (size_t)m * HW + lane * 8;
            if (sec == 0) *(v4u*)(SCR + off) = pack_h8(xm);
            else if (sec == 1) {
                *(v4u*)(SCK + off) = pack_h8(xm);
                float kw[8], kx[8]; load_f8(kkw + lane * 8, kw); float ss = 0.f;
#pragma unroll
                for (int i = 0; i < 8; ++i) { kx[i] = xm[i] * kw[i]; ss += kx[i] * kx[i]; }
                ss = sum8(ss);
                const float inv = 1.f / fmaxf(sqrtf(ss), 1e-12f);
#pragma unroll
                for (int i = 0; i < 8; ++i) kx[i] *= inv;
                *(v4u*)(SCKK + off) = pack_h8(kx);
            } else if (sec == 2) *(v4u*)(SCV + off) = pack_h8(xm);
            else {
                float o[8];
#pragma unroll
                for (int i = 0; i < 8; ++i) {
                    if (lane < 8) { const float e = __expf(2.f * xm[i]); o[i] = 1.f - 2.f * __builtin_amdgcn_rcpf(e + 1.f); }
                    else if (lane < 16) o[i] = xm[i];
                    else o[i] = sigmoid_(xm[i]);
                }
                *(v4u*)(LA + (size_t)m * 256 + lane * 8) = pack_bf8(o);
            }
        }
    }
}

template <int TT> __device__ __forceinline__ void conv_tile(Frame& F, int m0, int t0, int seq, bool sample) {
    const int c = F.tid;
    unsigned char* ws = F.ws;
    const bf16* PA = (const bf16*)(ws + WS_PROJA); bf16* CAT = (bf16*)(ws + WS_CAT);
    const float* cw = F.in[7]; const float* sconv = F.in[2];
    LAS float* ylds = (LAS float*)F.lds;
    float w[31];
#pragma unroll
    for (int j = 0; j < 31; ++j) w[j] = cw[j * 512 + c];
    float y[TT]; const float bias = F.in[8][c];
#pragma unroll
    for (int t = 0; t < TT; ++t) y[t] = bias;
    const bool lastp = (!sample) && (t0 + TT == LP);
    float* oconv = F.out + (sample ? O_CONV_S : O_CONV_P) + (size_t)seq * 30 * 512 + c;
    const bf16* pp = PA + ((size_t)m0 - 30) * 1024 + c; const float* scp = sconv + ((size_t)seq * 30 + t0) * 512 + c;
#pragma unroll
    for (int s = -30; s < TT; ++s) {
        float u;
        asm volatile("" : "+v"(pp), "+v"(scp));
        if (t0 + s >= 0) { const float val = bf2f(pp[0]), gate = bf2f(pp[512]); u = val * sigmoid_(gate); }
        else u = sample ? *scp : 0.f;
        pp += 1024; scp += 512;
#pragma unroll
        for (int t = 0; t < TT; ++t) { const int j = s - t + 30; if (j >= 0 && j <= 30) y[t] += u * w[j]; }
        if (sample) { if (s + 22 >= 0) oconv[(size_t)(s + 22) * 512] = u; }
        else if (lastp && s >= TT - 30) oconv[(size_t)(s - (TT - 30)) * 512] = u;
    }
#pragma unroll
    for (int t = 0; t < TT; ++t) ylds[t * 512 + c] = y[t];
    __syncthreads();
    const float* lg = F.in[9]; const float* lb = F.in[10];
    for (int t = F.wave; t < TT; t += NWAVES) {
        const LAS float* yr = ylds + t * 512 + F.lane * 8;
        float v[8];
        { const f32x4 a = *(const LAS f32x4*)yr, b = *(const LAS f32x4*)(yr + 4); v[0] = a.x; v[1] = a.y; v[2] = a.z; v[3] = a.w; v[4] = b.x; v[5] = b.y; v[6] = b.z; v[7] = b.w; }
        float s = 0.f;
#pragma unroll
        for (int i = 0; i < 8; ++i) s += v[i];
        const float mean = wave_sum(s) * (1.f / 512.f); float q = 0.f;
#pragma unroll
        for (int i = 0; i < 8; ++i) { v[i] -= mean; q += v[i] * v[i]; }
        const float rstd = rsqrtf(wave_sum(q) * (1.f / 512.f) + LN_EPS);
        float g8[8], b8[8], o[8]; load_f8(lg + F.lane * 8, g8); load_f8(lb + F.lane * 8, b8);
#pragma unroll
        for (int i = 0; i < 8; ++i) o[i] = silu_(v[i] * rstd * g8[i] + b8[i]);
        *(v4u*)(CAT + (size_t)(m0 + t) * 1024 + F.lane * 8) = pack_bf8(o);
    }
    __syncthreads();
}
__device__ __forceinline__ void conv_phase(Frame& F) {
    for (int it = F.vcu; it < 512 + 128; it += F.G) {
        if (it < 512) { const int m0 = it * 32; conv_tile<32>(F, m0, m0 & 2047, m0 >> 11, false); }
        else { const int seq = it - 512; conv_tile<8>(F, TP + seq * 8, 0, seq, true); }
    }
}

constexpr int SU = 8;
struct ScanPtrs { const h16* R; const h16* K; const h16* V; const h16* KK; const h16* B; const h16* W; h16* O; };
struct ScanBuf { v2u r[SU], k[SU], kk[SU], b[SU], w[SU]; unsigned short v[SU]; };
__device__ __forceinline__ void scan_load(ScanBuf& Bf, const ScanPtrs& P, size_t off, int ks, int row) {
#pragma unroll
    for (int i = 0; i < SU; ++i) { const size_t o = off + (size_t)i * HW;
        Bf.r[i] = *(const v2u*)(P.R + o + ks); Bf.k[i] = *(const v2u*)(P.K + o + ks); Bf.kk[i] = *(const v2u*)(P.KK + o + ks);
        Bf.b[i] = *(const v2u*)(P.B + o + ks); Bf.w[i] = *(const v2u*)(P.W + o + ks); Bf.v[i] = *(const unsigned short*)(P.V + o + row); }
}
__device__ __forceinline__ void scan_compute(const ScanBuf& Bf, float (&S)[4], const ScanPtrs& P, size_t off, int row, bool writer) {
#pragma unroll
    for (int i = 0; i < SU; ++i) {
        float r[4], k[4], kk[4], b[4], w[4]; h4(Bf.r[i], r); h4(Bf.k[i], k); h4(Bf.kk[i], kk); h4(Bf.b[i], b); h4(Bf.w[i], w);
        const float v = (float)__builtin_bit_cast(h16, Bf.v[i]);
        float d = (S[0] * kk[0] + S[1] * kk[1]) + (S[2] * kk[2] + S[3] * kk[3]);
        float pj[4];
#pragma unroll
        for (int j = 0; j < 4; ++j) pj[j] = fmaf(v, k[j], fmaf(-S[j], w[j], S[j]));
        d = dpp_sum16(d);
#pragma unroll
        for (int j = 0; j < 4; ++j) S[j] = fmaf(-d, b[j], pj[j]);
        float o = (S[0] * r[0] + S[1] * r[1]) + (S[2] * r[2] + S[3] * r[3]);
        o = dpp_sum16(o);
        if (writer) P.O[off + (size_t)i * HW + row] = (h16)o;
    }
}
template <int L> __device__ __forceinline__ void scan_task(const ScanPtrs& P, int mbase, int h, int v0, const float* s_in, float* s_out, int lane) {
    const int rl = lane >> 4, ks = (lane & 15) * 4, row = v0 + rl; const bool writer = (lane & 15) == 0;
    float S[4] = {0.f, 0.f, 0.f, 0.f};
    if (s_in) { const f32x4 s = *(const f32x4*)(s_in + (size_t)row * 64 + ks); S[0] = s.x; S[1] = s.y; S[2] = s.z; S[3] = s.w; }
    size_t off = (size_t)mbase * HW + h * 64;
    ScanBuf A;
    scan_load(A, P, off, ks, row);
    if constexpr (L == SU) { scan_compute(A, S, P, off, row, writer); }
    else {
        ScanBuf Bf;
        for (int t = 0; t < L; t += 2 * SU) {
            scan_load(Bf, P, off + (size_t)SU * HW, ks, row);
            scan_compute(A, S, P, off, row, writer);
            if (t + 2 * SU < L) scan_load(A, P, off + (size_t)2 * SU * HW, ks, row);
            scan_compute(Bf, S, P, off + (size_t)SU * HW, row, writer);
            off += (size_t)2 * SU * HW;
        }
    }
    *(f32x4*)(s_out + (size_t)row * 64 + ks) = (f32x4){S[0], S[1], S[2], S[3]};
}
constexpr int RING_SLOTS = 64, SLOT_BYTES = 1536, FLAG_OFF = 131072 + 1024;
constexpr unsigned SPIN_CAP = 1u << 22;
struct StepF { f32x4 r, k, kk, b, w; float v; };
__device__ __forceinline__ void ld_stepf(StepF& X, const LAS unsigned char* slot, unsigned rd, unsigned vd) {
    X.r = *(const LAS f32x4*)(slot + 0 * 256 + rd); X.k = *(const LAS f32x4*)(slot + 1 * 256 + rd); X.kk = *(const LAS f32x4*)(slot + 2 * 256 + rd);
    X.b = *(const LAS f32x4*)(slot + 3 * 256 + rd); X.w = *(const LAS f32x4*)(slot + 4 * 256 + rd); X.v = *(const LAS float*)(slot + vd);
}
__device__ __forceinline__ float step_computef(const StepF& X, float (&S)[4]) {
    float d = (S[0] * X.kk[0] + S[1] * X.kk[1]) + (S[2] * X.kk[2] + S[3] * X.kk[3]);
    float pj[4];
#pragma unroll
    for (int j = 0; j < 4; ++j) pj[j] = fmaf(X.v, X.k[j], fmaf(-S[j], X.w[j], S[j]));
    d = dpp_sum16(d);
#pragma unroll
    for (int j = 0; j < 4; ++j) S[j] = fmaf(-d, X.b[j], pj[j]);
    float o = (S[0] * X.r[0] + S[1] * X.r[1]) + (S[2] * X.r[2] + S[3] * X.r[3]);
    return dpp_sum16(o);
}
__device__ __forceinline__ unsigned min4(const volatile LAS unsigned* p) { const unsigned a = p[0], b = p[1], c = p[2], d = p[3]; return min(min(a, b), min(c, d)); }
__device__ __forceinline__ void scan_prompt_consumer(Frame& F, int mbase, int h, int v0, float* s_out) {
    const int lane = F.lane, rl = lane >> 4, l16 = lane & 15, ks = l16 * 4, row = v0 + rl;
    const LAS unsigned char* ring = F.lds;
    volatile LAS unsigned* prod = (volatile LAS unsigned*)(F.lds + FLAG_OFF); volatile LAS unsigned* cons = prod + 4;
    h16* O = (h16*)(F.ws + WS_O) + (size_t)mbase * HW + h * 64 + row;
    const unsigned rd = ks * 4, vd = 5 * 256 + row * 4;
    constexpr int L = LP;
    float S[4] = {0.f, 0.f, 0.f, 0.f};
    StepF A, B;
    { unsigned sp = 0; while (min4(prod) < 2u && ++sp < SPIN_CAP) __builtin_amdgcn_s_sleep(1); }
    asm volatile("" ::: "memory");
    ld_stepf(A, ring, rd, vd);
    float okeep = 0.f;
#pragma unroll 1
    for (int tb = 0; tb < L; tb += 16) {
#pragma unroll
        for (int j = 0; j < 16; ++j) {
            const int t = tb + j;
            if ((j & 3) == 0) {
                const unsigned need = (unsigned)min(t / 4 + 2, L / 4);
                unsigned sp = 0; while (min4(prod) < need && ++sp < SPIN_CAP) __builtin_amdgcn_s_sleep(1);
                asm volatile("" ::: "memory");
            }
            float o;
            if (j & 1) { ld_stepf(A, ring + ((t + 1) & (RING_SLOTS - 1)) * SLOT_BYTES, rd, vd); o = step_computef(B, S); }
            else       { ld_stepf(B, ring + ((t + 1) & (RING_SLOTS - 1)) * SLOT_BYTES, rd, vd); o = step_computef(A, S); }
            okeep = (l16 == j) ? o : okeep;
            if ((j & 3) == 3) { asm volatile("s_waitcnt lgkmcnt(0)" ::: "memory"); if (lane == 0) cons[F.wave] = (unsigned)(t + 1); }
        }
        O[(size_t)(tb + l16) * HW] = (h16)okeep;
    }
    *(f32x4*)(s_out + (size_t)row * 64 + ks) = (f32x4){S[0], S[1], S[2], S[3]};
}
__device__ __forceinline__ void scan_prompt_loader(Frame& F, int mbase, int h) {
    const int lane = F.lane, w = F.wave - 4;
    LAS unsigned char* ring = F.lds;
    volatile LAS unsigned* prod = (volatile LAS unsigned*)(F.lds + FLAG_OFF); volatile LAS unsigned* cons = prod + 4;
    const int arr = lane < 40 ? (lane >> 3) : 5, part = lane & 7;
    const size_t abase = arr == 0 ? WS_SCR : arr == 1 ? WS_SCK : arr == 2 ? WS_SCKK : arr == 3 ? WS_SCB : arr == 4 ? WS_SCW : WS_SCV;
    const unsigned char* src = F.ws + abase + ((size_t)mbase * HW + h * 64) * 2 + part * 16;
    const bool active = lane < 48;
    const unsigned dst = arr * 256 + part * 32;
    constexpr int L = LP, PF = 8;
    v4u buf[PF];
#pragma unroll
    for (int i = 0; i < PF; ++i) { const int s0 = w + 4 * i; buf[i] = active ? *(const v4u*)(src + (size_t)s0 * 1024) : (v4u){0u, 0u, 0u, 0u}; }
#pragma unroll 1
    for (int sb = w; sb < L; sb += 4 * PF) {
#pragma unroll
        for (int i = 0; i < PF; ++i) {
            const int st = sb + 4 * i;
            if (st >= RING_SLOTS) { unsigned sp = 0; while (min4(cons) < (unsigned)(st - RING_SLOTS + 1) && ++sp < SPIN_CAP) __builtin_amdgcn_s_sleep(1); }
            asm volatile("" ::: "memory");
            float f[8]; unpack_h8(buf[i], f);
            { const int sn = st + 4 * PF; if (sn < L) buf[i] = active ? *(const v4u*)(src + (size_t)sn * 1024) : (v4u){0u, 0u, 0u, 0u}; }
            if (active) { LAS unsigned char* p = ring + (st & (RING_SLOTS - 1)) * SLOT_BYTES + dst;
                *(LAS f32x4*)p = (f32x4){f[0], f[1], f[2], f[3]}; *(LAS f32x4*)(p + 16) = (f32x4){f[4], f[5], f[6], f[7]}; }
            asm volatile("s_waitcnt lgkmcnt(0)" ::: "memory");
            if (lane == 0) prod[w] = (unsigned)(st >> 2) + 1u;
        }
    }
}
__device__ __forceinline__ void scan_phase(Frame& F) {
    unsigned char* ws = F.ws;
    ScanPtrs P{(const h16*)(ws + WS_SCR), (const h16*)(ws + WS_SCK), (const h16*)(ws + WS_SCV), (const h16*)(ws + WS_SCKK), (const h16*)(ws + WS_SCB), (const h16*)(ws + WS_SCW), (h16*)(ws + WS_O)};
    for (int task = F.vcu; task < 256; task += F.G) {
        if (F.tid < 8) ((volatile LAS unsigned*)(F.lds + FLAG_OFF))[F.tid] = 0u;
        __syncthreads();
        const int pair = task >> 2, q = task & 3, n = pair >> 3, h = pair & 7;
        if (F.wave < 4) scan_prompt_consumer(F, n * LP, h, q * 16 + F.wave * 4, F.out + O_WKV_P + (size_t)pair * 4096);
        else scan_prompt_loader(F, n * LP, h);
        __syncthreads();
    }
    {
        const int gw = F.vcu * NWAVES + F.wave, NGW = F.G * NWAVES;
        for (int task = gw; task < NSB * 8 * 16; task += NGW) {
            const int pair = task >> 4, rg = task & 15, n = pair >> 3, h = pair & 7;
            scan_task<LS>(P, TP + n * LS, h, rg * 4, F.in[4] + (size_t)pair * 4096, F.out + O_WKV_S + (size_t)pair * 4096, F.lane);
        }
    }
}

__device__ __forceinline__ void p6_rows(Frame& F) {
    const int gw = F.vcu * NWAVES + F.wave, NGW = F.G * NWAVES, lane = F.lane;
    unsigned char* ws = F.ws;
    const h16* O = (const h16*)(ws + WS_O); const h16* SCR = (const h16*)(ws + WS_SCR); const h16* SCK = (const h16*)(ws + WS_SCK); const h16* SCV = (const h16*)(ws + WS_SCV); const h16* G = (const h16*)(ws + WS_G);
    bf16* CAT = (bf16*)(ws + WS_CAT);
    float rk[8], lg[8], lb[8]; load_f8(F.in[19] + lane * 8, rk); load_f8(F.in[20] + lane * 8, lg); load_f8(F.in[21] + lane * 8, lb);
    for (int m = gw; m < T; m += NGW) {
        const size_t off = (size_t)m * HW + lane * 8;
        float o[8], r[8], k[8], v[8], g[8];
        unpack_h8(*(const v4u*)(O + off), o); unpack_h8(*(const v4u*)(SCR + off), r); unpack_h8(*(const v4u*)(SCK + off), k); unpack_h8(*(const v4u*)(SCV + off), v); unpack_h8(*(const v4u*)(G + off), g);
        float s = 0.f, bs = 0.f;
#pragma unroll
        for (int i = 0; i < 8; ++i) { s += o[i]; bs += r[i] * k[i] * rk[i]; }
        const float mean = sum8(s) * (1.f / 64.f); bs = sum8(bs); float q = 0.f;
#pragma unroll
        for (int i = 0; i < 8; ++i) { o[i] -= mean; q += o[i] * o[i]; }
        const float rstd = rsqrtf(sum8(q) * (1.f / 64.f) + GN_EPS);
        float res[8];
#pragma unroll
        for (int i = 0; i < 8; ++i) res[i] = (o[i] * rstd * lg[i] + lb[i] + bs * v[i]) * g[i];
        *(v4u*)(CAT + (size_t)m * 1024 + 512 + lane * 8) = pack_bf8(res);
    }
}

template <int MODE> __device__ __forceinline__ void ln_rows(Frame& F, const float* g, const float* b, int nparts, const h16* pa, const h16* pb) {
    const int gw = F.vcu * NWAVES + F.wave, NGW = F.G * NWAVES, lane = F.lane;
    float* Z = (float*)(F.ws + WS_Z); bf16* XB = (bf16*)(F.ws + WS_XB);
    f32x4 gv[4], bv[4];
#pragma unroll
    for (int j = 0; j < 4; ++j) { gv[j] = *(const f32x4*)(g + 4 * (lane + 64 * j)); bv[j] = *(const f32x4*)(b + 4 * (lane + 64 * j)); }
    for (int m = gw; m < T; m += NGW) {
        float* zr = Z + (size_t)m * D;
        f32x4 v[4]; float s = 0.f;
#pragma unroll
        for (int j = 0; j < 4; ++j) v[j] = *(const f32x4*)(zr + 4 * (lane + 64 * j));
        if (m >= TP) {
#pragma unroll 2
            for (int sp = 0; sp < nparts; ++sp) { const h16* pr = (sp < 8 ? pa + (size_t)sp * (1u << 20) : pb + (size_t)(sp - 8) * (1u << 20)) + (size_t)(m - TP) * D;
#pragma unroll
                for (int j = 0; j < 4; ++j) { float f[4]; h4(*(const v2u*)(pr + 4 * (lane + 64 * j)), f); v[j] = v[j] + (f32x4){f[0], f[1], f[2], f[3]}; } }
        }
#pragma unroll
        for (int j = 0; j < 4; ++j) s += (v[j].x + v[j].y) + (v[j].z + v[j].w);
        const float mean = wave_sum(s) * (1.f / D); float s2 = 0.f;
#pragma unroll
        for (int j = 0; j < 4; ++j) { v[j] = v[j] - mean; s2 += (v[j].x * v[j].x + v[j].y * v[j].y) + (v[j].z * v[j].z + v[j].w * v[j].w); }
        const float rstd = rsqrtf(wave_sum(s2) * (1.f / D) + LN_EPS);
#pragma unroll
        for (int j = 0; j < 4; ++j) v[j] = v[j] * rstd * gv[j] + bv[j];
        if (MODE == 2) {
#pragma unroll
            for (int j = 0; j < 4; ++j) *(f32x4*)(F.out + O_Y + (size_t)m * D + 4 * (lane + 64 * j)) = v[j];
        } else {
            if (MODE == 0 && m >= TP) {
#pragma unroll
                for (int j = 0; j < 4; ++j) *(f32x4*)(zr + 4 * (lane + 64 * j)) = v[j] * ALPHA;
            }
#pragma unroll
            for (int j = 0; j < 4; ++j) { v2u w; w.x = pkbf(v[j].x, v[j].y); w.y = pkbf(v[j].z, v[j].w); *(v2u*)(XB + (size_t)m * D + 4 * (lane + 64 * j)) = w; }
        }
        if (MODE == 1) {
            const bool sample = m >= TP; const int seq = sample ? (m - TP) >> 3 : m >> 11, t = sample ? (m - TP) & 7 : m & 2047;
            if (sample) {
                float* op = F.out + O_POOL_S + ((size_t)seq * 15 + 7 + t) * D;
#pragma unroll
                for (int j = 0; j < 4; ++j) *(f32x4*)(op + 4 * (lane + 64 * j)) = v[j];
                if (t == 0) { const float* sp = F.in[5] + ((size_t)seq * 15 + 8) * D; float* o0 = F.out + O_POOL_S + (size_t)seq * 15 * D;
                    for (int i = lane; i < 7 * D / 4; i += 64) *(f32x4*)(o0 + 4 * i) = *(const f32x4*)(sp + 4 * i); }
            } else if (t >= LP - 15) {
                float* op = F.out + O_POOL_P + ((size_t)seq * 15 + (t - (LP - 15))) * D;
#pragma unroll
                for (int j = 0; j < 4; ++j) *(f32x4*)(op + 4 * (lane + 64 * j)) = v[j];
            }
        }
    }
}

template <int TT> __device__ __forceinline__ float pool_one(const float (&xs)[TT + 15], int t, int g, int cnt) {
    const float x0 = xs[t + 15];
    const float s2 = x0 + xs[t + 14];
    const float s4 = s2 + (xs[t + 13] + xs[t + 12]);
    const float s8 = s4 + ((xs[t + 11] + xs[t + 10]) + (xs[t + 9] + xs[t + 8]));
    const float s16 = s8 + (((xs[t + 7] + xs[t + 6]) + (xs[t + 5] + xs[t + 4])) + ((xs[t + 3] + xs[t + 2]) + (xs[t + 1] + xs[t + 0])));
    const float sum = g == 0 ? s2 : (g == 1 ? s4 : (g == 2 ? s8 : s16));
    return sum / (float)cnt - x0;
}
template <int TT> __device__ __forceinline__ void pool_tile(Frame& F, int m0, int t0, int seq, bool sample) {
    const bf16* XR = (const bf16*)(F.ws + WS_XR); bf16* PL = (bf16*)(F.ws + WS_PL); const float* spool = F.in[5];
    const int c = 2 * F.tid, g = c >> 8;
    float xa[TT + 15], xb[TT + 15];
    const bf16* zp = XR + ((size_t)m0 - 15) * D + c; const float* sp = spool + ((size_t)seq * 15 + t0) * D + c;
#pragma unroll
    for (int s = -15; s < TT; ++s) {
        asm volatile("" : "+v"(zp), "+v"(sp));
        if (t0 + s >= 0) { const unsigned w = *(const unsigned*)zp; xa[s + 15] = __uint_as_float(w << 16); xb[s + 15] = __uint_as_float(w & 0xffff0000u); }
        else if (sample) { xa[s + 15] = sp[0]; xb[s + 15] = sp[1]; }
        else { xa[s + 15] = 0.f; xb[s + 15] = 0.f; }
        zp += D; sp += D;
    }
    const int wdw = 2 << g;
#pragma unroll
    for (int t = 0; t < TT; ++t) {
        const int cnt = sample ? wdw : min(wdw, t0 + t + 1);
        const float p0 = pool_one<TT>(xa, t, g, cnt), p1 = pool_one<TT>(xb, t, g, cnt);
        *(unsigned*)(PL + (size_t)(m0 + t) * D + c) = pkbf(p0, p1);
    }
}
__device__ __forceinline__ void pool_phase(Frame& F) {
    for (int it = F.vcu; it < 512 + 128; it += F.G) {
        if (it < 512) { const int m0 = it * 32; pool_tile<32>(F, m0, m0 & 2047, m0 >> 11, false); }
        else { const int seq = it - 512; pool_tile<8>(F, TP + seq * 8, 0, seq, true); }
    }
}


#ifndef DIAG_AT
#define DIAG_AT -1
#endif
__device__ __forceinline__ bool dbad(float got, float want) { return !(fabsf(got - want) <= 0.03f * fabsf(want) + 0.02f); }
__device__ __forceinline__ float h2f(h16 x) { return (float)x; }
__device__ __forceinline__ void diag_checks(Frame& F, int at) {
    if (blockIdx.x != 0 || F.wave != 0) return;
    const int lane = F.lane; unsigned char* ws = F.ws;
    unsigned mask = 0;
    const bf16* PA = (const bf16*)(ws + WS_PROJA); const bf16* PB = (const bf16*)(ws + WS_PROJB);
    const h16* SCR = (const h16*)(ws + WS_SCR); const h16* SCK = (const h16*)(ws + WS_SCK); const h16* SCV = (const h16*)(ws + WS_SCV); const h16* SCKK = (const h16*)(ws + WS_SCKK);
    const h16* SCB = (const h16*)(ws + WS_SCB); const h16* SCW = (const h16*)(ws + WS_SCW);
    const int m = 1 + (lane * 131 + 7) % 9000;
    const int t = m & 2047;
    if (at == 3) {
        const int c = (lane * 29 + 5) % 512, h0 = c & ~63;
        auto xm = [&](int col) { const float p = bf2f(PB[(size_t)m * BP + col]); const float pv = t > 0 ? bf2f(PB[(size_t)(m - 1) * BP + col]) : 0.f; return p + F.in[11][col] * (pv - p); };
        float ss = 0.f; for (int j = 0; j < 64; ++j) { const float kx = xm(512 + h0 + j) * F.in[17][h0 + j]; ss += kx * kx; }
        const float kkn = xm(512 + c) * F.in[17][c] / fmaxf(sqrtf(ss), 1e-12f);
        float al = F.in[14][c]; for (int j = 0; j < 64; ++j) al += xm(1600 + j) * F.in[15][(size_t)j * 512 + c];
        const float a = 1.f / (1.f + expf(-al)); const float f = (1.f + (a - 1.f) * F.in[18][c]); const float k0 = xm(512 + c); const float b = kkn * a;
        const float gotk = h2f(SCK[(size_t)m * HW + c]);
        if (__ballot(dbad(gotk, k0 * f))) mask |= 1;
        if (__ballot(dbad(h2f(SCB[(size_t)m * HW + c]) * 10.f, b * 10.f))) mask |= 2;
        { const bf16* LA = (const bf16*)(ws + WS_LA); bool bad = false; for (int j = 0; j < 64; ++j) bad = bad || dbad(bf2f(LA[(size_t)m * 256 + 64 + j]), xm(1600 + j)); if (__ballot(bad)) mask |= 4; }
        { float g = 0.f; for (int j = 0; j < 128; ++j) g += (1.f / (1.f + expf(-xm(1664 + j)))) * F.in[16][(size_t)j * 512 + c];
          const h16* G = (const h16*)(ws + WS_G); if (__ballot(dbad(h2f(G[(size_t)m * HW + c]), g))) mask |= 8; }
        if (__ballot(dbad(gotk, k0 * f * f))) mask |= 16;
        if (__ballot(dbad(gotk, k0))) mask |= 32;
    }
    if (lane == 0) *(unsigned*)(ws + 0) = mask;
}
__device__ __forceinline__ void diag_fill(Frame& F) {
    const unsigned mask = *(const unsigned*)(F.ws + 0);
    const float C = sqrtf(exp2f(1.f + (float)mask));
    const int gt = blockIdx.x * NTHREADS + F.tid, NGT = F.G * NTHREADS;
    for (int i = gt; i < TS * D; i += NGT) F.out[O_Y + (size_t)TP * D + i] = C;
}

#define XB_TMO      128
#define XB_XCNT(j)  (256  + 64 * (j))
#define XB_XSUB(j)  (1280 + 64 * (j))
#define XB_XGEN(j)  (2304 + 64 * (j))
#define XB_TOP      3328
#define XB_TOPGEN   3392
#define XCD_BAR_WORDS 3456
#define XB_SPIN_CAP (1u << 18)

__device__ __forceinline__ unsigned xb_ld(unsigned* p)              { return __hip_atomic_load(p, __ATOMIC_RELAXED, __HIP_MEMORY_SCOPE_AGENT); }
__device__ __forceinline__ unsigned xb_add(unsigned* p, unsigned v) { return __hip_atomic_fetch_add(p, v, __ATOMIC_RELAXED, __HIP_MEMORY_SCOPE_AGENT); }
__device__ __forceinline__ unsigned xb_xcc_id() { return (unsigned)__builtin_amdgcn_s_getreg((3 << 11) | 20) & 0xFu; }
#define XB_SPIN(cond, bar) do { unsigned _sp = 0; while (cond) { __builtin_amdgcn_s_sleep(1); \
    if ((++_sp & 255u) == 0u) { if (xb_ld(&(bar)[XB_TMO])) break; if (_sp > XB_SPIN_CAP) { atomicAdd(&(bar)[XB_TMO], 1u); break; } } } } while (0)

struct XcdBarrier {
    unsigned* bar; unsigned x;
    volatile LAS unsigned* st;
};

__device__ __forceinline__ XcdBarrier xcd_barrier_post(unsigned* bar, volatile LAS unsigned* st) {
    XcdBarrier b; b.bar = bar; b.x = xb_xcc_id(); b.st = st;
    if (threadIdx.x == 0) (void)xb_add(&bar[XB_XCNT(b.x)], 1u);
    return b;
}
__device__ __forceinline__ void xcd_barrier_complete(unsigned* bar, unsigned x, unsigned& nloc, unsigned& nx) {
    const unsigned G = gridDim.x * gridDim.y * gridDim.z;
    unsigned sum, cnt, mine, sp = 0u;
    for (;;) {
        sum = 0u; cnt = 0u; mine = 0u;
#pragma unroll
        for (unsigned j = 0; j < 16; ++j) { const unsigned c = xb_ld(&bar[XB_XCNT(j)]); sum += c; cnt += (c > 0u) ? 1u : 0u; mine = (j == x) ? c : mine; }
        if (sum == G) break;
        __builtin_amdgcn_s_sleep(1);
        if ((++sp & 255u) == 0u) { if (xb_ld(&bar[XB_TMO])) break; if (sp > XB_SPIN_CAP) { atomicAdd(&bar[XB_TMO], 1u); break; } }
    }
    nloc = mine > 0u ? mine : 1u; nx = cnt > 0u ? cnt : 1u;
}

__device__ __forceinline__ void xcd_barrier(const XcdBarrier& b) {
    asm volatile("s_waitcnt vmcnt(0)" ::: "memory");
    __syncthreads();
    if (threadIdx.x == 0) {
        unsigned* bar = b.bar;
        __builtin_amdgcn_s_waitcnt(0);
        unsigned nloc = b.st[0], nx = b.st[1];
        if (nloc == 0u) { xcd_barrier_complete(bar, b.x, nloc, nx); b.st[0] = nloc; b.st[1] = nx; }
        const unsigned old = xb_add(&bar[XB_XSUB(b.x)], 1u);
        const unsigned gen = old / nloc;
        if (old + 1u == (gen + 1u) * nloc) {
            __builtin_amdgcn_fence(__ATOMIC_RELEASE, "agent");
            asm volatile("s_waitcnt vmcnt(0)" ::: "memory");
            const unsigned og = xb_add(&bar[XB_TOP], 1u);
            const unsigned tg = og / nx;
            if (og + 1u == (tg + 1u) * nx) xb_add(&bar[XB_TOPGEN], 1u);
            else XB_SPIN(xb_ld(&bar[XB_TOPGEN]) == tg, bar);
            __builtin_amdgcn_fence(__ATOMIC_ACQUIRE, "agent");
            xb_add(&bar[XB_XGEN(b.x)], 1u);
            asm volatile("s_waitcnt vmcnt(0)" ::: "memory");
        } else {
            XB_SPIN(xb_ld(&bar[XB_XGEN(b.x)]) == gen, bar);
            __builtin_amdgcn_fence(__ATOMIC_ACQUIRE, "agent");
            asm volatile("s_waitcnt vmcnt(0)" ::: "memory");
        }
    }
    __syncthreads();
}

struct Args { const float* in[32]; float* out; unsigned char* ws; int ph_lo, ph_hi, coop, pad; };

__global__ void __launch_bounds__(NTHREADS, 2) mk_fwd(Args args) {
    extern __shared__ __attribute__((aligned(16))) unsigned char lds_raw[];
    Frame F;
    F.lds = (LAS unsigned char*)lds_raw;
    F.tid = threadIdx.x; F.lane = F.tid & 63; F.wave = __builtin_amdgcn_readfirstlane(F.tid >> 6);
    F.G = gridDim.x; { const int bx = blockIdx.x; F.vcu = (F.G % 8 == 0) ? (bx % 8) * (F.G / 8) + bx / 8 : bx; }
    F.in = args.in;
    F.out = args.out; F.ws = args.ws;
    unsigned char* ws = args.ws;
    const int lo = args.ph_lo, hi = args.ph_hi;
    volatile LAS unsigned* MISC = (volatile LAS unsigned*)(F.lds + 131072 + 512);
    if (F.tid < 32) MISC[F.tid] = 0u;
    __syncthreads();
    XcdBarrier bar = xcd_barrier_post((unsigned*)ws, MISC + 8);
#ifndef PHMASK
#define PHMASK 0x3ffff
#endif
#define IN(k) ((((PHMASK) >> (k)) & 1) && lo <= (k) && (k) < hi)
#define SEAM(k) do { if (IN(k) && IN((k) + 1)) { xcd_barrier(bar); } } while (0)
    typedef pg8::bf16_t gb;

#ifndef DUP0
#define DUP0 0
#endif
#ifndef DUP9
#define DUP9 0
#endif
#ifndef DUP2
#define DUP2 0
#endif
    if (DUP0) { p0_prologue(F); }
    if (IN(0)) { p0_prologue(F); } SEAM(0);
    if (IN(1)) {
        pg8::Gemm g{(const gb*)(ws + WS_XB), (const gb*)(ws + WS_WIN), T, INP, D, D, D, 0}; pg8::StaticOrder S; S.init(T, INP, F.G, (int)blockIdx.x, D);
        EpiProj E{(bf16*)(ws + WS_PROJA), (bf16*)(ws + WS_PROJB)};
        pg8::gemm_phase<EpiProj, pg8::StaticOrder, true, true>(F.lds, g, S, E);
    } SEAM(1);
    if (DUP2) { p2_rows(F); }
    if (IN(2)) { p2_rows(F); } SEAM(2);
    if (IN(3)) {
        pg8::Gemm g{(const gb*)(ws + WS_LA), (const gb*)(ws + WS_LORAT), T, 1536, 256, 256, 256, 0}; pg8::StaticOrder S; S.init(T, 1536, F.G, (int)blockIdx.x, 256);
        EpiLora E{F.in[12], F.in[14], F.in[18], (h16*)(ws + WS_SCW), (h16*)(ws + WS_SCK), (h16*)(ws + WS_SCKK), (h16*)(ws + WS_SCB), (h16*)(ws + WS_G)};
        pg8::gemm_phase<EpiLora, pg8::StaticOrder, true, true>(F.lds, g, S, E);
    } SEAM(3);
    if (IN(4)) { conv_phase(F); }
#ifndef DUP5
#define DUP5 0
#endif
#ifndef DUP4
#define DUP4 0
#endif
    if (DUP4) { conv_phase(F); }
    if (IN(5)) { scan_phase(F); } SEAM(5);
    if (DUP5) { scan_phase(F); xcd_barrier(bar); }
    if (IN(6)) { p6_rows(F); } SEAM(6);
    if (IN(7)) {
        pg8::Gemm g{(const gb*)(ws + WS_CAT), (const gb*)(ws + WS_WOUT), T, D, D, D, D, 0}; SplitOrder S; S.init(D, F.G, (int)blockIdx.x, D, 4);
        EpiResid E{F.in[0], F.in[1], (float*)(ws + WS_Z), nullptr, nullptr, (h16*)(ws + WS_PART7), nullptr};
        pg8::gemm_phase<EpiResid, SplitOrder, true, true>(F.lds, g, S, E);
    } SEAM(7);
    if (IN(8)) { ln_rows<0>(F, F.in[25], F.in[26], 4, (const h16*)(ws + WS_PART7), nullptr); } SEAM(8);
#define FFN_PHASES(layer, pgu, pdn) \
    if (IN(pgu)) { \
        pg8::Gemm g{(const gb*)(ws + WS_XB), (const gb*)(ws + ((layer) ? WS_WGU1 : WS_WGU0)), T, 2 * FF, D, D, D, 0}; pg8::StaticOrder S; S.init(T, 2 * FF, F.G, (int)blockIdx.x, D); \
        EpiGateUp E{(bf16*)(ws + WS_H)}; \
        pg8::gemm_phase<EpiGateUp, pg8::StaticOrder, true, true>(F.lds, g, S, E); \
    } SEAM(pgu); \
    if (IN(pdn)) { \
        pg8::Gemm g{(const gb*)(ws + WS_H), (const gb*)(ws + ((layer) ? WS_WD1 : WS_WD0)), T, D, FF, FF, FF, 0}; SplitOrder S; S.init(D, F.G, (int)blockIdx.x, FF, 11); \
        EpiResid E{nullptr, nullptr, (float*)(ws + WS_Z), nullptr, (const bf16*)(ws + WS_XR), (h16*)(ws + WS_PARTA), (h16*)(ws + WS_PARTB)}; \
        pg8::gemm_phase<EpiResid, SplitOrder, true, true>(F.lds, g, S, E); \
    } SEAM(pdn);
    if (DUP9) { pg8::Gemm g{(const gb*)(ws + WS_XB), (const gb*)(ws + WS_WGU0), T, 2 * FF, D, D, D, 0}; pg8::StaticOrder S; S.init(T, 2 * FF, F.G, (int)blockIdx.x, D);
        EpiGateUp E{(bf16*)(ws + WS_H)}; pg8::gemm_phase<EpiGateUp, pg8::StaticOrder, true, true>(F.lds, g, S, E); xcd_barrier(bar); }
    FFN_PHASES(0, 9, 10)
    if (IN(11)) { ln_rows<1>(F, F.in[30], F.in[31], 11, (const h16*)(ws + WS_PARTA), (const h16*)(ws + WS_PARTB)); } SEAM(11);
    if (IN(12)) { pool_phase(F); } SEAM(12);
    if (IN(13)) {
        pg8::Gemm g{(const gb*)(ws + WS_PL), (const gb*)(ws + WS_POOLT), T, D, 256, D, 256, 256}; pg8::StaticOrder S; S.init(T, D, F.G, (int)blockIdx.x, 256);
        EpiResid E{nullptr, nullptr, (float*)(ws + WS_Z), F.in[24], (const bf16*)(ws + WS_XR), nullptr, nullptr};
        pg8::gemm_phase<EpiResid, pg8::StaticOrder, true, true>(F.lds, g, S, E);
    } SEAM(13);
    if (IN(14)) { ln_rows<0>(F, F.in[25] + D, F.in[26] + D, 0, nullptr, nullptr); } SEAM(14);
    FFN_PHASES(1, 15, 16)
    if (IN(17)) { ln_rows<2>(F, F.in[30] + D, F.in[31] + D, 11, (const h16*)(ws + WS_PARTA), (const h16*)(ws + WS_PARTB)); }
    if (lo == 100) diag_checks(F, args.pad);
    if (lo == 101) diag_fill(F);
#undef IN
#undef SEAM
}

extern "C" void kernel_launch(void* const* d_in, const int* in_sizes, int n_in, void* d_out, int out_size, void* d_ws, size_t ws_size, hipStream_t stream) {
    static int grid = 0;
    if (grid == 0) {
        if (n_in != 32 || out_size != (int)O_TOTAL || ws_size < WS_END) { fprintf(stderr, "kernel_launch: unexpected shapes: n_in %d out %d ws %zu\n", n_in, out_size, ws_size); grid = -1; return; }
        int dev = 0, cus = 0, per_cu = 0;
        if (hipGetDevice(&dev) != hipSuccess || hipDeviceGetAttribute(&cus, hipDeviceAttributeMultiprocessorCount, dev) != hipSuccess) { grid = -1; return; }
        if (hipFuncSetAttribute((const void*)mk_fwd, hipFuncAttributeMaxDynamicSharedMemorySize, LDS_BYTES) != hipSuccess) { fprintf(stderr, "kernel_launch: hipFuncSetAttribute failed\n"); grid = -1; return; }
        if (hipOccupancyMaxActiveBlocksPerMultiprocessor(&per_cu, (const void*)mk_fwd, NTHREADS, LDS_BYTES) != hipSuccess || per_cu < 1) { fprintf(stderr, "kernel_launch: occupancy query says %d\n", per_cu); (void)hipGetLastError(); per_cu = 1; }
        grid = cus * 1;
        if (per_cu < 1) grid = -1;
    }
    if (grid < 0) return;
    Args a{};
    for (int i = 0; i < 32; ++i) a.in[i] = (const float*)d_in[i];
    a.out = (float*)d_out; a.ws = (unsigned char*)d_ws;
#if MK_SINGLE
    if (hipMemsetAsync(d_ws, 0, 16384, stream) != hipSuccess) { fprintf(stderr, "kernel_launch: memset failed\n"); return; }
    a.ph_lo = 0; a.ph_hi = NPHASE; a.coop = 1;
    void* params[] = {&a};
    hipError_t e = hipLaunchCooperativeKernel((const void*)mk_fwd, dim3(grid), dim3(NTHREADS), params, LDS_BYTES, stream);
    if (e != hipSuccess) fprintf(stderr, "kernel_launch: cooperative launch failed: %s (grid %d)\n", hipGetErrorString(e), grid);
#else
    for (int p = 0; p < NPHASE; ++p) {
        if (DIAG_AT >= 0 && p > DIAG_AT) break;
        a.ph_lo = p; a.ph_hi = p + 1; a.coop = 0;
        hipLaunchKernelGGL(mk_fwd, dim3(grid), dim3(NTHREADS), LDS_BYTES, stream, a);
    }
    if (DIAG_AT >= 0) { a.pad = DIAG_AT; a.ph_lo = 100; a.ph_hi = 101; hipLaunchKernelGGL(mk_fwd, dim3(grid), dim3(NTHREADS), LDS_BYTES, stream, a);
                        a.ph_lo = 101; a.ph_hi = 102; hipLaunchKernelGGL(mk_fwd, dim3(grid), dim3(NTHREADS), LDS_BYTES, stream, a); }
#endif
}
```

```cpp
#include <hip/hip_runtime.h>
#include <hip/hip_cooperative_groups.h>
#include <cstdio>
#include <cstdint>
namespace cg = cooperative_groups;
namespace pg8 {
#define PG8_LAS __attribute__((address_space(3)))
typedef unsigned short bf16_t;
typedef short bf16x8 __attribute__((ext_vector_type(8)));
typedef float f32x4 __attribute__((ext_vector_type(4)));
typedef unsigned u32x4 __attribute__((ext_vector_type(4)));
constexpr int BM = 256, BK = 64, HALF = 128, HTB = HALF * BK * 2  , STAGE_BYTES = 8 * HTB, NXCD = 8, WGM = 8;

__host__ __device__ __forceinline__ int lds_byte(int r, int c) { const int st = (r >> 4) * 2 + (c >> 5), rr = r & 15, cc = c & 31, ob = rr * 64 + cc * 2; return st * 1024 + (ob ^ (((ob >> 9) & 1) << 5)); }
__host__ __device__ __forceinline__ void stage_rc(int b, int& R, int& C) { const int st = b / 1024, sb = b % 1024, swz = sb ^ (((sb >> 9) & 1) << 5); R = (st >> 1) * 16 + swz / 64; C = (st & 1) * 32 + (swz % 64) / 2; }
__host__ __device__ __forceinline__ int perm32(int rho) { const int n = rho >> 4, i = rho & 15; return 8 * (i >> 2) + 4 * n + (i & 3); }

struct Unit { int pm, pn, kt0, nt, mode; };
struct Gemm { const bf16_t* A; const bf16_t* Bt; int M, N, K, lda, ldb, acol; };

struct StaticOrder {
    int nM, nN, nwg, G, c, ntf;
    __host__ __device__ void init(int M, int N, int G_, int c_, int K_) { nM = M / BM; nN = N / BM; nwg = nM * nN; G = G_; c = c_; ntf = K_ / BK; }
    __host__ __device__ bool next(int i, Unit& u) const {
        const long L = (long)i * G + c; if (L >= nwg) return false;
        int wgid = (int)L; { const int q = nwg / NXCD, r = nwg % NXCD, xcd = wgid % NXCD, off = wgid / NXCD; wgid = (xcd < r ? xcd * (q + 1) : r * (q + 1) + (xcd - r) * q) + off; }
        const int nig = WGM * nN, gid = wgid / nig, fm = gid * WGM, gsz = (nM - fm) < WGM ? (nM - fm) : WGM;
        u.pm = fm + ((wgid % nig) % gsz); u.pn = (wgid % nig) / gsz; u.kt0 = 0; u.nt = ntf; u.mode = 0; return true;
    }
    __device__ __forceinline__ void a_ready(const Unit&) const {}
    __device__ __forceinline__ void done(const Unit&) const {}
};

__device__ __forceinline__ unsigned cvt_pk_bf16(float lo, float hi) { unsigned r; asm volatile("v_cvt_pk_bf16_f32 %0, %1, %2" : "=v"(r) : "v"(lo), "v"(hi)); return r; }
template <class Epi, class Sched, bool ALIGN_EPI = false, bool SP2 = false>
__device__ __forceinline__ void gemm_phase(PG8_LAS unsigned char* lds, const Gemm g, const Sched& S, const Epi& E) {
    const int tid = threadIdx.x, wid = __builtin_amdgcn_readfirstlane(tid >> 6), lane = tid & 63, wr = wid >> 2, wc = wid & 3, fr = lane & 15, fq = lane >> 4;
    const int K = g.K; (void)K;
    unsigned voffA[2], voffB[2];
#pragma unroll
    for (int i = 0; i < 2; ++i) { int R, C; stage_rc(tid * 16 + i * 8192, R, C); const int Rb = Epi::PERM ? ((R & ~31) + perm32(R & 31)) : R;
        voffA[i] = (unsigned)(R * g.lda + C) * 2u; voffB[i] = (unsigned)(Rb * g.ldb + C) * 2u; }
    const size_t kstep = (size_t)(BK * 2);
    const size_t hstepA = (size_t)HALF * g.lda * 2, hstepB = (size_t)HALF * g.ldb * 2;
    const size_t tstepA = 2 * hstepA, tstepB = 2 * hstepB; const size_t acolB = (size_t)g.acol * 2;
    const unsigned ldsw = (unsigned)wid * 1024u;
    const int aoff = lds_byte(wr * 64 + fr, fq * 8), boff = lds_byte(wc * 32 + fr, fq * 8);
#define PG8_SA(b, h) (((b) * 2 + (h)) * HTB)
#define PG8_SB(b, h) ((4 + (b) * 2 + (h)) * HTB)
#define PG8_STAGE(bufoff, gbase, voff) do { _Pragma("unroll") for (int _i = 0; _i < 2; ++_i) \
        __builtin_amdgcn_global_load_lds((const unsigned*)((const char*)(gbase) + (voff)[_i]), (PG8_LAS unsigned*)(lds + (bufoff) + ldsw + _i * 8192), 16, 0, 0); } while (0)
#define PG8_LDA(dst, b, h) do { _Pragma("unroll") for (int m = 0; m < 4; ++m) _Pragma("unroll") for (int k = 0; k < 2; ++k) dst[m][k] = *(const PG8_LAS bf16x8*)(lds + PG8_SA(b, h) + aoff + m * 2048 + k * 1024); } while (0)
#define PG8_LDB(dst, b, h) do { _Pragma("unroll") for (int n = 0; n < 2; ++n) _Pragma("unroll") for (int k = 0; k < 2; ++k) dst[n][k] = *(const PG8_LAS bf16x8*)(lds + PG8_SB(b, h) + boff + n * 2048 + k * 1024); } while (0)
#define PG8_MMA(ai, bj, At, Bt) do { __builtin_amdgcn_s_setprio(1); _Pragma("unroll") for (int m = 0; m < 4; ++m) _Pragma("unroll") for (int n = 0; n < 2; ++n) _Pragma("unroll") for (int k = 0; k < 2; ++k) \
        acc[ai][bj][m][n] = __builtin_amdgcn_mfma_f32_16x16x32_bf16(Bt[n][k], At[m][k], acc[ai][bj][m][n], 0, 0, 0); __builtin_amdgcn_s_setprio(0); } while (0)
#define PG8_WAIT_V(n) asm volatile("s_waitcnt vmcnt(" #n ")" ::: "memory")
#define PG8_WAIT_L(n) asm volatile("s_waitcnt lgkmcnt(" #n ")" ::: "memory")
#define PG8_BAR __builtin_amdgcn_s_barrier()
#define PG8_SCHED __builtin_amdgcn_sched_barrier(0)
    Unit cur, nxt; int ui = 0;
    if (!S.next(0, cur)) return;
    f32x4 acc[2][2][4][2];
#pragma unroll
    for (int a = 0; a < 2; ++a)
#pragma unroll
        for (int b = 0; b < 2; ++b)
#pragma unroll
            for (int m = 0; m < 4; ++m)
#pragma unroll
                for (int n = 0; n < 2; ++n) acc[a][b][m][n] = (f32x4){0.f, 0.f, 0.f, 0.f};
    bf16x8 At[4][2], B0[2][2], B1[2][2];
    const char* cA = (const char*)g.A + (size_t)cur.pm * tstepA + (size_t)cur.pn * acolB + (size_t)cur.kt0 * kstep; const char* cB = (const char*)g.Bt + (size_t)cur.pn * tstepB + (size_t)cur.kt0 * kstep;
    S.a_ready(cur);
    if constexpr (SP2) {
        PG8_STAGE(PG8_SB(0, 0), cB, voffB); PG8_STAGE(PG8_SB(0, 1), cB + hstepB, voffB); PG8_STAGE(PG8_SA(0, 0), cA, voffA); PG8_STAGE(PG8_SA(0, 1), cA + hstepA, voffA);
        if (wr == 1) PG8_BAR;
        PG8_WAIT_V(2); PG8_BAR;
        PG8_STAGE(PG8_SB(1, 0), cB + kstep, voffB); PG8_STAGE(PG8_SA(1, 0), cA + kstep, voffA); PG8_STAGE(PG8_SB(1, 1), cB + hstepB + kstep, voffB);
        PG8_WAIT_V(6); PG8_BAR;
    } else {
        PG8_STAGE(PG8_SB(0, 0), cB, voffB); PG8_STAGE(PG8_SA(0, 0), cA, voffA); PG8_STAGE(PG8_SB(0, 1), cB + hstepB, voffB); PG8_STAGE(PG8_SA(0, 1), cA + hstepA, voffA);
        if (wr == 1) PG8_BAR;
        PG8_WAIT_V(4); PG8_BAR;
        PG8_STAGE(PG8_SB(1, 0), cB + kstep, voffB); PG8_STAGE(PG8_SA(1, 0), cA + kstep, voffA); PG8_STAGE(PG8_SB(1, 1), cB + hstepB + kstep, voffB);
        PG8_WAIT_V(6); PG8_BAR;
    }
    for (;;) {
        const bool has_next = S.next(ui + 1, nxt);
        const char* nA = has_next ? (const char*)g.A + (size_t)nxt.pm * tstepA + (size_t)nxt.pn * acolB + (size_t)nxt.kt0 * kstep : cA; const char* nB = has_next ? (const char*)g.Bt + (size_t)nxt.pn * tstepB + (size_t)nxt.kt0 * kstep : cB;
        const int nt = cur.nt;
        _Pragma("unroll 1") for (int t = 0; t < nt; t += 2) {
            const bool last = (t == nt - 2);
            const char* a1 = cA + (size_t)(t + 1) * kstep;
            const char* a2 = last ? nA : cA + (size_t)(t + 2) * kstep; const char* b2 = last ? nB : cB + (size_t)(t + 2) * kstep;
            const char* a3 = a2 + kstep; const char* b3 = b2 + kstep;
            if (last && has_next) S.a_ready(nxt);
            if constexpr (SP2) {
            PG8_LDB(B0, 0, 0); PG8_LDB(B1, 0, 1); PG8_SCHED; PG8_LDA(At, 0, 0); PG8_STAGE(PG8_SA(1, 1), a1 + hstepA, voffA);
            PG8_WAIT_V(8); PG8_WAIT_L(0); PG8_BAR; PG8_MMA(0, 0, At, B0); PG8_MMA(0, 1, At, B1); PG8_BAR; PG8_SCHED;
            PG8_LDA(At, 0, 1); PG8_STAGE(PG8_SB(0, 0), b2, voffB); PG8_STAGE(PG8_SB(0, 1), b2 + hstepB, voffB); PG8_STAGE(PG8_SA(0, 0), a2, voffA);
            PG8_WAIT_V(8); PG8_WAIT_L(0); PG8_BAR; PG8_MMA(1, 0, At, B0); PG8_MMA(1, 1, At, B1); PG8_BAR; PG8_SCHED;
            PG8_LDB(B0, 1, 0); PG8_LDB(B1, 1, 1); PG8_SCHED; PG8_LDA(At, 1, 0); PG8_STAGE(PG8_SA(0, 1), a2 + hstepA, voffA);
            PG8_WAIT_V(8); PG8_WAIT_L(0); PG8_BAR; PG8_MMA(0, 0, At, B0); PG8_MMA(0, 1, At, B1); PG8_BAR; PG8_SCHED;
            PG8_LDA(At, 1, 1); PG8_STAGE(PG8_SB(1, 0), b3, voffB); PG8_STAGE(PG8_SB(1, 1), b3 + hstepB, voffB); PG8_STAGE(PG8_SA(1, 0), a3, voffA);
            PG8_WAIT_V(8); PG8_WAIT_L(0); PG8_BAR; PG8_MMA(1, 0, At, B0); PG8_MMA(1, 1, At, B1); PG8_BAR; PG8_SCHED;
            } else {
            PG8_LDB(B0, 0, 0); PG8_SCHED; PG8_LDA(At, 0, 0); PG8_STAGE(PG8_SA(1, 1), a1 + hstepA, voffA);
            PG8_WAIT_L(8); PG8_BAR; PG8_WAIT_L(0); PG8_MMA(0, 0, At, B0); PG8_BAR; PG8_SCHED;
            PG8_LDB(B1, 0, 1); PG8_STAGE(PG8_SB(0, 0), b2, voffB);
            PG8_BAR; PG8_WAIT_L(0); PG8_MMA(0, 1, At, B1); PG8_BAR;
            PG8_LDA(At, 0, 1); PG8_STAGE(PG8_SA(0, 0), a2, voffA);
            PG8_BAR; PG8_WAIT_L(0); PG8_MMA(1, 0, At, B0); PG8_BAR; PG8_SCHED;
            PG8_STAGE(PG8_SB(0, 1), b2 + hstepB, voffB);
            PG8_WAIT_V(6); PG8_BAR; PG8_MMA(1, 1, At, B1); PG8_BAR;
            PG8_LDB(B0, 1, 0); PG8_SCHED; PG8_LDA(At, 1, 0); PG8_STAGE(PG8_SA(0, 1), a2 + hstepA, voffA);
            PG8_WAIT_L(8); PG8_BAR; PG8_WAIT_L(0); PG8_MMA(0, 0, At, B0); PG8_BAR; PG8_SCHED;
            PG8_LDB(B1, 1, 1); PG8_STAGE(PG8_SB(1, 0), b3, voffB);
            PG8_BAR; PG8_WAIT_L(0); PG8_MMA(0, 1, At, B1); PG8_BAR;
            PG8_LDA(At, 1, 1); PG8_STAGE(PG8_SA(1, 0), a3, voffA);
            PG8_BAR; PG8_WAIT_L(0); PG8_MMA(1, 0, At, B0); PG8_BAR; PG8_SCHED;
            PG8_STAGE(PG8_SB(1, 1), b3 + hstepB, voffB);
            PG8_WAIT_V(6); PG8_BAR; PG8_MMA(1, 1, At, B1); PG8_BAR;
            }
        }
        if constexpr (ALIGN_EPI) { if (wr == 0) PG8_BAR; }
        if constexpr (!Epi::AFTER_DRAIN) { E(acc, cur, wr, wc, fr, fq); S.done(cur); }
        if (!has_next) break;
#pragma unroll
        for (int a = 0; a < 2; ++a)
#pragma unroll
            for (int b = 0; b < 2; ++b)
#pragma unroll
                for (int m = 0; m < 4; ++m)
#pragma unroll
                    for (int n = 0; n < 2; ++n) acc[a][b][m][n] = (f32x4){0.f, 0.f, 0.f, 0.f};
        cur = nxt; cA = nA; cB = nB; ++ui;
        if constexpr (ALIGN_EPI) { if (wr == 1) PG8_BAR; }
    }
    PG8_WAIT_V(0);
    if constexpr (!ALIGN_EPI) { if (wr == 0) PG8_BAR; }
    PG8_BAR;
    if constexpr (Epi::AFTER_DRAIN) { E.fused(acc, cur, wr, wc, fr, fq, lds, wid, lane); S.done(cur); }
#undef PG8_SA
#undef PG8_SB
#undef PG8_STAGE
#undef PG8_LDA
#undef PG8_LDB
#undef PG8_MMA
#undef PG8_WAIT_V
#undef PG8_WAIT_L
#undef PG8_BAR
#undef PG8_SCHED
}
}

#define GAS __attribute__((address_space(1)))
#define LAS __attribute__((address_space(3)))
typedef unsigned short bf16;
typedef unsigned v4u __attribute__((ext_vector_type(4)));
typedef unsigned v2u __attribute__((ext_vector_type(2)));
typedef float f32x4 __attribute__((ext_vector_type(4)));
typedef _Float16 h16;
typedef _Float16 h16x2 __attribute__((ext_vector_type(2)));

#ifndef MK_SINGLE
#define MK_SINGLE 1
#endif

constexpr int NWAVES = 8, NTHREADS = NWAVES * 64;
constexpr int D = 1024, TP = 16384, TS = 1024, T = TP + TS, LP = 2048, LS = 8, NPB = 8, NSB = 128;
constexpr int INP = 2816, BP = 1792, FF = 2816, HW = 512;
constexpr float ALPHA = 1.41421356237309515f, LN_EPS = 1e-5f, GN_EPS = 64e-5f;
constexpr int NPHASE = 18;

constexpr size_t MiB = 1u << 20;
constexpr size_t WS_WIN = 1 * MiB, WS_WOUT = WS_WIN + 5632 * 1024, WS_WGU0 = WS_WOUT + 2 * MiB, WS_WGU1 = WS_WGU0 + 11 * MiB, WS_WD0 = WS_WGU1 + 11 * MiB, WS_WD1 = WS_WD0 + 5632 * 1024,
                 WS_POOLT = WS_WD1 + 5632 * 1024, WS_LORAT = WS_POOLT + 512 * 1024;
constexpr size_t WS_XB = 43 * MiB;
constexpr size_t WS_SCW = 43 * MiB, WS_G = 60 * MiB;
constexpr size_t WS_PROJA = 77 * MiB;
constexpr size_t WS_PROJB = 111 * MiB;
constexpr size_t WS_CAT = 111 * MiB, WS_SCB = 145 * MiB, WS_O = 162 * MiB;
constexpr size_t WS_LA = 170 * MiB + 512 * 1024;
constexpr size_t WS_SCR = 179 * MiB, WS_SCV = 196 * MiB, WS_SCK = 213 * MiB, WS_SCKK = 230 * MiB;
constexpr size_t WS_Z = 188 * MiB;
constexpr size_t WS_H = 77 * MiB;
constexpr size_t WS_PL = 77 * MiB;
constexpr size_t WS_PART7 = 145 * MiB;
constexpr size_t WS_PARTA = 170 * MiB + 512 * 1024, WS_PARTB = 1 * MiB;
constexpr size_t WS_XR = 43 * MiB;
constexpr size_t WS_END = 256 * MiB;
static_assert(WS_LORAT + 1536 * 256 * 2 <= WS_XB, "weights");
static_assert(WS_PROJB + (size_t)T * BP * 2 <= WS_LA, "projb");
static_assert(WS_H + (size_t)T * FF * 2 <= WS_Z, "h");
static_assert(WS_Z + (size_t)T * D * 4 <= WS_END, "z");

constexpr size_t O_Y = 0, O_CONV_P = 17825792, O_SHIFT_P = 17948672, O_WKV_P = 17963008, O_POOL_P = 18225152,
                 O_CONV_S = 18348032, O_SHIFT_S = 20314112, O_WKV_S = 20543488, O_POOL_S = 24737792, O_TOTAL = 26703872;

constexpr int LDS_BYTES = 147456;

struct Frame {
    LAS unsigned char* lds;
    int tid, lane, wave, vcu, G;
    const float* const* in;
    float* out; unsigned char* ws;
};

__device__ __forceinline__ float bf2f(unsigned b) { return __uint_as_float(b << 16); }
__device__ __forceinline__ unsigned pkbf(float lo, float hi) { return pg8::cvt_pk_bf16(lo, hi); }
__device__ __forceinline__ unsigned pkh(float lo, float hi) { const unsigned short a = __builtin_bit_cast(unsigned short, (h16)lo), b = __builtin_bit_cast(unsigned short, (h16)hi); return (unsigned)a | ((unsigned)b << 16); }
__device__ __forceinline__ float hlo(unsigned u) { return (float)__builtin_bit_cast(h16, (unsigned short)(u & 0xffffu)); }
__device__ __forceinline__ float hhi(unsigned u) { return (float)__builtin_bit_cast(h16, (unsigned short)(u >> 16)); }
__device__ __forceinline__ void unpack_bf8(v4u w, float (&f)[8]) { const unsigned u0 = w.x, u1 = w.y, u2 = w.z, u3 = w.w;
    f[0] = __uint_as_float(u0 << 16); f[1] = __uint_as_float(u0 & 0xffff0000u); f[2] = __uint_as_float(u1 << 16); f[3] = __uint_as_float(u1 & 0xffff0000u);
    f[4] = __uint_as_float(u2 << 16); f[5] = __uint_as_float(u2 & 0xffff0000u); f[6] = __uint_as_float(u3 << 16); f[7] = __uint_as_float(u3 & 0xffff0000u); }
__device__ __forceinline__ void unpack_h8(v4u w, float (&f)[8]) { const unsigned u0 = w.x, u1 = w.y, u2 = w.z, u3 = w.w; f[0] = hlo(u0); f[1] = hhi(u0); f[2] = hlo(u1); f[3] = hhi(u1); f[4] = hlo(u2); f[5] = hhi(u2); f[6] = hlo(u3); f[7] = hhi(u3); }
__device__ __forceinline__ v4u pack_bf8(const float (&f)[8]) { v4u w; w.x = pkbf(f[0], f[1]); w.y = pkbf(f[2], f[3]); w.z = pkbf(f[4], f[5]); w.w = pkbf(f[6], f[7]); return w; }
__device__ __forceinline__ v4u pack_h8(const float (&f)[8]) { v4u w; w.x = pkh(f[0], f[1]); w.y = pkh(f[2], f[3]); w.z = pkh(f[4], f[5]); w.w = pkh(f[6], f[7]); return w; }
__device__ __forceinline__ void load_f8(const float* p, float (&f)[8]) { const f32x4 a = *(const f32x4*)p, b = *(const f32x4*)(p + 4); f[0] = a.x; f[1] = a.y; f[2] = a.z; f[3] = a.w; f[4] = b.x; f[5] = b.y; f[6] = b.z; f[7] = b.w; }
__device__ __forceinline__ void store_f8(float* p, const float (&f)[8]) { *(f32x4*)p = (f32x4){f[0], f[1], f[2], f[3]}; *(f32x4*)(p + 4) = (f32x4){f[4], f[5], f[6], f[7]}; }
__device__ __forceinline__ float sigmoid_(float x) { return __builtin_amdgcn_rcpf(1.f + __expf(-x)); }
__device__ __forceinline__ float silu_(float x) { return x * sigmoid_(x); }
__device__ __forceinline__ float wave_sum(float v) {
#pragma unroll
    for (int o = 1; o < 64; o <<= 1) v += __shfl_xor(v, o);
    return v;
}
__device__ __forceinline__ float sum8(float v) { v += __shfl_xor(v, 1); v += __shfl_xor(v, 2); v += __shfl_xor(v, 4); return v; }
template <int CTRL> __device__ __forceinline__ float dppf(float x) { return __builtin_bit_cast(float, __builtin_amdgcn_update_dpp(0, __builtin_bit_cast(int, x), CTRL, 0xF, 0xF, true)); }
__device__ __forceinline__ float dpp_sum16(float x) {
    x += dppf<0xB1>(x);
    x += dppf<0x4E>(x);
    x += dppf<0x141>(x);
    x += dppf<0x140>(x);
    return x;
}
__device__ __forceinline__ void h4(v2u x, float (&f)[4]) { const unsigned u0 = x.x, u1 = x.y; f[0] = hlo(u0); f[1] = hhi(u0); f[2] = hlo(u1); f[3] = hhi(u1); }
__device__ __forceinline__ const float* xrow_ptr(const Frame& F, int m) { return m < TP ? F.in[0] + (size_t)m * D : F.in[1] + (size_t)(m - TP) * D; }

using pg8::Unit; using pg8::HALF; using pg8::BM;
typedef pg8::u32x4 u32x4;
struct EpiProj {
    static constexpr bool PERM = true, AFTER_DRAIN = false;
    bf16* PA; bf16* PB;
    __device__ __forceinline__ void operator()(const pg8::f32x4 (&acc)[2][2][4][2], const Unit& u, int wr, int wc, int fr, int fq) const {
        const int row0 = u.pm * BM + wr * 64 + fr;
        bf16* base; int ldc, colt;
        if (u.pn < 4) { base = PA; ldc = 1024; colt = u.pn * BM; } else { base = PB; ldc = BP; colt = (u.pn - 4) * BM; }
        const int col0 = colt + wc * 32 + 8 * fq;
#pragma unroll
        for (int ai = 0; ai < 2; ++ai)
#pragma unroll
            for (int m = 0; m < 4; ++m) { bf16* rowp = base + (size_t)(row0 + ai * HALF + m * 16) * ldc + col0;
#pragma unroll
                for (int bj = 0; bj < 2; ++bj) { const pg8::f32x4 v0 = acc[ai][bj][m][0], v1 = acc[ai][bj][m][1];
                    u32x4 w; w.x = pkbf(v0[0], v0[1]); w.y = pkbf(v0[2], v0[3]); w.z = pkbf(v1[0], v1[1]); w.w = pkbf(v1[2], v1[3]);
                    *(u32x4*)(rowp + bj * HALF) = w; } }
    }
};
struct EpiLora {
    static constexpr bool PERM = true, AFTER_DRAIN = false;
    const float* w0; const float* a0; const float* ka;
    h16* SCW; h16* SCK; h16* SCKK; h16* SCB; h16* G;
    __device__ __forceinline__ void operator()(const pg8::f32x4 (&acc)[2][2][4][2], const Unit& u, int wr, int wc, int fr, int fq) const {
        const int row0 = u.pm * BM + wr * 64 + fr; const int sec = u.pn >> 1;
        const int c0 = (u.pn & 1) * BM + wc * 32 + 8 * fq;
#pragma unroll
        for (int bj = 0; bj < 2; ++bj)
#pragma unroll
            for (int n = 0; n < 2; ++n) {
                const int c = c0 + bj * HALF + 4 * n;
                f32x4 p0 = {0.f, 0.f, 0.f, 0.f}, p1 = {0.f, 0.f, 0.f, 0.f};
                if (sec == 0) p0 = *(const f32x4*)(w0 + c); else if (sec == 1) { p0 = *(const f32x4*)(a0 + c); p1 = *(const f32x4*)(ka + c); }
#pragma unroll
                for (int ai = 0; ai < 2; ++ai)
#pragma unroll
                    for (int m = 0; m < 4; ++m) {
                        const size_t off = (size_t)(row0 + ai * HALF + m * 16) * HW + c;
                        const pg8::f32x4 v = acc[ai][bj][m][n];
                        if (sec == 0) {
                            float o[4];
#pragma unroll
                            for (int i = 0; i < 4; ++i) { const float e = 0.60653065971f * sigmoid_(p0[i] + v[i]); o[i] = 1.f - __expf(-e); }
                            v2u w; w.x = pkh(o[0], o[1]); w.y = pkh(o[2], o[3]); *(v2u*)(SCW + off) = w;
                        } else if (sec == 1) {
                            float kx[4], kk[4], ko[4], bo[4];
                            h4(*(const v2u*)(SCK + off), kx); h4(*(const v2u*)(SCKK + off), kk);
#pragma unroll
                            for (int i = 0; i < 4; ++i) { const float a = sigmoid_(p0[i] + v[i]); ko[i] = kx[i] * (1.f + (a - 1.f) * p1[i]); bo[i] = kk[i] * a; }
                            v2u w; w.x = pkh(ko[0], ko[1]); w.y = pkh(ko[2], ko[3]); *(v2u*)(SCK + off) = w;
                            v2u x; x.x = pkh(bo[0], bo[1]); x.y = pkh(bo[2], bo[3]); *(v2u*)(SCB + off) = x;
                        } else {
                            v2u w; w.x = pkh(v[0], v[1]); w.y = pkh(v[2], v[3]); *(v2u*)(G + off) = w;
                        }
                        asm volatile("" ::: "memory");
                    }
            }
    }
};
struct EpiGateUp {
    static constexpr bool PERM = true, AFTER_DRAIN = false;
    bf16* H;
    __device__ __forceinline__ void operator()(const pg8::f32x4 (&acc)[2][2][4][2], const Unit& u, int wr, int wc, int fr, int fq) const {
        const int row0 = u.pm * BM + wr * 64 + fr; const int col0 = u.pn * HALF + wc * 32 + 8 * fq;
#pragma unroll
        for (int ai = 0; ai < 2; ++ai)
#pragma unroll
            for (int m = 0; m < 4; ++m) {
                const pg8::f32x4 g0 = acc[ai][0][m][0], g1 = acc[ai][0][m][1], u0 = acc[ai][1][m][0], u1 = acc[ai][1][m][1];
                u32x4 w; w.x = pkbf(silu_(g0[0]) * u0[0], silu_(g0[1]) * u0[1]); w.y = pkbf(silu_(g0[2]) * u0[2], silu_(g0[3]) * u0[3]);
                w.z = pkbf(silu_(g1[0]) * u1[0], silu_(g1[1]) * u1[1]); w.w = pkbf(silu_(g1[2]) * u1[2], silu_(g1[3]) * u1[3]);
                *(u32x4*)(H + (size_t)(row0 + ai * HALF + m * 16) * FF + col0) = w;
            }
    }
};
struct EpiResid {
    static constexpr bool PERM = false, AFTER_DRAIN = false;
    const float* xp; const float* xs; float* Z; const float* scale;
    const bf16* XBr;
    h16* pa; h16* pb;
    __device__ __forceinline__ void operator()(const pg8::f32x4 (&acc)[2][2][4][2], const Unit& u, int wr, int wc, int fr, int fq) const {
        const int col0 = u.pn * BM + wc * 32 + 4 * fq;
#pragma unroll
        for (int ai = 0; ai < 2; ++ai)
#pragma unroll
            for (int m = 0; m < 4; ++m) {
                const int row = u.pm * BM + ai * HALF + wr * 64 + m * 16 + fr;
                float* zr = Z + (size_t)row * D + col0;
                const float* br = xp ? ((row < TP ? xp + (size_t)row * D : xs + (size_t)(row - TP) * D) + col0) : nullptr;
                const bf16* bb = XBr + (size_t)row * D + col0;
#pragma unroll
                for (int bj = 0; bj < 2; ++bj)
#pragma unroll
                    for (int n = 0; n < 2; ++n) {
                        const int o = bj * HALF + n * 16;
                        pg8::f32x4 a = acc[ai][bj][m][n];
                        if (scale) a = a * *(const pg8::f32x4*)(scale + col0 + o);
                        if (u.mode == 1) {
                            const int sp = u.kt0 / u.nt;
                            h16* pr = (sp < 8 ? pa + (size_t)sp * (1u << 20) : pb + (size_t)(sp - 8) * (1u << 20)) + (size_t)(row - TP) * D + col0;
                            v2u w; w.x = pkh(a[0], a[1]); w.y = pkh(a[2], a[3]); *(v2u*)(pr + o) = w;
                        } else {
                            pg8::f32x4 b;
                            if (xp) b = *(const pg8::f32x4*)(br + o);
                            else { const v2u w = *(const v2u*)(bb + o); const unsigned w0 = w.x, w1 = w.y; b = (pg8::f32x4){__uint_as_float(w0 << 16), __uint_as_float(w0 & 0xffff0000u), __uint_as_float(w1 << 16), __uint_as_float(w1 & 0xffff0000u)}; }
                            *(pg8::f32x4*)(zr + o) = b * ALPHA + a;
                        }
                    }
            }
    }
};

struct SplitOrder {
    pg8::StaticOrder base; int NS, ntc, c;
    __device__ void init(int N, int G, int c_, int K, int NS_) { base.init(TP, N, G, c_, K); NS = NS_; ntc = (K / pg8::BK) / NS_; c = c_; }
    __device__ bool next(int i, Unit& u) const {
        if (i == 0) return base.next(0, u);
        if (i == 1) { if (c >= 16 * NS) return false; const int unit = c / NS, sp = c % NS; u.pm = 64 + (unit >> 2); u.pn = unit & 3; u.kt0 = sp * ntc; u.nt = ntc; u.mode = 1; return true; }
        return false;
    }
    __device__ __forceinline__ void a_ready(const Unit&) const {}
    __device__ __forceinline__ void done(const Unit&) const {}
};

__device__ __forceinline__ void transpose_item(const float* W, int K, int N, bf16* WT, int mode, LAS float* scr, int item, int lane) {
    const int nblk = N / 32, kb = item / nblk, nb = item % nblk, k0 = 64 * kb, n0 = 32 * nb;
    const int drow0 = mode == 0 ? n0 : ((n0 >> 7) * 256 + (mode == 2 ? 128 : 0) + (n0 & 127));
#pragma unroll 8
    for (int i = 0; i < 32; ++i) { const int kk = 2 * i + (lane >> 5); scr[kk * 33 + (lane & 31)] = W[(size_t)(k0 + kk) * N + n0 + (lane & 31)]; }
    asm volatile("s_waitcnt lgkmcnt(0)" ::: "memory");
    const int c = lane & 7;
#pragma unroll
    for (int j = 0; j < 4; ++j) { const int n = (lane >> 3) + 8 * j; const LAS float* s = scr + (8 * c) * 33 + n;
        v4u o; o.x = pkbf(s[0 * 33], s[1 * 33]); o.y = pkbf(s[2 * 33], s[3 * 33]); o.z = pkbf(s[4 * 33], s[5 * 33]); o.w = pkbf(s[6 * 33], s[7 * 33]);
        *(v4u*)(WT + (size_t)(drow0 + n) * K + k0 + 8 * c) = o; }
    asm volatile("s_waitcnt lgkmcnt(0)" ::: "memory");
}
__device__ __forceinline__ void p0_prologue(Frame& F) {
    LAS float* scr = (LAS float*)(F.lds + F.wave * 16384);
    const int gw = F.vcu * NWAVES + F.wave, NGW = F.G * NWAVES;
    unsigned char* ws = F.ws;
    constexpr int I_IN = 16 * 88, I_OUT = 16 * 32, I_GU = 16 * 88, I_DN = 44 * 32, I_PL = 4 * 8;
    constexpr int NITEMS = I_IN + I_OUT + 2 * (2 * I_GU + I_DN) + 4 * I_PL;
    for (int it = gw; it < NITEMS; it += NGW) {
        int r = it;
        if (r < I_IN) { transpose_item(F.in[6], D, INP, (bf16*)(ws + WS_WIN), 0, scr, r, F.lane); continue; } r -= I_IN;
        if (r < I_OUT) { transpose_item(F.in[22], D, D, (bf16*)(ws + WS_WOUT), 0, scr, r, F.lane); continue; } r -= I_OUT;
        constexpr int I_LAYER = 2 * I_GU + I_DN;
        if (r < 2 * I_LAYER) {
            const int l = r / I_LAYER; int q = r % I_LAYER;
            bf16* gu = (bf16*)(ws + (l ? WS_WGU1 : WS_WGU0)); bf16* dn = (bf16*)(ws + (l ? WS_WD1 : WS_WD0));
            if (q < I_GU) { transpose_item(F.in[27] + (size_t)l * D * FF, D, FF, gu, 1, scr, q, F.lane); continue; } q -= I_GU;
            if (q < I_GU) { transpose_item(F.in[28] + (size_t)l * D * FF, D, FF, gu, 2, scr, q, F.lane); continue; } q -= I_GU;
            transpose_item(F.in[29] + (size_t)l * FF * D, FF, D, dn, 0, scr, q, F.lane); continue;
        }
        r -= 2 * I_LAYER;
        { const int g = r / I_PL, ri = r % I_PL; transpose_item(F.in[23] + (size_t)g * 65536, 256, 256, (bf16*)(ws + WS_POOLT) + (size_t)g * 65536, 0, scr, ri, F.lane); }
    }
    const int gt = F.vcu * NTHREADS + F.tid, NGT = F.G * NTHREADS;
    bf16* XB = (bf16*)(ws + WS_XB);
    float* Zp = (float*)(ws + WS_Z);
    for (int i = gt; i < T * D / 8; i += NGT) { const int m = i >> 7, c8 = (i & 127) * 8; float f[8]; load_f8(xrow_ptr(F, m) + c8, f); *(v4u*)(XB + (size_t)m * D + c8) = pack_bf8(f);
        if (m >= TP) { float z[8];
#pragma unroll
            for (int e = 0; e < 8; ++e) z[e] = ALPHA * f[e];
            store_f8(Zp + (size_t)m * D + c8, z); } }
    bf16* LT = (bf16*)(ws + WS_LORAT);
    for (int i = gt; i < 1536 * 256 / 2; i += NGT) { const int j = i >> 7, k = (i & 127) * 2; float v[2];
#pragma unroll
        for (int e = 0; e < 2; ++e) { const int kk = k + e; float x = 0.f;
            if (j < 512) { if (kk < 64) x = F.in[13][(size_t)kk * 512 + j]; }
            else if (j < 1024) { if (kk >= 64 && kk < 128) x = F.in[15][(size_t)(kk - 64) * 512 + (j - 512)]; }
            else { if (kk >= 128) x = F.in[16][(size_t)(kk - 128) * 512 + (j - 1024)]; }
            v[e] = x; }
        *(unsigned*)(LT + (size_t)j * 256 + k) = pkbf(v[0], v[1]); }
}

__device__ __forceinline__ void p2_rows(Frame& F) {
    const int gw = F.vcu * NWAVES + F.wave, NGW = F.G * NWAVES, lane = F.lane;
    unsigned char* ws = F.ws;
    const bf16* PB = (const bf16*)(ws + WS_PROJB);
    h16* SCR = (h16*)(ws + WS_SCR); h16* SCK = (h16*)(ws + WS_SCK); h16* SCV = (h16*)(ws + WS_SCV); h16* SCKK = (h16*)(ws + WS_SCKK);
    bf16* LA = (bf16*)(ws + WS_LA);
    const float* mu = F.in[11]; const float* kkw = F.in[17]; const float* sshift = F.in[3];
    for (int m = gw; m < T; m += NGW) {
        const bool sample = m >= TP; const int seq = sample ? (m - TP) >> 3 : m >> 11, t = sample ? (m - TP) & 7 : m & 2047, L = sample ? LS : LP;
        const bf16* pb = PB + (size_t)m * BP;
        float* oshift = F.out + (sample ? O_SHIFT_S : O_SHIFT_P) + (size_t)seq * BP;
        const bool last = (t == L - 1);
#pragma unroll
        for (int sec = 0; sec < 4; ++sec) {
            if (sec == 3 && lane >= 32) break;
            const int col = sec * 512 + lane * 8;
            float p[8], pv[8], mv[8], xm[8];
            unpack_bf8(*(const v4u*)(pb + col), p);
            if (t > 0) unpack_bf8(*(const v4u*)(pb - BP + col), pv);
            else if (sample) load_f8(sshift + (size_t)seq * BP + col, pv);
            else {
#pragma unroll
                for (int i = 0; i < 8; ++i) pv[i] = 0.f; }
            load_f8(mu + col, mv);
#pragma unroll
            for (int i = 0; i < 8; ++i) xm[i] = p[i] + mv[i] * (pv[i] - p[i]);
            if (last) store_f8(oshift + col, p);
            const size_t off = (size_t)m * HW + lane * 8;
            if (sec == 0) *(v4u*)(SCR + off) = pack_h8(xm);
            else if (sec == 1) {
                *(v4u*)(SCK + off) = pack_h8(xm);
                float kw[8], kx[8]; load_f8(kkw + lane * 8, kw); float ss = 0.f;
#pragma unroll
                for (int i = 0; i < 8; ++i) { kx[i] = xm[i] * kw[i]; ss += kx[i] * kx[i]; }
                ss = sum8(ss);
                const float inv = 1.f / fmaxf(sqrtf(ss), 1e-12f);
#pragma unroll
                for (int i = 0; i < 8; ++i) kx[i] *= inv;
                *(v4u*)(SCKK + off) = pack_h8(kx);
            } else if (sec == 2) *(v4u*)(SCV + off) = pack_h8(xm);
            else {
                float o[8];
#pragma unroll
                for (int i = 0; i < 8; ++i) {
                    if (lane < 8) { const float e = __expf(2.f * xm[i]); o[i] = 1.f - 2.f * __builtin_amdgcn_rcpf(e + 1.f); }
                    else if (lane < 16) o[i] = xm[i];
                    else o[i] = sigmoid_(xm[i]);
                }
                *(v4u*)(LA + (size_t)m * 256 + lane * 8) = pack_bf8(o);
            }
        }
    }
}

template <int TT> __device__ __forceinline__ void conv_tile(Frame& F, int m0, int t0, int seq, bool sample) {
    const int c = F.tid;
    unsigned char* ws = F.ws;
    const bf16* PA = (const bf16*)(ws + WS_PROJA); bf16* CAT = (bf16*)(ws + WS_CAT);
    const float* cw = F.in[7]; const float* sconv = F.in[2];
    LAS float* ylds = (LAS float*)F.lds;
    float w[31];
#pragma unroll
    for (int j = 0; j < 31; ++j) w[j] = cw[j * 512 + c];
    float y[TT]; const float bias = F.in[8][c];
#pragma unroll
    for (int t = 0; t < TT; ++t) y[t] = bias;
    const bool lastp = (!sample) && (t0 + TT == LP);
    float* oconv = F.out + (sample ? O_CONV_S : O_CONV_P) + (size_t)seq * 30 * 512 + c;
    const bf16* pp = PA + ((size_t)m0 - 30) * 1024 + c; const float* scp = sconv + ((size_t)seq * 30 + t0) * 512 + c;
#pragma unroll
    for (int s = -30; s < TT; ++s) {
        float u;
        asm volatile("" : "+v"(pp), "+v"(scp));
        if (t0 + s >= 0) { const float val = bf2f(pp[0]), gate = bf2f(pp[512]); u = val * sigmoid_(gate); }
        else u = sample ? *scp : 0.f;
        pp += 1024; scp += 512;
#pragma unroll
        for (int t = 0; t < TT; ++t) { const int j = s - t + 30; if (j >= 0 && j <= 30) y[t] += u * w[j]; }
        if (sample) { if (s + 22 >= 0) oconv[(size_t)(s + 22) * 512] = u; }
        else if (lastp && s >= TT - 30) oconv[(size_t)(s - (TT - 30)) * 512] = u;
    }
#pragma unroll
    for (int t = 0; t < TT; ++t) ylds[t * 512 + c] = y[t];
    __syncthreads();
    const float* lg = F.in[9]; const float* lb = F.in[10];
    for (int t = F.wave; t < TT; t += NWAVES) {
        const LAS float* yr = ylds + t * 512 + F.lane * 8;
        float v[8];
        { const f32x4 a = *(const LAS f32x4*)yr, b = *(const LAS f32x4*)(yr + 4); v[0] = a.x; v[1] = a.y; v[2] = a.z; v[3] = a.w; v[4] = b.x; v[5] = b.y; v[6] = b.z; v[7] = b.w; }
        float s = 0.f;
#pragma unroll
        for (int i = 0; i < 8; ++i) s += v[i];
        const float mean = wave_sum(s) * (1.f / 512.f); float q = 0.f;
#pragma unroll
        for (int i = 0; i < 8; ++i) { v[i] -= mean; q += v[i] * v[i]; }
        const float rstd = rsqrtf(wave_sum(q) * (1.f / 512.f) + LN_EPS);
        float g8[8], b8[8], o[8]; load_f8(lg + F.lane * 8, g8); load_f8(lb + F.lane * 8, b8);
#pragma unroll
        for (int i = 0; i < 8; ++i) o[i] = silu_(v[i] * rstd * g8[i] + b8[i]);
        *(v4u*)(CAT + (size_t)(m0 + t) * 1024 + F.lane * 8) = pack_bf8(o);
    }
    __syncthreads();
}
__device__ __forceinline__ void conv_phase(Frame& F) {
    for (int it = F.vcu; it < 512 + 128; it += F.G) {
        if (it < 512) { const int m0 = it * 32; conv_tile<32>(F, m0, m0 & 2047, m0 >> 11, false); }
        else { const int seq = it - 512; conv_tile<8>(F, TP + seq * 8, 0, seq, true); }
    }
}

constexpr int SU = 8;
struct ScanPtrs { const h16* R; const h16* K; const h16* V; const h16* KK; const h16* B; const h16* W; h16* O; };
struct ScanBuf { v2u r[SU], k[SU], kk[SU], b[SU], w[SU]; unsigned short v[SU]; };
__device__ __forceinline__ void scan_load(ScanBuf& Bf, const ScanPtrs& P, size_t off, int ks, int row) {
#pragma unroll
    for (int i = 0; i < SU; ++i) { const size_t o = off + (size_t)i * HW;
        Bf.r[i] = *(const v2u*)(P.R + o + ks); Bf.k[i] = *(const v2u*)(P.K + o + ks); Bf.kk[i] = *(const v2u*)(P.KK + o + ks);
        Bf.b[i] = *(const v2u*)(P.B + o + ks); Bf.w[i] = *(const v2u*)(P.W + o + ks); Bf.v[i] = *(const unsigned short*)(P.V + o + row); }
}
__device__ __forceinline__ void scan_compute(const ScanBuf& Bf, float (&S)[4], const ScanPtrs& P, size_t off, int row, bool writer) {
#pragma unroll
    for (int i = 0; i < SU; ++i) {
        float r[4], k[4], kk[4], b[4], w[4]; h4(Bf.r[i], r); h4(Bf.k[i], k); h4(Bf.kk[i], kk); h4(Bf.b[i], b); h4(Bf.w[i], w);
        const float v = (float)__builtin_bit_cast(h16, Bf.v[i]);
        float d = (S[0] * kk[0] + S[1] * kk[1]) + (S[2] * kk[2] + S[3] * kk[3]);
        float pj[4];
#pragma unroll
        for (int j = 0; j < 4; ++j) pj[j] = fmaf(v, k[j], fmaf(-S[j], w[j], S[j]));
        d = dpp_sum16(d);
#pragma unroll
        for (int j = 0; j < 4; ++j) S[j] = fmaf(-d, b[j], pj[j]);
        float o = (S[0] * r[0] + S[1] * r[1]) + (S[2] * r[2] + S[3] * r[3]);
        o = dpp_sum16(o);
        if (writer) P.O[off + (size_t)i * HW + row] = (h16)o;
    }
}
template <int L> __device__ __forceinline__ void scan_task(const ScanPtrs& P, int mbase, int h, int v0, const float* s_in, float* s_out, int lane) {
    const int rl = lane >> 4, ks = (lane & 15) * 4, row = v0 + rl; const bool writer = (lane & 15) == 0;
    float S[4] = {0.f, 0.f, 0.f, 0.f};
    if (s_in) { const f32x4 s = *(const f32x4*)(s_in + (size_t)row * 64 + ks); S[0] = s.x; S[1] = s.y; S[2] = s.z; S[3] = s.w; }
    size_t off = (size_t)mbase * HW + h * 64;
    ScanBuf A;
    scan_load(A, P, off, ks, row);
    if constexpr (L == SU) { scan_compute(A, S, P, off, row, writer); }
    else {
        ScanBuf Bf;
        for (int t = 0; t < L; t += 2 * SU) {
            scan_load(Bf, P, off + (size_t)SU * HW, ks, row);
            scan_compute(A, S, P, off, row, writer);
            if (t + 2 * SU < L) scan_load(A, P, off + (size_t)2 * SU * HW, ks, row);
            scan_compute(Bf, S, P, off + (size_t)SU * HW, row, writer);
            off += (size_t)2 * SU * HW;
        }
    }
    *(f32x4*)(s_out + (size_t)row * 64 + ks) = (f32x4){S[0], S[1], S[2], S[3]};
}
constexpr int RING_SLOTS = 64, SLOT_BYTES = 1536, FLAG_OFF = 131072 + 1024;
constexpr unsigned SPIN_CAP = 1u << 22;
struct StepF { f32x4 r, k, kk, b, w; float v; };
__device__ __forceinline__ void ld_stepf(StepF& X, const LAS unsigned char* slot, unsigned rd, unsigned vd) {
    X.r = *(const LAS f32x4*)(slot + 0 * 256 + rd); X.k = *(const LAS f32x4*)(slot + 1 * 256 + rd); X.kk = *(const LAS f32x4*)(slot + 2 * 256 + rd);
    X.b = *(const LAS f32x4*)(slot + 3 * 256 + rd); X.w = *(const LAS f32x4*)(slot + 4 * 256 + rd); X.v = *(const LAS float*)(slot + vd);
}
__device__ __forceinline__ float step_computef(const StepF& X, float (&S)[4]) {
    float d = (S[0] * X.kk[0] + S[1] * X.kk[1]) + (S[2] * X.kk[2] + S[3] * X.kk[3]);
    float pj[4];
#pragma unroll
    for (int j = 0; j < 4; ++j) pj[j] = fmaf(X.v, X.k[j], fmaf(-S[j], X.w[j], S[j]));
    d = dpp_sum16(d);
#pragma unroll
    for (int j = 0; j < 4; ++j) S[j] = fmaf(-d, X.b[j], pj[j]);
    float o = (S[0] * X.r[0] + S[1] * X.r[1]) + (S[2] * X.r[2] + S[3] * X.r[3]);
    return dpp_sum16(o);
}
__device__ __forceinline__ unsigned min4(const volatile LAS unsigned* p) { const unsigned a = p[0], b = p[1], c = p[2], d = p[3]; return min(min(a, b), min(c, d)); }
__device__ __forceinline__ void scan_prompt_consumer(Frame& F, int mbase, int h, int v0, float* s_out) {
    const int lane = F.lane, rl = lane >> 4, l16 = lane & 15, ks = l16 * 4, row = v0 + rl;
    const LAS unsigned char* ring = F.lds;
    volatile LAS unsigned* prod = (volatile LAS unsigned*)(F.lds + FLAG_OFF); volatile LAS unsigned* cons = prod + 4;
    h16* O = (h16*)(F.ws + WS_O) + (size_t)mbase * HW + h * 64 + row;
    const unsigned rd = ks * 4, vd = 5 * 256 + row * 4;
    constexpr int L = LP;
    float S[4] = {0.f, 0.f, 0.f, 0.f};
    StepF A, B;
    __builtin_amdgcn_s_setprio(2);
    { unsigned sp = 0; while (min4(prod) < 2u && ++sp < SPIN_CAP) __builtin_amdgcn_s_sleep(1); }
    asm volatile("" ::: "memory");
    ld_stepf(A, ring, rd, vd);
    float okeep = 0.f;
#pragma unroll 1
    for (int tb = 0; tb < L; tb += 16) {
#pragma unroll
        for (int j = 0; j < 16; ++j) {
            const int t = tb + j;
            if (j == 0) {
                const unsigned need = (unsigned)min(t / 4 + 5, L / 4);
                unsigned sp = 0; while (min4(prod) < need && ++sp < SPIN_CAP) __builtin_amdgcn_s_sleep(1);
                asm volatile("" ::: "memory");
            }
            float o;
            if (j & 1) { ld_stepf(A, ring + ((t + 1) & (RING_SLOTS - 1)) * SLOT_BYTES, rd, vd); o = step_computef(B, S); }
            else       { ld_stepf(B, ring + ((t + 1) & (RING_SLOTS - 1)) * SLOT_BYTES, rd, vd); o = step_computef(A, S); }
            okeep = (l16 == j) ? o : okeep;
            if (j == 15) { asm volatile("s_waitcnt lgkmcnt(0)" ::: "memory"); if (lane == 0) cons[F.wave] = (unsigned)(t + 1); }
        }
        O[(size_t)(tb + l16) * HW] = (h16)okeep;
    }
    *(f32x4*)(s_out + (size_t)row * 64 + ks) = (f32x4){S[0], S[1], S[2], S[3]};
    __builtin_amdgcn_s_setprio(0);
}
__device__ __forceinline__ void scan_prompt_loader(Frame& F, int mbase, int h) {
    const int lane = F.lane, w = F.wave - 4;
    LAS unsigned char* ring = F.lds;
    volatile LAS unsigned* prod = (volatile LAS unsigned*)(F.lds + FLAG_OFF); volatile LAS unsigned* cons = prod + 4;
    const int arr = lane < 40 ? (lane >> 3) : 5, part = lane & 7;
    const size_t abase = arr == 0 ? WS_SCR : arr == 1 ? WS_SCK : arr == 2 ? WS_SCKK : arr == 3 ? WS_SCB : arr == 4 ? WS_SCW : WS_SCV;
    const unsigned char* src = F.ws + abase + ((size_t)mbase * HW + h * 64) * 2 + part * 16;
    const bool active = lane < 48;
    const unsigned dst = arr * 256 + part * 32;
    constexpr int L = LP, PF = 8;
    v4u buf[PF];
#pragma unroll
    for (int i = 0; i < PF; ++i) { const int s0 = w + 4 * i; buf[i] = active ? *(const v4u*)(src + (size_t)s0 * 1024) : (v4u){0u, 0u, 0u, 0u}; }
#pragma unroll 1
    for (int sb = w; sb < L; sb += 4 * PF) {
#pragma unroll
        for (int i = 0; i < PF; ++i) {
            const int st = sb + 4 * i;
            if (st >= RING_SLOTS) { unsigned sp = 0; while (min4(cons) < (unsigned)(st - RING_SLOTS + 1) && ++sp < SPIN_CAP) __builtin_amdgcn_s_sleep(1); }
            asm volatile("" ::: "memory");
            float f[8]; unpack_h8(buf[i], f);
            { const int sn = st + 4 * PF; if (sn < L) buf[i] = active ? *(const v4u*)(src + (size_t)sn * 1024) : (v4u){0u, 0u, 0u, 0u}; }
            if (active) { LAS unsigned char* p = ring + (st & (RING_SLOTS - 1)) * SLOT_BYTES + dst;
                *(LAS f32x4*)p = (f32x4){f[0], f[1], f[2], f[3]}; *(LAS f32x4*)(p + 16) = (f32x4){f[4], f[5], f[6], f[7]}; }
            asm volatile("s_waitcnt lgkmcnt(0)" ::: "memory");
            if (lane == 0) prod[w] = (unsigned)(st >> 2) + 1u;
        }
    }
}
__device__ __forceinline__ void scan_phase(Frame& F) {
    unsigned char* ws = F.ws;
    ScanPtrs P{(const h16*)(ws + WS_SCR), (const h16*)(ws + WS_SCK), (const h16*)(ws + WS_SCV), (const h16*)(ws + WS_SCKK), (const h16*)(ws + WS_SCB), (const h16*)(ws + WS_SCW), (h16*)(ws + WS_O)};
    for (int task = F.vcu; task < 256; task += F.G) {
        if (F.tid < 8) ((volatile LAS unsigned*)(F.lds + FLAG_OFF))[F.tid] = 0u;
        __syncthreads();
        const int pair = task >> 2, q = task & 3, n = pair >> 3, h = pair & 7;
        if (F.wave < 4) scan_prompt_consumer(F, n * LP, h, q * 16 + F.wave * 4, F.out + O_WKV_P + (size_t)pair * 4096);
        else scan_prompt_loader(F, n * LP, h);
        __syncthreads();
    }
    {
        const int gw = F.vcu * NWAVES + F.wave, NGW = F.G * NWAVES;
        for (int task = gw; task < NSB * 8 * 16; task += NGW) {
            const int pair = task >> 4, rg = task & 15, n = pair >> 3, h = pair & 7;
            scan_task<LS>(P, TP + n * LS, h, rg * 4, F.in[4] + (size_t)pair * 4096, F.out + O_WKV_S + (size_t)pair * 4096, F.lane);
        }
    }
}

__device__ __forceinline__ void p6_rows(Frame& F) {
    const int gw = F.vcu * NWAVES + F.wave, NGW = F.G * NWAVES, lane = F.lane;
    unsigned char* ws = F.ws;
    const h16* O = (const h16*)(ws + WS_O); const h16* SCR = (const h16*)(ws + WS_SCR); const h16* SCK = (const h16*)(ws + WS_SCK); const h16* SCV = (const h16*)(ws + WS_SCV); const h16* G = (const h16*)(ws + WS_G);
    bf16* CAT = (bf16*)(ws + WS_CAT);
    float rk[8], lg[8], lb[8]; load_f8(F.in[19] + lane * 8, rk); load_f8(F.in[20] + lane * 8, lg); load_f8(F.in[21] + lane * 8, lb);
    for (int m = gw; m < T; m += NGW) {
        const size_t off = (size_t)m * HW + lane * 8;
        float o[8], r[8], k[8], v[8], g[8];
        unpack_h8(*(const v4u*)(O + off), o); unpack_h8(*(const v4u*)(SCR + off), r); unpack_h8(*(const v4u*)(SCK + off), k); unpack_h8(*(const v4u*)(SCV + off), v); unpack_h8(*(const v4u*)(G + off), g);
        float s = 0.f, bs = 0.f;
#pragma unroll
        for (int i = 0; i < 8; ++i) { s += o[i]; bs += r[i] * k[i] * rk[i]; }
        const float mean = sum8(s) * (1.f / 64.f); bs = sum8(bs); float q = 0.f;
#pragma unroll
        for (int i = 0; i < 8; ++i) { o[i] -= mean; q += o[i] * o[i]; }
        const float rstd = rsqrtf(sum8(q) * (1.f / 64.f) + GN_EPS);
        float res[8];
#pragma unroll
        for (int i = 0; i < 8; ++i) res[i] = (o[i] * rstd * lg[i] + lb[i] + bs * v[i]) * g[i];
        *(v4u*)(CAT + (size_t)m * 1024 + 512 + lane * 8) = pack_bf8(res);
    }
}

template <int MODE> __device__ __forceinline__ void ln_rows(Frame& F, const float* g, const float* b, int nparts, const h16* pa, const h16* pb) {
    const int gw = F.vcu * NWAVES + F.wave, NGW = F.G * NWAVES, lane = F.lane;
    float* Z = (float*)(F.ws + WS_Z); bf16* XB = (bf16*)(F.ws + WS_XB);
    f32x4 gv[4], bv[4];
#pragma unroll
    for (int j = 0; j < 4; ++j) { gv[j] = *(const f32x4*)(g + 4 * (lane + 64 * j)); bv[j] = *(const f32x4*)(b + 4 * (lane + 64 * j)); }
    for (int m = gw; m < T; m += NGW) {
        float* zr = Z + (size_t)m * D;
        f32x4 v[4]; float s = 0.f;
#pragma unroll
        for (int j = 0; j < 4; ++j) v[j] = *(const f32x4*)(zr + 4 * (lane + 64 * j));
        if (m >= TP) {
#pragma unroll 2
            for (int sp = 0; sp < nparts; ++sp) { const h16* pr = (sp < 8 ? pa + (size_t)sp * (1u << 20) : pb + (size_t)(sp - 8) * (1u << 20)) + (size_t)(m - TP) * D;
#pragma unroll
                for (int j = 0; j < 4; ++j) { float f[4]; h4(*(const v2u*)(pr + 4 * (lane + 64 * j)), f); v[j] = v[j] + (f32x4){f[0], f[1], f[2], f[3]}; } }
        }
#pragma unroll
        for (int j = 0; j < 4; ++j) s += (v[j].x + v[j].y) + (v[j].z + v[j].w);
        const float mean = wave_sum(s) * (1.f / D); float s2 = 0.f;
#pragma unroll
        for (int j = 0; j < 4; ++j) { v[j] = v[j] - mean; s2 += (v[j].x * v[j].x + v[j].y * v[j].y) + (v[j].z * v[j].z + v[j].w * v[j].w); }
        const float rstd = rsqrtf(wave_sum(s2) * (1.f / D) + LN_EPS);
#pragma unroll
        for (int j = 0; j < 4; ++j) v[j] = v[j] * rstd * gv[j] + bv[j];
        if (MODE == 2) {
#pragma unroll
            for (int j = 0; j < 4; ++j) *(f32x4*)(F.out + O_Y + (size_t)m * D + 4 * (lane + 64 * j)) = v[j];
        } else {
            if (MODE == 0 && m >= TP) {
#pragma unroll
                for (int j = 0; j < 4; ++j) *(f32x4*)(zr + 4 * (lane + 64 * j)) = v[j] * ALPHA;
            }
#pragma unroll
            for (int j = 0; j < 4; ++j) { v2u w; w.x = pkbf(v[j].x, v[j].y); w.y = pkbf(v[j].z, v[j].w); *(v2u*)(XB + (size_t)m * D + 4 * (lane + 64 * j)) = w; }
        }
        if (MODE == 1) {
            const bool sample = m >= TP; const int seq = sample ? (m - TP) >> 3 : m >> 11, t = sample ? (m - TP) & 7 : m & 2047;
            if (sample) {
                float* op = F.out + O_POOL_S + ((size_t)seq * 15 + 7 + t) * D;
#pragma unroll
                for (int j = 0; j < 4; ++j) *(f32x4*)(op + 4 * (lane + 64 * j)) = v[j];
                if (t == 0) { const float* sp = F.in[5] + ((size_t)seq * 15 + 8) * D; float* o0 = F.out + O_POOL_S + (size_t)seq * 15 * D;
                    for (int i = lane; i < 7 * D / 4; i += 64) *(f32x4*)(o0 + 4 * i) = *(const f32x4*)(sp + 4 * i); }
            } else if (t >= LP - 15) {
                float* op = F.out + O_POOL_P + ((size_t)seq * 15 + (t - (LP - 15))) * D;
#pragma unroll
                for (int j = 0; j < 4; ++j) *(f32x4*)(op + 4 * (lane + 64 * j)) = v[j];
            }
        }
    }
}

template <int TT> __device__ __forceinline__ float pool_one(const float (&xs)[TT + 15], int t, int g, int cnt) {
    const float x0 = xs[t + 15];
    const float s2 = x0 + xs[t + 14];
    const float s4 = s2 + (xs[t + 13] + xs[t + 12]);
    const float s8 = s4 + ((xs[t + 11] + xs[t + 10]) + (xs[t + 9] + xs[t + 8]));
    const float s16 = s8 + (((xs[t + 7] + xs[t + 6]) + (xs[t + 5] + xs[t + 4])) + ((xs[t + 3] + xs[t + 2]) + (xs[t + 1] + xs[t + 0])));
    const float sum = g == 0 ? s2 : (g == 1 ? s4 : (g == 2 ? s8 : s16));
    return sum / (float)cnt - x0;
}
template <int TT> __device__ __forceinline__ void pool_tile(Frame& F, int m0, int t0, int seq, bool sample) {
    const bf16* XR = (const bf16*)(F.ws + WS_XR); bf16* PL = (bf16*)(F.ws + WS_PL); const float* spool = F.in[5];
    const int c = 2 * F.tid, g = c >> 8;
    float xa[TT + 15], xb[TT + 15];
    const bf16* zp = XR + ((size_t)m0 - 15) * D + c; const float* sp = spool + ((size_t)seq * 15 + t0) * D + c;
#pragma unroll
    for (int s = -15; s < TT; ++s) {
        asm volatile("" : "+v"(zp), "+v"(sp));
        if (t0 + s >= 0) { const unsigned w = *(const unsigned*)zp; xa[s + 15] = __uint_as_float(w << 16); xb[s + 15] = __uint_as_float(w & 0xffff0000u); }
        else if (sample) { xa[s + 15] = sp[0]; xb[s + 15] = sp[1]; }
        else { xa[s + 15] = 0.f; xb[s + 15] = 0.f; }
        zp += D; sp += D;
    }
    const int wdw = 2 << g;
#pragma unroll
    for (int t = 0; t < TT; ++t) {
        const int cnt = sample ? wdw : min(wdw, t0 + t + 1);
        const float p0 = pool_one<TT>(xa, t, g, cnt), p1 = pool_one<TT>(xb, t, g, cnt);
        *(unsigned*)(PL + (size_t)(m0 + t) * D + c) = pkbf(p0, p1);
    }
}
__device__ __forceinline__ void pool_phase(Frame& F) {
    for (int it = F.vcu; it < 512 + 128; it += F.G) {
        if (it < 512) { const int m0 = it * 32; pool_tile<32>(F, m0, m0 & 2047, m0 >> 11, false); }
        else { const int seq = it - 512; pool_tile<8>(F, TP + seq * 8, 0, seq, true); }
    }
}


#ifndef DIAG_AT
#define DIAG_AT -1
#endif
__device__ __forceinline__ bool dbad(float got, float want) { return !(fabsf(got - want) <= 0.03f * fabsf(want) + 0.02f); }
__device__ __forceinline__ float h2f(h16 x) { return (float)x; }
__device__ __forceinline__ void diag_checks(Frame& F, int at) {
    if (blockIdx.x != 0 || F.wave != 0) return;
    const int lane = F.lane; unsigned char* ws = F.ws;
    unsigned mask = 0;
    const bf16* PA = (const bf16*)(ws + WS_PROJA); const bf16* PB = (const bf16*)(ws + WS_PROJB);
    const h16* SCR = (const h16*)(ws + WS_SCR); const h16* SCK = (const h16*)(ws + WS_SCK); const h16* SCV = (const h16*)(ws + WS_SCV); const h16* SCKK = (const h16*)(ws + WS_SCKK);
    const h16* SCB = (const h16*)(ws + WS_SCB); const h16* SCW = (const h16*)(ws + WS_SCW);
    const int m = 1 + (lane * 131 + 7) % 9000;
    const int t = m & 2047;
    if (at == 3) {
        const int c = (lane * 29 + 5) % 512, h0 = c & ~63;
        auto xm = [&](int col) { const float p = bf2f(PB[(size_t)m * BP + col]); const float pv = t > 0 ? bf2f(PB[(size_t)(m - 1) * BP + col]) : 0.f; return p + F.in[11][col] * (pv - p); };
        float ss = 0.f; for (int j = 0; j < 64; ++j) { const float kx = xm(512 + h0 + j) * F.in[17][h0 + j]; ss += kx * kx; }
        const float kkn = xm(512 + c) * F.in[17][c] / fmaxf(sqrtf(ss), 1e-12f);
        float al = F.in[14][c]; for (int j = 0; j < 64; ++j) al += xm(1600 + j) * F.in[15][(size_t)j * 512 + c];
        const float a = 1.f / (1.f + expf(-al)); const float f = (1.f + (a - 1.f) * F.in[18][c]); const float k0 = xm(512 + c); const float b = kkn * a;
        const float gotk = h2f(SCK[(size_t)m * HW + c]);
        if (__ballot(dbad(gotk, k0 * f))) mask |= 1;
        if (__ballot(dbad(h2f(SCB[(size_t)m * HW + c]) * 10.f, b * 10.f))) mask |= 2;
        { const bf16* LA = (const bf16*)(ws + WS_LA); bool bad = false; for (int j = 0; j < 64; ++j) bad = bad || dbad(bf2f(LA[(size_t)m * 256 + 64 + j]), xm(1600 + j)); if (__ballot(bad)) mask |= 4; }
        { float g = 0.f; for (int j = 0; j < 128; ++j) g += (1.f / (1.f + expf(-xm(1664 + j)))) * F.in[16][(size_t)j * 512 + c];
          const h16* G = (const h16*)(ws + WS_G); if (__ballot(dbad(h2f(G[(size_t)m * HW + c]), g))) mask |= 8; }
        if (__ballot(dbad(gotk, k0 * f * f))) mask |= 16;
        if (__ballot(dbad(gotk, k0))) mask |= 32;
    }
    if (lane == 0) *(unsigned*)(ws + 0) = mask;
}
__device__ __forceinline__ void diag_fill(Frame& F) {
    const unsigned mask = *(const unsigned*)(F.ws + 0);
    const float C = sqrtf(exp2f(1.f + (float)mask));
    const int gt = blockIdx.x * NTHREADS + F.tid, NGT = F.G * NTHREADS;
    for (int i = gt; i < TS * D; i += NGT) F.out[O_Y + (size_t)TP * D + i] = C;
}

#define XB_TMO      128
#define XB_XCNT(j)  (256  + 64 * (j))
#define XB_XSUB(j)  (1280 + 64 * (j))
#define XB_XGEN(j)  (2304 + 64 * (j))
#define XB_TOP      3328
#define XB_TOPGEN   3392
#define XCD_BAR_WORDS 3456
#define XB_SPIN_CAP (1u << 18)

__device__ __forceinline__ unsigned xb_ld(unsigned* p)              { return __hip_atomic_load(p, __ATOMIC_RELAXED, __HIP_MEMORY_SCOPE_AGENT); }
__device__ __forceinline__ unsigned xb_add(unsigned* p, unsigned v) { return __hip_atomic_fetch_add(p, v, __ATOMIC_RELAXED, __HIP_MEMORY_SCOPE_AGENT); }
__device__ __forceinline__ unsigned xb_xcc_id() { return (unsigned)__builtin_amdgcn_s_getreg((3 << 11) | 20) & 0xFu; }
#define XB_SPIN(cond, bar) do { unsigned _sp = 0; while (cond) { __builtin_amdgcn_s_sleep(1); \
    if ((++_sp & 255u) == 0u) { if (xb_ld(&(bar)[XB_TMO])) break; if (_sp > XB_SPIN_CAP) { atomicAdd(&(bar)[XB_TMO], 1u); break; } } } } while (0)

struct XcdBarrier {
    unsigned* bar; unsigned x;
    volatile LAS unsigned* st;
};

__device__ __forceinline__ XcdBarrier xcd_barrier_post(unsigned* bar, volatile LAS unsigned* st) {
    XcdBarrier b; b.bar = bar; b.x = xb_xcc_id(); b.st = st;
    if (threadIdx.x == 0) (void)xb_add(&bar[XB_XCNT(b.x)], 1u);
    return b;
}
__device__ __forceinline__ void xcd_barrier_complete(unsigned* bar, unsigned x, unsigned& nloc, unsigned& nx) {
    const unsigned G = gridDim.x * gridDim.y * gridDim.z;
    unsigned sum, cnt, mine, sp = 0u;
    for (;;) {
        sum = 0u; cnt = 0u; mine = 0u;
#pragma unroll
        for (unsigned j = 0; j < 16; ++j) { const unsigned c = xb_ld(&bar[XB_XCNT(j)]); sum += c; cnt += (c > 0u) ? 1u : 0u; mine = (j == x) ? c : mine; }
        if (sum == G) break;
        __builtin_amdgcn_s_sleep(1);
        if ((++sp & 255u) == 0u) { if (xb_ld(&bar[XB_TMO])) break; if (sp > XB_SPIN_CAP) { atomicAdd(&bar[XB_TMO], 1u); break; } }
    }
    nloc = mine > 0u ? mine : 1u; nx = cnt > 0u ? cnt : 1u;
}

__device__ __forceinline__ void xcd_barrier(const XcdBarrier& b) {
    asm volatile("s_waitcnt vmcnt(0)" ::: "memory");
    __syncthreads();
    if (threadIdx.x == 0) {
        unsigned* bar = b.bar;
        __builtin_amdgcn_s_waitcnt(0);
        unsigned nloc = b.st[0], nx = b.st[1];
        if (nloc == 0u) { xcd_barrier_complete(bar, b.x, nloc, nx); b.st[0] = nloc; b.st[1] = nx; }
        const unsigned old = xb_add(&bar[XB_XSUB(b.x)], 1u);
        const unsigned gen = old / nloc;
        if (old + 1u == (gen + 1u) * nloc) {
            __builtin_amdgcn_fence(__ATOMIC_RELEASE, "agent");
            asm volatile("s_waitcnt vmcnt(0)" ::: "memory");
            const unsigned og = xb_add(&bar[XB_TOP], 1u);
            const unsigned tg = og / nx;
            if (og + 1u == (tg + 1u) * nx) xb_add(&bar[XB_TOPGEN], 1u);
            else XB_SPIN(xb_ld(&bar[XB_TOPGEN]) == tg, bar);
            __builtin_amdgcn_fence(__ATOMIC_ACQUIRE, "agent");
            xb_add(&bar[XB_XGEN(b.x)], 1u);
            asm volatile("s_waitcnt vmcnt(0)" ::: "memory");
        } else {
            XB_SPIN(xb_ld(&bar[XB_XGEN(b.x)]) == gen, bar);
            __builtin_amdgcn_fence(__ATOMIC_ACQUIRE, "agent");
            asm volatile("s_waitcnt vmcnt(0)" ::: "memory");
        }
    }
    __syncthreads();
}

struct Args { const float* in[32]; float* out; unsigned char* ws; int ph_lo, ph_hi, coop, pad; };

__global__ void __launch_bounds__(NTHREADS, 2) mk_fwd(Args args) {
    extern __shared__ __attribute__((aligned(16))) unsigned char lds_raw[];
    Frame F;
    F.lds = (LAS unsigned char*)lds_raw;
    F.tid = threadIdx.x; F.lane = F.tid & 63; F.wave = __builtin_amdgcn_readfirstlane(F.tid >> 6);
    F.G = gridDim.x; { const int bx = blockIdx.x; F.vcu = (F.G % 8 == 0) ? (bx % 8) * (F.G / 8) + bx / 8 : bx; }
    F.in = args.in;
    F.out = args.out; F.ws = args.ws;
    unsigned char* ws = args.ws;
    const int lo = args.ph_lo, hi = args.ph_hi;
    volatile LAS unsigned* MISC = (volatile LAS unsigned*)(F.lds + 131072 + 512);
    if (F.tid < 32) MISC[F.tid] = 0u;
    __syncthreads();
    XcdBarrier bar = xcd_barrier_post((unsigned*)ws, MISC + 8);
#ifndef PHMASK
#define PHMASK 0x3ffff
#endif
#define IN(k) ((((PHMASK) >> (k)) & 1) && lo <= (k) && (k) < hi)
#define SEAM(k) do { if (IN(k) && IN((k) + 1)) { xcd_barrier(bar); } } while (0)
    typedef pg8::bf16_t gb;

#ifndef DUP0
#define DUP0 0
#endif
#ifndef DUP9
#define DUP9 0
#endif
#ifndef DUP2
#define DUP2 0
#endif
    if (DUP0) { p0_prologue(F); }
    if (IN(0)) { p0_prologue(F); } SEAM(0);
    if (IN(1)) {
        pg8::Gemm g{(const gb*)(ws + WS_XB), (const gb*)(ws + WS_WIN), T, INP, D, D, D, 0}; pg8::StaticOrder S; S.init(T, INP, F.G, (int)blockIdx.x, D);
        EpiProj E{(bf16*)(ws + WS_PROJA), (bf16*)(ws + WS_PROJB)};
        pg8::gemm_phase<EpiProj, pg8::StaticOrder, true, true>(F.lds, g, S, E);
    } SEAM(1);
    if (DUP2) { p2_rows(F); }
    if (IN(2)) { p2_rows(F); } SEAM(2);
    if (IN(3)) {
        pg8::Gemm g{(const gb*)(ws + WS_LA), (const gb*)(ws + WS_LORAT), T, 1536, 256, 256, 256, 0}; pg8::StaticOrder S; S.init(T, 1536, F.G, (int)blockIdx.x, 256);
        EpiLora E{F.in[12], F.in[14], F.in[18], (h16*)(ws + WS_SCW), (h16*)(ws + WS_SCK), (h16*)(ws + WS_SCKK), (h16*)(ws + WS_SCB), (h16*)(ws + WS_G)};
        pg8::gemm_phase<EpiLora, pg8::StaticOrder, true, true>(F.lds, g, S, E);
    } SEAM(3);
    if (IN(4)) { conv_phase(F); }
#ifndef DUP5
#define DUP5 0
#endif
#ifndef DUP4
#define DUP4 0
#endif
    if (DUP4) { conv_phase(F); }
    if (IN(5)) { scan_phase(F); } SEAM(5);
    if (DUP5) { scan_phase(F); xcd_barrier(bar); }
    if (IN(6)) { p6_rows(F); } SEAM(6);
    if (IN(7)) {
        pg8::Gemm g{(const gb*)(ws + WS_CAT), (const gb*)(ws + WS_WOUT), T, D, D, D, D, 0}; SplitOrder S; S.init(D, F.G, (int)blockIdx.x, D, 4);
        EpiResid E{F.in[0], F.in[1], (float*)(ws + WS_Z), nullptr, nullptr, (h16*)(ws + WS_PART7), nullptr};
        pg8::gemm_phase<EpiResid, SplitOrder, true, true>(F.lds, g, S, E);
    } SEAM(7);
    if (IN(8)) { ln_rows<0>(F, F.in[25], F.in[26], 4, (const h16*)(ws + WS_PART7), nullptr); } SEAM(8);
#define FFN_PHASES(layer, pgu, pdn) \
    if (IN(pgu)) { \
        pg8::Gemm g{(const gb*)(ws + WS_XB), (const gb*)(ws + ((layer) ? WS_WGU1 : WS_WGU0)), T, 2 * FF, D, D, D, 0}; pg8::StaticOrder S; S.init(T, 2 * FF, F.G, (int)blockIdx.x, D); \
        EpiGateUp E{(bf16*)(ws + WS_H)}; \
        pg8::gemm_phase<EpiGateUp, pg8::StaticOrder, true, true>(F.lds, g, S, E); \
    } SEAM(pgu); \
    if (IN(pdn)) { \
        pg8::Gemm g{(const gb*)(ws + WS_H), (const gb*)(ws + ((layer) ? WS_WD1 : WS_WD0)), T, D, FF, FF, FF, 0}; SplitOrder S; S.init(D, F.G, (int)blockIdx.x, FF, 11); \
        EpiResid E{nullptr, nullptr, (float*)(ws + WS_Z), nullptr, (const bf16*)(ws + WS_XR), (h16*)(ws + WS_PARTA), (h16*)(ws + WS_PARTB)}; \
        pg8::gemm_phase<EpiResid, SplitOrder, true, true>(F.lds, g, S, E); \
    } SEAM(pdn);
    if (DUP9) { pg8::Gemm g{(const gb*)(ws + WS_XB), (const gb*)(ws + WS_WGU0), T, 2 * FF, D, D, D, 0}; pg8::StaticOrder S; S.init(T, 2 * FF, F.G, (int)blockIdx.x, D);
        EpiGateUp E{(bf16*)(ws + WS_H)}; pg8::gemm_phase<EpiGateUp, pg8::StaticOrder, true, true>(F.lds, g, S, E); xcd_barrier(bar); }
    FFN_PHASES(0, 9, 10)
    if (IN(11)) { ln_rows<1>(F, F.in[30], F.in[31], 11, (const h16*)(ws + WS_PARTA), (const h16*)(ws + WS_PARTB)); } SEAM(11);
    if (IN(12)) { pool_phase(F); } SEAM(12);
    if (IN(13)) {
        pg8::Gemm g{(const gb*)(ws + WS_PL), (const gb*)(ws + WS_POOLT), T, D, 256, D, 256, 256}; pg8::StaticOrder S; S.init(T, D, F.G, (int)blockIdx.x, 256);
        EpiResid E{nullptr, nullptr, (float*)(ws + WS_Z), F.in[24], (const bf16*)(ws + WS_XR), nullptr, nullptr};
        pg8::gemm_phase<EpiResid, pg8::StaticOrder, true, true>(F.lds, g, S, E);
    } SEAM(13);
    if (IN(14)) { ln_rows<0>(F, F.in[25] + D, F.in[26] + D, 0, nullptr, nullptr); } SEAM(14);
    FFN_PHASES(1, 15, 16)
    if (IN(17)) { ln_rows<2>(F, F.in[30] + D, F.in[31] + D, 11, (const h16*)(ws + WS_PARTA), (const h16*)(ws + WS_PARTB)); }
    if (lo == 100) diag_checks(F, args.pad);
    if (lo == 101) diag_fill(F);
#undef IN
#undef SEAM
}

extern "C" void kernel_launch(void* const* d_in, const int* in_sizes, int n_in, void* d_out, int out_size, void* d_ws, size_t ws_size, hipStream_t stream) {
    static int grid = 0;
    if (grid == 0) {
        if (n_in != 32 || out_size != (int)O_TOTAL || ws_size < WS_END) { fprintf(stderr, "kernel_launch: unexpected shapes: n_in %d out %d ws %zu\n", n_in, out_size, ws_size); grid = -1; return; }
        int dev = 0, cus = 0, per_cu = 0;
        if (hipGetDevice(&dev) != hipSuccess || hipDeviceGetAttribute(&cus, hipDeviceAttributeMultiprocessorCount, dev) != hipSuccess) { grid = -1; return; }
        if (hipFuncSetAttribute((const void*)mk_fwd, hipFuncAttributeMaxDynamicSharedMemorySize, LDS_BYTES) != hipSuccess) { fprintf(stderr, "kernel_launch: hipFuncSetAttribute failed\n"); grid = -1; return; }
        if (hipOccupancyMaxActiveBlocksPerMultiprocessor(&per_cu, (const void*)mk_fwd, NTHREADS, LDS_BYTES) != hipSuccess || per_cu < 1) { fprintf(stderr, "kernel_launch: occupancy query says %d\n", per_cu); (void)hipGetLastError(); per_cu = 1; }
        grid = cus * 1;
        if (per_cu < 1) grid = -1;
    }
    if (grid < 0) return;
    Args a{};
    for (int i = 0; i < 32; ++i) a.in[i] = (const float*)d_in[i];
    a.out = (float*)d_out; a.ws = (unsigned char*)d_ws;
#if MK_SINGLE
    if (hipMemsetAsync(d_ws, 0, 16384, stream) != hipSuccess) { fprintf(stderr, "kernel_launch: memset failed\n"); return; }
    a.ph_lo = 0; a.ph_hi = NPHASE; a.coop = 1;
    void* params[] = {&a};
    hipError_t e = hipLaunchCooperativeKernel((const void*)mk_fwd, dim3(grid), dim3(NTHREADS), params, LDS_BYTES, stream);
    if (e != hipSuccess) fprintf(stderr, "kernel_launch: cooperative launch failed: %s (grid %d)\n", hipGetErrorString(e), grid);
#else
    for (int p = 0; p < NPHASE; ++p) {
        if (DIAG_AT >= 0 && p > DIAG_AT) break;
        a.ph_lo = p; a.ph_hi = p + 1; a.coop = 0;
        hipLaunchKernelGGL(mk_fwd, dim3(grid), dim3(NTHREADS), LDS_BYTES, stream, a);
    }
    if (DIAG_AT >= 0) { a.pad = DIAG_AT; a.ph_lo = 100; a.ph_hi = 101; hipLaunchKernelGGL(mk_fwd, dim3(grid), dim3(NTHREADS), LDS_BYTES, stream, a);
                        a.ph_lo = 101; a.ph_hi = 102; hipLaunchKernelGGL(mk_fwd, dim3(grid), dim3(NTHREADS), LDS_BYTES, stream, a); }
#endif
}
```

```cpp
#include <hip/hip_runtime.h>
#include <hip/hip_cooperative_groups.h>
#include <cstdio>
#include <cstdint>
namespace cg = cooperative_groups;
namespace pg8 {
#define PG8_LAS __attribute__((address_space(3)))
typedef unsigned short bf16_t;
typedef short bf16x8 __attribute__((ext_vector_type(8)));
typedef float f32x4 __attribute__((ext_vector_type(4)));
typedef unsigned u32x4 __attribute__((ext_vector_type(4)));
constexpr int BM = 256, BK = 64, HALF = 128, HTB = HALF * BK * 2  , STAGE_BYTES = 8 * HTB, NXCD = 8, WGM = 8;

__host__ __device__ __forceinline__ int lds_byte(int r, int c) { const int st = (r >> 4) * 2 + (c >> 5), rr = r & 15, cc = c & 31, ob = rr * 64 + cc * 2; return st * 1024 + (ob ^ (((ob >> 9) & 1) << 5)); }
__host__ __device__ __forceinline__ void stage_rc(int b, int& R, int& C) { const int st = b / 1024, sb = b % 1024, swz = sb ^ (((sb >> 9) & 1) << 5); R = (st >> 1) * 16 + swz / 64; C = (st & 1) * 32 + (swz % 64) / 2; }
__host__ __device__ __forceinline__ int perm32(int rho) { const int n = rho >> 4, i = rho & 15; return 8 * (i >> 2) + 4 * n + (i & 3); }

struct Unit { int pm, pn, kt0, nt, mode; };
struct Gemm { const bf16_t* A; const bf16_t* Bt; int M, N, K, lda, ldb, acol; };

struct StaticOrder {
    int nM, nN, nwg, G, c, ntf;
    __host__ __device__ void init(int M, int N, int G_, int c_, int K_) { nM = M / BM; nN = N / BM; nwg = nM * nN; G = G_; c = c_; ntf = K_ / BK; }
    __host__ __device__ bool next(int i, Unit& u) const {
        const long L = (long)i * G + c; if (L >= nwg) return false;
        int wgid = (int)L; { const int q = nwg / NXCD, r = nwg % NXCD, xcd = wgid % NXCD, off = wgid / NXCD; wgid = (xcd < r ? xcd * (q + 1) : r * (q + 1) + (xcd - r) * q) + off; }
        const int nig = WGM * nN, gid = wgid / nig, fm = gid * WGM, gsz = (nM - fm) < WGM ? (nM - fm) : WGM;
        u.pm = fm + ((wgid % nig) % gsz); u.pn = (wgid % nig) / gsz; u.kt0 = 0; u.nt = ntf; u.mode = 0; return true;
    }
    __device__ __forceinline__ void a_ready(const Unit&) const {}
    __device__ __forceinline__ void done(const Unit&) const {}
};

__device__ __forceinline__ unsigned cvt_pk_bf16(float lo, float hi) { unsigned r; asm volatile("v_cvt_pk_bf16_f32 %0, %1, %2" : "=v"(r) : "v"(lo), "v"(hi)); return r; }
template <class Epi, class Sched, bool ALIGN_EPI = false, bool SP2 = false>
__device__ __forceinline__ void gemm_phase(PG8_LAS unsigned char* lds, const Gemm g, const Sched& S, const Epi& E) {
    const int tid = threadIdx.x, wid = __builtin_amdgcn_readfirstlane(tid >> 6), lane = tid & 63, wr = wid >> 2, wc = wid & 3, fr = lane & 15, fq = lane >> 4;
    const int K = g.K; (void)K;
    unsigned voffA[2], voffB[2];
#pragma unroll
    for (int i = 0; i < 2; ++i) { int R, C; stage_rc(tid * 16 + i * 8192, R, C); const int Rb = Epi::PERM ? ((R & ~31) + perm32(R & 31)) : R;
        voffA[i] = (unsigned)(R * g.lda + C) * 2u; voffB[i] = (unsigned)(Rb * g.ldb + C) * 2u; }
    const size_t kstep = (size_t)(BK * 2);
    const size_t hstepA = (size_t)HALF * g.lda * 2, hstepB = (size_t)HALF * g.ldb * 2;
    const size_t tstepA = 2 * hstepA, tstepB = 2 * hstepB; const size_t acolB = (size_t)g.acol * 2;
    const unsigned ldsw = (unsigned)wid * 1024u;
    const int aoff = lds_byte(wr * 64 + fr, fq * 8), boff = lds_byte(wc * 32 + fr, fq * 8);
#define PG8_SA(b, h) (((b) * 2 + (h)) * HTB)
#define PG8_SB(b, h) ((4 + (b) * 2 + (h)) * HTB)
#define PG8_STAGE(bufoff, gbase, voff) do { _Pragma("unroll") for (int _i = 0; _i < 2; ++_i) \
        __builtin_amdgcn_global_load_lds((const unsigned*)((const char*)(gbase) + (voff)[_i]), (PG8_LAS unsigned*)(lds + (bufoff) + ldsw + _i * 8192), 16, 0, 0); } while (0)
#define PG8_LDA(dst, b, h) do { _Pragma("unroll") for (int m = 0; m < 4; ++m) _Pragma("unroll") for (int k = 0; k < 2; ++k) dst[m][k] = *(const PG8_LAS bf16x8*)(lds + PG8_SA(b, h) + aoff + m * 2048 + k * 1024); } while (0)
#define PG8_LDB(dst, b, h) do { _Pragma("unroll") for (int n = 0; n < 2; ++n) _Pragma("unroll") for (int k = 0; k < 2; ++k) dst[n][k] = *(const PG8_LAS bf16x8*)(lds + PG8_SB(b, h) + boff + n * 2048 + k * 1024); } while (0)
#define PG8_MMA(ai, bj, At, Bt) do { __builtin_amdgcn_s_setprio(1); _Pragma("unroll") for (int m = 0; m < 4; ++m) _Pragma("unroll") for (int n = 0; n < 2; ++n) _Pragma("unroll") for (int k = 0; k < 2; ++k) \
        acc[ai][bj][m][n] = __builtin_amdgcn_mfma_f32_16x16x32_bf16(Bt[n][k], At[m][k], acc[ai][bj][m][n], 0, 0, 0); __builtin_amdgcn_s_setprio(0); } while (0)
#define PG8_WAIT_V(n) asm volatile("s_waitcnt vmcnt(" #n ")" ::: "memory")
#define PG8_WAIT_L(n) asm volatile("s_waitcnt lgkmcnt(" #n ")" ::: "memory")
#define PG8_BAR __builtin_amdgcn_s_barrier()
#define PG8_SCHED __builtin_amdgcn_sched_barrier(0)
    Unit cur, nxt; int ui = 0;
    if (!S.next(0, cur)) return;
    f32x4 acc[2][2][4][2];
#pragma unroll
    for (int a = 0; a < 2; ++a)
#pragma unroll
        for (int b = 0; b < 2; ++b)
#pragma unroll
            for (int m = 0; m < 4; ++m)
#pragma unroll
                for (int n = 0; n < 2; ++n) acc[a][b][m][n] = (f32x4){0.f, 0.f, 0.f, 0.f};
    bf16x8 At[4][2], B0[2][2], B1[2][2];
    const char* cA = (const char*)g.A + (size_t)cur.pm * tstepA + (size_t)cur.pn * acolB + (size_t)cur.kt0 * kstep; const char* cB = (const char*)g.Bt + (size_t)cur.pn * tstepB + (size_t)cur.kt0 * kstep;
    S.a_ready(cur);
    if constexpr (SP2) {
        PG8_STAGE(PG8_SB(0, 0), cB, voffB); PG8_STAGE(PG8_SB(0, 1), cB + hstepB, voffB); PG8_STAGE(PG8_SA(0, 0), cA, voffA); PG8_STAGE(PG8_SA(0, 1), cA + hstepA, voffA);
        if (wr == 1) PG8_BAR;
        PG8_WAIT_V(2); PG8_BAR;
        PG8_STAGE(PG8_SB(1, 0), cB + kstep, voffB); PG8_STAGE(PG8_SA(1, 0), cA + kstep, voffA); PG8_STAGE(PG8_SB(1, 1), cB + hstepB + kstep, voffB);
        PG8_WAIT_V(6); PG8_BAR;
    } else {
        PG8_STAGE(PG8_SB(0, 0), cB, voffB); PG8_STAGE(PG8_SA(0, 0), cA, voffA); PG8_STAGE(PG8_SB(0, 1), cB + hstepB, voffB); PG8_STAGE(PG8_SA(0, 1), cA + hstepA, voffA);
        if (wr == 1) PG8_BAR;
        PG8_WAIT_V(4); PG8_BAR;
        PG8_STAGE(PG8_SB(1, 0), cB + kstep, voffB); PG8_STAGE(PG8_SA(1, 0), cA + kstep, voffA); PG8_STAGE(PG8_SB(1, 1), cB + hstepB + kstep, voffB);
        PG8_WAIT_V(6); PG8_BAR;
    }
    for (;;) {
        const bool has_next = S.next(ui + 1, nxt);
        const char* nA = has_next ? (const char*)g.A + (size_t)nxt.pm * tstepA + (size_t)nxt.pn * acolB + (size_t)nxt.kt0 * kstep : cA; const char* nB = has_next ? (const char*)g.Bt + (size_t)nxt.pn * tstepB + (size_t)nxt.kt0 * kstep : cB;
        const int nt = cur.nt;
        _Pragma("unroll 1") for (int t = 0; t < nt; t += 2) {
            const bool last = (t == nt - 2);
            const char* a1 = cA + (size_t)(t + 1) * kstep;
            const char* a2 = last ? nA : cA + (size_t)(t + 2) * kstep; const char* b2 = last ? nB : cB + (size_t)(t + 2) * kstep;
            const char* a3 = a2 + kstep; const char* b3 = b2 + kstep;
            if (last && has_next) S.a_ready(nxt);
            if constexpr (SP2) {
            PG8_LDB(B0, 0, 0); PG8_LDB(B1, 0, 1); PG8_SCHED; PG8_LDA(At, 0, 0); PG8_STAGE(PG8_SA(1, 1), a1 + hstepA, voffA);
            PG8_WAIT_V(8); PG8_WAIT_L(0); PG8_BAR; PG8_MMA(0, 0, At, B0); PG8_MMA(0, 1, At, B1); PG8_BAR; PG8_SCHED;
            PG8_LDA(At, 0, 1); PG8_STAGE(PG8_SB(0, 0), b2, voffB); PG8_STAGE(PG8_SB(0, 1), b2 + hstepB, voffB); PG8_STAGE(PG8_SA(0, 0), a2, voffA);
            PG8_WAIT_V(8); PG8_WAIT_L(0); PG8_BAR; PG8_MMA(1, 0, At, B0); PG8_MMA(1, 1, At, B1); PG8_BAR; PG8_SCHED;
            PG8_LDB(B0, 1, 0); PG8_LDB(B1, 1, 1); PG8_SCHED; PG8_LDA(At, 1, 0); PG8_STAGE(PG8_SA(0, 1), a2 + hstepA, voffA);
            PG8_WAIT_V(8); PG8_WAIT_L(0); PG8_BAR; PG8_MMA(0, 0, At, B0); PG8_MMA(0, 1, At, B1); PG8_BAR; PG8_SCHED;
            PG8_LDA(At, 1, 1); PG8_STAGE(PG8_SB(1, 0), b3, voffB); PG8_STAGE(PG8_SB(1, 1), b3 + hstepB, voffB); PG8_STAGE(PG8_SA(1, 0), a3, voffA);
            PG8_WAIT_V(8); PG8_WAIT_L(0); PG8_BAR; PG8_MMA(1, 0, At, B0); PG8_MMA(1, 1, At, B1); PG8_BAR; PG8_SCHED;
            } else {
            PG8_LDB(B0, 0, 0); PG8_SCHED; PG8_LDA(At, 0, 0); PG8_STAGE(PG8_SA(1, 1), a1 + hstepA, voffA);
            PG8_WAIT_L(8); PG8_BAR; PG8_WAIT_L(0); PG8_MMA(0, 0, At, B0); PG8_BAR; PG8_SCHED;
            PG8_LDB(B1, 0, 1); PG8_STAGE(PG8_SB(0, 0), b2, voffB);
            PG8_BAR; PG8_WAIT_L(0); PG8_MMA(0, 1, At, B1); PG8_BAR;
            PG8_LDA(At, 0, 1); PG8_STAGE(PG8_SA(0, 0), a2, voffA);
            PG8_BAR; PG8_WAIT_L(0); PG8_MMA(1, 0, At, B0); PG8_BAR; PG8_SCHED;
            PG8_STAGE(PG8_SB(0, 1), b2 + hstepB, voffB);
            PG8_WAIT_V(6); PG8_BAR; PG8_MMA(1, 1, At, B1); PG8_BAR;
            PG8_LDB(B0, 1, 0); PG8_SCHED; PG8_LDA(At, 1, 0); PG8_STAGE(PG8_SA(0, 1), a2 + hstepA, voffA);
            PG8_WAIT_L(8); PG8_BAR; PG8_WAIT_L(0); PG8_MMA(0, 0, At, B0); PG8_BAR; PG8_SCHED;
            PG8_LDB(B1, 1, 1); PG8_STAGE(PG8_SB(1, 0), b3, voffB);
            PG8_BAR; PG8_WAIT_L(0); PG8_MMA(0, 1, At, B1); PG8_BAR;
            PG8_LDA(At, 1, 1); PG8_STAGE(PG8_SA(1, 0), a3, voffA);
            PG8_BAR; PG8_WAIT_L(0); PG8_MMA(1, 0, At, B0); PG8_BAR; PG8_SCHED;
            PG8_STAGE(PG8_SB(1, 1), b3 + hstepB, voffB);
            PG8_WAIT_V(6); PG8_BAR; PG8_MMA(1, 1, At, B1); PG8_BAR;
            }
        }
        if constexpr (ALIGN_EPI) { if (wr == 0) PG8_BAR; }
        if constexpr (!Epi::AFTER_DRAIN) { E(acc, cur, wr, wc, fr, fq); S.done(cur); }
        if (!has_next) break;
#pragma unroll
        for (int a = 0; a < 2; ++a)
#pragma unroll
            for (int b = 0; b < 2; ++b)
#pragma unroll
                for (int m = 0; m < 4; ++m)
#pragma unroll
                    for (int n = 0; n < 2; ++n) acc[a][b][m][n] = (f32x4){0.f, 0.f, 0.f, 0.f};
        cur = nxt; cA = nA; cB = nB; ++ui;
        if constexpr (ALIGN_EPI) { if (wr == 1) PG8_BAR; }
    }
    PG8_WAIT_V(0);
    if constexpr (!ALIGN_EPI) { if (wr == 0) PG8_BAR; }
    PG8_BAR;
    if constexpr (Epi::AFTER_DRAIN) { E.fused(acc, cur, wr, wc, fr, fq, lds, wid, lane); S.done(cur); }
#undef PG8_SA
#undef PG8_SB
#undef PG8_STAGE
#undef PG8_LDA
#undef PG8_LDB
#undef PG8_MMA
#undef PG8_WAIT_V
#undef PG8_WAIT_L
#undef PG8_BAR
#undef PG8_SCHED
}
}

#define GAS __attribute__((address_space(1)))
#define LAS __attribute__((address_space(3)))
typedef unsigned short bf16;
typedef unsigned v4u __attribute__((ext_vector_type(4)));
typedef unsigned v2u __attribute__((ext_vector_type(2)));
typedef float f32x4 __attribute__((ext_vector_type(4)));
typedef _Float16 h16;
typedef _Float16 h16x2 __attribute__((ext_vector_type(2)));

#ifndef MK_SINGLE
#define MK_SINGLE 1
#endif

constexpr int NWAVES = 8, NTHREADS = NWAVES * 64;
constexpr int D = 1024, TP = 16384, TS = 1024, T = TP + TS, LP = 2048, LS = 8, NPB = 8, NSB = 128;
constexpr int INP = 2816, BP = 1792, FF = 2816, HW = 512;
constexpr float ALPHA = 1.41421356237309515f, LN_EPS = 1e-5f, GN_EPS = 64e-5f;
constexpr int NPHASE = 18;

constexpr size_t MiB = 1u << 20;
constexpr size_t WS_WIN = 1 * MiB, WS_WOUT = WS_WIN + 5632 * 1024, WS_WGU0 = WS_WOUT + 2 * MiB, WS_WGU1 = WS_WGU0 + 11 * MiB, WS_WD0 = WS_WGU1 + 11 * MiB, WS_WD1 = WS_WD0 + 5632 * 1024,
                 WS_POOLT = WS_WD1 + 5632 * 1024, WS_LORAT = WS_POOLT + 512 * 1024;
constexpr size_t WS_XB = 43 * MiB;
constexpr size_t WS_SCW = 43 * MiB, WS_G = 60 * MiB;
constexpr size_t WS_PROJA = 77 * MiB;
constexpr size_t WS_PROJB = 111 * MiB;
constexpr size_t WS_CAT = 111 * MiB, WS_SCB = 145 * MiB, WS_O = 162 * MiB;
constexpr size_t WS_LA = 170 * MiB + 512 * 1024;
constexpr size_t WS_SCR = 179 * MiB, WS_SCV = 196 * MiB, WS_SCK = 213 * MiB, WS_SCKK = 230 * MiB;
constexpr size_t WS_Z = 188 * MiB;
constexpr size_t WS_H = 77 * MiB;
constexpr size_t WS_PL = 77 * MiB;
constexpr size_t WS_PART7 = 145 * MiB;
constexpr size_t WS_PARTA = 170 * MiB + 512 * 1024, WS_PARTB = 1 * MiB;
constexpr size_t WS_XR = 43 * MiB;
constexpr size_t WS_END = 256 * MiB;
static_assert(WS_LORAT + 1536 * 256 * 2 <= WS_XB, "weights");
static_assert(WS_PROJB + (size_t)T * BP * 2 <= WS_LA, "projb");
static_assert(WS_H + (size_t)T * FF * 2 <= WS_Z, "h");
static_assert(WS_Z + (size_t)T * D * 4 <= WS_END, "z");

constexpr size_t O_Y = 0, O_CONV_P = 17825792, O_SHIFT_P = 17948672, O_WKV_P = 17963008, O_POOL_P = 18225152,
                 O_CONV_S = 18348032, O_SHIFT_S = 20314112, O_WKV_S = 20543488, O_POOL_S = 24737792, O_TOTAL = 26703872;

constexpr int LDS_BYTES = 147456;

struct Frame {
    LAS unsigned char* lds;
    int tid, lane, wave, vcu, G;
    const float* const* in;
    float* out; unsigned char* ws;
};

__device__ __forceinline__ float bf2f(unsigned b) { return __uint_as_float(b << 16); }
__device__ __forceinline__ unsigned pkbf(float lo, float hi) { return pg8::cvt_pk_bf16(lo, hi); }
__device__ __forceinline__ unsigned pkh(float lo, float hi) { const unsigned short a = __builtin_bit_cast(unsigned short, (h16)lo), b = __builtin_bit_cast(unsigned short, (h16)hi); return (unsigned)a | ((unsigned)b << 16); }
__device__ __forceinline__ float hlo(unsigned u) { return (float)__builtin_bit_cast(h16, (unsigned short)(u & 0xffffu)); }
__device__ __forceinline__ float hhi(unsigned u) { return (float)__builtin_bit_cast(h16, (unsigned short)(u >> 16)); }
__device__ __forceinline__ void unpack_bf8(v4u w, float (&f)[8]) { const unsigned u0 = w.x, u1 = w.y, u2 = w.z, u3 = w.w;
    f[0] = __uint_as_float(u0 << 16); f[1] = __uint_as_float(u0 & 0xffff0000u); f[2] = __uint_as_float(u1 << 16); f[3] = __uint_as_float(u1 & 0xffff0000u);
    f[4] = __uint_as_float(u2 << 16); f[5] = __uint_as_float(u2 & 0xffff0000u); f[6] = __uint_as_float(u3 << 16); f[7] = __uint_as_float(u3 & 0xffff0000u); }
__device__ __forceinline__ void unpack_h8(v4u w, float (&f)[8]) { const unsigned u0 = w.x, u1 = w.y, u2 = w.z, u3 = w.w; f[0] = hlo(u0); f[1] = hhi(u0); f[2] = hlo(u1); f[3] = hhi(u1); f[4] = hlo(u2); f[5] = hhi(u2); f[6] = hlo(u3); f[7] = hhi(u3); }
__device__ __forceinline__ v4u pack_bf8(const float (&f)[8]) { v4u w; w.x = pkbf(f[0], f[1]); w.y = pkbf(f[2], f[3]); w.z = pkbf(f[4], f[5]); w.w = pkbf(f[6], f[7]); return w; }
__device__ __forceinline__ v4u pack_h8(const float (&f)[8]) { v4u w; w.x = pkh(f[0], f[1]); w.y = pkh(f[2], f[3]); w.z = pkh(f[4], f[5]); w.w = pkh(f[6], f[7]); return w; }
__device__ __forceinline__ void load_f8(const float* p, float (&f)[8]) { const f32x4 a = *(const f32x4*)p, b = *(const f32x4*)(p + 4); f[0] = a.x; f[1] = a.y; f[2] = a.z; f[3] = a.w; f[4] = b.x; f[5] = b.y; f[6] = b.z; f[7] = b.w; }
__device__ __forceinline__ void store_f8(float* p, const float (&f)[8]) { *(f32x4*)p = (f32x4){f[0], f[1], f[2], f[3]}; *(f32x4*)(p + 4) = (f32x4){f[4], f[5], f[6], f[7]}; }
__device__ __forceinline__ float sigmoid_(float x) { return __builtin_amdgcn_rcpf(1.f + __expf(-x)); }
__device__ __forceinline__ float silu_(float x) { return x * sigmoid_(x); }
__device__ __forceinline__ float wave_sum(float v) {
#pragma unroll
    for (int o = 1; o < 64; o <<= 1) v += __shfl_xor(v, o);
    return v;
}
__device__ __forceinline__ float sum8(float v) { v += __shfl_xor(v, 1); v += __shfl_xor(v, 2); v += __shfl_xor(v, 4); return v; }
template <int CTRL> __device__ __forceinline__ float dppf(float x) { return __builtin_bit_cast(float, __builtin_amdgcn_update_dpp(0, __builtin_bit_cast(int, x), CTRL, 0xF, 0xF, true)); }
__device__ __forceinline__ float dpp_sum16(float x) {
    x += dppf<0xB1>(x);
    x += dppf<0x4E>(x);
    x += dppf<0x141>(x);
    x += dppf<0x140>(x);
    return x;
}
__device__ __forceinline__ void h4(v2u x, float (&f)[4]) { const unsigned u0 = x.x, u1 = x.y; f[0] = hlo(u0); f[1] = hhi(u0); f[2] = hlo(u1); f[3] = hhi(u1); }
__device__ __forceinline__ const float* xrow_ptr(const Frame& F, int m) { return m < TP ? F.in[0] + (size_t)m * D : F.in[1] + (size_t)(m - TP) * D; }

using pg8::Unit; using pg8::HALF; using pg8::BM;
typedef pg8::u32x4 u32x4;
struct EpiProj {
    static constexpr bool PERM = true, AFTER_DRAIN = false;
    bf16* PA; bf16* PB;
    __device__ __forceinline__ void operator()(const pg8::f32x4 (&acc)[2][2][4][2], const Unit& u, int wr, int wc, int fr, int fq) const {
        const int row0 = u.pm * BM + wr * 64 + fr;
        bf16* base; int ldc, colt;
        if (u.pn < 4) { base = PA; ldc = 1024; colt = u.pn * BM; } else { base = PB; ldc = BP; colt = (u.pn - 4) * BM; }
        const int col0 = colt + wc * 32 + 8 * fq;
#pragma unroll
        for (int ai = 0; ai < 2; ++ai)
#pragma unroll
            for (int m = 0; m < 4; ++m) { bf16* rowp = base + (size_t)(row0 + ai * HALF + m * 16) * ldc + col0;
#pragma unroll
                for (int bj = 0; bj < 2; ++bj) { const pg8::f32x4 v0 = acc[ai][bj][m][0], v1 = acc[ai][bj][m][1];
                    u32x4 w; w.x = pkbf(v0[0], v0[1]); w.y = pkbf(v0[2], v0[3]); w.z = pkbf(v1[0], v1[1]); w.w = pkbf(v1[2], v1[3]);
                    *(u32x4*)(rowp + bj * HALF) = w; } }
    }
};
struct EpiLora {
    static constexpr bool PERM = true, AFTER_DRAIN = false;
    const float* w0; const float* a0; const float* ka;
    h16* SCW; h16* SCK; h16* SCKK; h16* SCB; h16* G;
    __device__ __forceinline__ void operator()(const pg8::f32x4 (&acc)[2][2][4][2], const Unit& u, int wr, int wc, int fr, int fq) const {
        const int row0 = u.pm * BM + wr * 64 + fr; const int sec = u.pn >> 1;
        const int c0 = (u.pn & 1) * BM + wc * 32 + 8 * fq;
#pragma unroll
        for (int bj = 0; bj < 2; ++bj)
#pragma unroll
            for (int n = 0; n < 2; ++n) {
                const int c = c0 + bj * HALF + 4 * n;
                f32x4 p0 = {0.f, 0.f, 0.f, 0.f}, p1 = {0.f, 0.f, 0.f, 0.f};
                if (sec == 0) p0 = *(const f32x4*)(w0 + c); else if (sec == 1) { p0 = *(const f32x4*)(a0 + c); p1 = *(const f32x4*)(ka + c); }
#pragma unroll
                for (int ai = 0; ai < 2; ++ai)
#pragma unroll
                    for (int m = 0; m < 4; ++m) {
                        const size_t off = (size_t)(row0 + ai * HALF + m * 16) * HW + c;
                        const pg8::f32x4 v = acc[ai][bj][m][n];
                        if (sec == 0) {
                            float o[4];
#pragma unroll
                            for (int i = 0; i < 4; ++i) { const float e = 0.60653065971f * sigmoid_(p0[i] + v[i]); o[i] = 1.f - __expf(-e); }
                            v2u w; w.x = pkh(o[0], o[1]); w.y = pkh(o[2], o[3]); *(v2u*)(SCW + off) = w;
                        } else if (sec == 1) {
                            float kx[4], kk[4], ko[4], bo[4];
                            h4(*(const v2u*)(SCK + off), kx); h4(*(const v2u*)(SCKK + off), kk);
#pragma unroll
                            for (int i = 0; i < 4; ++i) { const float a = sigmoid_(p0[i] + v[i]); ko[i] = kx[i] * (1.f + (a - 1.f) * p1[i]); bo[i] = kk[i] * a; }
                            v2u w; w.x = pkh(ko[0], ko[1]); w.y = pkh(ko[2], ko[3]); *(v2u*)(SCK + off) = w;
                            v2u x; x.x = pkh(bo[0], bo[1]); x.y = pkh(bo[2], bo[3]); *(v2u*)(SCB + off) = x;
                        } else {
                            v2u w; w.x = pkh(v[0], v[1]); w.y = pkh(v[2], v[3]); *(v2u*)(G + off) = w;
                        }
                        asm volatile("" ::: "memory");
                    }
            }
    }
};
struct EpiGateUp {
    static constexpr bool PERM = true, AFTER_DRAIN = false;
    bf16* H;
    __device__ __forceinline__ void operator()(const pg8::f32x4 (&acc)[2][2][4][2], const Unit& u, int wr, int wc, int fr, int fq) const {
        const int row0 = u.pm * BM + wr * 64 + fr; const int col0 = u.pn * HALF + wc * 32 + 8 * fq;
#pragma unroll
        for (int ai = 0; ai < 2; ++ai)
#pragma unroll
            for (int m = 0; m < 4; ++m) {
                const pg8::f32x4 g0 = acc[ai][0][m][0], g1 = acc[ai][0][m][1], u0 = acc[ai][1][m][0], u1 = acc[ai][1][m][1];
                u32x4 w; w.x = pkbf(silu_(g0[0]) * u0[0], silu_(g0[1]) * u0[1]); w.y = pkbf(silu_(g0[2]) * u0[2], silu_(g0[3]) * u0[3]);
                w.z = pkbf(silu_(g1[0]) * u1[0], silu_(g1[1]) * u1[1]); w.w = pkbf(silu_(g1[2]) * u1[2], silu_(g1[3]) * u1[3]);
                *(u32x4*)(H + (size_t)(row0 + ai * HALF + m * 16) * FF + col0) = w;
            }
    }
};
struct EpiResid {
    static constexpr bool PERM = false, AFTER_DRAIN = false;
    const float* xp; const float* xs; float* Z; const float* scale;
    const bf16* XBr;
    h16* pa; h16* pb;
    __device__ __forceinline__ void operator()(const pg8::f32x4 (&acc)[2][2][4][2], const Unit& u, int wr, int wc, int fr, int fq) const {
        const int col0 = u.pn * BM + wc * 32 + 4 * fq;
#pragma unroll
        for (int ai = 0; ai < 2; ++ai)
#pragma unroll
            for (int m = 0; m < 4; ++m) {
                const int row = u.pm * BM + ai * HALF + wr * 64 + m * 16 + fr;
                float* zr = Z + (size_t)row * D + col0;
                const float* br = xp ? ((row < TP ? xp + (size_t)row * D : xs + (size_t)(row - TP) * D) + col0) : nullptr;
                const bf16* bb = XBr + (size_t)row * D + col0;
#pragma unroll
                for (int bj = 0; bj < 2; ++bj)
#pragma unroll
                    for (int n = 0; n < 2; ++n) {
                        const int o = bj * HALF + n * 16;
                        pg8::f32x4 a = acc[ai][bj][m][n];
                        if (scale) a = a * *(const pg8::f32x4*)(scale + col0 + o);
                        if (u.mode == 1) {
                            const int sp = u.kt0 / u.nt;
                            h16* pr = (sp < 8 ? pa + (size_t)sp * (1u << 20) : pb + (size_t)(sp - 8) * (1u << 20)) + (size_t)(row - TP) * D + col0;
                            v2u w; w.x = pkh(a[0], a[1]); w.y = pkh(a[2], a[3]); *(v2u*)(pr + o) = w;
                        } else {
                            pg8::f32x4 b;
                            if (xp) b = *(const pg8::f32x4*)(br + o);
                            else { const v2u w = *(const v2u*)(bb + o); const unsigned w0 = w.x, w1 = w.y; b = (pg8::f32x4){__uint_as_float(w0 << 16), __uint_as_float(w0 & 0xffff0000u), __uint_as_float(w1 << 16), __uint_as_float(w1 & 0xffff0000u)}; }
                            *(pg8::f32x4*)(zr + o) = b * ALPHA + a;
                        }
                    }
            }
    }
};

struct SplitOrder {
    pg8::StaticOrder base; int NS, ntc, c;
    __device__ void init(int N, int G, int c_, int K, int NS_) { base.init(TP, N, G, c_, K); NS = NS_; ntc = (K / pg8::BK) / NS_; c = c_; }
    __device__ bool next(int i, Unit& u) const {
        if (i == 0) return base.next(0, u);
        if (i == 1) { if (c >= 16 * NS) return false; const int unit = c / NS, sp = c % NS; u.pm = 64 + (unit >> 2); u.pn = unit & 3; u.kt0 = sp * ntc; u.nt = ntc; u.mode = 1; return true; }
        return false;
    }
    __device__ __forceinline__ void a_ready(const Unit&) const {}
    __device__ __forceinline__ void done(const Unit&) const {}
};

__device__ __forceinline__ void transpose_item(const float* W, int K, int N, bf16* WT, int mode, LAS float* scr, int item, int lane) {
    const int nblk = N / 32, kb = item / nblk, nb = item % nblk, k0 = 64 * kb, n0 = 32 * nb;
    const int drow0 = mode == 0 ? n0 : ((n0 >> 7) * 256 + (mode == 2 ? 128 : 0) + (n0 & 127));
#pragma unroll 8
    for (int i = 0; i < 32; ++i) { const int kk = 2 * i + (lane >> 5); scr[kk * 33 + (lane & 31)] = W[(size_t)(k0 + kk) * N + n0 + (lane & 31)]; }
    asm volatile("s_waitcnt lgkmcnt(0)" ::: "memory");
    const int c = lane & 7;
#pragma unroll
    for (int j = 0; j < 4; ++j) { const int n = (lane >> 3) + 8 * j; const LAS float* s = scr + (8 * c) * 33 + n;
        v4u o; o.x = pkbf(s[0 * 33], s[1 * 33]); o.y = pkbf(s[2 * 33], s[3 * 33]); o.z = pkbf(s[4 * 33], s[5 * 33]); o.w = pkbf(s[6 * 33], s[7 * 33]);
        *(v4u*)(WT + (size_t)(drow0 + n) * K + k0 + 8 * c) = o; }
    asm volatile("s_waitcnt lgkmcnt(0)" ::: "memory");
}
__device__ __forceinline__ void p0_prologue(Frame& F) {
    LAS float* scr = (LAS float*)(F.lds + F.wave * 16384);
    const int gw = F.vcu * NWAVES + F.wave, NGW = F.G * NWAVES;
    unsigned char* ws = F.ws;
    constexpr int I_IN = 16 * 88, I_OUT = 16 * 32, I_GU = 16 * 88, I_DN = 44 * 32, I_PL = 4 * 8;
    constexpr int NITEMS = I_IN + I_OUT + 2 * (2 * I_GU + I_DN) + 4 * I_PL;
    for (int it = gw; it < NITEMS; it += NGW) {
        int r = it;
        if (r < I_IN) { transpose_item(F.in[6], D, INP, (bf16*)(ws + WS_WIN), 0, scr, r, F.lane); continue; } r -= I_IN;
        if (r < I_OUT) { transpose_item(F.in[22], D, D, (bf16*)(ws + WS_WOUT), 0, scr, r, F.lane); continue; } r -= I_OUT;
        constexpr int I_LAYER = 2 * I_GU + I_DN;
        if (r < 2 * I_LAYER) {
            const int l = r / I_LAYER; int q = r % I_LAYER;
            bf16* gu = (bf16*)(ws + (l ? WS_WGU1 : WS_WGU0)); bf16* dn = (bf16*)(ws + (l ? WS_WD1 : WS_WD0));
            if (q < I_GU) { transpose_item(F.in[27] + (size_t)l * D * FF, D, FF, gu, 1, scr, q, F.lane); continue; } q -= I_GU;
            if (q < I_GU) { transpose_item(F.in[28] + (size_t)l * D * FF, D, FF, gu, 2, scr, q, F.lane); continue; } q -= I_GU;
            transpose_item(F.in[29] + (size_t)l * FF * D, FF, D, dn, 0, scr, q, F.lane); continue;
        }
        r -= 2 * I_LAYER;
        { const int g = r / I_PL, ri = r % I_PL; transpose_item(F.in[23] + (size_t)g * 65536, 256, 256, (bf16*)(ws + WS_POOLT) + (size_t)g * 65536, 0, scr, ri, F.lane); }
    }
    const int gt = F.vcu * NTHREADS + F.tid, NGT = F.G * NTHREADS;
    bf16* XB = (bf16*)(ws + WS_XB);
    float* Zp = (float*)(ws + WS_Z);
    for (int i = gt; i < T * D / 8; i += NGT) { const int m = i >> 7, c8 = (i & 127) * 8; float f[8]; load_f8(xrow_ptr(F, m) + c8, f); *(v4u*)(XB + (size_t)m * D + c8) = pack_bf8(f);
        if (m >= TP) { float z[8];
#pragma unroll
            for (int e = 0; e < 8; ++e) z[e] = ALPHA * f[e];
            store_f8(Zp + (size_t)m * D + c8, z); } }
    bf16* LT = (bf16*)(ws + WS_LORAT);
    for (int i = gt; i < 1536 * 256 / 2; i += NGT) { const int j = i >> 7, k = (i & 127) * 2; float v[2];
#pragma unroll
        for (int e = 0; e < 2; ++e) { const int kk = k + e; float x = 0.f;
            if (j < 512) { if (kk < 64) x = F.in[13][(size_t)kk * 512 + j]; }
            else if (j < 1024) { if (kk >= 64 && kk < 128) x = F.in[15][(size_t)(kk - 64) * 512 + (j - 512)]; }
            else { if (kk >= 128) x = F.in[16][(size_t)(kk - 128) * 512 + (j - 1024)]; }
            v[e] = x; }
        *(unsigned*)(LT + (size_t)j * 256 + k) = pkbf(v[0], v[1]); }
}

__device__ __forceinline__ void p2_rows(Frame& F) {
    const int gw = F.vcu * NWAVES + F.wave, NGW = F.G * NWAVES, lane = F.lane;
    unsigned char* ws = F.ws;
    const bf16* PB = (const bf16*)(ws + WS_PROJB);
    h16* SCR = (h16*)(ws + WS_SCR); h16* SCK = (h16*)(ws + WS_SCK); h16* SCV = (h16*)(ws + WS_SCV); h16* SCKK = (h16*)(ws + WS_SCKK);
    bf16* LA = (bf16*)(ws + WS_LA);
    const float* mu = F.in[11]; const float* kkw = F.in[17]; const float* sshift = F.in[3];
    for (int m = gw; m < T; m += NGW) {
        const bool sample = m >= TP; const int seq = sample ? (m - TP) >> 3 : m >> 11, t = sample ? (m - TP) & 7 : m & 2047, L = sample ? LS : LP;
        const bf16* pb = PB + (size_t)m * BP;
        float* oshift = F.out + (sample ? O_SHIFT_S : O_SHIFT_P) + (size_t)seq * BP;
        const bool last = (t == L - 1);
#pragma unroll
        for (int sec = 0; sec < 4; ++sec) {
            if (sec == 3 && lane >= 32) break;
            const int col = sec * 512 + lane * 8;
            float p[8], pv[8], mv[8], xm[8];
            unpack_bf8(*(const v4u*)(pb + col), p);
            if (t > 0) unpack_bf8(*(const v4u*)(pb - BP + col), pv);
            else if (sample) load_f8(sshift + (size_t)seq * BP + col, pv);
            else {
#pragma unroll
                for (int i = 0; i < 8; ++i) pv[i] = 0.f; }
            load_f8(mu + col, mv);
#pragma unroll
            for (int i = 0; i < 8; ++i) xm[i] = p[i] + mv[i] * (pv[i] - p[i]);
            if (last) store_f8(oshift + col, p);
            const size_t off = (size_t)m * HW + lane * 8;
            if (sec == 0) *(v4u*)(SCR + off) = pack_h8(xm);
            else if (sec == 1) {
                *(v4u*)(SCK + off) = pack_h8(xm);
                float kw[8], kx[8]; load_f8(kkw + lane * 8, kw); float ss = 0.f;
#pragma unroll
                for (int i = 0; i < 8; ++i) { kx[i] = xm[i] * kw[i]; ss += kx[i] * kx[i]; }
                ss = sum8(ss);
                const float inv = 1.f / fmaxf(sqrtf(ss), 1e-12f);
#pragma unroll
                for (int i = 0; i < 8; ++i) kx[i] *= inv;
                *(v4u*)(SCKK + off) = pack_h8(kx);
            } else if (sec == 2) *(v4u*)(SCV + off) = pack_h8(xm);
            else {
                float o[8];
#pragma unroll
                for (int i = 0; i < 8; ++i) {
                    if (lane < 8) { const float e = __expf(2.f * xm[i]); o[i] = 1.f - 2.f * __builtin_amdgcn_rcpf(e + 1.f); }
                    else if (lane < 16) o[i] = xm[i];
                    else o[i] = sigmoid_(xm[i]);
                }
                *(v4u*)(LA + (size_t)m * 256 + lane * 8) = pack_bf8(o);
            }
        }
    }
}

template <int TT> __device__ __forceinline__ void conv_tile(Frame& F, int m0, int t0, int seq, bool sample) {
    const int c = F.tid;
    unsigned char* ws = F.ws;
    const bf16* PA = (const bf16*)(ws + WS_PROJA); bf16* CAT = (bf16*)(ws + WS_CAT);
    const float* cw = F.in[7]; const float* sconv = F.in[2];
    LAS float* ylds = (LAS float*)F.lds;
    float w[31];
#pragma unroll
    for (int j = 0; j < 31; ++j) w[j] = cw[j * 512 + c];
    float y[TT]; const float bias = F.in[8][c];
#pragma unroll
    for (int t = 0; t < TT; ++t) y[t] = bias;
    const bool lastp = (!sample) && (t0 + TT == LP);
    float* oconv = F.out + (sample ? O_CONV_S : O_CONV_P) + (size_t)seq * 30 * 512 + c;
    const bf16* pp = PA + ((size_t)m0 - 30) * 1024 + c; const float* scp = sconv + ((size_t)seq * 30 + t0) * 512 + c;
#pragma unroll
    for (int s = -30; s < TT; ++s) {
        float u;
        asm volatile("" : "+v"(pp), "+v"(scp));
        if (t0 + s >= 0) { const float val = bf2f(pp[0]), gate = bf2f(pp[512]); u = val * sigmoid_(gate); }
        else u = sample ? *scp : 0.f;
        pp += 1024; scp += 512;
#pragma unroll
        for (int t = 0; t < TT; ++t) { const int j = s - t + 30; if (j >= 0 && j <= 30) y[t] += u * w[j]; }
        if (sample) { if (s + 22 >= 0) oconv[(size_t)(s + 22) * 512] = u; }
        else if (lastp && s >= TT - 30) oconv[(size_t)(s - (TT - 30)) * 512] = u;
    }
#pragma unroll
    for (int t = 0; t < TT; ++t) ylds[t * 512 + c] = y[t];
    __syncthreads();
    const float* lg = F.in[9]; const float* lb = F.in[10];
    for (int t = F.wave; t < TT; t += NWAVES) {
        const LAS float* yr = ylds + t * 512 + F.lane * 8;
        float v[8];
        { const f32x4 a = *(const LAS f32x4*)yr, b = *(const LAS f32x4*)(yr + 4); v[0] = a.x; v[1] = a.y; v[2] = a.z; v[3] = a.w; v[4] = b.x; v[5] = b.y; v[6] = b.z; v[7] = b.w; }
        float s = 0.f;
#pragma unroll
        for (int i = 0; i < 8; ++i) s += v[i];
        const float mean = wave_sum(s) * (1.f / 512.f); float q = 0.f;
#pragma unroll
        for (int i = 0; i < 8; ++i) { v[i] -= mean; q += v[i] * v[i]; }
        const float rstd = rsqrtf(wave_sum(q) * (1.f / 512.f) + LN_EPS);
        float g8[8], b8[8], o[8]; load_f8(lg + F.lane * 8, g8); load_f8(lb + F.lane * 8, b8);
#pragma unroll
        for (int i = 0; i < 8; ++i) o[i] = silu_(v[i] * rstd * g8[i] + b8[i]);
        *(v4u*)(CAT + (size_t)(m0 + t) * 1024 + F.lane * 8) = pack_bf8(o);
    }
    __syncthreads();
}
__device__ __forceinline__ void conv_phase(Frame& F) {
    for (int it = F.vcu; it < 512 + 128; it += F.G) {
        if (it < 512) { const int m0 = it * 32; conv_tile<32>(F, m0, m0 & 2047, m0 >> 11, false); }
        else { const int seq = it - 512; conv_tile<8>(F, TP + seq * 8, 0, seq, true); }
    }
}

constexpr int SU = 8;
struct ScanPtrs { const h16* R; const h16* K; const h16* V; const h16* KK; const h16* B; const h16* W; h16* O; };
struct ScanBuf { v2u r[SU], k[SU], kk[SU], b[SU], w[SU]; unsigned short v[SU]; };
__device__ __forceinline__ void scan_load(ScanBuf& Bf, const ScanPtrs& P, size_t off, int ks, int row) {
#pragma unroll
    for (int i = 0; i < SU; ++i) { const size_t o = off + (size_t)i * HW;
        Bf.r[i] = *(const v2u*)(P.R + o + ks); Bf.k[i] = *(const v2u*)(P.K + o + ks); Bf.kk[i] = *(const v2u*)(P.KK + o + ks);
        Bf.b[i] = *(const v2u*)(P.B + o + ks); Bf.w[i] = *(const v2u*)(P.W + o + ks); Bf.v[i] = *(const unsigned short*)(P.V + o + row); }
}
__device__ __forceinline__ void scan_compute(const ScanBuf& Bf, float (&S)[4], const ScanPtrs& P, size_t off, int row, bool writer) {
#pragma unroll
    for (int i = 0; i < SU; ++i) {
        float r[4], k[4], kk[4], b[4], w[4]; h4(Bf.r[i], r); h4(Bf.k[i], k); h4(Bf.kk[i], kk); h4(Bf.b[i], b); h4(Bf.w[i], w);
        const float v = (float)__builtin_bit_cast(h16, Bf.v[i]);
        float d = (S[0] * kk[0] + S[1] * kk[1]) + (S[2] * kk[2] + S[3] * kk[3]);
        float pj[4];
#pragma unroll
        for (int j = 0; j < 4; ++j) pj[j] = fmaf(v, k[j], fmaf(-S[j], w[j], S[j]));
        d = dpp_sum16(d);
#pragma unroll
        for (int j = 0; j < 4; ++j) S[j] = fmaf(-d, b[j], pj[j]);
        float o = (S[0] * r[0] + S[1] * r[1]) + (S[2] * r[2] + S[3] * r[3]);
        o = dpp_sum16(o);
        if (writer) P.O[off + (size_t)i * HW + row] = (h16)o;
    }
}
template <int L> __device__ __forceinline__ void scan_task(const ScanPtrs& P, int mbase, int h, int v0, const float* s_in, float* s_out, int lane) {
    const int rl = lane >> 4, ks = (lane & 15) * 4, row = v0 + rl; const bool writer = (lane & 15) == 0;
    float S[4] = {0.f, 0.f, 0.f, 0.f};
    if (s_in) { const f32x4 s = *(const f32x4*)(s_in + (size_t)row * 64 + ks); S[0] = s.x; S[1] = s.y; S[2] = s.z; S[3] = s.w; }
    size_t off = (size_t)mbase * HW + h * 64;
    ScanBuf A;
    scan_load(A, P, off, ks, row);
    if constexpr (L == SU) { scan_compute(A, S, P, off, row, writer); }
    else {
        ScanBuf Bf;
        for (int t = 0; t < L; t += 2 * SU) {
            scan_load(Bf, P, off + (size_t)SU * HW, ks, row);
            scan_compute(A, S, P, off, row, writer);
            if (t + 2 * SU < L) scan_load(A, P, off + (size_t)2 * SU * HW, ks, row);
            scan_compute(Bf, S, P, off + (size_t)SU * HW, row, writer);
            off += (size_t)2 * SU * HW;
        }
    }
    *(f32x4*)(s_out + (size_t)row * 64 + ks) = (f32x4){S[0], S[1], S[2], S[3]};
}
constexpr int RING_SLOTS = 64, SLOT_BYTES = 1536, FLAG_OFF = 131072 + 1024;
constexpr unsigned SPIN_CAP = 1u << 22;
struct StepF { f32x4 r, k, kk, b, w; float v; };
__device__ __forceinline__ void ld_stepf(StepF& X, const LAS unsigned char* slot, unsigned rd, unsigned vd) {
    X.r = *(const LAS f32x4*)(slot + 0 * 256 + rd); X.k = *(const LAS f32x4*)(slot + 1 * 256 + rd); X.kk = *(const LAS f32x4*)(slot + 2 * 256 + rd);
    X.b = *(const LAS f32x4*)(slot + 3 * 256 + rd); X.w = *(const LAS f32x4*)(slot + 4 * 256 + rd); X.v = *(const LAS float*)(slot + vd);
}
__device__ __forceinline__ float step_computef(const StepF& X, float (&S)[4]) {
    float d = (S[0] * X.kk[0] + S[1] * X.kk[1]) + (S[2] * X.kk[2] + S[3] * X.kk[3]);
    float pj[4];
#pragma unroll
    for (int j = 0; j < 4; ++j) pj[j] = fmaf(X.v, X.k[j], fmaf(-S[j], X.w[j], S[j]));
    d = dpp_sum16(d);
#pragma unroll
    for (int j = 0; j < 4; ++j) S[j] = fmaf(-d, X.b[j], pj[j]);
    float o = (S[0] * X.r[0] + S[1] * X.r[1]) + (S[2] * X.r[2] + S[3] * X.r[3]);
    return dpp_sum16(o);
}
__device__ __forceinline__ unsigned min4(const volatile LAS unsigned* p) { const unsigned a = p[0], b = p[1], c = p[2], d = p[3]; return min(min(a, b), min(c, d)); }
__device__ __forceinline__ void scan_prompt_consumer(Frame& F, int mbase, int h, int v0, float* s_out) {
    const int lane = F.lane, rl = lane >> 4, l16 = lane & 15, ks = l16 * 4, row = v0 + rl;
    const LAS unsigned char* ring = F.lds;
    volatile LAS unsigned* prod = (volatile LAS unsigned*)(F.lds + FLAG_OFF); volatile LAS unsigned* cons = prod + 4;
    h16* O = (h16*)(F.ws + WS_O) + (size_t)mbase * HW + h * 64 + row;
    const unsigned rd = ks * 4, vd = 5 * 256 + row * 4;
    constexpr int L = LP;
    float S[4] = {0.f, 0.f, 0.f, 0.f};
    StepF A, B;
    __builtin_amdgcn_s_setprio(2);
    { unsigned sp = 0; while (min4(prod) < 2u && ++sp < SPIN_CAP) __builtin_amdgcn_s_sleep(1); }
    asm volatile("" ::: "memory");
    ld_stepf(A, ring, rd, vd);
    float okeep = 0.f;
#pragma unroll 1
    for (int tb = 0; tb < L; tb += 16) {
#pragma unroll
        for (int j = 0; j < 16; ++j) {
            const int t = tb + j;
            if (j == 0) {
                const unsigned need = (unsigned)min(t / 4 + 5, L / 4);
                unsigned sp = 0; while (min4(prod) < need && ++sp < SPIN_CAP) __builtin_amdgcn_s_sleep(1);
                asm volatile("" ::: "memory");
            }
            float o;
            if (j & 1) { ld_stepf(A, ring + ((t + 1) & (RING_SLOTS - 1)) * SLOT_BYTES, rd, vd); o = step_computef(B, S); }
            else       { ld_stepf(B, ring + ((t + 1) & (RING_SLOTS - 1)) * SLOT_BYTES, rd, vd); o = step_computef(A, S); }
            okeep = (l16 == j) ? o : okeep;
            if (j == 15) { asm volatile("s_waitcnt lgkmcnt(0)" ::: "memory"); if (lane == 0) cons[F.wave] = (unsigned)(t + 1); }
        }
        O[(size_t)(tb + l16) * HW] = (h16)okeep;
    }
    *(f32x4*)(s_out + (size_t)row * 64 + ks) = (f32x4){S[0], S[1], S[2], S[3]};
    __builtin_amdgcn_s_setprio(0);
}
__device__ __forceinline__ void scan_prompt_loader(Frame& F, int mbase, int h) {
    const int lane = F.lane, w = F.wave - 4;
    LAS unsigned char* ring = F.lds;
    volatile LAS unsigned* prod = (volatile LAS unsigned*)(F.lds + FLAG_OFF); volatile LAS unsigned* cons = prod + 4;
    const int arr = lane < 40 ? (lane >> 3) : 5, part = lane & 7;
    const size_t abase = arr == 0 ? WS_SCR : arr == 1 ? WS_SCK : arr == 2 ? WS_SCKK : arr == 3 ? WS_SCB : arr == 4 ? WS_SCW : WS_SCV;
    const unsigned char* src = F.ws + abase + ((size_t)mbase * HW + h * 64) * 2 + part * 16;
    const bool active = lane < 48;
    const unsigned dst = arr * 256 + part * 32;
    constexpr int L = LP, PF = 8;
    v4u buf[PF]; unsigned cmin = 0u;
#pragma unroll
    for (int i = 0; i < PF; ++i) { const int s0 = w + 4 * i; buf[i] = active ? *(const v4u*)(src + (size_t)s0 * 1024) : (v4u){0u, 0u, 0u, 0u}; }
#pragma unroll 1
    for (int sb = w; sb < L; sb += 4 * PF) {
#pragma unroll
        for (int i = 0; i < PF; ++i) {
            const int st = sb + 4 * i;
            if (st >= RING_SLOTS && cmin < (unsigned)(st - RING_SLOTS + 1)) { unsigned sp = 0; while ((cmin = min4(cons)) < (unsigned)(st - RING_SLOTS + 1) && ++sp < SPIN_CAP) __builtin_amdgcn_s_sleep(1); }
            asm volatile("" ::: "memory");
            float f[8]; unpack_h8(buf[i], f);
            { const int sn = st + 4 * PF; if (sn < L) buf[i] = active ? *(const v4u*)(src + (size_t)sn * 1024) : (v4u){0u, 0u, 0u, 0u}; }
            if (active) { LAS unsigned char* p = ring + (st & (RING_SLOTS - 1)) * SLOT_BYTES + dst;
                *(LAS f32x4*)p = (f32x4){f[0], f[1], f[2], f[3]}; *(LAS f32x4*)(p + 16) = (f32x4){f[4], f[5], f[6], f[7]}; }
            asm volatile("s_waitcnt lgkmcnt(0)" ::: "memory");
            if (lane == 0) prod[w] = (unsigned)(st >> 2) + 1u;
        }
    }
}
__device__ __forceinline__ void scan_phase(Frame& F) {
    unsigned char* ws = F.ws;
    ScanPtrs P{(const h16*)(ws + WS_SCR), (const h16*)(ws + WS_SCK), (const h16*)(ws + WS_SCV), (const h16*)(ws + WS_SCKK), (const h16*)(ws + WS_SCB), (const h16*)(ws + WS_SCW), (h16*)(ws + WS_O)};
    for (int task = F.vcu; task < 256; task += F.G) {
        if (F.tid < 8) ((volatile LAS unsigned*)(F.lds + FLAG_OFF))[F.tid] = 0u;
        __syncthreads();
        const int pair = task >> 2, q = task & 3, n = pair >> 3, h = pair & 7;
        if (F.wave < 4) scan_prompt_consumer(F, n * LP, h, q * 16 + F.wave * 4, F.out + O_WKV_P + (size_t)pair * 4096);
        else scan_prompt_loader(F, n * LP, h);
        __syncthreads();
    }
    {
        const int gw = F.vcu * NWAVES + F.wave, NGW = F.G * NWAVES;
        for (int task = gw; task < NSB * 8 * 16; task += NGW) {
            const int pair = task >> 4, rg = task & 15, n = pair >> 3, h = pair & 7;
            scan_task<LS>(P, TP + n * LS, h, rg * 4, F.in[4] + (size_t)pair * 4096, F.out + O_WKV_S + (size_t)pair * 4096, F.lane);
        }
    }
}

__device__ __forceinline__ void p6_rows(Frame& F) {
    const int gw = F.vcu * NWAVES + F.wave, NGW = F.G * NWAVES, lane = F.lane;
    unsigned char* ws = F.ws;
    const h16* O = (const h16*)(ws + WS_O); const h16* SCR = (const h16*)(ws + WS_SCR); const h16* SCK = (const h16*)(ws + WS_SCK); const h16* SCV = (const h16*)(ws + WS_SCV); const h16* G = (const h16*)(ws + WS_G);
    bf16* CAT = (bf16*)(ws + WS_CAT);
    float rk[8], lg[8], lb[8]; load_f8(F.in[19] + lane * 8, rk); load_f8(F.in[20] + lane * 8, lg); load_f8(F.in[21] + lane * 8, lb);
    for (int m = gw; m < T; m += NGW) {
        const size_t off = (size_t)m * HW + lane * 8;
        float o[8], r[8], k[8], v[8], g[8];
        unpack_h8(*(const v4u*)(O + off), o); unpack_h8(*(const v4u*)(SCR + off), r); unpack_h8(*(const v4u*)(SCK + off), k); unpack_h8(*(const v4u*)(SCV + off), v); unpack_h8(*(const v4u*)(G + off), g);
        float s = 0.f, bs = 0.f;
#pragma unroll
        for (int i = 0; i < 8; ++i) { s += o[i]; bs += r[i] * k[i] * rk[i]; }
        const float mean = sum8(s) * (1.f / 64.f); bs = sum8(bs); float q = 0.f;
#pragma unroll
        for (int i = 0; i < 8; ++i) { o[i] -= mean; q += o[i] * o[i]; }
        const float rstd = rsqrtf(sum8(q) * (1.f / 64.f) + GN_EPS);
        float res[8];
#pragma unroll
        for (int i = 0; i < 8; ++i) res[i] = (o[i] * rstd * lg[i] + lb[i] + bs * v[i]) * g[i];
        *(v4u*)(CAT + (size_t)m * 1024 + 512 + lane * 8) = pack_bf8(res);
    }
}

template <int MODE> __device__ __forceinline__ void ln_rows(Frame& F, const float* g, const float* b, int nparts, const h16* pa, const h16* pb) {
    const int gw = F.vcu * NWAVES + F.wave, NGW = F.G * NWAVES, lane = F.lane;
    float* Z = (float*)(F.ws + WS_Z); bf16* XB = (bf16*)(F.ws + WS_XB);
    f32x4 gv[4], bv[4];
#pragma unroll
    for (int j = 0; j < 4; ++j) { gv[j] = *(const f32x4*)(g + 4 * (lane + 64 * j)); bv[j] = *(const f32x4*)(b + 4 * (lane + 64 * j)); }
    for (int m = gw; m < T; m += NGW) {
        float* zr = Z + (size_t)m * D;
        f32x4 v[4]; float s = 0.f;
#pragma unroll
        for (int j = 0; j < 4; ++j) v[j] = *(const f32x4*)(zr + 4 * (lane + 64 * j));
        if (m >= TP) {
#pragma unroll 2
            for (int sp = 0; sp < nparts; ++sp) { const h16* pr = (sp < 8 ? pa + (size_t)sp * (1u << 20) : pb + (size_t)(sp - 8) * (1u << 20)) + (size_t)(m - TP) * D;
#pragma unroll
                for (int j = 0; j < 4; ++j) { float f[4]; h4(*(const v2u*)(pr + 4 * (lane + 64 * j)), f); v[j] = v[j] + (f32x4){f[0], f[1], f[2], f[3]}; } }
        }
#pragma unroll
        for (int j = 0; j < 4; ++j) s += (v[j].x + v[j].y) + (v[j].z + v[j].w);
        const float mean = wave_sum(s) * (1.f / D); float s2 = 0.f;
#pragma unroll
        for (int j = 0; j < 4; ++j) { v[j] = v[j] - mean; s2 += (v[j].x * v[j].x + v[j].y * v[j].y) + (v[j].z * v[j].z + v[j].w * v[j].w); }
        const float rstd = rsqrtf(wave_sum(s2) * (1.f / D) + LN_EPS);
#pragma unroll
        for (int j = 0; j < 4; ++j) v[j] = v[j] * rstd * gv[j] + bv[j];
        if (MODE == 2) {
#pragma unroll
            for (int j = 0; j < 4; ++j) *(f32x4*)(F.out + O_Y + (size_t)m * D + 4 * (lane + 64 * j)) = v[j];
        } else {
            if (MODE == 0 && m >= TP) {
#pragma unroll
                for (int j = 0; j < 4; ++j) *(f32x4*)(zr + 4 * (lane + 64 * j)) = v[j] * ALPHA;
            }
#pragma unroll
            for (int j = 0; j < 4; ++j) { v2u w; w.x = pkbf(v[j].x, v[j].y); w.y = pkbf(v[j].z, v[j].w); *(v2u*)(XB + (size_t)m * D + 4 * (lane + 64 * j)) = w; }
        }
        if (MODE == 1) {
            const bool sample = m >= TP; const int seq = sample ? (m - TP) >> 3 : m >> 11, t = sample ? (m - TP) & 7 : m & 2047;
            if (sample) {
                float* op = F.out + O_POOL_S + ((size_t)seq * 15 + 7 + t) * D;
#pragma unroll
                for (int j = 0; j < 4; ++j) *(f32x4*)(op + 4 * (lane + 64 * j)) = v[j];
                if (t == 0) { const float* sp = F.in[5] + ((size_t)seq * 15 + 8) * D; float* o0 = F.out + O_POOL_S + (size_t)seq * 15 * D;
                    for (int i = lane; i < 7 * D / 4; i += 64) *(f32x4*)(o0 + 4 * i) = *(const f32x4*)(sp + 4 * i); }
            } else if (t >= LP - 15) {
                float* op = F.out + O_POOL_P + ((size_t)seq * 15 + (t - (LP - 15))) * D;
#pragma unroll
                for (int j = 0; j < 4; ++j) *(f32x4*)(op + 4 * (lane + 64 * j)) = v[j];
            }
        }
    }
}

template <int TT> __device__ __forceinline__ float pool_one(const float (&xs)[TT + 15], int t, int g, int cnt) {
    const float x0 = xs[t + 15];
    const float s2 = x0 + xs[t + 14];
    const float s4 = s2 + (xs[t + 13] + xs[t + 12]);
    const float s8 = s4 + ((xs[t + 11] + xs[t + 10]) + (xs[t + 9] + xs[t + 8]));
    const float s16 = s8 + (((xs[t + 7] + xs[t + 6]) + (xs[t + 5] + xs[t + 4])) + ((xs[t + 3] + xs[t + 2]) + (xs[t + 1] + xs[t + 0])));
    const float sum = g == 0 ? s2 : (g == 1 ? s4 : (g == 2 ? s8 : s16));
    return sum / (float)cnt - x0;
}
template <int TT> __device__ __forceinline__ void pool_tile(Frame& F, int m0, int t0, int seq, bool sample) {
    const bf16* XR = (const bf16*)(F.ws + WS_XR); bf16* PL = (bf16*)(F.ws + WS_PL); const float* spool = F.in[5];
    const int c = 2 * F.tid, g = c >> 8;
    float xa[TT + 15], xb[TT + 15];
    const bf16* zp = XR + ((size_t)m0 - 15) * D + c; const float* sp = spool + ((size_t)seq * 15 + t0) * D + c;
#pragma unroll
    for (int s = -15; s < TT; ++s) {
        asm volatile("" : "+v"(zp), "+v"(sp));
        if (t0 + s >= 0) { const unsigned w = *(const unsigned*)zp; xa[s + 15] = __uint_as_float(w << 16); xb[s + 15] = __uint_as_float(w & 0xffff0000u); }
        else if (sample) { xa[s + 15] = sp[0]; xb[s + 15] = sp[1]; }
        else { xa[s + 15] = 0.f; xb[s + 15] = 0.f; }
        zp += D; sp += D;
    }
    const int wdw = 2 << g;
#pragma unroll
    for (int t = 0; t < TT; ++t) {
        const int cnt = sample ? wdw : min(wdw, t0 + t + 1);
        const float p0 = pool_one<TT>(xa, t, g, cnt), p1 = pool_one<TT>(xb, t, g, cnt);
        *(unsigned*)(PL + (size_t)(m0 + t) * D + c) = pkbf(p0, p1);
    }
}
__device__ __forceinline__ void pool_phase(Frame& F) {
    for (int it = F.vcu; it < 512 + 128; it += F.G) {
        if (it < 512) { const int m0 = it * 32; pool_tile<32>(F, m0, m0 & 2047, m0 >> 11, false); }
        else { const int seq = it - 512; pool_tile<8>(F, TP + seq * 8, 0, seq, true); }
    }
}


#ifndef DIAG_AT
#define DIAG_AT -1
#endif
__device__ __forceinline__ bool dbad(float got, float want) { return !(fabsf(got - want) <= 0.03f * fabsf(want) + 0.02f); }
__device__ __forceinline__ float h2f(h16 x) { return (float)x; }
__device__ __forceinline__ void diag_checks(Frame& F, int at) {
    if (blockIdx.x != 0 || F.wave != 0) return;
    const int lane = F.lane; unsigned char* ws = F.ws;
    unsigned mask = 0;
    const bf16* PA = (const bf16*)(ws + WS_PROJA); const bf16* PB = (const bf16*)(ws + WS_PROJB);
    const h16* SCR = (const h16*)(ws + WS_SCR); const h16* SCK = (const h16*)(ws + WS_SCK); const h16* SCV = (const h16*)(ws + WS_SCV); const h16* SCKK = (const h16*)(ws + WS_SCKK);
    const h16* SCB = (const h16*)(ws + WS_SCB); const h16* SCW = (const h16*)(ws + WS_SCW);
    const int m = 1 + (lane * 131 + 7) % 9000;
    const int t = m & 2047;
    if (at == 3) {
        const int c = (lane * 29 + 5) % 512, h0 = c & ~63;
        auto xm = [&](int col) { const float p = bf2f(PB[(size_t)m * BP + col]); const float pv = t > 0 ? bf2f(PB[(size_t)(m - 1) * BP + col]) : 0.f; return p + F.in[11][col] * (pv - p); };
        float ss = 0.f; for (int j = 0; j < 64; ++j) { const float kx = xm(512 + h0 + j) * F.in[17][h0 + j]; ss += kx * kx; }
        const float kkn = xm(512 + c) * F.in[17][c] / fmaxf(sqrtf(ss), 1e-12f);
        float al = F.in[14][c]; for (int j = 0; j < 64; ++j) al += xm(1600 + j) * F.in[15][(size_t)j * 512 + c];
        const float a = 1.f / (1.f + expf(-al)); const float f = (1.f + (a - 1.f) * F.in[18][c]); const float k0 = xm(512 + c); const float b = kkn * a;
        const float gotk = h2f(SCK[(size_t)m * HW + c]);
        if (__ballot(dbad(gotk, k0 * f))) mask |= 1;
        if (__ballot(dbad(h2f(SCB[(size_t)m * HW + c]) * 10.f, b * 10.f))) mask |= 2;
        { const bf16* LA = (const bf16*)(ws + WS_LA); bool bad = false; for (int j = 0; j < 64; ++j) bad = bad || dbad(bf2f(LA[(size_t)m * 256 + 64 + j]), xm(1600 + j)); if (__ballot(bad)) mask |= 4; }
        { float g = 0.f; for (int j = 0; j < 128; ++j) g += (1.f / (1.f + expf(-xm(1664 + j)))) * F.in[16][(size_t)j * 512 + c];
          const h16* G = (const h16*)(ws + WS_G); if (__ballot(dbad(h2f(G[(size_t)m * HW + c]), g))) mask |= 8; }
        if (__ballot(dbad(gotk, k0 * f * f))) mask |= 16;
        if (__ballot(dbad(gotk, k0))) mask |= 32;
    }
    if (lane == 0) *(unsigned*)(ws + 0) = mask;
}
__device__ __forceinline__ void diag_fill(Frame& F) {
    const unsigned mask = *(const unsigned*)(F.ws + 0);
    const float C = sqrtf(exp2f(1.f + (float)mask));
    const int gt = blockIdx.x * NTHREADS + F.tid, NGT = F.G * NTHREADS;
    for (int i = gt; i < TS * D; i += NGT) F.out[O_Y + (size_t)TP * D + i] = C;
}

#define XB_TMO      128
#define XB_XCNT(j)  (256  + 64 * (j))
#define XB_XSUB(j)  (1280 + 64 * (j))
#define XB_XGEN(j)  (2304 + 64 * (j))
#define XB_TOP      3328
#define XB_TOPGEN   3392
#define XCD_BAR_WORDS 3456
#define XB_SPIN_CAP (1u << 18)

__device__ __forceinline__ unsigned xb_ld(unsigned* p)              { return __hip_atomic_load(p, __ATOMIC_RELAXED, __HIP_MEMORY_SCOPE_AGENT); }
__device__ __forceinline__ unsigned xb_add(unsigned* p, unsigned v) { return __hip_atomic_fetch_add(p, v, __ATOMIC_RELAXED, __HIP_MEMORY_SCOPE_AGENT); }
__device__ __forceinline__ unsigned xb_xcc_id() { return (unsigned)__builtin_amdgcn_s_getreg((3 << 11) | 20) & 0xFu; }
#define XB_SPIN(cond, bar) do { unsigned _sp = 0; while (cond) { __builtin_amdgcn_s_sleep(1); \
    if ((++_sp & 255u) == 0u) { if (xb_ld(&(bar)[XB_TMO])) break; if (_sp > XB_SPIN_CAP) { atomicAdd(&(bar)[XB_TMO], 1u); break; } } } } while (0)

struct XcdBarrier {
    unsigned* bar; unsigned x;
    volatile LAS unsigned* st;
};

__device__ __forceinline__ XcdBarrier xcd_barrier_post(unsigned* bar, volatile LAS unsigned* st) {
    XcdBarrier b; b.bar = bar; b.x = xb_xcc_id(); b.st = st;
    if (threadIdx.x == 0) (void)xb_add(&bar[XB_XCNT(b.x)], 1u);
    return b;
}
__device__ __forceinline__ void xcd_barrier_complete(unsigned* bar, unsigned x, unsigned& nloc, unsigned& nx) {
    const unsigned G = gridDim.x * gridDim.y * gridDim.z;
    unsigned sum, cnt, mine, sp = 0u;
    for (;;) {
        sum = 0u; cnt = 0u; mine = 0u;
#pragma unroll
        for (unsigned j = 0; j < 16; ++j) { const unsigned c = xb_ld(&bar[XB_XCNT(j)]); sum += c; cnt += (c > 0u) ? 1u : 0u; mine = (j == x) ? c : mine; }
        if (sum == G) break;
        __builtin_amdgcn_s_sleep(1);
        if ((++sp & 255u) == 0u) { if (xb_ld(&bar[XB_TMO])) break; if (sp > XB_SPIN_CAP) { atomicAdd(&bar[XB_TMO], 1u); break; } }
    }
    nloc = mine > 0u ? mine : 1u; nx = cnt > 0u ? cnt : 1u;
}

__device__ __forceinline__ void xcd_barrier(const XcdBarrier& b) {
    asm volatile("s_waitcnt vmcnt(0)" ::: "memory");
    __syncthreads();
    if (threadIdx.x == 0) {
        unsigned* bar = b.bar;
        __builtin_amdgcn_s_waitcnt(0);
        unsigned nloc = b.st[0], nx = b.st[1];
        if (nloc == 0u) { xcd_barrier_complete(bar, b.x, nloc, nx); b.st[0] = nloc; b.st[1] = nx; }
        const unsigned old = xb_add(&bar[XB_XSUB(b.x)], 1u);
        const unsigned gen = old / nloc;
        if (old + 1u == (gen + 1u) * nloc) {
            __builtin_amdgcn_fence(__ATOMIC_RELEASE, "agent");
            asm volatile("s_waitcnt vmcnt(0)" ::: "memory");
            const unsigned og = xb_add(&bar[XB_TOP], 1u);
            const unsigned tg = og / nx;
            if (og + 1u == (tg + 1u) * nx) xb_add(&bar[XB_TOPGEN], 1u);
            else XB_SPIN(xb_ld(&bar[XB_TOPGEN]) == tg, bar);
            __builtin_amdgcn_fence(__ATOMIC_ACQUIRE, "agent");
            xb_add(&bar[XB_XGEN(b.x)], 1u);
            asm volatile("s_waitcnt vmcnt(0)" ::: "memory");
        } else {
            XB_SPIN(xb_ld(&bar[XB_XGEN(b.x)]) == gen, bar);
            __builtin_amdgcn_fence(__ATOMIC_ACQUIRE, "agent");
            asm volatile("s_waitcnt vmcnt(0)" ::: "memory");
        }
    }
    __syncthreads();
}

struct Args { const float* in[32]; float* out; unsigned char* ws; int ph_lo, ph_hi, coop, pad; };

__global__ void __launch_bounds__(NTHREADS, 2) mk_fwd(Args args) {
    extern __shared__ __attribute__((aligned(16))) unsigned char lds_raw[];
    Frame F;
    F.lds = (LAS unsigned char*)lds_raw;
    F.tid = threadIdx.x; F.lane = F.tid & 63; F.wave = __builtin_amdgcn_readfirstlane(F.tid >> 6);
    F.G = gridDim.x; { const int bx = blockIdx.x; F.vcu = (F.G % 8 == 0) ? (bx % 8) * (F.G / 8) + bx / 8 : bx; }
    F.in = args.in;
    F.out = args.out; F.ws = args.ws;
    unsigned char* ws = args.ws;
    const int lo = args.ph_lo, hi = args.ph_hi;
    volatile LAS unsigned* MISC = (volatile LAS unsigned*)(F.lds + 131072 + 512);
    if (F.tid < 32) MISC[F.tid] = 0u;
    __syncthreads();
    XcdBarrier bar = xcd_barrier_post((unsigned*)ws, MISC + 8);
#ifndef PHMASK
#define PHMASK 0x3ffff
#endif
#define IN(k) ((((PHMASK) >> (k)) & 1) && lo <= (k) && (k) < hi)
#define SEAM(k) do { if (IN(k) && IN((k) + 1)) { xcd_barrier(bar); } } while (0)
    typedef pg8::bf16_t gb;

#ifndef DUP0
#define DUP0 0
#endif
#ifndef DUP9
#define DUP9 0
#endif
#ifndef DUP2
#define DUP2 0
#endif
    if (DUP0) { p0_prologue(F); }
    if (IN(0)) { p0_prologue(F); } SEAM(0);
    if (IN(1)) {
        pg8::Gemm g{(const gb*)(ws + WS_XB), (const gb*)(ws + WS_WIN), T, INP, D, D, D, 0}; pg8::StaticOrder S; S.init(T, INP, F.G, (int)blockIdx.x, D);
        EpiProj E{(bf16*)(ws + WS_PROJA), (bf16*)(ws + WS_PROJB)};
        pg8::gemm_phase<EpiProj, pg8::StaticOrder, true, true>(F.lds, g, S, E);
    } SEAM(1);
    if (DUP2) { p2_rows(F); }
    if (IN(2)) { p2_rows(F); } SEAM(2);
    if (IN(3)) {
        pg8::Gemm g{(const gb*)(ws + WS_LA), (const gb*)(ws + WS_LORAT), T, 1536, 256, 256, 256, 0}; pg8::StaticOrder S; S.init(T, 1536, F.G, (int)blockIdx.x, 256);
        EpiLora E{F.in[12], F.in[14], F.in[18], (h16*)(ws + WS_SCW), (h16*)(ws + WS_SCK), (h16*)(ws + WS_SCKK), (h16*)(ws + WS_SCB), (h16*)(ws + WS_G)};
        pg8::gemm_phase<EpiLora, pg8::StaticOrder, true, true>(F.lds, g, S, E);
    } SEAM(3);
    if (IN(4)) { conv_phase(F); }
#ifndef DUP5
#define DUP5 0
#endif
#ifndef DUP4
#define DUP4 0
#endif
    if (DUP4) { conv_phase(F); }
    if (IN(5)) { scan_phase(F); } SEAM(5);
    if (DUP5) { scan_phase(F); xcd_barrier(bar); }
    if (IN(6)) { p6_rows(F); } SEAM(6);
    if (IN(7)) {
        pg8::Gemm g{(const gb*)(ws + WS_CAT), (const gb*)(ws + WS_WOUT), T, D, D, D, D, 0}; SplitOrder S; S.init(D, F.G, (int)blockIdx.x, D, 4);
        EpiResid E{F.in[0], F.in[1], (float*)(ws + WS_Z), nullptr, nullptr, (h16*)(ws + WS_PART7), nullptr};
        pg8::gemm_phase<EpiResid, SplitOrder, true, true>(F.lds, g, S, E);
    } SEAM(7);
    if (IN(8)) { ln_rows<0>(F, F.in[25], F.in[26], 4, (const h16*)(ws + WS_PART7), nullptr); } SEAM(8);
#define FFN_PHASES(layer, pgu, pdn) \
    if (IN(pgu)) { \
        pg8::Gemm g{(const gb*)(ws + WS_XB), (const gb*)(ws + ((layer) ? WS_WGU1 : WS_WGU0)), T, 2 * FF, D, D, D, 0}; pg8::StaticOrder S; S.init(T, 2 * FF, F.G, (int)blockIdx.x, D); \
        EpiGateUp E{(bf16*)(ws + WS_H)}; \
        pg8::gemm_phase<EpiGateUp, pg8::StaticOrder, true, true>(F.lds, g, S, E); \
    } SEAM(pgu); \
    if (IN(pdn)) { \
        pg8::Gemm g{(const gb*)(ws + WS_H), (const gb*)(ws + ((layer) ? WS_WD1 : WS_WD0)), T, D, FF, FF, FF, 0}; SplitOrder S; S.init(D, F.G, (int)blockIdx.x, FF, 11); \
        EpiResid E{nullptr, nullptr, (float*)(ws + WS_Z), nullptr, (const bf16*)(ws + WS_XR), (h16*)(ws + WS_PARTA), (h16*)(ws + WS_PARTB)}; \
        pg8::gemm_phase<EpiResid, SplitOrder, true, true>(F.lds, g, S, E); \
    } SEAM(pdn);
    if (DUP9) { pg8::Gemm g{(const gb*)(ws + WS_XB), (const gb*)(ws + WS_WGU0), T, 2 * FF, D, D, D, 0}; pg8::StaticOrder S; S.init(T, 2 * FF, F.G, (int)blockIdx.x, D);
        EpiGateUp E{(bf16*)(ws + WS_H)}; pg8::gemm_phase<EpiGateUp, pg8::StaticOrder, true, true>(F.lds, g, S, E); xcd_barrier(bar); }
    FFN_PHASES(0, 9, 10)
    if (IN(11)) { ln_rows<1>(F, F.in[30], F.in[31], 11, (const h16*)(ws + WS_PARTA), (const h16*)(ws + WS_PARTB)); } SEAM(11);
    if (IN(12)) { pool_phase(F); } SEAM(12);
    if (IN(13)) {
        pg8::Gemm g{(const gb*)(ws + WS_PL), (const gb*)(ws + WS_POOLT), T, D, 256, D, 256, 256}; pg8::StaticOrder S; S.init(T, D, F.G, (int)blockIdx.x, 256);
        EpiResid E{nullptr, nullptr, (float*)(ws + WS_Z), F.in[24], (const bf16*)(ws + WS_XR), nullptr, nullptr};
        pg8::gemm_phase<EpiResid, pg8::StaticOrder, true, true>(F.lds, g, S, E);
    } SEAM(13);
    if (IN(14)) { ln_rows<0>(F, F.in[25] + D, F.in[26] + D, 0, nullptr, nullptr); } SEAM(14);
    FFN_PHASES(1, 15, 16)
    if (IN(17)) { ln_rows<2>(F, F.in[30] + D, F.in[31] + D, 11, (const h16*)(ws + WS_PARTA), (const h16*)(ws + WS_PARTB)); }
    if (lo == 100) diag_checks(F, args.pad);
    if (lo == 101) diag_fill(F);
#undef IN
#undef SEAM
}

extern "C" void kernel_launch(void* const* d_in, const int* in_sizes, int n_in, void* d_out, int out_size, void* d_ws, size_t ws_size, hipStream_t stream) {
    static int grid = 0;
    if (grid == 0) {
        if (n_in != 32 || out_size != (int)O_TOTAL || ws_size < WS_END) { fprintf(stderr, "kernel_launch: unexpected shapes: n_in %d out %d ws %zu\n", n_in, out_size, ws_size); grid = -1; return; }
        int dev = 0, cus = 0, per_cu = 0;
        if (hipGetDevice(&dev) != hipSuccess || hipDeviceGetAttribute(&cus, hipDeviceAttributeMultiprocessorCount, dev) != hipSuccess) { grid = -1; return; }
        if (hipFuncSetAttribute((const void*)mk_fwd, hipFuncAttributeMaxDynamicSharedMemorySize, LDS_BYTES) != hipSuccess) { fprintf(stderr, "kernel_launch: hipFuncSetAttribute failed\n"); grid = -1; return; }
        if (hipOccupancyMaxActiveBlocksPerMultiprocessor(&per_cu, (const void*)mk_fwd, NTHREADS, LDS_BYTES) != hipSuccess || per_cu < 1) { fprintf(stderr, "kernel_launch: occupancy query says %d\n", per_cu); (void)hipGetLastError(); per_cu = 1; }
        grid = cus * 1;
        if (per_cu < 1) grid = -1;
    }
    if (grid < 0) return;
    Args a{};
    for (int i = 0; i < 32; ++i) a.in[i] = (const float*)d_in[i];
    a.out = (float*)d_out; a.ws = (unsigned char*)d_ws;
#if MK_SINGLE
    if (hipMemsetAsync(d_ws, 0, 16384, stream) != hipSuccess) { fprintf(stderr, "kernel_launch: memset failed\n"); return; }
    a.ph_lo = 0; a.ph_hi = NPHASE; a.coop = 1;
    void* params[] = {&a};
    hipError_t e = hipLaunchCooperativeKernel((const void*)mk_fwd, dim3(grid), dim3(NTHREADS), params, LDS_BYTES, stream);
    if (e != hipSuccess) fprintf(stderr, "kernel_launch: cooperative launch failed: %s (grid %d)\n", hipGetErrorString(e), grid);
#else
    for (int p = 0; p < NPHASE; ++p) {
        if (DIAG_AT >= 0 && p > DIAG_AT) break;
        a.ph_lo = p; a.ph_hi = p + 1; a.coop = 0;
        hipLaunchKernelGGL(mk_fwd, dim3(grid), dim3(NTHREADS), LDS_BYTES, stream, a);
    }
    if (DIAG_AT >= 0) { a.pad = DIAG_AT; a.ph_lo = 100; a.ph_hi = 101; hipLaunchKernelGGL(mk_fwd, dim3(grid), dim3(NTHREADS), LDS_BYTES, stream, a);
                        a.ph_lo = 101; a.ph_hi = 102; hipLaunchKernelGGL(mk_fwd, dim3(grid), dim3(NTHREADS), LDS_BYTES, stream, a); }
#endif
}
```

```cpp
#include <hip/hip_runtime.h>
#include <hip/hip_cooperative_groups.h>
#include <cstdio>
#include <cstdint>
namespace cg = cooperative_groups;
namespace pg8 {
#define PG8_LAS __attribute__((address_space(3)))
typedef unsigned short bf16_t;
typedef short bf16x8 __attribute__((ext_vector_type(8)));
typedef float f32x4 __attribute__((ext_vector_type(4)));
typedef unsigned u32x4 __attribute__((ext_vector_type(4)));
constexpr int BM = 256, BK = 64, HALF = 128, HTB = HALF * BK * 2  , STAGE_BYTES = 8 * HTB, NXCD = 8, WGM = 8;

__host__ __device__ __forceinline__ int lds_byte(int r, int c) { const int st = (r >> 4) * 2 + (c >> 5), rr = r & 15, cc = c & 31, ob = rr * 64 + cc * 2; return st * 1024 + (ob ^ (((ob >> 9) & 1) << 5)); }
__host__ __device__ __forceinline__ void stage_rc(int b, int& R, int& C) { const int st = b / 1024, sb = b % 1024, swz = sb ^ (((sb >> 9) & 1) << 5); R = (st >> 1) * 16 + swz / 64; C = (st & 1) * 32 + (swz % 64) / 2; }
__host__ __device__ __forceinline__ int perm32(int rho) { const int n = rho >> 4, i = rho & 15; return 8 * (i >> 2) + 4 * n + (i & 3); }

struct Unit { int pm, pn, kt0, nt, mode; };
struct Gemm { const bf16_t* A; const bf16_t* Bt; int M, N, K, lda, ldb, acol; };

struct StaticOrder {
    int nM, nN, nwg, G, c, ntf;
    __host__ __device__ void init(int M, int N, int G_, int c_, int K_) { nM = M / BM; nN = N / BM; nwg = nM * nN; G = G_; c = c_; ntf = K_ / BK; }
    __host__ __device__ bool next(int i, Unit& u) const {
        const long L = (long)i * G + c; if (L >= nwg) return false;
        int wgid = (int)L; { const int q = nwg / NXCD, r = nwg % NXCD, xcd = wgid % NXCD, off = wgid / NXCD; wgid = (xcd < r ? xcd * (q + 1) : r * (q + 1) + (xcd - r) * q) + off; }
        const int nig = WGM * nN, gid = wgid / nig, fm = gid * WGM, gsz = (nM - fm) < WGM ? (nM - fm) : WGM;
        u.pm = fm + ((wgid % nig) % gsz); u.pn = (wgid % nig) / gsz; u.kt0 = 0; u.nt = ntf; u.mode = 0; return true;
    }
    __device__ __forceinline__ void a_ready(const Unit&) const {}
    __device__ __forceinline__ void done(const Unit&) const {}
};

__device__ __forceinline__ unsigned cvt_pk_bf16(float lo, float hi) { unsigned r; asm volatile("v_cvt_pk_bf16_f32 %0, %1, %2" : "=v"(r) : "v"(lo), "v"(hi)); return r; }
template <class Epi, class Sched, bool ALIGN_EPI = false, bool SP2 = false>
__device__ __forceinline__ void gemm_phase(PG8_LAS unsigned char* lds, const Gemm g, const Sched& S, const Epi& E) {
    const int tid = threadIdx.x, wid = __builtin_amdgcn_readfirstlane(tid >> 6), lane = tid & 63, wr = wid >> 2, wc = wid & 3, fr = lane & 15, fq = lane >> 4;
    const int K = g.K; (void)K;
    unsigned voffA[2], voffB[2];
#pragma unroll
    for (int i = 0; i < 2; ++i) { int R, C; stage_rc(tid * 16 + i * 8192, R, C); const int Rb = Epi::PERM ? ((R & ~31) + perm32(R & 31)) : R;
        voffA[i] = (unsigned)(R * g.lda + C) * 2u; voffB[i] = (unsigned)(Rb * g.ldb + C) * 2u; }
    const size_t kstep = (size_t)(BK * 2);
    const size_t hstepA = (size_t)HALF * g.lda * 2, hstepB = (size_t)HALF * g.ldb * 2;
    const size_t tstepA = 2 * hstepA, tstepB = 2 * hstepB; const size_t acolB = (size_t)g.acol * 2;
    const unsigned ldsw = (unsigned)wid * 1024u;
    const int aoff = lds_byte(wr * 64 + fr, fq * 8), boff = lds_byte(wc * 32 + fr, fq * 8);
#define PG8_SA(b, h) (((b) * 2 + (h)) * HTB)
#define PG8_SB(b, h) ((4 + (b) * 2 + (h)) * HTB)
#define PG8_STAGE(bufoff, gbase, voff) do { _Pragma("unroll") for (int _i = 0; _i < 2; ++_i) \
        __builtin_amdgcn_global_load_lds((const unsigned*)((const char*)(gbase) + (voff)[_i]), (PG8_LAS unsigned*)(lds + (bufoff) + ldsw + _i * 8192), 16, 0, 0); } while (0)
#define PG8_LDA(dst, b, h) do { _Pragma("unroll") for (int m = 0; m < 4; ++m) _Pragma("unroll") for (int k = 0; k < 2; ++k) dst[m][k] = *(const PG8_LAS bf16x8*)(lds + PG8_SA(b, h) + aoff + m * 2048 + k * 1024); } while (0)
#define PG8_LDB(dst, b, h) do { _Pragma("unroll") for (int n = 0; n < 2; ++n) _Pragma("unroll") for (int k = 0; k < 2; ++k) dst[n][k] = *(const PG8_LAS bf16x8*)(lds + PG8_SB(b, h) + boff + n * 2048 + k * 1024); } while (0)
#define PG8_MMA(ai, bj, At, Bt) do { __builtin_amdgcn_s_setprio(1); _Pragma("unroll") for (int m = 0; m < 4; ++m) _Pragma("unroll") for (int n = 0; n < 2; ++n) _Pragma("unroll") for (int k = 0; k < 2; ++k) \
        acc[ai][bj][m][n] = __builtin_amdgcn_mfma_f32_16x16x32_bf16(Bt[n][k], At[m][k], acc[ai][bj][m][n], 0, 0, 0); __builtin_amdgcn_s_setprio(0); } while (0)
#define PG8_WAIT_V(n) asm volatile("s_waitcnt vmcnt(" #n ")" ::: "memory")
#define PG8_WAIT_L(n) asm volatile("s_waitcnt lgkmcnt(" #n ")" ::: "memory")
#define PG8_BAR __builtin_amdgcn_s_barrier()
#define PG8_SCHED __builtin_amdgcn_sched_barrier(0)
    Unit cur, nxt; int ui = 0;
    if (!S.next(0, cur)) return;
    f32x4 acc[2][2][4][2];
#pragma unroll
    for (int a = 0; a < 2; ++a)
#pragma unroll
        for (int b = 0; b < 2; ++b)
#pragma unroll
            for (int m = 0; m < 4; ++m)
#pragma unroll
                for (int n = 0; n < 2; ++n) acc[a][b][m][n] = (f32x4){0.f, 0.f, 0.f, 0.f};
    bf16x8 At[4][2], B0[2][2], B1[2][2];
    const char* cA = (const char*)g.A + (size_t)cur.pm * tstepA + (size_t)cur.pn * acolB + (size_t)cur.kt0 * kstep; const char* cB = (const char*)g.Bt + (size_t)cur.pn * tstepB + (size_t)cur.kt0 * kstep;
    S.a_ready(cur);
    if constexpr (SP2) {
        PG8_STAGE(PG8_SB(0, 0), cB, voffB); PG8_STAGE(PG8_SB(0, 1), cB + hstepB, voffB); PG8_STAGE(PG8_SA(0, 0), cA, voffA); PG8_STAGE(PG8_SA(0, 1), cA + hstepA, voffA);
        if (wr == 1) PG8_BAR;
        PG8_WAIT_V(2); PG8_BAR;
        PG8_STAGE(PG8_SB(1, 0), cB + kstep, voffB); PG8_STAGE(PG8_SA(1, 0), cA + kstep, voffA); PG8_STAGE(PG8_SB(1, 1), cB + hstepB + kstep, voffB);
        PG8_WAIT_V(6); PG8_BAR;
    } else {
        PG8_STAGE(PG8_SB(0, 0), cB, voffB); PG8_STAGE(PG8_SA(0, 0), cA, voffA); PG8_STAGE(PG8_SB(0, 1), cB + hstepB, voffB); PG8_STAGE(PG8_SA(0, 1), cA + hstepA, voffA);
        if (wr == 1) PG8_BAR;
        PG8_WAIT_V(4); PG8_BAR;
        PG8_STAGE(PG8_SB(1, 0), cB + kstep, voffB); PG8_STAGE(PG8_SA(1, 0), cA + kstep, voffA); PG8_STAGE(PG8_SB(1, 1), cB + hstepB + kstep, voffB);
        PG8_WAIT_V(6); PG8_BAR;
    }
    for (;;) {
        const bool has_next = S.next(ui + 1, nxt);
        const char* nA = has_next ? (const char*)g.A + (size_t)nxt.pm * tstepA + (size_t)nxt.pn * acolB + (size_t)nxt.kt0 * kstep : cA; const char* nB = has_next ? (const char*)g.Bt + (size_t)nxt.pn * tstepB + (size_t)nxt.kt0 * kstep : cB;
        const int nt = cur.nt;
        _Pragma("unroll 1") for (int t = 0; t < nt; t += 2) {
            const bool last = (t == nt - 2);
            const char* a1 = cA + (size_t)(t + 1) * kstep;
            const char* a2 = last ? nA : cA + (size_t)(t + 2) * kstep; const char* b2 = last ? nB : cB + (size_t)(t + 2) * kstep;
            const char* a3 = a2 + kstep; const char* b3 = b2 + kstep;
            if (last && has_next) S.a_ready(nxt);
            if constexpr (SP2) {
            PG8_LDB(B0, 0, 0); PG8_LDB(B1, 0, 1); PG8_SCHED; PG8_LDA(At, 0, 0); PG8_STAGE(PG8_SA(1, 1), a1 + hstepA, voffA);
            PG8_WAIT_V(8); PG8_WAIT_L(0); PG8_BAR; PG8_MMA(0, 0, At, B0); PG8_MMA(0, 1, At, B1); PG8_BAR; PG8_SCHED;
            PG8_LDA(At, 0, 1); PG8_STAGE(PG8_SB(0, 0), b2, voffB); PG8_STAGE(PG8_SB(0, 1), b2 + hstepB, voffB); PG8_STAGE(PG8_SA(0, 0), a2, voffA);
            PG8_WAIT_V(8); PG8_WAIT_L(0); PG8_BAR; PG8_MMA(1, 0, At, B0); PG8_MMA(1, 1, At, B1); PG8_BAR; PG8_SCHED;
            PG8_LDB(B0, 1, 0); PG8_LDB(B1, 1, 1); PG8_SCHED; PG8_LDA(At, 1, 0); PG8_STAGE(PG8_SA(0, 1), a2 + hstepA, voffA);
            PG8_WAIT_V(8); PG8_WAIT_L(0); PG8_BAR; PG8_MMA(0, 0, At, B0); PG8_MMA(0, 1, At, B1); PG8_BAR; PG8_SCHED;
            PG8_LDA(At, 1, 1); PG8_STAGE(PG8_SB(1, 0), b3, voffB); PG8_STAGE(PG8_SB(1, 1), b3 + hstepB, voffB); PG8_STAGE(PG8_SA(1, 0), a3, voffA);
            PG8_WAIT_V(8); PG8_WAIT_L(0); PG8_BAR; PG8_MMA(1, 0, At, B0); PG8_MMA(1, 1, At, B1); PG8_BAR; PG8_SCHED;
            } else {
            PG8_LDB(B0, 0, 0); PG8_SCHED; PG8_LDA(At, 0, 0); PG8_STAGE(PG8_SA(1, 1), a1 + hstepA, voffA);
            PG8_WAIT_L(8); PG8_BAR; PG8_WAIT_L(0); PG8_MMA(0, 0, At, B0); PG8_BAR; PG8_SCHED;
            PG8_LDB(B1, 0, 1); PG8_STAGE(PG8_SB(0, 0), b2, voffB);
            PG8_BAR; PG8_WAIT_L(0); PG8_MMA(0, 1, At, B1); PG8_BAR;
            PG8_LDA(At, 0, 1); PG8_STAGE(PG8_SA(0, 0), a2, voffA);
            PG8_BAR; PG8_WAIT_L(0); PG8_MMA(1, 0, At, B0); PG8_BAR; PG8_SCHED;
            PG8_STAGE(PG8_SB(0, 1), b2 + hstepB, voffB);
            PG8_WAIT_V(6); PG8_BAR; PG8_MMA(1, 1, At, B1); PG8_BAR;
            PG8_LDB(B0, 1, 0); PG8_SCHED; PG8_LDA(At, 1, 0); PG8_STAGE(PG8_SA(0, 1), a2 + hstepA, voffA);
            PG8_WAIT_L(8); PG8_BAR; PG8_WAIT_L(0); PG8_MMA(0, 0, At, B0); PG8_BAR; PG8_SCHED;
            PG8_LDB(B1, 1, 1); PG8_STAGE(PG8_SB(1, 0), b3, voffB);
            PG8_BAR; PG8_WAIT_L(0); PG8_MMA(0, 1, At, B1); PG8_BAR;
            PG8_LDA(At, 1, 1); PG8_STAGE(PG8_SA(1, 0), a3, voffA);
            PG8_BAR; PG8_WAIT_L(0); PG8_MMA(1, 0, At, B0); PG8_BAR; PG8_SCHED;
            PG8_STAGE(PG8_SB(1, 1), b3 + hstepB, voffB);
            PG8_WAIT_V(6); PG8_BAR; PG8_MMA(1, 1, At, B1); PG8_BAR;
            }
        }
        if constexpr (ALIGN_EPI) { if (wr == 0) PG8_BAR; }
        if constexpr (!Epi::AFTER_DRAIN) { E(acc, cur, wr, wc, fr, fq); S.done(cur); }
        if (!has_next) break;
#pragma unroll
        for (int a = 0; a < 2; ++a)
#pragma unroll
            for (int b = 0; b < 2; ++b)
#pragma unroll
                for (int m = 0; m < 4; ++m)
#pragma unroll
                    for (int n = 0; n < 2; ++n) acc[a][b][m][n] = (f32x4){0.f, 0.f, 0.f, 0.f};
        cur = nxt; cA = nA; cB = nB; ++ui;
        if constexpr (ALIGN_EPI) { if (wr == 1) PG8_BAR; }
    }
    PG8_WAIT_V(0);
    if constexpr (!ALIGN_EPI) { if (wr == 0) PG8_BAR; }
    PG8_BAR;
    if constexpr (Epi::AFTER_DRAIN) { E.fused(acc, cur, wr, wc, fr, fq, lds, wid, lane); S.done(cur); }
#undef PG8_SA
#undef PG8_SB
#undef PG8_STAGE
#undef PG8_LDA
#undef PG8_LDB
#undef PG8_MMA
#undef PG8_WAIT_V
#undef PG8_WAIT_L
#undef PG8_BAR
#undef PG8_SCHED
}
}

#define GAS __attribute__((address_space(1)))
#define LAS __attribute__((address_space(3)))
typedef unsigned short bf16;
typedef unsigned v4u __attribute__((ext_vector_type(4)));
typedef unsigned v2u __attribute__((ext_vector_type(2)));
typedef float f32x4 __attribute__((ext_vector_type(4)));
typedef _Float16 h16;
typedef _Float16 h16x2 __attribute__((ext_vector_type(2)));

#ifndef MK_SINGLE
#define MK_SINGLE 1
#endif

constexpr int NWAVES = 8, NTHREADS = NWAVES * 64;
constexpr int D = 1024, TP = 16384, TS = 1024, T = TP + TS, LP = 2048, LS = 8, NPB = 8, NSB = 128;
constexpr int INP = 2816, BP = 1792, FF = 2816, HW = 512;
constexpr float ALPHA = 1.41421356237309515f, LN_EPS = 1e-5f, GN_EPS = 64e-5f;
constexpr int NPHASE = 18;

constexpr size_t MiB = 1u << 20;
constexpr size_t WS_WIN = 1 * MiB, WS_WOUT = WS_WIN + 5632 * 1024, WS_WGU0 = WS_WOUT + 2 * MiB, WS_WGU1 = WS_WGU0 + 11 * MiB, WS_WD0 = WS_WGU1 + 11 * MiB, WS_WD1 = WS_WD0 + 5632 * 1024,
                 WS_POOLT = WS_WD1 + 5632 * 1024, WS_LORAT = WS_POOLT + 512 * 1024;
constexpr size_t WS_XB = 43 * MiB;
constexpr size_t WS_SCW = 43 * MiB, WS_G = 60 * MiB;
constexpr size_t WS_PROJA = 77 * MiB;
constexpr size_t WS_PROJB = 111 * MiB;
constexpr size_t WS_CAT = 111 * MiB, WS_SCB = 145 * MiB, WS_O = 162 * MiB;
constexpr size_t WS_LA = 170 * MiB + 512 * 1024;
constexpr size_t WS_SCR = 179 * MiB, WS_SCV = 196 * MiB, WS_SCK = 213 * MiB, WS_SCKK = 230 * MiB;
constexpr size_t WS_Z = 188 * MiB;
constexpr size_t WS_H = 77 * MiB;
constexpr size_t WS_PL = 77 * MiB;
constexpr size_t WS_PART7 = 145 * MiB;
constexpr size_t WS_PARTA = 170 * MiB + 512 * 1024, WS_PARTB = 1 * MiB;
constexpr size_t WS_XR = 43 * MiB;
constexpr size_t WS_END = 256 * MiB;
static_assert(WS_LORAT + 1536 * 256 * 2 <= WS_XB, "weights");
static_assert(WS_PROJB + (size_t)T * BP * 2 <= WS_LA, "projb");
static_assert(WS_H + (size_t)T * FF * 2 <= WS_Z, "h");
static_assert(WS_Z + (size_t)T * D * 4 <= WS_END, "z");

constexpr size_t O_Y = 0, O_CONV_P = 17825792, O_SHIFT_P = 17948672, O_WKV_P = 17963008, O_POOL_P = 18225152,
                 O_CONV_S = 18348032, O_SHIFT_S = 20314112, O_WKV_S = 20543488, O_POOL_S = 24737792, O_TOTAL = 26703872;

constexpr int LDS_BYTES = 147456;

struct Frame {
    LAS unsigned char* lds;
    int tid, lane, wave, vcu, G;
    const float* const* in;
    float* out; unsigned char* ws;
};

__device__ __forceinline__ float bf2f(unsigned b) { return __uint_as_float(b << 16); }
__device__ __forceinline__ unsigned pkbf(float lo, float hi) { return pg8::cvt_pk_bf16(lo, hi); }
__device__ __forceinline__ unsigned pkh(float lo, float hi) { const unsigned short a = __builtin_bit_cast(unsigned short, (h16)lo), b = __builtin_bit_cast(unsigned short, (h16)hi); return (unsigned)a | ((unsigned)b << 16); }
__device__ __forceinline__ float hlo(unsigned u) { return (float)__builtin_bit_cast(h16, (unsigned short)(u & 0xffffu)); }
__device__ __forceinline__ float hhi(unsigned u) { return (float)__builtin_bit_cast(h16, (unsigned short)(u >> 16)); }
__device__ __forceinline__ void unpack_bf8(v4u w, float (&f)[8]) { const unsigned u0 = w.x, u1 = w.y, u2 = w.z, u3 = w.w;
    f[0] = __uint_as_float(u0 << 16); f[1] = __uint_as_float(u0 & 0xffff0000u); f[2] = __uint_as_float(u1 << 16); f[3] = __uint_as_float(u1 & 0xffff0000u);
    f[4] = __uint_as_float(u2 << 16); f[5] = __uint_as_float(u2 & 0xffff0000u); f[6] = __uint_as_float(u3 << 16); f[7] = __uint_as_float(u3 & 0xffff0000u); }
__device__ __forceinline__ void unpack_h8(v4u w, float (&f)[8]) { const unsigned u0 = w.x, u1 = w.y, u2 = w.z, u3 = w.w; f[0] = hlo(u0); f[1] = hhi(u0); f[2] = hlo(u1); f[3] = hhi(u1); f[4] = hlo(u2); f[5] = hhi(u2); f[6] = hlo(u3); f[7] = hhi(u3); }
__device__ __forceinline__ v4u pack_bf8(const float (&f)[8]) { v4u w; w.x = pkbf(f[0], f[1]); w.y = pkbf(f[2], f[3]); w.z = pkbf(f[4], f[5]); w.w = pkbf(f[6], f[7]); return w; }
__device__ __forceinline__ v4u pack_h8(const float (&f)[8]) { v4u w; w.x = pkh(f[0], f[1]); w.y = pkh(f[2], f[3]); w.z = pkh(f[4], f[5]); w.w = pkh(f[6], f[7]); return w; }
__device__ __forceinline__ void load_f8(const float* p, float (&f)[8]) { const f32x4 a = *(const f32x4*)p, b = *(const f32x4*)(p + 4); f[0] = a.x; f[1] = a.y; f[2] = a.z; f[3] = a.w; f[4] = b.x; f[5] = b.y; f[6] = b.z; f[7] = b.w; }
__device__ __forceinline__ void store_f8(float* p, const float (&f)[8]) { *(f32x4*)p = (f32x4){f[0], f[1], f[2], f[3]}; *(f32x4*)(p + 4) = (f32x4){f[4], f[5], f[6], f[7]}; }
__device__ __forceinline__ float sigmoid_(float x) { return __builtin_amdgcn_rcpf(1.f + __expf(-x)); }
__device__ __forceinline__ float silu_(float x) { return x * sigmoid_(x); }
__device__ __forceinline__ float wave_sum(float v) {
#pragma unroll
    for (int o = 1; o < 64; o <<= 1) v += __shfl_xor(v, o);
    return v;
}
__device__ __forceinline__ float sum8(float v) { v += __shfl_xor(v, 1); v += __shfl_xor(v, 2); v += __shfl_xor(v, 4); return v; }
template <int CTRL> __device__ __forceinline__ float dppf(float x) { return __builtin_bit_cast(float, __builtin_amdgcn_update_dpp(0, __builtin_bit_cast(int, x), CTRL, 0xF, 0xF, true)); }
__device__ __forceinline__ float dpp_sum16(float x) {
    x += dppf<0xB1>(x);
    x += dppf<0x4E>(x);
    x += dppf<0x141>(x);
    x += dppf<0x140>(x);
    return x;
}
__device__ __forceinline__ void h4(v2u x, float (&f)[4]) { const unsigned u0 = x.x, u1 = x.y; f[0] = hlo(u0); f[1] = hhi(u0); f[2] = hlo(u1); f[3] = hhi(u1); }
__device__ __forceinline__ const float* xrow_ptr(const Frame& F, int m) { return m < TP ? F.in[0] + (size_t)m * D : F.in[1] + (size_t)(m - TP) * D; }

using pg8::Unit; using pg8::HALF; using pg8::BM;
typedef pg8::u32x4 u32x4;
struct EpiProj {
    static constexpr bool PERM = true, AFTER_DRAIN = false;
    bf16* PA; bf16* PB;
    __device__ __forceinline__ void operator()(const pg8::f32x4 (&acc)[2][2][4][2], const Unit& u, int wr, int wc, int fr, int fq) const {
        const int row0 = u.pm * BM + wr * 64 + fr;
        bf16* base; int ldc, colt;
        if (u.pn < 4) { base = PA; ldc = 1024; colt = u.pn * BM; } else { base = PB; ldc = BP; colt = (u.pn - 4) * BM; }
        const int col0 = colt + wc * 32 + 8 * fq;
#pragma unroll
        for (int ai = 0; ai < 2; ++ai)
#pragma unroll
            for (int m = 0; m < 4; ++m) { bf16* rowp = base + (size_t)(row0 + ai * HALF + m * 16) * ldc + col0;
#pragma unroll
                for (int bj = 0; bj < 2; ++bj) { const pg8::f32x4 v0 = acc[ai][bj][m][0], v1 = acc[ai][bj][m][1];
                    u32x4 w; w.x = pkbf(v0[0], v0[1]); w.y = pkbf(v0[2], v0[3]); w.z = pkbf(v1[0], v1[1]); w.w = pkbf(v1[2], v1[3]);
                    *(u32x4*)(rowp + bj * HALF) = w; } }
    }
};
struct EpiLora {
    static constexpr bool PERM = true, AFTER_DRAIN = false;
    const float* w0; const float* a0; const float* ka;
    h16* SCW; h16* SCK; h16* SCKK; h16* SCB; h16* G;
    __device__ __forceinline__ void operator()(const pg8::f32x4 (&acc)[2][2][4][2], const Unit& u, int wr, int wc, int fr, int fq) const {
        const int row0 = u.pm * BM + wr * 64 + fr; const int sec = u.pn >> 1;
        const int c0 = (u.pn & 1) * BM + wc * 32 + 8 * fq;
#pragma unroll
        for (int bj = 0; bj < 2; ++bj)
#pragma unroll
            for (int n = 0; n < 2; ++n) {
                const int c = c0 + bj * HALF + 4 * n;
                f32x4 p0 = {0.f, 0.f, 0.f, 0.f}, p1 = {0.f, 0.f, 0.f, 0.f};
                if (sec == 0) p0 = *(const f32x4*)(w0 + c); else if (sec == 1) { p0 = *(const f32x4*)(a0 + c); p1 = *(const f32x4*)(ka + c); }
#pragma unroll
                for (int ai = 0; ai < 2; ++ai)
#pragma unroll
                    for (int m = 0; m < 4; ++m) {
                        const size_t off = (size_t)(row0 + ai * HALF + m * 16) * HW + c;
                        const pg8::f32x4 v = acc[ai][bj][m][n];
                        if (sec == 0) {
                            float o[4];
#pragma unroll
                            for (int i = 0; i < 4; ++i) { const float e = 0.60653065971f * sigmoid_(p0[i] + v[i]); o[i] = 1.f - __expf(-e); }
                            v2u w; w.x = pkh(o[0], o[1]); w.y = pkh(o[2], o[3]); *(v2u*)(SCW + off) = w;
                        } else if (sec == 1) {
                            float kx[4], kk[4], ko[4], bo[4];
                            h4(*(const v2u*)(SCK + off), kx); h4(*(const v2u*)(SCKK + off), kk);
#pragma unroll
                            for (int i = 0; i < 4; ++i) { const float a = sigmoid_(p0[i] + v[i]); ko[i] = kx[i] * (1.f + (a - 1.f) * p1[i]); bo[i] = kk[i] * a; }
                            v2u w; w.x = pkh(ko[0], ko[1]); w.y = pkh(ko[2], ko[3]); *(v2u*)(SCK + off) = w;
                            v2u x; x.x = pkh(bo[0], bo[1]); x.y = pkh(bo[2], bo[3]); *(v2u*)(SCB + off) = x;
                        } else {
                            v2u w; w.x = pkh(v[0], v[1]); w.y = pkh(v[2], v[3]); *(v2u*)(G + off) = w;
                        }
                        asm volatile("" ::: "memory");
                    }
            }
    }
};
struct EpiGateUp {
    static constexpr bool PERM = true, AFTER_DRAIN = false;
    bf16* H;
    __device__ __forceinline__ void operator()(const pg8::f32x4 (&acc)[2][2][4][2], const Unit& u, int wr, int wc, int fr, int fq) const {
        const int row0 = u.pm * BM + wr * 64 + fr; const int col0 = u.pn * HALF + wc * 32 + 8 * fq;
#pragma unroll
        for (int ai = 0; ai < 2; ++ai)
#pragma unroll
            for (int m = 0; m < 4; ++m) {
                const pg8::f32x4 g0 = acc[ai][0][m][0], g1 = acc[ai][0][m][1], u0 = acc[ai][1][m][0], u1 = acc[ai][1][m][1];
                u32x4 w; w.x = pkbf(silu_(g0[0]) * u0[0], silu_(g0[1]) * u0[1]); w.y = pkbf(silu_(g0[2]) * u0[2], silu_(g0[3]) * u0[3]);
                w.z = pkbf(silu_(g1[0]) * u1[0], silu_(g1[1]) * u1[1]); w.w = pkbf(silu_(g1[2]) * u1[2], silu_(g1[3]) * u1[3]);
                *(u32x4*)(H + (size_t)(row0 + ai * HALF + m * 16) * FF + col0) = w;
            }
    }
};
struct EpiResid {
    static constexpr bool PERM = false, AFTER_DRAIN = false;
    const float* xp; const float* xs; float* Z; const float* scale;
    const bf16* XBr;
    h16* pa; h16* pb;
    __device__ __forceinline__ void operator()(const pg8::f32x4 (&acc)[2][2][4][2], const Unit& u, int wr, int wc, int fr, int fq) const {
        const int col0 = u.pn * BM + wc * 32 + 4 * fq;
#pragma unroll
        for (int ai = 0; ai < 2; ++ai)
#pragma unroll
            for (int m = 0; m < 4; ++m) {
                const int row = u.pm * BM + ai * HALF + wr * 64 + m * 16 + fr;
                float* zr = Z + (size_t)row * D + col0;
                const float* br = xp ? ((row < TP ? xp + (size_t)row * D : xs + (size_t)(row - TP) * D) + col0) : nullptr;
                const bf16* bb = XBr + (size_t)row * D + col0;
#pragma unroll
                for (int bj = 0; bj < 2; ++bj)
#pragma unroll
                    for (int n = 0; n < 2; ++n) {
                        const int o = bj * HALF + n * 16;
                        pg8::f32x4 a = acc[ai][bj][m][n];
                        if (scale) a = a * *(const pg8::f32x4*)(scale + col0 + o);
                        if (u.mode == 1) {
                            const int sp = u.kt0 / u.nt;
                            h16* pr = (sp < 8 ? pa + (size_t)sp * (1u << 20) : pb + (size_t)(sp - 8) * (1u << 20)) + (size_t)(row - TP) * D + col0;
                            v2u w; w.x = pkh(a[0], a[1]); w.y = pkh(a[2], a[3]); *(v2u*)(pr + o) = w;
                        } else {
                            pg8::f32x4 b;
                            if (xp) b = *(const pg8::f32x4*)(br + o);
                            else { const v2u w = *(const v2u*)(bb + o); const unsigned w0 = w.x, w1 = w.y; b = (pg8::f32x4){__uint_as_float(w0 << 16), __uint_as_float(w0 & 0xffff0000u), __uint_as_float(w1 << 16), __uint_as_float(w1 & 0xffff0000u)}; }
                            *(pg8::f32x4*)(zr + o) = b * ALPHA + a;
                        }
                    }
            }
    }
};

struct SplitOrder {
    pg8::StaticOrder base; int NS, ntc, c;
    __device__ void init(int N, int G, int c_, int K, int NS_) { base.init(TP, N, G, c_, K); NS = NS_; ntc = (K / pg8::BK) / NS_; c = c_; }
    __device__ bool next(int i, Unit& u) const {
        if (i == 0) return base.next(0, u);
        if (i == 1) { if (c >= 16 * NS) return false; const int unit = c / NS, sp = c % NS; u.pm = 64 + (unit >> 2); u.pn = unit & 3; u.kt0 = sp * ntc; u.nt = ntc; u.mode = 1; return true; }
        return false;
    }
    __device__ __forceinline__ void a_ready(const Unit&) const {}
    __device__ __forceinline__ void done(const Unit&) const {}
};

__device__ __forceinline__ void transpose_item(const float* W, int K, int N, bf16* WT, int mode, LAS float* scr, int item, int lane) {
    const int nblk = N / 32, kb = item / nblk, nb = item % nblk, k0 = 64 * kb, n0 = 32 * nb;
    const int drow0 = mode == 0 ? n0 : ((n0 >> 7) * 256 + (mode == 2 ? 128 : 0) + (n0 & 127));
#pragma unroll 8
    for (int i = 0; i < 32; ++i) { const int kk = 2 * i + (lane >> 5); scr[kk * 33 + (lane & 31)] = W[(size_t)(k0 + kk) * N + n0 + (lane & 31)]; }
    asm volatile("s_waitcnt lgkmcnt(0)" ::: "memory");
    const int c = lane & 7;
#pragma unroll
    for (int j = 0; j < 4; ++j) { const int n = (lane >> 3) + 8 * j; const LAS float* s = scr + (8 * c) * 33 + n;
        v4u o; o.x = pkbf(s[0 * 33], s[1 * 33]); o.y = pkbf(s[2 * 33], s[3 * 33]); o.z = pkbf(s[4 * 33], s[5 * 33]); o.w = pkbf(s[6 * 33], s[7 * 33]);
        *(v4u*)(WT + (size_t)(drow0 + n) * K + k0 + 8 * c) = o; }
    asm volatile("s_waitcnt lgkmcnt(0)" ::: "memory");
}
__device__ __forceinline__ void p0_prologue(Frame& F) {
    LAS float* scr = (LAS float*)(F.lds + F.wave * 16384);
    const int gw = F.vcu * NWAVES + F.wave, NGW = F.G * NWAVES;
    unsigned char* ws = F.ws;
    constexpr int I_IN = 16 * 88, I_OUT = 16 * 32, I_GU = 16 * 88, I_DN = 44 * 32, I_PL = 4 * 8;
    constexpr int NITEMS = I_IN + I_OUT + 2 * (2 * I_GU + I_DN) + 4 * I_PL;
    for (int it = gw; it < NITEMS; it += NGW) {
        int r = it;
        if (r < I_IN) { transpose_item(F.in[6], D, INP, (bf16*)(ws + WS_WIN), 0, scr, r, F.lane); continue; } r -= I_IN;
        if (r < I_OUT) { transpose_item(F.in[22], D, D, (bf16*)(ws + WS_WOUT), 0, scr, r, F.lane); continue; } r -= I_OUT;
        constexpr int I_LAYER = 2 * I_GU + I_DN;
        if (r < 2 * I_LAYER) {
            const int l = r / I_LAYER; int q = r % I_LAYER;
            bf16* gu = (bf16*)(ws + (l ? WS_WGU1 : WS_WGU0)); bf16* dn = (bf16*)(ws + (l ? WS_WD1 : WS_WD0));
            if (q < I_GU) { transpose_item(F.in[27] + (size_t)l * D * FF, D, FF, gu, 1, scr, q, F.lane); continue; } q -= I_GU;
            if (q < I_GU) { transpose_item(F.in[28] + (size_t)l * D * FF, D, FF, gu, 2, scr, q, F.lane); continue; } q -= I_GU;
            transpose_item(F.in[29] + (size_t)l * FF * D, FF, D, dn, 0, scr, q, F.lane); continue;
        }
        r -= 2 * I_LAYER;
        { const int g = r / I_PL, ri = r % I_PL; transpose_item(F.in[23] + (size_t)g * 65536, 256, 256, (bf16*)(ws + WS_POOLT) + (size_t)g * 65536, 0, scr, ri, F.lane); }
    }
    const int gt = F.vcu * NTHREADS + F.tid, NGT = F.G * NTHREADS;
    bf16* XB = (bf16*)(ws + WS_XB);
    float* Zp = (float*)(ws + WS_Z);
    for (int i = gt; i < T * D / 8; i += NGT) { const int m = i >> 7, c8 = (i & 127) * 8; float f[8]; load_f8(xrow_ptr(F, m) + c8, f); *(v4u*)(XB + (size_t)m * D + c8) = pack_bf8(f);
        if (m >= TP) { float z[8];
#pragma unroll
            for (int e = 0; e < 8; ++e) z[e] = ALPHA * f[e];
            store_f8(Zp + (size_t)m * D + c8, z); } }
    bf16* LT = (bf16*)(ws + WS_LORAT);
    for (int i = gt; i < 1536 * 256 / 2; i += NGT) { const int j = i >> 7, k = (i & 127) * 2; float v[2];
#pragma unroll
        for (int e = 0; e < 2; ++e) { const int kk = k + e; float x = 0.f;
            if (j < 512) { if (kk < 64) x = F.in[13][(size_t)kk * 512 + j]; }
            else if (j < 1024) { if (kk >= 64 && kk < 128) x = F.in[15][(size_t)(kk - 64) * 512 + (j - 512)]; }
            else { if (kk >= 128) x = F.in[16][(size_t)(kk - 128) * 512 + (j - 1024)]; }
            v[e] = x; }
        *(unsigned*)(LT + (size_t)j * 256 + k) = pkbf(v[0], v[1]); }
}

struct P2In { v4u cur[4], prv[4]; };
__device__ __forceinline__ void p2_load(P2In& X, const bf16* PB, int m, int lane) {
    const bool sample = m >= TP; const int t = sample ? (m - TP) & 7 : m & 2047;
    const bf16* pb = PB + (size_t)m * BP;
#pragma unroll
    for (int sec = 0; sec < 4; ++sec) {
        const int col = sec * 512 + lane * 8;
        if (sec < 3 || lane < 32) { X.cur[sec] = *(const v4u*)(pb + col); X.prv[sec] = t > 0 ? *(const v4u*)(pb - BP + col) : (v4u){0u, 0u, 0u, 0u}; }
        else { X.cur[sec] = (v4u){0u, 0u, 0u, 0u}; X.prv[sec] = (v4u){0u, 0u, 0u, 0u}; }
    }
}
__device__ __forceinline__ void p2_finish(const P2In& X, Frame& F, int m, int lane, const float (&mu)[4][8], const float (&kw)[8]) {
    unsigned char* ws = F.ws;
    h16* SCR = (h16*)(ws + WS_SCR); h16* SCK = (h16*)(ws + WS_SCK); h16* SCV = (h16*)(ws + WS_SCV); h16* SCKK = (h16*)(ws + WS_SCKK);
    bf16* LA = (bf16*)(ws + WS_LA);
    const bool sample = m >= TP; const int seq = sample ? (m - TP) >> 3 : m >> 11, t = sample ? (m - TP) & 7 : m & 2047, L = sample ? LS : LP;
    float* oshift = F.out + (sample ? O_SHIFT_S : O_SHIFT_P) + (size_t)seq * BP;
    const bool last = (t == L - 1);
#pragma unroll
    for (int sec = 0; sec < 4; ++sec) {
        if (sec == 3 && lane >= 32) break;
        const int col = sec * 512 + lane * 8;
        float p[8], pv[8], xm[8];
        unpack_bf8(X.cur[sec], p);
        if (t == 0 && sample) load_f8(F.in[3] + (size_t)seq * BP + col, pv); else unpack_bf8(X.prv[sec], pv);
#pragma unroll
        for (int i = 0; i < 8; ++i) xm[i] = p[i] + mu[sec][i] * (pv[i] - p[i]);
        if (last) store_f8(oshift + col, p);
        const size_t off = (size_t)m * HW + lane * 8;
        if (sec == 0) *(v4u*)(SCR + off) = pack_h8(xm);
        else if (sec == 1) {
            *(v4u*)(SCK + off) = pack_h8(xm);
            float kx[8]; float ss = 0.f;
#pragma unroll
            for (int i = 0; i < 8; ++i) { kx[i] = xm[i] * kw[i]; ss += kx[i] * kx[i]; }
            ss = sum8(ss);
            const float inv = 1.f / fmaxf(sqrtf(ss), 1e-12f);
#pragma unroll
            for (int i = 0; i < 8; ++i) kx[i] *= inv;
            *(v4u*)(SCKK + off) = pack_h8(kx);
        } else if (sec == 2) *(v4u*)(SCV + off) = pack_h8(xm);
        else {
            float o[8];
#pragma unroll
            for (int i = 0; i < 8; ++i) {
                if (lane < 8) { const float e = __expf(2.f * xm[i]); o[i] = 1.f - 2.f * __builtin_amdgcn_rcpf(e + 1.f); }
                else if (lane < 16) o[i] = xm[i];
                else o[i] = sigmoid_(xm[i]);
            }
            *(v4u*)(LA + (size_t)m * 256 + lane * 8) = pack_bf8(o);
        }
    }
}
__device__ __forceinline__ void p2_rows(Frame& F) {
    const int gw = F.vcu * NWAVES + F.wave, NGW = F.G * NWAVES, lane = F.lane;
    const bf16* PB = (const bf16*)(F.ws + WS_PROJB);
    float mu[4][8], kw[8];
#pragma unroll
    for (int sec = 0; sec < 4; ++sec) { if (sec < 3 || lane < 32) load_f8(F.in[11] + sec * 512 + lane * 8, mu[sec]); else {
#pragma unroll
            for (int i = 0; i < 8; ++i) mu[sec][i] = 0.f; } }
    load_f8(F.in[17] + lane * 8, kw);
    for (int m = gw; m < T; m += 2 * NGW) {
        const int m2 = m + NGW; const bool has2 = m2 < T;
        P2In A, B;
        p2_load(A, PB, m, lane);
        if (has2) p2_load(B, PB, m2, lane);
        p2_finish(A, F, m, lane, mu, kw);
        if (has2) p2_finish(B, F, m2, lane, mu, kw);
    }
}

template <int TT, bool FAST> __device__ __forceinline__ void conv_tile(Frame& F, int m0, int t0, int seq, bool sample) {
    const int c = F.tid;
    unsigned char* ws = F.ws;
    const bf16* PA = (const bf16*)(ws + WS_PROJA); bf16* CAT = (bf16*)(ws + WS_CAT);
    const float* cw = F.in[7]; const float* sconv = F.in[2];
    LAS float* ylds = (LAS float*)F.lds;
    float w[31];
#pragma unroll
    for (int j = 0; j < 31; ++j) w[j] = cw[j * 512 + c];
    float y[TT]; const float bias = F.in[8][c];
#pragma unroll
    for (int t = 0; t < TT; ++t) y[t] = bias;
    const bool lastp = (!sample) && (t0 + TT == LP);
    float* oconv = F.out + (sample ? O_CONV_S : O_CONV_P) + (size_t)seq * 30 * 512 + c;
    const bf16* pp = PA + ((size_t)m0 - 30) * 1024 + c; const float* scp = sconv + ((size_t)seq * 30 + t0) * 512 + c;
    unsigned rv[TT + 30], rg[TT + 30];
#pragma unroll
    for (int s = -30; s < TT; ++s) {
        asm volatile("" : "+v"(pp), "+v"(scp));
        if (FAST || t0 + s >= 0) { rv[s + 30] = pp[0]; rg[s + 30] = pp[512]; }
        else { rv[s + 30] = sample ? __float_as_uint(*scp) : 0u; rg[s + 30] = 0u; }
        pp += 1024; scp += 512;
    }
#pragma unroll
    for (int s = -30; s < TT; ++s) {
        float u;
        if (FAST || t0 + s >= 0) u = bf2f(rv[s + 30]) * sigmoid_(bf2f(rg[s + 30]));
        else u = __uint_as_float(rv[s + 30]);
#pragma unroll
        for (int t = 0; t < TT; ++t) { const int j = s - t + 30; if (j >= 0 && j <= 30) y[t] += u * w[j]; }
        if (sample) { if (s + 22 >= 0) oconv[(size_t)(s + 22) * 512] = u; }
        else if (lastp && s >= TT - 30) oconv[(size_t)(s - (TT - 30)) * 512] = u;
    }
#pragma unroll
    for (int t = 0; t < TT; ++t) ylds[t * 512 + c] = y[t];
    __syncthreads();
    const float* lg = F.in[9]; const float* lb = F.in[10];
    for (int t = F.wave; t < TT; t += NWAVES) {
        const LAS float* yr = ylds + t * 512 + F.lane * 8;
        float v[8];
        { const f32x4 a = *(const LAS f32x4*)yr, b = *(const LAS f32x4*)(yr + 4); v[0] = a.x; v[1] = a.y; v[2] = a.z; v[3] = a.w; v[4] = b.x; v[5] = b.y; v[6] = b.z; v[7] = b.w; }
        float s = 0.f;
#pragma unroll
        for (int i = 0; i < 8; ++i) s += v[i];
        const float mean = wave_sum(s) * (1.f / 512.f); float q = 0.f;
#pragma unroll
        for (int i = 0; i < 8; ++i) { v[i] -= mean; q += v[i] * v[i]; }
        const float rstd = rsqrtf(wave_sum(q) * (1.f / 512.f) + LN_EPS);
        float g8[8], b8[8], o[8]; load_f8(lg + F.lane * 8, g8); load_f8(lb + F.lane * 8, b8);
#pragma unroll
        for (int i = 0; i < 8; ++i) o[i] = silu_(v[i] * rstd * g8[i] + b8[i]);
        *(v4u*)(CAT + (size_t)(m0 + t) * 1024 + F.lane * 8) = pack_bf8(o);
    }
    __syncthreads();
}
__device__ __forceinline__ void conv_phase(Frame& F) {
    for (int it = F.vcu; it < 512 + 128; it += F.G) {
        if (it < 512) { const int m0 = it * 32, t0 = m0 & 2047; if (t0 >= 32) conv_tile<32, true>(F, m0, t0, m0 >> 11, false); else conv_tile<32, false>(F, m0, t0, m0 >> 11, false); }
        else { const int seq = it - 512; conv_tile<8, false>(F, TP + seq * 8, 0, seq, true); }
    }
}

constexpr int SU = 8;
struct ScanPtrs { const h16* R; const h16* K; const h16* V; const h16* KK; const h16* B; const h16* W; h16* O; };
struct ScanBuf { v2u r[SU], k[SU], kk[SU], b[SU], w[SU]; unsigned short v[SU]; };
__device__ __forceinline__ void scan_load(ScanBuf& Bf, const ScanPtrs& P, size_t off, int ks, int row) {
#pragma unroll
    for (int i = 0; i < SU; ++i) { const size_t o = off + (size_t)i * HW;
        Bf.r[i] = *(const v2u*)(P.R + o + ks); Bf.k[i] = *(const v2u*)(P.K + o + ks); Bf.kk[i] = *(const v2u*)(P.KK + o + ks);
        Bf.b[i] = *(const v2u*)(P.B + o + ks); Bf.w[i] = *(const v2u*)(P.W + o + ks); Bf.v[i] = *(const unsigned short*)(P.V + o + row); }
}
__device__ __forceinline__ void scan_compute(const ScanBuf& Bf, float (&S)[4], const ScanPtrs& P, size_t off, int row, bool writer) {
#pragma unroll
    for (int i = 0; i < SU; ++i) {
        float r[4], k[4], kk[4], b[4], w[4]; h4(Bf.r[i], r); h4(Bf.k[i], k); h4(Bf.kk[i], kk); h4(Bf.b[i], b); h4(Bf.w[i], w);
        const float v = (float)__builtin_bit_cast(h16, Bf.v[i]);
        float d = (S[0] * kk[0] + S[1] * kk[1]) + (S[2] * kk[2] + S[3] * kk[3]);
        float pj[4];
#pragma unroll
        for (int j = 0; j < 4; ++j) pj[j] = fmaf(v, k[j], fmaf(-S[j], w[j], S[j]));
        d = dpp_sum16(d);
#pragma unroll
        for (int j = 0; j < 4; ++j) S[j] = fmaf(-d, b[j], pj[j]);
        float o = (S[0] * r[0] + S[1] * r[1]) + (S[2] * r[2] + S[3] * r[3]);
        o = dpp_sum16(o);
        if (writer) P.O[off + (size_t)i * HW + row] = (h16)o;
    }
}
template <int L> __device__ __forceinline__ void scan_task(const ScanPtrs& P, int mbase, int h, int v0, const float* s_in, float* s_out, int lane) {
    const int rl = lane >> 4, ks = (lane & 15) * 4, row = v0 + rl; const bool writer = (lane & 15) == 0;
    float S[4] = {0.f, 0.f, 0.f, 0.f};
    if (s_in) { const f32x4 s = *(const f32x4*)(s_in + (size_t)row * 64 + ks); S[0] = s.x; S[1] = s.y; S[2] = s.z; S[3] = s.w; }
    size_t off = (size_t)mbase * HW + h * 64;
    ScanBuf A;
    scan_load(A, P, off, ks, row);
    if constexpr (L == SU) { scan_compute(A, S, P, off, row, writer); }
    else {
        ScanBuf Bf;
        for (int t = 0; t < L; t += 2 * SU) {
            scan_load(Bf, P, off + (size_t)SU * HW, ks, row);
            scan_compute(A, S, P, off, row, writer);
            if (t + 2 * SU < L) scan_load(A, P, off + (size_t)2 * SU * HW, ks, row);
            scan_compute(Bf, S, P, off + (size_t)SU * HW, row, writer);
            off += (size_t)2 * SU * HW;
        }
    }
    *(f32x4*)(s_out + (size_t)row * 64 + ks) = (f32x4){S[0], S[1], S[2], S[3]};
}
constexpr int RING_SLOTS = 64, SLOT_BYTES = 1536, FLAG_OFF = 131072 + 1024;
constexpr unsigned SPIN_CAP = 1u << 22;
struct StepF { f32x4 r, k, kk, b, w; float v; };
__device__ __forceinline__ void ld_stepf(StepF& X, const LAS unsigned char* slot, unsigned rd, unsigned vd) {
    X.r = *(const LAS f32x4*)(slot + 0 * 256 + rd); X.k = *(const LAS f32x4*)(slot + 1 * 256 + rd); X.kk = *(const LAS f32x4*)(slot + 2 * 256 + rd);
    X.b = *(const LAS f32x4*)(slot + 3 * 256 + rd); X.w = *(const LAS f32x4*)(slot + 4 * 256 + rd); X.v = *(const LAS float*)(slot + vd);
}
__device__ __forceinline__ float step_computef(const StepF& X, float (&S)[4]) {
    float d = (S[0] * X.kk[0] + S[1] * X.kk[1]) + (S[2] * X.kk[2] + S[3] * X.kk[3]);
    float pj[4];
#pragma unroll
    for (int j = 0; j < 4; ++j) pj[j] = fmaf(X.v, X.k[j], fmaf(-S[j], X.w[j], S[j]));
    d = dpp_sum16(d);
#pragma unroll
    for (int j = 0; j < 4; ++j) S[j] = fmaf(-d, X.b[j], pj[j]);
    float o = (S[0] * X.r[0] + S[1] * X.r[1]) + (S[2] * X.r[2] + S[3] * X.r[3]);
    return dpp_sum16(o);
}
__device__ __forceinline__ unsigned min4(const volatile LAS unsigned* p) { const unsigned a = p[0], b = p[1], c = p[2], d = p[3]; return min(min(a, b), min(c, d)); }
__device__ __forceinline__ void scan_prompt_consumer(Frame& F, int mbase, int h, int v0, float* s_out) {
    const int lane = F.lane, rl = lane >> 4, l16 = lane & 15, ks = l16 * 4, row = v0 + rl;
    const LAS unsigned char* ring = F.lds;
    volatile LAS unsigned* prod = (volatile LAS unsigned*)(F.lds + FLAG_OFF); volatile LAS unsigned* cons = prod + 4;
    h16* O = (h16*)(F.ws + WS_O) + (size_t)mbase * HW + h * 64 + row;
    const unsigned rd = ks * 4, vd = 5 * 256 + row * 4;
    constexpr int L = LP;
    float S[4] = {0.f, 0.f, 0.f, 0.f};
    StepF A, B;
    __builtin_amdgcn_s_setprio(2);
    { unsigned sp = 0; while (min4(prod) < 2u && ++sp < SPIN_CAP) __builtin_amdgcn_s_sleep(1); }
    asm volatile("" ::: "memory");
    ld_stepf(A, ring, rd, vd);
    float okeep = 0.f;
#pragma unroll 1
    for (int tb = 0; tb < L; tb += 16) {
#pragma unroll
        for (int j = 0; j < 16; ++j) {
            const int t = tb + j;
            if (j == 0) {
                const unsigned need = (unsigned)min(t / 4 + 5, L / 4);
                unsigned sp = 0; while (min4(prod) < need && ++sp < SPIN_CAP) __builtin_amdgcn_s_sleep(1);
                asm volatile("" ::: "memory");
            }
            float o;
            if (j & 1) { ld_stepf(A, ring + ((t + 1) & (RING_SLOTS - 1)) * SLOT_BYTES, rd, vd); o = step_computef(B, S); }
            else       { ld_stepf(B, ring + ((t + 1) & (RING_SLOTS - 1)) * SLOT_BYTES, rd, vd); o = step_computef(A, S); }
            okeep = (l16 == j) ? o : okeep;
            if (j == 15) { asm volatile("s_waitcnt lgkmcnt(0)" ::: "memory"); if (lane == 0) cons[F.wave] = (unsigned)(t + 1); }
        }
        O[(size_t)(tb + l16) * HW] = (h16)okeep;
    }
    *(f32x4*)(s_out + (size_t)row * 64 + ks) = (f32x4){S[0], S[1], S[2], S[3]};
    __builtin_amdgcn_s_setprio(0);
}
__device__ __forceinline__ void scan_prompt_loader(Frame& F, int mbase, int h) {
    const int lane = F.lane, w = F.wave - 4;
    LAS unsigned char* ring = F.lds;
    volatile LAS unsigned* prod = (volatile LAS unsigned*)(F.lds + FLAG_OFF); volatile LAS unsigned* cons = prod + 4;
    const int arr = lane < 40 ? (lane >> 3) : 5, part = lane & 7;
    const size_t abase = arr == 0 ? WS_SCR : arr == 1 ? WS_SCK : arr == 2 ? WS_SCKK : arr == 3 ? WS_SCB : arr == 4 ? WS_SCW : WS_SCV;
    const unsigned char* src = F.ws + abase + ((size_t)mbase * HW + h * 64) * 2 + part * 16;
    const bool active = lane < 48;
    const unsigned dst = arr * 256 + part * 32;
    constexpr int L = LP, PF = 8;
    v4u buf[PF]; unsigned cmin = 0u;
#pragma unroll
    for (int i = 0; i < PF; ++i) { const int s0 = w + 4 * i; buf[i] = active ? *(const v4u*)(src + (size_t)s0 * 1024) : (v4u){0u, 0u, 0u, 0u}; }
#pragma unroll 1
    for (int sb = w; sb < L; sb += 4 * PF) {
#pragma unroll
        for (int i = 0; i < PF; ++i) {
            const int st = sb + 4 * i;
            if (st >= RING_SLOTS && cmin < (unsigned)(st - RING_SLOTS + 1)) { unsigned sp = 0; while ((cmin = min4(cons)) < (unsigned)(st - RING_SLOTS + 1) && ++sp < SPIN_CAP) __builtin_amdgcn_s_sleep(1); }
            asm volatile("" ::: "memory");
            float f[8]; unpack_h8(buf[i], f);
            { const int sn = st + 4 * PF; if (sn < L) buf[i] = active ? *(const v4u*)(src + (size_t)sn * 1024) : (v4u){0u, 0u, 0u, 0u}; }
            if (active) { LAS unsigned char* p = ring + (st & (RING_SLOTS - 1)) * SLOT_BYTES + dst;
                *(LAS f32x4*)p = (f32x4){f[0], f[1], f[2], f[3]}; *(LAS f32x4*)(p + 16) = (f32x4){f[4], f[5], f[6], f[7]}; }
            asm volatile("s_waitcnt lgkmcnt(0)" ::: "memory");
            if (lane == 0) prod[w] = (unsigned)(st >> 2) + 1u;
        }
    }
}
__device__ __forceinline__ void scan_phase(Frame& F) {
    unsigned char* ws = F.ws;
    ScanPtrs P{(const h16*)(ws + WS_SCR), (const h16*)(ws + WS_SCK), (const h16*)(ws + WS_SCV), (const h16*)(ws + WS_SCKK), (const h16*)(ws + WS_SCB), (const h16*)(ws + WS_SCW), (h16*)(ws + WS_O)};
    for (int task = F.vcu; task < 256; task += F.G) {
        if (F.tid < 8) ((volatile LAS unsigned*)(F.lds + FLAG_OFF))[F.tid] = 0u;
        __syncthreads();
        const int pair = task >> 2, q = task & 3, n = pair >> 3, h = pair & 7;
        if (F.wave < 4) scan_prompt_consumer(F, n * LP, h, q * 16 + F.wave * 4, F.out + O_WKV_P + (size_t)pair * 4096);
        else scan_prompt_loader(F, n * LP, h);
        __syncthreads();
    }
    {
        const int gw = F.vcu * NWAVES + F.wave, NGW = F.G * NWAVES;
        for (int task = gw; task < NSB * 8 * 16; task += NGW) {
            const int pair = task >> 4, rg = task & 15, n = pair >> 3, h = pair & 7;
            scan_task<LS>(P, TP + n * LS, h, rg * 4, F.in[4] + (size_t)pair * 4096, F.out + O_WKV_S + (size_t)pair * 4096, F.lane);
        }
    }
}

struct P6In { v4u o, r, k, v, g; };
__device__ __forceinline__ void p6_load(P6In& X, const unsigned char* ws, int m, int lane) {
    const size_t off = ((size_t)m * HW + lane * 8) * 2;
    X.o = *(const v4u*)(ws + WS_O + off); X.r = *(const v4u*)(ws + WS_SCR + off); X.k = *(const v4u*)(ws + WS_SCK + off); X.v = *(const v4u*)(ws + WS_SCV + off); X.g = *(const v4u*)(ws + WS_G + off);
}
__device__ __forceinline__ void p6_finish(const P6In& X, bf16* CAT, int m, int lane, const float (&rk)[8], const float (&lg)[8], const float (&lb)[8]) {
    float o[8], r[8], k[8], v[8], g[8];
    unpack_h8(X.o, o); unpack_h8(X.r, r); unpack_h8(X.k, k); unpack_h8(X.v, v); unpack_h8(X.g, g);
    float s = 0.f, bs = 0.f;
#pragma unroll
    for (int i = 0; i < 8; ++i) { s += o[i]; bs += r[i] * k[i] * rk[i]; }
    const float mean = sum8(s) * (1.f / 64.f); bs = sum8(bs); float q = 0.f;
#pragma unroll
    for (int i = 0; i < 8; ++i) { o[i] -= mean; q += o[i] * o[i]; }
    const float rstd = rsqrtf(sum8(q) * (1.f / 64.f) + GN_EPS);
    float res[8];
#pragma unroll
    for (int i = 0; i < 8; ++i) res[i] = (o[i] * rstd * lg[i] + lb[i] + bs * v[i]) * g[i];
    *(v4u*)(CAT + (size_t)m * 1024 + 512 + lane * 8) = pack_bf8(res);
}
__device__ __forceinline__ void p6_rows(Frame& F) {
    const int gw = F.vcu * NWAVES + F.wave, NGW = F.G * NWAVES, lane = F.lane;
    const unsigned char* ws = F.ws; bf16* CAT = (bf16*)(F.ws + WS_CAT);
    float rk[8], lg[8], lb[8]; load_f8(F.in[19] + lane * 8, rk); load_f8(F.in[20] + lane * 8, lg); load_f8(F.in[21] + lane * 8, lb);
    for (int m = gw; m < T; m += 4 * NGW) {
        P6In X[4];
#pragma unroll
        for (int u = 0; u < 4; ++u) { const int mm = m + u * NGW; if (mm < T) p6_load(X[u], ws, mm, lane); }
#pragma unroll
        for (int u = 0; u < 4; ++u) { const int mm = m + u * NGW; if (mm < T) p6_finish(X[u], CAT, mm, lane, rk, lg, lb); }
    }
}

template <int MODE> __device__ __forceinline__ void ln_finish(Frame& F, int m, f32x4 (&v)[4], const f32x4 (&gv)[4], const f32x4 (&bv)[4], int nparts, const h16* pa, const h16* pb) {
    const int lane = F.lane;
    float* zr = (float*)(F.ws + WS_Z) + (size_t)m * D; bf16* XB = (bf16*)(F.ws + WS_XB);
    float s = 0.f;
    if (m >= TP) {
#pragma unroll 2
        for (int sp = 0; sp < nparts; ++sp) { const h16* pr = (sp < 8 ? pa + (size_t)sp * (1u << 20) : pb + (size_t)(sp - 8) * (1u << 20)) + (size_t)(m - TP) * D;
#pragma unroll
            for (int j = 0; j < 4; ++j) { float f[4]; h4(*(const v2u*)(pr + 4 * (lane + 64 * j)), f); v[j] = v[j] + (f32x4){f[0], f[1], f[2], f[3]}; } }
    }
#pragma unroll
    for (int j = 0; j < 4; ++j) s += (v[j].x + v[j].y) + (v[j].z + v[j].w);
    const float mean = wave_sum(s) * (1.f / D); float s2 = 0.f;
#pragma unroll
    for (int j = 0; j < 4; ++j) { v[j] = v[j] - mean; s2 += (v[j].x * v[j].x + v[j].y * v[j].y) + (v[j].z * v[j].z + v[j].w * v[j].w); }
    const float rstd = rsqrtf(wave_sum(s2) * (1.f / D) + LN_EPS);
#pragma unroll
    for (int j = 0; j < 4; ++j) v[j] = v[j] * rstd * gv[j] + bv[j];
    if (MODE == 2) {
#pragma unroll
        for (int j = 0; j < 4; ++j) *(f32x4*)(F.out + O_Y + (size_t)m * D + 4 * (lane + 64 * j)) = v[j];
    } else {
        if (MODE == 0 && m >= TP) {
#pragma unroll
            for (int j = 0; j < 4; ++j) *(f32x4*)(zr + 4 * (lane + 64 * j)) = v[j] * ALPHA;
        }
#pragma unroll
        for (int j = 0; j < 4; ++j) { v2u w; w.x = pkbf(v[j].x, v[j].y); w.y = pkbf(v[j].z, v[j].w); *(v2u*)(XB + (size_t)m * D + 4 * (lane + 64 * j)) = w; }
    }
    if (MODE == 1) {
        const bool sample = m >= TP; const int seq = sample ? (m - TP) >> 3 : m >> 11, t = sample ? (m - TP) & 7 : m & 2047;
        if (sample) {
            float* op = F.out + O_POOL_S + ((size_t)seq * 15 + 7 + t) * D;
#pragma unroll
            for (int j = 0; j < 4; ++j) *(f32x4*)(op + 4 * (lane + 64 * j)) = v[j];
            if (t == 0) { const float* sp = F.in[5] + ((size_t)seq * 15 + 8) * D; float* o0 = F.out + O_POOL_S + (size_t)seq * 15 * D;
                for (int i = lane; i < 7 * D / 4; i += 64) *(f32x4*)(o0 + 4 * i) = *(const f32x4*)(sp + 4 * i); }
        } else if (t >= LP - 15) {
            float* op = F.out + O_POOL_P + ((size_t)seq * 15 + (t - (LP - 15))) * D;
#pragma unroll
            for (int j = 0; j < 4; ++j) *(f32x4*)(op + 4 * (lane + 64 * j)) = v[j];
        }
    }
}
template <int MODE> __device__ __forceinline__ void ln_rows(Frame& F, const float* g, const float* b, int nparts, const h16* pa, const h16* pb) {
    const int gw = F.vcu * NWAVES + F.wave, NGW = F.G * NWAVES, lane = F.lane;
    const float* Z = (const float*)(F.ws + WS_Z);
    f32x4 gv[4], bv[4];
#pragma unroll
    for (int j = 0; j < 4; ++j) { gv[j] = *(const f32x4*)(g + 4 * (lane + 64 * j)); bv[j] = *(const f32x4*)(b + 4 * (lane + 64 * j)); }
    constexpr int LU = 4;
    for (int m = gw; m < T; m += LU * NGW) {
        f32x4 v[LU][4];
#pragma unroll
        for (int u = 0; u < LU; ++u) { const int mm = m + u * NGW; if (mm < T) {
#pragma unroll
                for (int j = 0; j < 4; ++j) v[u][j] = *(const f32x4*)(Z + (size_t)mm * D + 4 * (lane + 64 * j)); } }
#pragma unroll
        for (int u = 0; u < LU; ++u) { const int mm = m + u * NGW; if (mm < T) ln_finish<MODE>(F, mm, v[u], gv, bv, nparts, pa, pb); }
    }
}

template <int TT> __device__ __forceinline__ float pool_one(const float (&xs)[TT + 15], int t, int g, int cnt) {
    const float x0 = xs[t + 15];
    const float s2 = x0 + xs[t + 14];
    const float s4 = s2 + (xs[t + 13] + xs[t + 12]);
    const float s8 = s4 + ((xs[t + 11] + xs[t + 10]) + (xs[t + 9] + xs[t + 8]));
    const float s16 = s8 + (((xs[t + 7] + xs[t + 6]) + (xs[t + 5] + xs[t + 4])) + ((xs[t + 3] + xs[t + 2]) + (xs[t + 1] + xs[t + 0])));
    const float sum = g == 0 ? s2 : (g == 1 ? s4 : (g == 2 ? s8 : s16));
    return sum / (float)cnt - x0;
}
template <int TT> __device__ __forceinline__ void pool_tile(Frame& F, int m0, int t0, int seq, bool sample) {
    const bf16* XR = (const bf16*)(F.ws + WS_XR); bf16* PL = (bf16*)(F.ws + WS_PL); const float* spool = F.in[5];
    const int c = 2 * F.tid, g = c >> 8;
    float xa[TT + 15], xb[TT + 15];
    const bf16* zp = XR + ((size_t)m0 - 15) * D + c; const float* sp = spool + ((size_t)seq * 15 + t0) * D + c;
#pragma unroll
    for (int s = -15; s < TT; ++s) {
        asm volatile("" : "+v"(zp), "+v"(sp));
        if (t0 + s >= 0) { const unsigned w = *(const unsigned*)zp; xa[s + 15] = __uint_as_float(w << 16); xb[s + 15] = __uint_as_float(w & 0xffff0000u); }
        else if (sample) { xa[s + 15] = sp[0]; xb[s + 15] = sp[1]; }
        else { xa[s + 15] = 0.f; xb[s + 15] = 0.f; }
        zp += D; sp += D;
    }
    const int wdw = 2 << g;
#pragma unroll
    for (int t = 0; t < TT; ++t) {
        const int cnt = sample ? wdw : min(wdw, t0 + t + 1);
        const float p0 = pool_one<TT>(xa, t, g, cnt), p1 = pool_one<TT>(xb, t, g, cnt);
        *(unsigned*)(PL + (size_t)(m0 + t) * D + c) = pkbf(p0, p1);
    }
}
__device__ __forceinline__ void pool_phase(Frame& F) {
    for (int it = F.vcu; it < 512 + 128; it += F.G) {
        if (it < 512) { const int m0 = it * 32; pool_tile<32>(F, m0, m0 & 2047, m0 >> 11, false); }
        else { const int seq = it - 512; pool_tile<8>(F, TP + seq * 8, 0, seq, true); }
    }
}


#ifndef DIAG_AT
#define DIAG_AT -1
#endif
__device__ __forceinline__ bool dbad(float got, float want) { return !(fabsf(got - want) <= 0.03f * fabsf(want) + 0.02f); }
__device__ __forceinline__ float h2f(h16 x) { return (float)x; }
__device__ __forceinline__ void diag_checks(Frame& F, int at) {
    if (blockIdx.x != 0 || F.wave != 0) return;
    const int lane = F.lane; unsigned char* ws = F.ws;
    unsigned mask = 0;
    const bf16* PA = (const bf16*)(ws + WS_PROJA); const bf16* PB = (const bf16*)(ws + WS_PROJB);
    const h16* SCR = (const h16*)(ws + WS_SCR); const h16* SCK = (const h16*)(ws + WS_SCK); const h16* SCV = (const h16*)(ws + WS_SCV); const h16* SCKK = (const h16*)(ws + WS_SCKK);
    const h16* SCB = (const h16*)(ws + WS_SCB); const h16* SCW = (const h16*)(ws + WS_SCW);
    const int m = 1 + (lane * 131 + 7) % 9000;
    const int t = m & 2047;
    if (at == 3) {
        const int c = (lane * 29 + 5) % 512, h0 = c & ~63;
        auto xm = [&](int col) { const float p = bf2f(PB[(size_t)m * BP + col]); const float pv = t > 0 ? bf2f(PB[(size_t)(m - 1) * BP + col]) : 0.f; return p + F.in[11][col] * (pv - p); };
        float ss = 0.f; for (int j = 0; j < 64; ++j) { const float kx = xm(512 + h0 + j) * F.in[17][h0 + j]; ss += kx * kx; }
        const float kkn = xm(512 + c) * F.in[17][c] / fmaxf(sqrtf(ss), 1e-12f);
        float al = F.in[14][c]; for (int j = 0; j < 64; ++j) al += xm(1600 + j) * F.in[15][(size_t)j * 512 + c];
        const float a = 1.f / (1.f + expf(-al)); const float f = (1.f + (a - 1.f) * F.in[18][c]); const float k0 = xm(512 + c); const float b = kkn * a;
        const float gotk = h2f(SCK[(size_t)m * HW + c]);
        if (__ballot(dbad(gotk, k0 * f))) mask |= 1;
        if (__ballot(dbad(h2f(SCB[(size_t)m * HW + c]) * 10.f, b * 10.f))) mask |= 2;
        { const bf16* LA = (const bf16*)(ws + WS_LA); bool bad = false; for (int j = 0; j < 64; ++j) bad = bad || dbad(bf2f(LA[(size_t)m * 256 + 64 + j]), xm(1600 + j)); if (__ballot(bad)) mask |= 4; }
        { float g = 0.f; for (int j = 0; j < 128; ++j) g += (1.f / (1.f + expf(-xm(1664 + j)))) * F.in[16][(size_t)j * 512 + c];
          const h16* G = (const h16*)(ws + WS_G); if (__ballot(dbad(h2f(G[(size_t)m * HW + c]), g))) mask |= 8; }
        if (__ballot(dbad(gotk, k0 * f * f))) mask |= 16;
        if (__ballot(dbad(gotk, k0))) mask |= 32;
    }
    if (lane == 0) *(unsigned*)(ws + 0) = mask;
}
__device__ __forceinline__ void diag_fill(Frame& F) {
    const unsigned mask = *(const unsigned*)(F.ws + 0);
    const float C = sqrtf(exp2f(1.f + (float)mask));
    const int gt = blockIdx.x * NTHREADS + F.tid, NGT = F.G * NTHREADS;
    for (int i = gt; i < TS * D; i += NGT) F.out[O_Y + (size_t)TP * D + i] = C;
}

#define XB_TMO      128
#define XB_XCNT(j)  (256  + 64 * (j))
#define XB_XSUB(j)  (1280 + 64 * (j))
#define XB_XGEN(j)  (2304 + 64 * (j))
#define XB_TOP      3328
#define XB_TOPGEN   3392
#define XCD_BAR_WORDS 3456
#define XB_SPIN_CAP (1u << 18)

__device__ __forceinline__ unsigned xb_ld(unsigned* p)              { return __hip_atomic_load(p, __ATOMIC_RELAXED, __HIP_MEMORY_SCOPE_AGENT); }
__device__ __forceinline__ unsigned xb_add(unsigned* p, unsigned v) { return __hip_atomic_fetch_add(p, v, __ATOMIC_RELAXED, __HIP_MEMORY_SCOPE_AGENT); }
__device__ __forceinline__ unsigned xb_xcc_id() { return (unsigned)__builtin_amdgcn_s_getreg((3 << 11) | 20) & 0xFu; }
#define XB_SPIN(cond, bar) do { unsigned _sp = 0; while (cond) { __builtin_amdgcn_s_sleep(1); \
    if ((++_sp & 255u) == 0u) { if (xb_ld(&(bar)[XB_TMO])) break; if (_sp > XB_SPIN_CAP) { atomicAdd(&(bar)[XB_TMO], 1u); break; } } } } while (0)

struct XcdBarrier {
    unsigned* bar; unsigned x;
    volatile LAS unsigned* st;
};

__device__ __forceinline__ XcdBarrier xcd_barrier_post(unsigned* bar, volatile LAS unsigned* st) {
    XcdBarrier b; b.bar = bar; b.x = xb_xcc_id(); b.st = st;
    if (threadIdx.x == 0) (void)xb_add(&bar[XB_XCNT(b.x)], 1u);
    return b;
}
__device__ __forceinline__ void xcd_barrier_complete(unsigned* bar, unsigned x, unsigned& nloc, unsigned& nx) {
    const unsigned G = gridDim.x * gridDim.y * gridDim.z;
    unsigned sum, cnt, mine, sp = 0u;
    for (;;) {
        sum = 0u; cnt = 0u; mine = 0u;
#pragma unroll
        for (unsigned j = 0; j < 16; ++j) { const unsigned c = xb_ld(&bar[XB_XCNT(j)]); sum += c; cnt += (c > 0u) ? 1u : 0u; mine = (j == x) ? c : mine; }
        if (sum == G) break;
        __builtin_amdgcn_s_sleep(1);
        if ((++sp & 255u) == 0u) { if (xb_ld(&bar[XB_TMO])) break; if (sp > XB_SPIN_CAP) { atomicAdd(&bar[XB_TMO], 1u); break; } }
    }
    nloc = mine > 0u ? mine : 1u; nx = cnt > 0u ? cnt : 1u;
}

__device__ __forceinline__ void xcd_barrier(const XcdBarrier& b) {
    asm volatile("s_waitcnt vmcnt(0)" ::: "memory");
    __syncthreads();
    if (threadIdx.x == 0) {
        unsigned* bar = b.bar;
        __builtin_amdgcn_s_waitcnt(0);
        unsigned nloc = b.st[0], nx = b.st[1];
        if (nloc == 0u) { xcd_barrier_complete(bar, b.x, nloc, nx); b.st[0] = nloc; b.st[1] = nx; }
        const unsigned old = xb_add(&bar[XB_XSUB(b.x)], 1u);
        const unsigned gen = old / nloc;
        if (old + 1u == (gen + 1u) * nloc) {
            __builtin_amdgcn_fence(__ATOMIC_RELEASE, "agent");
            asm volatile("s_waitcnt vmcnt(0)" ::: "memory");
            const unsigned og = xb_add(&bar[XB_TOP], 1u);
            const unsigned tg = og / nx;
            if (og + 1u == (tg + 1u) * nx) xb_add(&bar[XB_TOPGEN], 1u);
            else XB_SPIN(xb_ld(&bar[XB_TOPGEN]) == tg, bar);
            __builtin_amdgcn_fence(__ATOMIC_ACQUIRE, "agent");
            xb_add(&bar[XB_XGEN(b.x)], 1u);
            asm volatile("s_waitcnt vmcnt(0)" ::: "memory");
        } else {
            XB_SPIN(xb_ld(&bar[XB_XGEN(b.x)]) == gen, bar);
            __builtin_amdgcn_fence(__ATOMIC_ACQUIRE, "agent");
            asm volatile("s_waitcnt vmcnt(0)" ::: "memory");
        }
    }
    __syncthreads();
}

struct Args { const float* in[32]; float* out; unsigned char* ws; int ph_lo, ph_hi, coop, pad; };

__global__ void __launch_bounds__(NTHREADS, 2) mk_fwd(Args args) {
    extern __shared__ __attribute__((aligned(16))) unsigned char lds_raw[];
    Frame F;
    F.lds = (LAS unsigned char*)lds_raw;
    F.tid = threadIdx.x; F.lane = F.tid & 63; F.wave = __builtin_amdgcn_readfirstlane(F.tid >> 6);
    F.G = gridDim.x; { const int bx = blockIdx.x; F.vcu = (F.G % 8 == 0) ? (bx % 8) * (F.G / 8) + bx / 8 : bx; }
    F.in = args.in;
    F.out = args.out; F.ws = args.ws;
    unsigned char* ws = args.ws;
    const int lo = args.ph_lo, hi = args.ph_hi;
    volatile LAS unsigned* MISC = (volatile LAS unsigned*)(F.lds + 131072 + 512);
    if (F.tid < 32) MISC[F.tid] = 0u;
    __syncthreads();
    XcdBarrier bar = xcd_barrier_post((unsigned*)ws, MISC + 8);
#ifndef PHMASK
#define PHMASK 0x3ffff
#endif
#define IN(k) ((((PHMASK) >> (k)) & 1) && lo <= (k) && (k) < hi)
#define SEAM(k) do { if (IN(k) && IN((k) + 1)) { xcd_barrier(bar); } } while (0)
    typedef pg8::bf16_t gb;

#ifndef DUP0
#define DUP0 0
#endif
#ifndef DUP9
#define DUP9 0
#endif
#ifndef DUP2
#define DUP2 0
#endif
    if (DUP0) { p0_prologue(F); }
    if (IN(0)) { p0_prologue(F); } SEAM(0);
    if (IN(1)) {
        pg8::Gemm g{(const gb*)(ws + WS_XB), (const gb*)(ws + WS_WIN), T, INP, D, D, D, 0}; pg8::StaticOrder S; S.init(T, INP, F.G, (int)blockIdx.x, D);
        EpiProj E{(bf16*)(ws + WS_PROJA), (bf16*)(ws + WS_PROJB)};
        pg8::gemm_phase<EpiProj, pg8::StaticOrder, true, true>(F.lds, g, S, E);
    } SEAM(1);
    if (DUP2) { p2_rows(F); }
    if (IN(2)) { p2_rows(F); } SEAM(2);
    if (IN(3)) {
        pg8::Gemm g{(const gb*)(ws + WS_LA), (const gb*)(ws + WS_LORAT), T, 1536, 256, 256, 256, 0}; pg8::StaticOrder S; S.init(T, 1536, F.G, (int)blockIdx.x, 256);
        EpiLora E{F.in[12], F.in[14], F.in[18], (h16*)(ws + WS_SCW), (h16*)(ws + WS_SCK), (h16*)(ws + WS_SCKK), (h16*)(ws + WS_SCB), (h16*)(ws + WS_G)};
        pg8::gemm_phase<EpiLora, pg8::StaticOrder, true, true>(F.lds, g, S, E);
    } SEAM(3);
    if (IN(4)) { conv_phase(F); }
#ifndef DUP5
#define DUP5 0
#endif
#ifndef DUP4
#define DUP4 0
#endif
    if (DUP4) { conv_phase(F); }
    if (IN(5)) { scan_phase(F); } SEAM(5);
    if (DUP5) { scan_phase(F); xcd_barrier(bar); }
    if (IN(6)) { p6_rows(F); } SEAM(6);
    if (IN(7)) {
        pg8::Gemm g{(const gb*)(ws + WS_CAT), (const gb*)(ws + WS_WOUT), T, D, D, D, D, 0}; SplitOrder S; S.init(D, F.G, (int)blockIdx.x, D, 4);
        EpiResid E{F.in[0], F.in[1], (float*)(ws + WS_Z), nullptr, nullptr, (h16*)(ws + WS_PART7), nullptr};
        pg8::gemm_phase<EpiResid, SplitOrder, true, true>(F.lds, g, S, E);
    } SEAM(7);
    if (IN(8)) { ln_rows<0>(F, F.in[25], F.in[26], 4, (const h16*)(ws + WS_PART7), nullptr); } SEAM(8);
#define FFN_PHASES(layer, pgu, pdn) \
    if (IN(pgu)) { \
        pg8::Gemm g{(const gb*)(ws + WS_XB), (const gb*)(ws + ((layer) ? WS_WGU1 : WS_WGU0)), T, 2 * FF, D, D, D, 0}; pg8::StaticOrder S; S.init(T, 2 * FF, F.G, (int)blockIdx.x, D); \
        EpiGateUp E{(bf16*)(ws + WS_H)}; \
        pg8::gemm_phase<EpiGateUp, pg8::StaticOrder, true, true>(F.lds, g, S, E); \
    } SEAM(pgu); \
    if (IN(pdn)) { \
        pg8::Gemm g{(const gb*)(ws + WS_H), (const gb*)(ws + ((layer) ? WS_WD1 : WS_WD0)), T, D, FF, FF, FF, 0}; SplitOrder S; S.init(D, F.G, (int)blockIdx.x, FF, 11); \
        EpiResid E{nullptr, nullptr, (float*)(ws + WS_Z), nullptr, (const bf16*)(ws + WS_XR), (h16*)(ws + WS_PARTA), (h16*)(ws + WS_PARTB)}; \
        pg8::gemm_phase<EpiResid, SplitOrder, true, true>(F.lds, g, S, E); \
    } SEAM(pdn);
    if (DUP9) { pg8::Gemm g{(const gb*)(ws + WS_XB), (const gb*)(ws + WS_WGU0), T, 2 * FF, D, D, D, 0}; pg8::StaticOrder S; S.init(T, 2 * FF, F.G, (int)blockIdx.x, D);
        EpiGateUp E{(bf16*)(ws + WS_H)}; pg8::gemm_phase<EpiGateUp, pg8::StaticOrder, true, true>(F.lds, g, S, E); xcd_barrier(bar); }
    FFN_PHASES(0, 9, 10)
    if (IN(11)) { ln_rows<1>(F, F.in[30], F.in[31], 11, (const h16*)(ws + WS_PARTA), (const h16*)(ws + WS_PARTB)); } SEAM(11);
    if (IN(12)) { pool_phase(F); } SEAM(12);
    if (IN(13)) {
        pg8::Gemm g{(const gb*)(ws + WS_PL), (const gb*)(ws + WS_POOLT), T, D, 256, D, 256, 256}; pg8::StaticOrder S; S.init(T, D, F.G, (int)blockIdx.x, 256);
        EpiResid E{nullptr, nullptr, (float*)(ws + WS_Z), F.in[24], (const bf16*)(ws + WS_XR), nullptr, nullptr};
        pg8::gemm_phase<EpiResid, pg8::StaticOrder, true, true>(F.lds, g, S, E);
    } SEAM(13);
    if (IN(14)) { ln_rows<0>(F, F.in[25] + D, F.in[26] + D, 0, nullptr, nullptr); } SEAM(14);
    FFN_PHASES(1, 15, 16)
    if (IN(17)) { ln_rows<2>(F, F.in[30] + D, F.in[31] + D, 11, (const h16*)(ws + WS_PARTA), (const h16*)(ws + WS_PARTB)); }
    if (lo == 100) diag_checks(F, args.pad);
    if (lo == 101) diag_fill(F);
#undef IN
#undef SEAM
}

extern "C" void kernel_launch(void* const* d_in, const int* in_sizes, int n_in, void* d_out, int out_size, void* d_ws, size_t ws_size, hipStream_t stream) {
    static int grid = 0;
    if (grid == 0) {
        if (n_in != 32 || out_size != (int)O_TOTAL || ws_size < WS_END) { fprintf(stderr, "kernel_launch: unexpected shapes: n_in %d out %d ws %zu\n", n_in, out_size, ws_size); grid = -1; return; }
        int dev = 0, cus = 0, per_cu = 0;
        if (hipGetDevice(&dev) != hipSuccess || hipDeviceGetAttribute(&cus, hipDeviceAttributeMultiprocessorCount, dev) != hipSuccess) { grid = -1; return; }
        if (hipFuncSetAttribute((const void*)mk_fwd, hipFuncAttributeMaxDynamicSharedMemorySize, LDS_BYTES) != hipSuccess) { fprintf(stderr, "kernel_launch: hipFuncSetAttribute failed\n"); grid = -1; return; }
        if (hipOccupancyMaxActiveBlocksPerMultiprocessor(&per_cu, (const void*)mk_fwd, NTHREADS, LDS_BYTES) != hipSuccess || per_cu < 1) { fprintf(stderr, "kernel_launch: occupancy query says %d\n", per_cu); (void)hipGetLastError(); per_cu = 1; }
        grid = cus * 1;
        if (per_cu < 1) grid = -1;
    }
    if (grid < 0) return;
    Args a{};
    for (int i = 0; i < 32; ++i) a.in[i] = (const float*)d_in[i];
    a.out = (float*)d_out; a.ws = (unsigned char*)d_ws;
#if MK_SINGLE
    if (hipMemsetAsync(d_ws, 0, 16384, stream) != hipSuccess) { fprintf(stderr, "kernel_launch: memset failed\n"); return; }
    a.ph_lo = 0; a.ph_hi = NPHASE; a.coop = 1;
    void* params[] = {&a};
    hipError_t e = hipLaunchCooperativeKernel((const void*)mk_fwd, dim3(grid), dim3(NTHREADS), params, LDS_BYTES, stream);
    if (e != hipSuccess) fprintf(stderr, "kernel_launch: cooperative launch failed: %s (grid %d)\n", hipGetErrorString(e), grid);
#else
    for (int p = 0; p < NPHASE; ++p) {
        if (DIAG_AT >= 0 && p > DIAG_AT) break;
        a.ph_lo = p; a.ph_hi = p + 1; a.coop = 0;
        hipLaunchKernelGGL(mk_fwd, dim3(grid), dim3(NTHREADS), LDS_BYTES, stream, a);
    }
    if (DIAG_AT >= 0) { a.pad = DIAG_AT; a.ph_lo = 100; a.ph_hi = 101; hipLaunchKernelGGL(mk_fwd, dim3(grid), dim3(NTHREADS), LDS_BYTES, stream, a);
                        a.ph_lo = 101; a.ph_hi = 102; hipLaunchKernelGGL(mk_fwd, dim3(grid), dim3(NTHREADS), LDS_BYTES, stream, a); }
#endif
}
```

```cpp
#include <hip/hip_runtime.h>
#include <hip/hip_cooperative_groups.h>
#include <cstdio>
#include <cstdint>
namespace cg = cooperative_groups;
namespace pg8 {
#define PG8_LAS __attribute__((address_space(3)))
typedef unsigned short bf16_t;
typedef short bf16x8 __attribute__((ext_vector_type(8)));
typedef float f32x4 __attribute__((ext_vector_type(4)));
typedef unsigned u32x4 __attribute__((ext_vector_type(4)));
constexpr int BM = 256, BK = 64, HALF = 128, HTB = HALF * BK * 2  , STAGE_BYTES = 8 * HTB, NXCD = 8, WGM = 8;

__host__ __device__ __forceinline__ int lds_byte(int r, int c) { const int st = (r >> 4) * 2 + (c >> 5), rr = r & 15, cc = c & 31, ob = rr * 64 + cc * 2; return st * 1024 + (ob ^ (((ob >> 9) & 1) << 5)); }
__host__ __device__ __forceinline__ void stage_rc(int b, int& R, int& C) { const int st = b / 1024, sb = b % 1024, swz = sb ^ (((sb >> 9) & 1) << 5); R = (st >> 1) * 16 + swz / 64; C = (st & 1) * 32 + (swz % 64) / 2; }
__host__ __device__ __forceinline__ int perm32(int rho) { const int n = rho >> 4, i = rho & 15; return 8 * (i >> 2) + 4 * n + (i & 3); }

struct Unit { int pm, pn, kt0, nt, mode; };
struct Gemm { const bf16_t* A; const bf16_t* Bt; int M, N, K, lda, ldb, acol; };

struct StaticOrder {
    int nM, nN, nwg, G, c, ntf;
    __host__ __device__ void init(int M, int N, int G_, int c_, int K_) { nM = M / BM; nN = N / BM; nwg = nM * nN; G = G_; c = c_; ntf = K_ / BK; }
    __host__ __device__ bool next(int i, Unit& u) const {
        const long L = (long)i * G + c; if (L >= nwg) return false;
        int wgid = (int)L; { const int q = nwg / NXCD, r = nwg % NXCD, xcd = wgid % NXCD, off = wgid / NXCD; wgid = (xcd < r ? xcd * (q + 1) : r * (q + 1) + (xcd - r) * q) + off; }
        const int nig = WGM * nN, gid = wgid / nig, fm = gid * WGM, gsz = (nM - fm) < WGM ? (nM - fm) : WGM;
        u.pm = fm + ((wgid % nig) % gsz); u.pn = (wgid % nig) / gsz; u.kt0 = 0; u.nt = ntf; u.mode = 0; return true;
    }
    __device__ __forceinline__ void a_ready(const Unit&) const {}
    __device__ __forceinline__ void done(const Unit&) const {}
};

__device__ __forceinline__ unsigned cvt_pk_bf16(float lo, float hi) { unsigned r; asm volatile("v_cvt_pk_bf16_f32 %0, %1, %2" : "=v"(r) : "v"(lo), "v"(hi)); return r; }
template <class Epi, class Sched, bool ALIGN_EPI = false, bool SP2 = false>
__device__ __forceinline__ void gemm_phase(PG8_LAS unsigned char* lds, const Gemm g, const Sched& S, const Epi& E) {
    const int tid = threadIdx.x, wid = __builtin_amdgcn_readfirstlane(tid >> 6), lane = tid & 63, wr = wid >> 2, wc = wid & 3, fr = lane & 15, fq = lane >> 4;
    const int K = g.K; (void)K;
    unsigned voffA[2], voffB[2];
#pragma unroll
    for (int i = 0; i < 2; ++i) { int R, C; stage_rc(tid * 16 + i * 8192, R, C); const int Rb = Epi::PERM ? ((R & ~31) + perm32(R & 31)) : R;
        voffA[i] = (unsigned)(R * g.lda + C) * 2u; voffB[i] = (unsigned)(Rb * g.ldb + C) * 2u; }
    const size_t kstep = (size_t)(BK * 2);
    const size_t hstepA = (size_t)HALF * g.lda * 2, hstepB = (size_t)HALF * g.ldb * 2;
    const size_t tstepA = 2 * hstepA, tstepB = 2 * hstepB; const size_t acolB = (size_t)g.acol * 2;
    const unsigned ldsw = (unsigned)wid * 1024u;
    const int aoff = lds_byte(wr * 64 + fr, fq * 8), boff = lds_byte(wc * 32 + fr, fq * 8);
#define PG8_SA(b, h) (((b) * 2 + (h)) * HTB)
#define PG8_SB(b, h) ((4 + (b) * 2 + (h)) * HTB)
#define PG8_STAGE(bufoff, gbase, voff) do { _Pragma("unroll") for (int _i = 0; _i < 2; ++_i) \
        __builtin_amdgcn_global_load_lds((const unsigned*)((const char*)(gbase) + (voff)[_i]), (PG8_LAS unsigned*)(lds + (bufoff) + ldsw + _i * 8192), 16, 0, 0); } while (0)
#define PG8_LDA(dst, b, h) do { _Pragma("unroll") for (int m = 0; m < 4; ++m) _Pragma("unroll") for (int k = 0; k < 2; ++k) dst[m][k] = *(const PG8_LAS bf16x8*)(lds + PG8_SA(b, h) + aoff + m * 2048 + k * 1024); } while (0)
#define PG8_LDB(dst, b, h) do { _Pragma("unroll") for (int n = 0; n < 2; ++n) _Pragma("unroll") for (int k = 0; k < 2; ++k) dst[n][k] = *(const PG8_LAS bf16x8*)(lds + PG8_SB(b, h) + boff + n * 2048 + k * 1024); } while (0)
#define PG8_MMA(ai, bj, At, Bt) do { __builtin_amdgcn_s_setprio(1); _Pragma("unroll") for (int m = 0; m < 4; ++m) _Pragma("unroll") for (int n = 0; n < 2; ++n) _Pragma("unroll") for (int k = 0; k < 2; ++k) \
        acc[ai][bj][m][n] = __builtin_amdgcn_mfma_f32_16x16x32_bf16(Bt[n][k], At[m][k], acc[ai][bj][m][n], 0, 0, 0); __builtin_amdgcn_s_setprio(0); } while (0)
#define PG8_WAIT_V(n) asm volatile("s_waitcnt vmcnt(" #n ")" ::: "memory")
#define PG8_WAIT_L(n) asm volatile("s_waitcnt lgkmcnt(" #n ")" ::: "memory")
#define PG8_BAR __builtin_amdgcn_s_barrier()
#define PG8_SCHED __builtin_amdgcn_sched_barrier(0)
    Unit cur, nxt; int ui = 0;
    if (!S.next(0, cur)) return;
    f32x4 acc[2][2][4][2];
#pragma unroll
    for (int a = 0; a < 2; ++a)
#pragma unroll
        for (int b = 0; b < 2; ++b)
#pragma unroll
            for (int m = 0; m < 4; ++m)
#pragma unroll
                for (int n = 0; n < 2; ++n) acc[a][b][m][n] = (f32x4){0.f, 0.f, 0.f, 0.f};
    bf16x8 At[4][2], B0[2][2], B1[2][2];
    const char* cA = (const char*)g.A + (size_t)cur.pm * tstepA + (size_t)cur.pn * acolB + (size_t)cur.kt0 * kstep; const char* cB = (const char*)g.Bt + (size_t)cur.pn * tstepB + (size_t)cur.kt0 * kstep;
    S.a_ready(cur);
    if constexpr (SP2) {
        PG8_STAGE(PG8_SB(0, 0), cB, voffB); PG8_STAGE(PG8_SB(0, 1), cB + hstepB, voffB); PG8_STAGE(PG8_SA(0, 0), cA, voffA); PG8_STAGE(PG8_SA(0, 1), cA + hstepA, voffA);
        if (wr == 1) PG8_BAR;
        PG8_WAIT_V(2); PG8_BAR;
        PG8_STAGE(PG8_SB(1, 0), cB + kstep, voffB); PG8_STAGE(PG8_SA(1, 0), cA + kstep, voffA); PG8_STAGE(PG8_SB(1, 1), cB + hstepB + kstep, voffB);
        PG8_WAIT_V(6); PG8_BAR;
    } else {
        PG8_STAGE(PG8_SB(0, 0), cB, voffB); PG8_STAGE(PG8_SA(0, 0), cA, voffA); PG8_STAGE(PG8_SB(0, 1), cB + hstepB, voffB); PG8_STAGE(PG8_SA(0, 1), cA + hstepA, voffA);
        if (wr == 1) PG8_BAR;
        PG8_WAIT_V(4); PG8_BAR;
        PG8_STAGE(PG8_SB(1, 0), cB + kstep, voffB); PG8_STAGE(PG8_SA(1, 0), cA + kstep, voffA); PG8_STAGE(PG8_SB(1, 1), cB + hstepB + kstep, voffB);
        PG8_WAIT_V(6); PG8_BAR;
    }
    for (;;) {
        const bool has_next = S.next(ui + 1, nxt);
        const char* nA = has_next ? (const char*)g.A + (size_t)nxt.pm * tstepA + (size_t)nxt.pn * acolB + (size_t)nxt.kt0 * kstep : cA; const char* nB = has_next ? (const char*)g.Bt + (size_t)nxt.pn * tstepB + (size_t)nxt.kt0 * kstep : cB;
        const int nt = cur.nt;
        _Pragma("unroll 1") for (int t = 0; t < nt; t += 2) {
            const bool last = (t == nt - 2);
            const char* a1 = cA + (size_t)(t + 1) * kstep;
            const char* a2 = last ? nA : cA + (size_t)(t + 2) * kstep; const char* b2 = last ? nB : cB + (size_t)(t + 2) * kstep;
            const char* a3 = a2 + kstep; const char* b3 = b2 + kstep;
            if (last && has_next) S.a_ready(nxt);
            if constexpr (SP2) {
            PG8_LDB(B0, 0, 0); PG8_LDB(B1, 0, 1); PG8_SCHED; PG8_LDA(At, 0, 0); PG8_STAGE(PG8_SA(1, 1), a1 + hstepA, voffA);
            PG8_WAIT_V(8); PG8_WAIT_L(0); PG8_BAR; PG8_MMA(0, 0, At, B0); PG8_MMA(0, 1, At, B1); PG8_BAR; PG8_SCHED;
            PG8_LDA(At, 0, 1); PG8_STAGE(PG8_SB(0, 0), b2, voffB); PG8_STAGE(PG8_SB(0, 1), b2 + hstepB, voffB); PG8_STAGE(PG8_SA(0, 0), a2, voffA);
            PG8_WAIT_V(8); PG8_WAIT_L(0); PG8_BAR; PG8_MMA(1, 0, At, B0); PG8_MMA(1, 1, At, B1); PG8_BAR; PG8_SCHED;
            PG8_LDB(B0, 1, 0); PG8_LDB(B1, 1, 1); PG8_SCHED; PG8_LDA(At, 1, 0); PG8_STAGE(PG8_SA(0, 1), a2 + hstepA, voffA);
            PG8_WAIT_V(8); PG8_WAIT_L(0); PG8_BAR; PG8_MMA(0, 0, At, B0); PG8_MMA(0, 1, At, B1); PG8_BAR; PG8_SCHED;
            PG8_LDA(At, 1, 1); PG8_STAGE(PG8_SB(1, 0), b3, voffB); PG8_STAGE(PG8_SB(1, 1), b3 + hstepB, voffB); PG8_STAGE(PG8_SA(1, 0), a3, voffA);
            PG8_WAIT_V(8); PG8_WAIT_L(0); PG8_BAR; PG8_MMA(1, 0, At, B0); PG8_MMA(1, 1, At, B1); PG8_BAR; PG8_SCHED;
            } else {
            PG8_LDB(B0, 0, 0); PG8_SCHED; PG8_LDA(At, 0, 0); PG8_STAGE(PG8_SA(1, 1), a1 + hstepA, voffA);
            PG8_WAIT_L(8); PG8_BAR; PG8_WAIT_L(0); PG8_MMA(0, 0, At, B0); PG8_BAR; PG8_SCHED;
            PG8_LDB(B1, 0, 1); PG8_STAGE(PG8_SB(0, 0), b2, voffB);
            PG8_BAR; PG8_WAIT_L(0); PG8_MMA(0, 1, At, B1); PG8_BAR;
            PG8_LDA(At, 0, 1); PG8_STAGE(PG8_SA(0, 0), a2, voffA);
            PG8_BAR; PG8_WAIT_L(0); PG8_MMA(1, 0, At, B0); PG8_BAR; PG8_SCHED;
            PG8_STAGE(PG8_SB(0, 1), b2 + hstepB, voffB);
            PG8_WAIT_V(6); PG8_BAR; PG8_MMA(1, 1, At, B1); PG8_BAR;
            PG8_LDB(B0, 1, 0); PG8_SCHED; PG8_LDA(At, 1, 0); PG8_STAGE(PG8_SA(0, 1), a2 + hstepA, voffA);
            PG8_WAIT_L(8); PG8_BAR; PG8_WAIT_L(0); PG8_MMA(0, 0, At, B0); PG8_BAR; PG8_SCHED;
            PG8_LDB(B1, 1, 1); PG8_STAGE(PG8_SB(1, 0), b3, voffB);
            PG8_BAR; PG8_WAIT_L(0); PG8_MMA(0, 1, At, B1); PG8_BAR;
            PG8_LDA(At, 1, 1); PG8_STAGE(PG8_SA(1, 0), a3, voffA);
            PG8_BAR; PG8_WAIT_L(0); PG8_MMA(1, 0, At, B0); PG8_BAR; PG8_SCHED;
            PG8_STAGE(PG8_SB(1, 1), b3 + hstepB, voffB);
            PG8_WAIT_V(6); PG8_BAR; PG8_MMA(1, 1, At, B1); PG8_BAR;
            }
        }
        if constexpr (ALIGN_EPI) { if (wr == 0) PG8_BAR; }
        if constexpr (!Epi::AFTER_DRAIN) { E(acc, cur, wr, wc, fr, fq); S.done(cur); }
        if (!has_next) break;
#pragma unroll
        for (int a = 0; a < 2; ++a)
#pragma unroll
            for (int b = 0; b < 2; ++b)
#pragma unroll
                for (int m = 0; m < 4; ++m)
#pragma unroll
                    for (int n = 0; n < 2; ++n) acc[a][b][m][n] = (f32x4){0.f, 0.f, 0.f, 0.f};
        cur = nxt; cA = nA; cB = nB; ++ui;
        if constexpr (ALIGN_EPI) { if (wr == 1) PG8_BAR; }
    }
    PG8_WAIT_V(0);
    if constexpr (!ALIGN_EPI) { if (wr == 0) PG8_BAR; }
    PG8_BAR;
    if constexpr (Epi::AFTER_DRAIN) { E.fused(acc, cur, wr, wc, fr, fq, lds, wid, lane); S.done(cur); }
#undef PG8_SA
#undef PG8_SB
#undef PG8_STAGE
#undef PG8_LDA
#undef PG8_LDB
#undef PG8_MMA
#undef PG8_WAIT_V
#undef PG8_WAIT_L
#undef PG8_BAR
#undef PG8_SCHED
}
}

#define GAS __attribute__((address_space(1)))
#define LAS __attribute__((address_space(3)))
typedef unsigned short bf16;
typedef unsigned v4u __attribute__((ext_vector_type(4)));
typedef unsigned v2u __attribute__((ext_vector_type(2)));
typedef float f32x4 __attribute__((ext_vector_type(4)));
typedef _Float16 h16;
typedef _Float16 h16x2 __attribute__((ext_vector_type(2)));

#ifndef MK_SINGLE
#define MK_SINGLE 1
#endif

constexpr int NWAVES = 8, NTHREADS = NWAVES * 64;
constexpr int D = 1024, TP = 16384, TS = 1024, T = TP + TS, LP = 2048, LS = 8, NPB = 8, NSB = 128;
constexpr int INP = 2816, BP = 1792, FF = 2816, HW = 512;
constexpr float ALPHA = 1.41421356237309515f, LN_EPS = 1e-5f, GN_EPS = 64e-5f;
constexpr int NPHASE = 18;

constexpr size_t MiB = 1u << 20;
constexpr size_t WS_WIN = 1 * MiB, WS_WOUT = WS_WIN + 5632 * 1024, WS_WGU0 = WS_WOUT + 2 * MiB, WS_WGU1 = WS_WGU0 + 11 * MiB, WS_WD0 = WS_WGU1 + 11 * MiB, WS_WD1 = WS_WD0 + 5632 * 1024,
                 WS_POOLT = WS_WD1 + 5632 * 1024, WS_LORAT = WS_POOLT + 512 * 1024;
constexpr size_t WS_XB = 43 * MiB;
constexpr size_t WS_SCW = 43 * MiB, WS_G = 60 * MiB;
constexpr size_t WS_PROJA = 77 * MiB;
constexpr size_t WS_PROJB = 111 * MiB;
constexpr size_t WS_CAT = 111 * MiB, WS_SCB = 145 * MiB, WS_O = 162 * MiB;
constexpr size_t WS_LA = 170 * MiB + 512 * 1024;
constexpr size_t WS_SCR = 179 * MiB, WS_SCV = 196 * MiB, WS_SCK = 213 * MiB, WS_SCKK = 230 * MiB;
constexpr size_t WS_Z = 222 * MiB;
constexpr size_t WS_H = 77 * MiB;
constexpr size_t WS_PL = 77 * MiB;
constexpr size_t WS_PART7 = 145 * MiB;
constexpr size_t WS_PARTA = 170 * MiB + 512 * 1024, WS_PARTB = 1 * MiB;
constexpr size_t WS_XR = 43 * MiB;
constexpr size_t WS_END = 256 * MiB;
static_assert(WS_LORAT + 1536 * 256 * 2 <= WS_XB, "weights");
static_assert(WS_PROJB + (size_t)T * BP * 2 <= WS_LA, "projb");
static_assert(WS_H + (size_t)T * FF * 2 <= WS_Z, "h");
static_assert(WS_Z + (size_t)T * D * 2 <= WS_END, "z");

constexpr size_t O_Y = 0, O_CONV_P = 17825792, O_SHIFT_P = 17948672, O_WKV_P = 17963008, O_POOL_P = 18225152,
                 O_CONV_S = 18348032, O_SHIFT_S = 20314112, O_WKV_S = 20543488, O_POOL_S = 24737792, O_TOTAL = 26703872;

constexpr int LDS_BYTES = 147456;

struct Frame {
    LAS unsigned char* lds;
    int tid, lane, wave, vcu, G;
    const float* const* in;
    float* out; unsigned char* ws;
};

__device__ __forceinline__ float bf2f(unsigned b) { return __uint_as_float(b << 16); }
__device__ __forceinline__ unsigned pkbf(float lo, float hi) { return pg8::cvt_pk_bf16(lo, hi); }
__device__ __forceinline__ unsigned pkh(float lo, float hi) { const unsigned short a = __builtin_bit_cast(unsigned short, (h16)lo), b = __builtin_bit_cast(unsigned short, (h16)hi); return (unsigned)a | ((unsigned)b << 16); }
__device__ __forceinline__ float hlo(unsigned u) { return (float)__builtin_bit_cast(h16, (unsigned short)(u & 0xffffu)); }
__device__ __forceinline__ float hhi(unsigned u) { return (float)__builtin_bit_cast(h16, (unsigned short)(u >> 16)); }
__device__ __forceinline__ void unpack_bf8(v4u w, float (&f)[8]) { const unsigned u0 = w.x, u1 = w.y, u2 = w.z, u3 = w.w;
    f[0] = __uint_as_float(u0 << 16); f[1] = __uint_as_float(u0 & 0xffff0000u); f[2] = __uint_as_float(u1 << 16); f[3] = __uint_as_float(u1 & 0xffff0000u);
    f[4] = __uint_as_float(u2 << 16); f[5] = __uint_as_float(u2 & 0xffff0000u); f[6] = __uint_as_float(u3 << 16); f[7] = __uint_as_float(u3 & 0xffff0000u); }
__device__ __forceinline__ void unpack_h8(v4u w, float (&f)[8]) { const unsigned u0 = w.x, u1 = w.y, u2 = w.z, u3 = w.w; f[0] = hlo(u0); f[1] = hhi(u0); f[2] = hlo(u1); f[3] = hhi(u1); f[4] = hlo(u2); f[5] = hhi(u2); f[6] = hlo(u3); f[7] = hhi(u3); }
__device__ __forceinline__ v4u pack_bf8(const float (&f)[8]) { v4u w; w.x = pkbf(f[0], f[1]); w.y = pkbf(f[2], f[3]); w.z = pkbf(f[4], f[5]); w.w = pkbf(f[6], f[7]); return w; }
__device__ __forceinline__ v4u pack_h8(const float (&f)[8]) { v4u w; w.x = pkh(f[0], f[1]); w.y = pkh(f[2], f[3]); w.z = pkh(f[4], f[5]); w.w = pkh(f[6], f[7]); return w; }
__device__ __forceinline__ void load_f8(const float* p, float (&f)[8]) { const f32x4 a = *(const f32x4*)p, b = *(const f32x4*)(p + 4); f[0] = a.x; f[1] = a.y; f[2] = a.z; f[3] = a.w; f[4] = b.x; f[5] = b.y; f[6] = b.z; f[7] = b.w; }
__device__ __forceinline__ void store_f8(float* p, const float (&f)[8]) { *(f32x4*)p = (f32x4){f[0], f[1], f[2], f[3]}; *(f32x4*)(p + 4) = (f32x4){f[4], f[5], f[6], f[7]}; }
__device__ __forceinline__ float sigmoid_(float x) { return __builtin_amdgcn_rcpf(1.f + __expf(-x)); }
__device__ __forceinline__ float silu_(float x) { return x * sigmoid_(x); }
__device__ __forceinline__ float wave_sum(float v) {
#pragma unroll
    for (int o = 1; o < 64; o <<= 1) v += __shfl_xor(v, o);
    return v;
}
__device__ __forceinline__ float sum8(float v) { v += __shfl_xor(v, 1); v += __shfl_xor(v, 2); v += __shfl_xor(v, 4); return v; }
template <int CTRL> __device__ __forceinline__ float dppf(float x) { return __builtin_bit_cast(float, __builtin_amdgcn_update_dpp(0, __builtin_bit_cast(int, x), CTRL, 0xF, 0xF, true)); }
__device__ __forceinline__ float dpp_sum16(float x) {
    x += dppf<0xB1>(x);
    x += dppf<0x4E>(x);
    x += dppf<0x141>(x);
    x += dppf<0x140>(x);
    return x;
}
__device__ __forceinline__ void h4(v2u x, float (&f)[4]) { const unsigned u0 = x.x, u1 = x.y; f[0] = hlo(u0); f[1] = hhi(u0); f[2] = hlo(u1); f[3] = hhi(u1); }
__device__ __forceinline__ const float* xrow_ptr(const Frame& F, int m) { return m < TP ? F.in[0] + (size_t)m * D : F.in[1] + (size_t)(m - TP) * D; }

using pg8::Unit; using pg8::HALF; using pg8::BM;
typedef pg8::u32x4 u32x4;
struct EpiProj {
    static constexpr bool PERM = true, AFTER_DRAIN = false;
    bf16* PA; bf16* PB;
    __device__ __forceinline__ void operator()(const pg8::f32x4 (&acc)[2][2][4][2], const Unit& u, int wr, int wc, int fr, int fq) const {
        const int row0 = u.pm * BM + wr * 64 + fr;
        if (u.pn < 4) {
            const int col0 = u.pn * HALF + wc * 32 + 8 * fq;
#pragma unroll
            for (int ai = 0; ai < 2; ++ai)
#pragma unroll
                for (int m = 0; m < 4; ++m) {
                    const pg8::f32x4 v0 = acc[ai][0][m][0], v1 = acc[ai][0][m][1], g0 = acc[ai][1][m][0], g1 = acc[ai][1][m][1];
                    u32x4 w; w.x = pkbf(v0[0] * sigmoid_(g0[0]), v0[1] * sigmoid_(g0[1])); w.y = pkbf(v0[2] * sigmoid_(g0[2]), v0[3] * sigmoid_(g0[3]));
                    w.z = pkbf(v1[0] * sigmoid_(g1[0]), v1[1] * sigmoid_(g1[1])); w.w = pkbf(v1[2] * sigmoid_(g1[2]), v1[3] * sigmoid_(g1[3]));
                    *(u32x4*)(PA + (size_t)(row0 + ai * HALF + m * 16) * 512 + col0) = w;
                }
        } else {
            const int col0 = (u.pn - 4) * BM + wc * 32 + 8 * fq;
#pragma unroll
            for (int ai = 0; ai < 2; ++ai)
#pragma unroll
                for (int m = 0; m < 4; ++m) { bf16* rowp = PB + (size_t)(row0 + ai * HALF + m * 16) * BP + col0;
#pragma unroll
                    for (int bj = 0; bj < 2; ++bj) { const pg8::f32x4 v0 = acc[ai][bj][m][0], v1 = acc[ai][bj][m][1];
                        u32x4 w; w.x = pkbf(v0[0], v0[1]); w.y = pkbf(v0[2], v0[3]); w.z = pkbf(v1[0], v1[1]); w.w = pkbf(v1[2], v1[3]);
                        *(u32x4*)(rowp + bj * HALF) = w; } }
        }
    }
};
struct EpiLora {
    static constexpr bool PERM = true, AFTER_DRAIN = false;
    const float* w0; const float* a0; const float* ka;
    h16* SCW; h16* SCK; h16* SCKK; h16* SCB; h16* G;
    __device__ __forceinline__ void operator()(const pg8::f32x4 (&acc)[2][2][4][2], const Unit& u, int wr, int wc, int fr, int fq) const {
        const int row0 = u.pm * BM + wr * 64 + fr; const int sec = u.pn >> 1;
        const int c0 = (u.pn & 1) * BM + wc * 32 + 8 * fq;
#pragma unroll
        for (int bj = 0; bj < 2; ++bj) {
            const int c = c0 + bj * HALF;
            float p0[8], p1[8];
            if (sec == 0) load_f8(w0 + c, p0); else if (sec == 1) { load_f8(a0 + c, p0); load_f8(ka + c, p1); }
#pragma unroll
            for (int ai = 0; ai < 2; ++ai) {
                v4u kxr[4], kkr[4];
                if (sec == 1) {
#pragma unroll
                    for (int m = 0; m < 4; ++m) { const size_t off = (size_t)(row0 + ai * HALF + m * 16) * HW + c; kxr[m] = *(const v4u*)(SCK + off); kkr[m] = *(const v4u*)(SCKK + off); }
                }
#pragma unroll
                for (int m = 0; m < 4; ++m) {
                    const size_t off = (size_t)(row0 + ai * HALF + m * 16) * HW + c;
                    const pg8::f32x4 v0 = acc[ai][bj][m][0], v1 = acc[ai][bj][m][1];
                    const float v[8] = {v0[0], v0[1], v0[2], v0[3], v1[0], v1[1], v1[2], v1[3]};
                    if (sec == 0) {
                        float o[8];
#pragma unroll
                        for (int i = 0; i < 8; ++i) { const float e = 0.60653065971f * sigmoid_(p0[i] + v[i]); o[i] = 1.f - __expf(-e); }
                        *(v4u*)(SCW + off) = pack_h8(o);
                    } else if (sec == 1) {
                        float kx[8], kk[8], ko[8], bo[8];
                        unpack_h8(kxr[m], kx); unpack_h8(kkr[m], kk);
#pragma unroll
                        for (int i = 0; i < 8; ++i) { const float a = sigmoid_(p0[i] + v[i]); ko[i] = kx[i] * (1.f + (a - 1.f) * p1[i]); bo[i] = kk[i] * a; }
                        *(v4u*)(SCK + off) = pack_h8(ko); *(v4u*)(SCB + off) = pack_h8(bo);
                    } else {
                        *(v4u*)(G + off) = pack_h8(v);
                    }
                }
                asm volatile("" ::: "memory");
            }
        }
    }
};
struct EpiGateUp {
    static constexpr bool PERM = true, AFTER_DRAIN = false;
    bf16* H;
    __device__ __forceinline__ void operator()(const pg8::f32x4 (&acc)[2][2][4][2], const Unit& u, int wr, int wc, int fr, int fq) const {
        const int row0 = u.pm * BM + wr * 64 + fr; const int col0 = u.pn * HALF + wc * 32 + 8 * fq;
#pragma unroll
        for (int ai = 0; ai < 2; ++ai)
#pragma unroll
            for (int m = 0; m < 4; ++m) {
                const pg8::f32x4 g0 = acc[ai][0][m][0], g1 = acc[ai][0][m][1], u0 = acc[ai][1][m][0], u1 = acc[ai][1][m][1];
                u32x4 w; w.x = pkbf(silu_(g0[0]) * u0[0], silu_(g0[1]) * u0[1]); w.y = pkbf(silu_(g0[2]) * u0[2], silu_(g0[3]) * u0[3]);
                w.z = pkbf(silu_(g1[0]) * u1[0], silu_(g1[1]) * u1[1]); w.w = pkbf(silu_(g1[2]) * u1[2], silu_(g1[3]) * u1[3]);
                *(u32x4*)(H + (size_t)(row0 + ai * HALF + m * 16) * FF + col0) = w;
            }
    }
};
struct EpiResid {
    static constexpr bool PERM = true, AFTER_DRAIN = false;
    const float* xp; const float* xs; bf16* Z; const float* scale;
    const bf16* XBr;
    h16* pa; h16* pb;
    __device__ __forceinline__ void operator()(const pg8::f32x4 (&acc)[2][2][4][2], const Unit& u, int wr, int wc, int fr, int fq) const {
        const int col0 = u.pn * BM + wc * 32 + 8 * fq;
        float sc[2][8];
#pragma unroll
        for (int bj = 0; bj < 2; ++bj) { if (scale) load_f8(scale + col0 + bj * HALF, sc[bj]); else {
#pragma unroll
                for (int i = 0; i < 8; ++i) sc[bj][i] = 1.f; } }
#pragma unroll
        for (int ai = 0; ai < 2; ++ai)
#pragma unroll
            for (int m = 0; m < 4; ++m) {
                const int row = u.pm * BM + ai * HALF + wr * 64 + m * 16 + fr;
#pragma unroll
                for (int bj = 0; bj < 2; ++bj) {
                    const int c = col0 + bj * HALF;
                    const pg8::f32x4 a0 = acc[ai][bj][m][0], a1 = acc[ai][bj][m][1];
                    float a[8] = {a0[0] * sc[bj][0], a0[1] * sc[bj][1], a0[2] * sc[bj][2], a0[3] * sc[bj][3], a1[0] * sc[bj][4], a1[1] * sc[bj][5], a1[2] * sc[bj][6], a1[3] * sc[bj][7]};
                    if (u.mode == 1) {
                        const int sp = u.kt0 / u.nt;
                        h16* pr = (sp < 8 ? pa + (size_t)sp * (1u << 20) : pb + (size_t)(sp - 8) * (1u << 20)) + (size_t)(row - TP) * D + c;
                        *(v4u*)pr = pack_h8(a);
                    } else {
                        float b[8];
                        if (xp) load_f8((row < TP ? xp + (size_t)row * D : xs + (size_t)(row - TP) * D) + c, b);
                        else unpack_bf8(*(const v4u*)(XBr + (size_t)row * D + c), b);
#pragma unroll
                        for (int i = 0; i < 8; ++i) a[i] = ALPHA * b[i] + a[i];
                        *(v4u*)(Z + (size_t)row * D + c) = pack_bf8(a);
                    }
                }
            }
    }
};

struct SplitOrder {
    pg8::StaticOrder base; int NS, ntc, c;
    __device__ void init(int N, int G, int c_, int K, int NS_) { base.init(TP, N, G, c_, K); NS = NS_; ntc = (K / pg8::BK) / NS_; c = c_; }
    __device__ bool next(int i, Unit& u) const {
        if (i == 0) return base.next(0, u);
        if (i == 1) { if (c >= 16 * NS) return false; const int unit = c / NS, sp = c % NS; u.pm = 64 + (unit >> 2); u.pn = unit & 3; u.kt0 = sp * ntc; u.nt = ntc; u.mode = 1; return true; }
        return false;
    }
    __device__ __forceinline__ void a_ready(const Unit&) const {}
    __device__ __forceinline__ void done(const Unit&) const {}
};

__device__ __forceinline__ void transpose_item(const float* W, int K, int N, bf16* WT, int mode, LAS float* scr, int item, int lane) {
    const int nblk = N / 32, kb = item / nblk, nb = item % nblk, k0 = 64 * kb, n0 = 32 * nb;
    int drow0;
    if (mode == 0) drow0 = n0;
    else if (mode == 3) drow0 = n0 >= 1024 ? n0 : (n0 < 512 ? ((n0 >> 7) * 256 + (n0 & 127)) : ((((n0 - 512) >> 7) * 256) + 128 + ((n0 - 512) & 127)));
    else drow0 = (n0 >> 7) * 256 + (mode == 2 ? 128 : 0) + (n0 & 127);
    float tv[32];
#pragma unroll
    for (int i = 0; i < 32; ++i) { const int kk = 2 * i + (lane >> 5); tv[i] = W[(size_t)(k0 + kk) * N + n0 + (lane & 31)]; }
#pragma unroll
    for (int i = 0; i < 32; ++i) { const int kk = 2 * i + (lane >> 5); scr[kk * 33 + (lane & 31)] = tv[i]; }
    asm volatile("s_waitcnt lgkmcnt(0)" ::: "memory");
    const int c = lane & 7;
#pragma unroll
    for (int j = 0; j < 4; ++j) { const int n = (lane >> 3) + 8 * j; const LAS float* s = scr + (8 * c) * 33 + n;
        v4u o; o.x = pkbf(s[0 * 33], s[1 * 33]); o.y = pkbf(s[2 * 33], s[3 * 33]); o.z = pkbf(s[4 * 33], s[5 * 33]); o.w = pkbf(s[6 * 33], s[7 * 33]);
        *(v4u*)(WT + (size_t)(drow0 + n) * K + k0 + 8 * c) = o; }
    asm volatile("s_waitcnt lgkmcnt(0)" ::: "memory");
}
__device__ __forceinline__ void p0_prologue(Frame& F) {
    LAS float* scr = (LAS float*)(F.lds + F.wave * 16384);
    const int gw = F.vcu * NWAVES + F.wave, NGW = F.G * NWAVES;
    unsigned char* ws = F.ws;
    constexpr int I_IN = 16 * 88, I_OUT = 16 * 32, I_GU = 16 * 88, I_DN = 44 * 32, I_PL = 4 * 8;
    constexpr int NITEMS = I_IN + I_OUT + 2 * (2 * I_GU + I_DN) + 4 * I_PL;
    for (int it = gw; it < NITEMS; it += NGW) {
        int r = it;
        if (r < I_IN) { transpose_item(F.in[6], D, INP, (bf16*)(ws + WS_WIN), 3, scr, r, F.lane); continue; } r -= I_IN;
        if (r < I_OUT) { transpose_item(F.in[22], D, D, (bf16*)(ws + WS_WOUT), 0, scr, r, F.lane); continue; } r -= I_OUT;
        constexpr int I_LAYER = 2 * I_GU + I_DN;
        if (r < 2 * I_LAYER) {
            const int l = r / I_LAYER; int q = r % I_LAYER;
            bf16* gu = (bf16*)(ws + (l ? WS_WGU1 : WS_WGU0)); bf16* dn = (bf16*)(ws + (l ? WS_WD1 : WS_WD0));
            if (q < I_GU) { transpose_item(F.in[27] + (size_t)l * D * FF, D, FF, gu, 1, scr, q, F.lane); continue; } q -= I_GU;
            if (q < I_GU) { transpose_item(F.in[28] + (size_t)l * D * FF, D, FF, gu, 2, scr, q, F.lane); continue; } q -= I_GU;
            transpose_item(F.in[29] + (size_t)l * FF * D, FF, D, dn, 0, scr, q, F.lane); continue;
        }
        r -= 2 * I_LAYER;
        { const int g = r / I_PL, ri = r % I_PL; transpose_item(F.in[23] + (size_t)g * 65536, 256, 256, (bf16*)(ws + WS_POOLT) + (size_t)g * 65536, 0, scr, ri, F.lane); }
    }
    const int gt = F.vcu * NTHREADS + F.tid, NGT = F.G * NTHREADS;
    bf16* XB = (bf16*)(ws + WS_XB);
    bf16* Zp = (bf16*)(ws + WS_Z);
    for (int i0 = gt; i0 < T * D / 8; i0 += 4 * NGT) {
        float f[4][8];
#pragma unroll
        for (int u = 0; u < 4; ++u) { const int i = i0 + u * NGT; if (i < T * D / 8) { const int m = i >> 7, c8 = (i & 127) * 8; load_f8(xrow_ptr(F, m) + c8, f[u]); } }
#pragma unroll
        for (int u = 0; u < 4; ++u) { const int i = i0 + u * NGT; if (i < T * D / 8) { const int m = i >> 7, c8 = (i & 127) * 8;
            *(v4u*)(XB + (size_t)m * D + c8) = pack_bf8(f[u]);
            if (m >= TP) { float z[8];
#pragma unroll
                for (int e = 0; e < 8; ++e) z[e] = ALPHA * f[u][e];
                *(v4u*)(Zp + (size_t)m * D + c8) = pack_bf8(z); } } }
    }
    bf16* LT = (bf16*)(ws + WS_LORAT);
    for (int i = gt; i < 1536 * 256 / 2; i += NGT) { const int j = i >> 7, k = (i & 127) * 2; float v[2];
#pragma unroll
        for (int e = 0; e < 2; ++e) { const int kk = k + e; float x = 0.f;
            if (j < 512) { if (kk < 64) x = F.in[13][(size_t)kk * 512 + j]; }
            else if (j < 1024) { if (kk >= 64 && kk < 128) x = F.in[15][(size_t)(kk - 64) * 512 + (j - 512)]; }
            else { if (kk >= 128) x = F.in[16][(size_t)(kk - 128) * 512 + (j - 1024)]; }
            v[e] = x; }
        *(unsigned*)(LT + (size_t)j * 256 + k) = pkbf(v[0], v[1]); }
}

struct P2In { v4u cur[4], prv[4]; };
__device__ __forceinline__ void p2_load(P2In& X, const bf16* PB, int m, int lane) {
    const bool sample = m >= TP; const int t = sample ? (m - TP) & 7 : m & 2047;
    const bf16* pb = PB + (size_t)m * BP;
#pragma unroll
    for (int sec = 0; sec < 4; ++sec) {
        const int col = sec * 512 + lane * 8;
        if (sec < 3 || lane < 32) { X.cur[sec] = *(const v4u*)(pb + col); X.prv[sec] = t > 0 ? *(const v4u*)(pb - BP + col) : (v4u){0u, 0u, 0u, 0u}; }
        else { X.cur[sec] = (v4u){0u, 0u, 0u, 0u}; X.prv[sec] = (v4u){0u, 0u, 0u, 0u}; }
    }
}
__device__ __forceinline__ void p2_finish(const P2In& X, Frame& F, int m, int lane, const float (&mu)[4][8], const float (&kw)[8]) {
    unsigned char* ws = F.ws;
    h16* SCR = (h16*)(ws + WS_SCR); h16* SCK = (h16*)(ws + WS_SCK); h16* SCV = (h16*)(ws + WS_SCV); h16* SCKK = (h16*)(ws + WS_SCKK);
    bf16* LA = (bf16*)(ws + WS_LA);
    const bool sample = m >= TP; const int seq = sample ? (m - TP) >> 3 : m >> 11, t = sample ? (m - TP) & 7 : m & 2047, L = sample ? LS : LP;
    float* oshift = F.out + (sample ? O_SHIFT_S : O_SHIFT_P) + (size_t)seq * BP;
    const bool last = (t == L - 1);
#pragma unroll
    for (int sec = 0; sec < 4; ++sec) {
        if (sec == 3 && lane >= 32) break;
        const int col = sec * 512 + lane * 8;
        float p[8], pv[8], xm[8];
        unpack_bf8(X.cur[sec], p);
        if (t == 0 && sample) load_f8(F.in[3] + (size_t)seq * BP + col, pv); else unpack_bf8(X.prv[sec], pv);
#pragma unroll
        for (int i = 0; i < 8; ++i) xm[i] = p[i] + mu[sec][i] * (pv[i] - p[i]);
        if (last) store_f8(oshift + col, p);
        const size_t off = (size_t)m * HW + lane * 8;
        if (sec == 0) *(v4u*)(SCR + off) = pack_h8(xm);
        else if (sec == 1) {
            *(v4u*)(SCK + off) = pack_h8(xm);
            float kx[8]; float ss = 0.f;
#pragma unroll
            for (int i = 0; i < 8; ++i) { kx[i] = xm[i] * kw[i]; ss += kx[i] * kx[i]; }
            ss = sum8(ss);
            const float inv = 1.f / fmaxf(sqrtf(ss), 1e-12f);
#pragma unroll
            for (int i = 0; i < 8; ++i) kx[i] *= inv;
            *(v4u*)(SCKK + off) = pack_h8(kx);
        } else if (sec == 2) *(v4u*)(SCV + off) = pack_h8(xm);
        else {
            float o[8];
#pragma unroll
            for (int i = 0; i < 8; ++i) {
                if (lane < 8) { const float e = __expf(2.f * xm[i]); o[i] = 1.f - 2.f * __builtin_amdgcn_rcpf(e + 1.f); }
                else if (lane < 16) o[i] = xm[i];
                else o[i] = sigmoid_(xm[i]);
            }
            *(v4u*)(LA + (size_t)m * 256 + lane * 8) = pack_bf8(o);
        }
    }
}
__device__ __forceinline__ void p2_rows(Frame& F) {
    const int gw = F.vcu * NWAVES + F.wave, NGW = F.G * NWAVES, lane = F.lane;
    const bf16* PB = (const bf16*)(F.ws + WS_PROJB);
    float mu[4][8], kw[8];
#pragma unroll
    for (int sec = 0; sec < 4; ++sec) { if (sec < 3 || lane < 32) load_f8(F.in[11] + sec * 512 + lane * 8, mu[sec]); else {
#pragma unroll
            for (int i = 0; i < 8; ++i) mu[sec][i] = 0.f; } }
    load_f8(F.in[17] + lane * 8, kw);
    for (int m = gw; m < T; m += 2 * NGW) {
        const int m2 = m + NGW; const bool has2 = m2 < T;
        P2In A, B;
        p2_load(A, PB, m, lane);
        if (has2) p2_load(B, PB, m2, lane);
        p2_finish(A, F, m, lane, mu, kw);
        if (has2) p2_finish(B, F, m2, lane, mu, kw);
    }
}

template <int TT, bool FAST> __device__ __forceinline__ void conv_tile(Frame& F, int m0, int t0, int seq, bool sample) {
    const int c = F.tid;
    unsigned char* ws = F.ws;
    const bf16* PA = (const bf16*)(ws + WS_PROJA); bf16* CAT = (bf16*)(ws + WS_CAT);
    const float* cw = F.in[7]; const float* sconv = F.in[2];
    LAS float* ylds = (LAS float*)F.lds;
    float w[31];
#pragma unroll
    for (int j = 0; j < 31; ++j) w[j] = cw[j * 512 + c];
    float y[TT]; const float bias = F.in[8][c];
#pragma unroll
    for (int t = 0; t < TT; ++t) y[t] = bias;
    const bool lastp = (!sample) && (t0 + TT == LP);
    float* oconv = F.out + (sample ? O_CONV_S : O_CONV_P) + (size_t)seq * 30 * 512 + c;
    const bf16* pp = PA + ((size_t)m0 - 30) * 512 + c; const float* scp = sconv + ((size_t)seq * 30 + t0) * 512 + c;
    constexpr int NR = TT + 30, H1 = (NR + 1) / 2;
#pragma unroll
    for (int hh = 0; hh < 2; ++hh) {
        const int r0 = hh ? H1 : 0, r1 = hh ? NR : H1;
        unsigned rv[H1];
#pragma unroll
        for (int ri = r0; ri < r1; ++ri) {
            const int s2 = ri - 30;
            asm volatile("" : "+v"(pp), "+v"(scp));
            if (FAST || t0 + s2 >= 0) rv[ri - r0] = pp[0];
            else rv[ri - r0] = sample ? __float_as_uint(*scp) : 0u;
            pp += 512; scp += 512;
        }
#pragma unroll
        for (int ri = r0; ri < r1; ++ri) {
            const int s2 = ri - 30;
            float u;
            if (FAST || t0 + s2 >= 0) u = bf2f(rv[ri - r0]);
            else u = __uint_as_float(rv[ri - r0]);
#pragma unroll
            for (int t = 0; t < TT; ++t) { const int j = s2 - t + 30; if (j >= 0 && j <= 30) y[t] += u * w[j]; }
            if (sample) { if (s2 + 22 >= 0) oconv[(size_t)(s2 + 22) * 512] = u; }
            else if (lastp && s2 >= TT - 30) oconv[(size_t)(s2 - (TT - 30)) * 512] = u;
        }
        asm volatile("" ::: "memory");
    }
#pragma unroll
    for (int t = 0; t < TT; ++t) ylds[t * 512 + c] = y[t];
    __syncthreads();
    const float* lg = F.in[9]; const float* lb = F.in[10];
    for (int t = F.wave; t < TT; t += NWAVES) {
        const LAS float* yr = ylds + t * 512 + F.lane * 8;
        float v[8];
        { const f32x4 a = *(const LAS f32x4*)yr, b = *(const LAS f32x4*)(yr + 4); v[0] = a.x; v[1] = a.y; v[2] = a.z; v[3] = a.w; v[4] = b.x; v[5] = b.y; v[6] = b.z; v[7] = b.w; }
        float s = 0.f;
#pragma unroll
        for (int i = 0; i < 8; ++i) s += v[i];
        const float mean = wave_sum(s) * (1.f / 512.f); float q = 0.f;
#pragma unroll
        for (int i = 0; i < 8; ++i) { v[i] -= mean; q += v[i] * v[i]; }
        const float rstd = rsqrtf(wave_sum(q) * (1.f / 512.f) + LN_EPS);
        float g8[8], b8[8], o[8]; load_f8(lg + F.lane * 8, g8); load_f8(lb + F.lane * 8, b8);
#pragma unroll
        for (int i = 0; i < 8; ++i) o[i] = silu_(v[i] * rstd * g8[i] + b8[i]);
        *(v4u*)(CAT + (size_t)(m0 + t) * 1024 + F.lane * 8) = pack_bf8(o);
    }
    __syncthreads();
}
__device__ __forceinline__ void conv_phase(Frame& F) {
    for (int it = F.vcu; it < 512 + 128; it += F.G) {
        if (it < 512) { const int m0 = it * 32, t0 = m0 & 2047; if (t0 >= 32) conv_tile<32, true>(F, m0, t0, m0 >> 11, false); else conv_tile<32, false>(F, m0, t0, m0 >> 11, false); }
        else { const int seq = it - 512; conv_tile<8, false>(F, TP + seq * 8, 0, seq, true); }
    }
}

constexpr int SU = 8;
struct ScanPtrs { const h16* R; const h16* K; const h16* V; const h16* KK; const h16* B; const h16* W; h16* O; };
struct ScanBuf { v2u r[SU], k[SU], kk[SU], b[SU], w[SU]; unsigned short v[SU]; };
__device__ __forceinline__ void scan_load(ScanBuf& Bf, const ScanPtrs& P, size_t off, int ks, int row) {
#pragma unroll
    for (int i = 0; i < SU; ++i) { const size_t o = off + (size_t)i * HW;
        Bf.r[i] = *(const v2u*)(P.R + o + ks); Bf.k[i] = *(const v2u*)(P.K + o + ks); Bf.kk[i] = *(const v2u*)(P.KK + o + ks);
        Bf.b[i] = *(const v2u*)(P.B + o + ks); Bf.w[i] = *(const v2u*)(P.W + o + ks); Bf.v[i] = *(const unsigned short*)(P.V + o + row); }
}
__device__ __forceinline__ void scan_compute(const ScanBuf& Bf, float (&S)[4], const ScanPtrs& P, size_t off, int row, bool writer) {
#pragma unroll
    for (int i = 0; i < SU; ++i) {
        float r[4], k[4], kk[4], b[4], w[4]; h4(Bf.r[i], r); h4(Bf.k[i], k); h4(Bf.kk[i], kk); h4(Bf.b[i], b); h4(Bf.w[i], w);
        const float v = (float)__builtin_bit_cast(h16, Bf.v[i]);
        float d = (S[0] * kk[0] + S[1] * kk[1]) + (S[2] * kk[2] + S[3] * kk[3]);
        float pj[4];
#pragma unroll
        for (int j = 0; j < 4; ++j) pj[j] = fmaf(v, k[j], fmaf(-S[j], w[j], S[j]));
        d = dpp_sum16(d);
#pragma unroll
        for (int j = 0; j < 4; ++j) S[j] = fmaf(-d, b[j], pj[j]);
        float o = (S[0] * r[0] + S[1] * r[1]) + (S[2] * r[2] + S[3] * r[3]);
        o = dpp_sum16(o);
        if (writer) P.O[off + (size_t)i * HW + row] = (h16)o;
    }
}
template <int L> __device__ __forceinline__ void scan_task(const ScanPtrs& P, int mbase, int h, int v0, const float* s_in, float* s_out, int lane) {
    const int rl = lane >> 4, ks = (lane & 15) * 4, row = v0 + rl; const bool writer = (lane & 15) == 0;
    float S[4] = {0.f, 0.f, 0.f, 0.f};
    if (s_in) { const f32x4 s = *(const f32x4*)(s_in + (size_t)row * 64 + ks); S[0] = s.x; S[1] = s.y; S[2] = s.z; S[3] = s.w; }
    size_t off = (size_t)mbase * HW + h * 64;
    ScanBuf A;
    scan_load(A, P, off, ks, row);
    if constexpr (L == SU) { scan_compute(A, S, P, off, row, writer); }
    else {
        ScanBuf Bf;
        for (int t = 0; t < L; t += 2 * SU) {
            scan_load(Bf, P, off + (size_t)SU * HW, ks, row);
            scan_compute(A, S, P, off, row, writer);
            if (t + 2 * SU < L) scan_load(A, P, off + (size_t)2 * SU * HW, ks, row);
            scan_compute(Bf, S, P, off + (size_t)SU * HW, row, writer);
            off += (size_t)2 * SU * HW;
        }
    }
    *(f32x4*)(s_out + (size_t)row * 64 + ks) = (f32x4){S[0], S[1], S[2], S[3]};
}
constexpr int RING_SLOTS = 64, SLOT_BYTES = 1536, FLAG_OFF = 131072 + 1024;
constexpr unsigned SPIN_CAP = 1u << 22;
struct StepF { f32x4 r, k, kk, b, w; float v; };
__device__ __forceinline__ void ld_stepf(StepF& X, const LAS unsigned char* slot, unsigned rd, unsigned vd) {
    X.r = *(const LAS f32x4*)(slot + 0 * 256 + rd); X.k = *(const LAS f32x4*)(slot + 1 * 256 + rd); X.kk = *(const LAS f32x4*)(slot + 2 * 256 + rd);
    X.b = *(const LAS f32x4*)(slot + 3 * 256 + rd); X.w = *(const LAS f32x4*)(slot + 4 * 256 + rd); X.v = *(const LAS float*)(slot + vd);
}
typedef float f32x2 __attribute__((ext_vector_type(2)));
__device__ __forceinline__ float step_computef(const StepF& X, f32x2& S01, f32x2& S23) {
    const f32x2 kk01 = {X.kk.x, X.kk.y}, kk23 = {X.kk.z, X.kk.w}, w01 = {X.w.x, X.w.y}, w23 = {X.w.z, X.w.w};
    const f32x2 k01 = {X.k.x, X.k.y}, k23 = {X.k.z, X.k.w}, b01 = {X.b.x, X.b.y}, b23 = {X.b.z, X.b.w}, r01 = {X.r.x, X.r.y}, r23 = {X.r.z, X.r.w};
    f32x2 p = S01 * kk01; p = S23 * kk23 + p;
    float d = p.x + p.y;
    const f32x2 vv = {X.v, X.v};
    const f32x2 pj01 = vv * k01 + (S01 - S01 * w01), pj23 = vv * k23 + (S23 - S23 * w23);
    d = dpp_sum16(d);
    const f32x2 dd = {d, d};
    S01 = pj01 - dd * b01; S23 = pj23 - dd * b23;
    f32x2 q = S01 * r01; q = S23 * r23 + q;
    return dpp_sum16(q.x + q.y);
}
__device__ __forceinline__ unsigned min4(const volatile LAS unsigned* p) { const unsigned a = p[0], b = p[1], c = p[2], d = p[3]; return min(min(a, b), min(c, d)); }
__device__ __forceinline__ void scan_prompt_consumer(Frame& F, int mbase, int h, int v0, float* s_out) {
    const int lane = F.lane, rl = lane >> 4, l16 = lane & 15, ks = l16 * 4, row = v0 + rl;
    const LAS unsigned char* ring = F.lds;
    volatile LAS unsigned* prod = (volatile LAS unsigned*)(F.lds + FLAG_OFF); volatile LAS unsigned* cons = prod + 4;
    h16* O = (h16*)(F.ws + WS_O) + (size_t)mbase * HW + h * 64 + row;
    const unsigned rd = ks * 4, vd = 5 * 256 + row * 4;
    constexpr int L = LP;
    f32x2 S01 = {0.f, 0.f}, S23 = {0.f, 0.f};
    StepF Q[4];
    __builtin_amdgcn_s_setprio(2);
    { unsigned sp = 0; while (min4(prod) < 2u && ++sp < SPIN_CAP) __builtin_amdgcn_s_sleep(1); }
    asm volatile("" ::: "memory");
    ld_stepf(Q[0], ring, rd, vd);
    ld_stepf(Q[1], ring + SLOT_BYTES, rd, vd);
    ld_stepf(Q[2], ring + 2 * SLOT_BYTES, rd, vd);
    float okeep = 0.f;
#pragma unroll 1
    for (int tb = 0; tb < L; tb += 16) {
#pragma unroll
        for (int j = 0; j < 16; ++j) {
            const int t = tb + j;
            if (j == 0) {
                const unsigned need = (unsigned)min(t / 4 + 5, L / 4);
                unsigned sp = 0; while (min4(prod) < need && ++sp < SPIN_CAP) __builtin_amdgcn_s_sleep(1);
                asm volatile("" ::: "memory");
            }
            __builtin_amdgcn_sched_barrier(0x7);
            ld_stepf(Q[(j + 3) & 3], ring + ((t + 3) & (RING_SLOTS - 1)) * SLOT_BYTES, rd, vd);
            __builtin_amdgcn_sched_barrier(0x7);
            const float o = step_computef(Q[j & 3], S01, S23);
            okeep = (l16 == j) ? o : okeep;
            if (j == 15) { asm volatile("s_waitcnt lgkmcnt(0)" ::: "memory"); if (lane == 0) cons[F.wave] = (unsigned)(t + 1); }
        }
        O[(size_t)(tb + l16) * HW] = (h16)okeep;
    }
    *(f32x4*)(s_out + (size_t)row * 64 + ks) = (f32x4){S01.x, S01.y, S23.x, S23.y};
    __builtin_amdgcn_s_setprio(0);
}
__device__ __forceinline__ void scan_prompt_loader(Frame& F, int mbase, int h) {
    const int lane = F.lane, w = F.wave - 4;
    LAS unsigned char* ring = F.lds;
    volatile LAS unsigned* prod = (volatile LAS unsigned*)(F.lds + FLAG_OFF); volatile LAS unsigned* cons = prod + 4;
    const int arr = lane < 40 ? (lane >> 3) : 5, part = lane & 7;
    const size_t abase = arr == 0 ? WS_SCR : arr == 1 ? WS_SCK : arr == 2 ? WS_SCKK : arr == 3 ? WS_SCB : arr == 4 ? WS_SCW : WS_SCV;
    const unsigned char* src = F.ws + abase + ((size_t)mbase * HW + h * 64) * 2 + part * 16;
    const bool active = lane < 48;
    const unsigned dst = arr * 256 + part * 32;
    constexpr int L = LP, PF = 16;
    v4u buf[PF]; unsigned cmin = 0u;
    const unsigned char* lp = src + (size_t)w * 1024;
#pragma unroll
    for (int i = 0; i < PF; ++i) { asm volatile("" : "+v"(lp)); buf[i] = active ? *(const v4u*)lp : (v4u){0u, 0u, 0u, 0u}; lp += 4096; }
    unsigned slot = (unsigned)w;
#pragma unroll 1
    for (int sb = w; sb < L; sb += 4 * PF) {
#pragma unroll
        for (int i = 0; i < PF; ++i) {
            const int st = sb + 4 * i;
            if (st >= RING_SLOTS && cmin < (unsigned)(st - RING_SLOTS + 1)) { unsigned sp = 0; while ((cmin = min4(cons)) < (unsigned)(st - RING_SLOTS + 1) && ++sp < SPIN_CAP) __builtin_amdgcn_s_sleep(1); }
            asm volatile("" ::: "memory");
            float f[8]; unpack_h8(buf[i], f);
            { asm volatile("" : "+v"(lp)); if (st + 4 * PF < L) buf[i] = active ? *(const v4u*)lp : (v4u){0u, 0u, 0u, 0u}; lp += 4096; }
            if (active) { LAS unsigned char* p = ring + slot * SLOT_BYTES + dst;
                *(LAS f32x4*)p = (f32x4){f[0], f[1], f[2], f[3]}; *(LAS f32x4*)(p + 16) = (f32x4){f[4], f[5], f[6], f[7]}; }
            slot = (slot + 4) & (RING_SLOTS - 1);
            asm volatile("s_waitcnt lgkmcnt(0)" ::: "memory");
            if (lane == 0) prod[w] = (unsigned)(st >> 2) + 1u;
        }
    }
}
__device__ __forceinline__ void scan_sample_pair(Frame& F, int pair) {
    const int lane = F.lane, n = pair >> 3, h = pair & 7;
    const unsigned char* ws = F.ws;
    LAS float* st = (LAS float*)(F.lds + F.wave * 12288);
    const size_t eoff = (size_t)(TP + n * LS) * HW + h * 64;
    v4u raw[5];
#pragma unroll
    for (int q = 0; q < 5; ++q) { const int id = lane + 64 * q, stp = id / 40, rem = id % 40, arr = rem >> 3, part = rem & 7;
        const size_t ab = arr == 0 ? WS_SCR : arr == 1 ? WS_SCK : arr == 2 ? WS_SCKK : arr == 3 ? WS_SCB : WS_SCW;
        raw[q] = *(const v4u*)(ws + ab + (eoff + (size_t)stp * HW) * 2 + part * 16); }
    unsigned short vr[8];
#pragma unroll
    for (int t = 0; t < 8; ++t) vr[t] = *(const unsigned short*)(ws + WS_SCV + (eoff + (size_t)t * HW + lane) * 2);
    float S[64];
    const float* sin = F.in[4] + (size_t)pair * 4096 + lane * 64;
#pragma unroll
    for (int c = 0; c < 16; ++c) { const f32x4 x = *(const f32x4*)(sin + 4 * c); S[4 * c] = x.x; S[4 * c + 1] = x.y; S[4 * c + 2] = x.z; S[4 * c + 3] = x.w; }
#pragma unroll
    for (int q = 0; q < 5; ++q) { const int id = lane + 64 * q, stp = id / 40, rem = id % 40, arr = rem >> 3, part = rem & 7;
        float f[8]; unpack_h8(raw[q], f); LAS float* d = st + (stp * 5 + arr) * 64 + part * 8;
        *(LAS f32x4*)d = (f32x4){f[0], f[1], f[2], f[3]}; *(LAS f32x4*)(d + 4) = (f32x4){f[4], f[5], f[6], f[7]}; }
#pragma unroll
    for (int t = 0; t < 8; ++t) st[2560 + t * 64 + lane] = (float)__builtin_bit_cast(h16, vr[t]);
    asm volatile("s_waitcnt lgkmcnt(0)" ::: "memory");
    h16* O = (h16*)(F.ws + WS_O) + eoff + lane;
#pragma unroll 1
    for (int t = 0; t < 8; ++t) {
        const LAS float* q = st + t * 320;
        float d0 = 0.f, d1 = 0.f, d2 = 0.f, d3 = 0.f;
#pragma unroll
        for (int c = 0; c < 16; ++c) { const f32x4 kk = *(const LAS f32x4*)(q + 128 + 4 * c);
            d0 = fmaf(S[4 * c], kk.x, d0); d1 = fmaf(S[4 * c + 1], kk.y, d1); d2 = fmaf(S[4 * c + 2], kk.z, d2); d3 = fmaf(S[4 * c + 3], kk.w, d3); }
        const float d = (d0 + d1) + (d2 + d3), v = st[2560 + t * 64 + lane];
        float o0 = 0.f, o1 = 0.f, o2 = 0.f, o3 = 0.f;
#pragma unroll
        for (int c = 0; c < 16; ++c) {
            const f32x4 r = *(const LAS f32x4*)(q + 4 * c), k = *(const LAS f32x4*)(q + 64 + 4 * c), b = *(const LAS f32x4*)(q + 192 + 4 * c), w = *(const LAS f32x4*)(q + 256 + 4 * c);
            float s0 = S[4 * c], s1 = S[4 * c + 1], s2 = S[4 * c + 2], s3 = S[4 * c + 3];
            s0 = fmaf(-d, b.x, fmaf(v, k.x, fmaf(-s0, w.x, s0))); s1 = fmaf(-d, b.y, fmaf(v, k.y, fmaf(-s1, w.y, s1)));
            s2 = fmaf(-d, b.z, fmaf(v, k.z, fmaf(-s2, w.z, s2))); s3 = fmaf(-d, b.w, fmaf(v, k.w, fmaf(-s3, w.w, s3)));
            S[4 * c] = s0; S[4 * c + 1] = s1; S[4 * c + 2] = s2; S[4 * c + 3] = s3;
            o0 = fmaf(s0, r.x, o0); o1 = fmaf(s1, r.y, o1); o2 = fmaf(s2, r.z, o2); o3 = fmaf(s3, r.w, o3);
        }
        O[(size_t)t * HW] = (h16)((o0 + o1) + (o2 + o3));
    }
    float* sout = F.out + O_WKV_S + (size_t)pair * 4096 + lane * 64;
#pragma unroll
    for (int c = 0; c < 16; ++c) *(f32x4*)(sout + 4 * c) = (f32x4){S[4 * c], S[4 * c + 1], S[4 * c + 2], S[4 * c + 3]};
}
__device__ __forceinline__ void scan_phase(Frame& F) {
    unsigned char* ws = F.ws;
    ScanPtrs P{(const h16*)(ws + WS_SCR), (const h16*)(ws + WS_SCK), (const h16*)(ws + WS_SCV), (const h16*)(ws + WS_SCKK), (const h16*)(ws + WS_SCB), (const h16*)(ws + WS_SCW), (h16*)(ws + WS_O)};
    for (int task = F.vcu; task < 256; task += F.G) {
        if (F.tid < 8) ((volatile LAS unsigned*)(F.lds + FLAG_OFF))[F.tid] = 0u;
        __syncthreads();
        const int pair = task >> 2, q = task & 3, n = pair >> 3, h = pair & 7;
        if (F.wave < 4) scan_prompt_consumer(F, n * LP, h, q * 16 + F.wave * 4, F.out + O_WKV_P + (size_t)pair * 4096);
        else scan_prompt_loader(F, n * LP, h);
        __syncthreads();
    }
    if (F.wave < 4) { for (int pair = F.wave * F.G + F.vcu; pair < NSB * 8; pair += 4 * F.G) scan_sample_pair(F, pair); }
}

struct P6In { v4u o, r, k, v, g; };
__device__ __forceinline__ void p6_load(P6In& X, const unsigned char* ws, int m, int lane) {
    const size_t off = ((size_t)m * HW + lane * 8) * 2;
    X.o = *(const v4u*)(ws + WS_O + off); X.r = *(const v4u*)(ws + WS_SCR + off); X.k = *(const v4u*)(ws + WS_SCK + off); X.v = *(const v4u*)(ws + WS_SCV + off); X.g = *(const v4u*)(ws + WS_G + off);
}
__device__ __forceinline__ void p6_finish(const P6In& X, bf16* CAT, int m, int lane, const float (&rk)[8], const float (&lg)[8], const float (&lb)[8]) {
    float o[8], r[8], k[8], v[8], g[8];
    unpack_h8(X.o, o); unpack_h8(X.r, r); unpack_h8(X.k, k); unpack_h8(X.v, v); unpack_h8(X.g, g);
    float s = 0.f, bs = 0.f;
#pragma unroll
    for (int i = 0; i < 8; ++i) { s += o[i]; bs += r[i] * k[i] * rk[i]; }
    const float mean = sum8(s) * (1.f / 64.f); bs = sum8(bs); float q = 0.f;
#pragma unroll
    for (int i = 0; i < 8; ++i) { o[i] -= mean; q += o[i] * o[i]; }
    const float rstd = rsqrtf(sum8(q) * (1.f / 64.f) + GN_EPS);
    float res[8];
#pragma unroll
    for (int i = 0; i < 8; ++i) res[i] = (o[i] * rstd * lg[i] + lb[i] + bs * v[i]) * g[i];
    *(v4u*)(CAT + (size_t)m * 1024 + 512 + lane * 8) = pack_bf8(res);
}
__device__ __forceinline__ void p6_rows(Frame& F) {
    const int gw = F.vcu * NWAVES + F.wave, NGW = F.G * NWAVES, lane = F.lane;
    const unsigned char* ws = F.ws; bf16* CAT = (bf16*)(F.ws + WS_CAT);
    float rk[8], lg[8], lb[8]; load_f8(F.in[19] + lane * 8, rk); load_f8(F.in[20] + lane * 8, lg); load_f8(F.in[21] + lane * 8, lb);
    for (int m = gw; m < T; m += 4 * NGW) {
        P6In X[4];
#pragma unroll
        for (int u = 0; u < 4; ++u) { const int mm = m + u * NGW; if (mm < T) p6_load(X[u], ws, mm, lane); }
#pragma unroll
        for (int u = 0; u < 4; ++u) { const int mm = m + u * NGW; if (mm < T) p6_finish(X[u], CAT, mm, lane, rk, lg, lb); }
    }
}

template <int MODE, int NP> __device__ __forceinline__ void ln_finish(Frame& F, int m, f32x4 (&v)[4], const f32x4 (&gv)[4], const f32x4 (&bv)[4], const h16* pa, const h16* pb) {
    const int lane = F.lane;
    bf16* zr = (bf16*)(F.ws + WS_Z) + (size_t)m * D; bf16* XB = (bf16*)(F.ws + WS_XB);
    float s = 0.f;
    if (NP > 0 && m >= TP) {
        v2u sl[NP > 0 ? NP : 1][4];
#pragma unroll
        for (int sp = 0; sp < NP; ++sp) { const h16* pr = (sp < 8 ? pa + (size_t)sp * (1u << 20) : pb + (size_t)(sp - 8) * (1u << 20)) + (size_t)(m - TP) * D;
#pragma unroll
            for (int j = 0; j < 4; ++j) sl[sp][j] = *(const v2u*)(pr + 4 * (lane + 64 * j)); }
#pragma unroll
        for (int sp = 0; sp < NP; ++sp)
#pragma unroll
            for (int j = 0; j < 4; ++j) { float f[4]; h4(sl[sp][j], f); v[j] = v[j] + (f32x4){f[0], f[1], f[2], f[3]}; }
    }
#pragma unroll
    for (int j = 0; j < 4; ++j) s += (v[j].x + v[j].y) + (v[j].z + v[j].w);
    const float mean = wave_sum(s) * (1.f / D); float s2 = 0.f;
#pragma unroll
    for (int j = 0; j < 4; ++j) { v[j] = v[j] - mean; s2 += (v[j].x * v[j].x + v[j].y * v[j].y) + (v[j].z * v[j].z + v[j].w * v[j].w); }
    const float rstd = rsqrtf(wave_sum(s2) * (1.f / D) + LN_EPS);
#pragma unroll
    for (int j = 0; j < 4; ++j) v[j] = v[j] * rstd * gv[j] + bv[j];
    if (MODE == 2) {
#pragma unroll
        for (int j = 0; j < 4; ++j) *(f32x4*)(F.out + O_Y + (size_t)m * D + 4 * (lane + 64 * j)) = v[j];
    } else {
        if ((MODE == 0 || MODE == 1) && m >= TP) {
#pragma unroll
            for (int j = 0; j < 4; ++j) { v2u w; w.x = pkbf(v[j].x * ALPHA, v[j].y * ALPHA); w.y = pkbf(v[j].z * ALPHA, v[j].w * ALPHA); *(v2u*)(zr + 4 * (lane + 64 * j)) = w; }
        }
#pragma unroll
        for (int j = 0; j < 4; ++j) { v2u w; w.x = pkbf(v[j].x, v[j].y); w.y = pkbf(v[j].z, v[j].w); *(v2u*)(XB + (size_t)m * D + 4 * (lane + 64 * j)) = w; }
    }
    if (MODE == 1) {
        const bool sample = m >= TP; const int seq = sample ? (m - TP) >> 3 : m >> 11, t = sample ? (m - TP) & 7 : m & 2047;
        if (sample) {
            float* op = F.out + O_POOL_S + ((size_t)seq * 15 + 7 + t) * D;
#pragma unroll
            for (int j = 0; j < 4; ++j) *(f32x4*)(op + 4 * (lane + 64 * j)) = v[j];
            if (t == 0) { const float* sp = F.in[5] + ((size_t)seq * 15 + 8) * D; float* o0 = F.out + O_POOL_S + (size_t)seq * 15 * D;
                for (int i = lane; i < 7 * D / 4; i += 64) *(f32x4*)(o0 + 4 * i) = *(const f32x4*)(sp + 4 * i); }
        } else if (t >= LP - 15) {
            float* op = F.out + O_POOL_P + ((size_t)seq * 15 + (t - (LP - 15))) * D;
#pragma unroll
            for (int j = 0; j < 4; ++j) *(f32x4*)(op + 4 * (lane + 64 * j)) = v[j];
        }
    }
}
template <int MODE, int NP> __device__ __forceinline__ void ln_rows(Frame& F, const float* g, const float* b, const h16* pa, const h16* pb, int TL = T) {
    const int gw = F.vcu * NWAVES + F.wave, NGW = F.G * NWAVES, lane = F.lane;
    const bf16* Z = (const bf16*)(F.ws + WS_Z);
    f32x4 gv[4], bv[4];
#pragma unroll
    for (int j = 0; j < 4; ++j) { gv[j] = *(const f32x4*)(g + 4 * (lane + 64 * j)); bv[j] = *(const f32x4*)(b + 4 * (lane + 64 * j)); }
    constexpr int LU = 4;
    for (int m = gw; m < TL; m += LU * NGW) {
        f32x4 v[LU][4];
#pragma unroll
        for (int u = 0; u < LU; ++u) { const int mm = m + u * NGW; if (mm < TL) {
#pragma unroll
                for (int j = 0; j < 4; ++j) { const v2u w = *(const v2u*)(Z + (size_t)mm * D + 4 * (lane + 64 * j)); const unsigned w0 = w.x, w1 = w.y;
                    v[u][j] = (f32x4){__uint_as_float(w0 << 16), __uint_as_float(w0 & 0xffff0000u), __uint_as_float(w1 << 16), __uint_as_float(w1 & 0xffff0000u)}; } } }
#pragma unroll
        for (int u = 0; u < LU; ++u) { const int mm = m + u * NGW; if (mm < TL) ln_finish<MODE, NP>(F, mm, v[u], gv, bv, pa, pb); }
    }
}

template <int TT> __device__ __forceinline__ float pool_one(const float (&xs)[TT + 15], int t, int g, int cnt) {
    const float x0 = xs[t + 15];
    const float s2 = x0 + xs[t + 14];
    const float s4 = s2 + (xs[t + 13] + xs[t + 12]);
    const float s8 = s4 + ((xs[t + 11] + xs[t + 10]) + (xs[t + 9] + xs[t + 8]));
    const float s16 = s8 + (((xs[t + 7] + xs[t + 6]) + (xs[t + 5] + xs[t + 4])) + ((xs[t + 3] + xs[t + 2]) + (xs[t + 1] + xs[t + 0])));
    const float sum = g == 0 ? s2 : (g == 1 ? s4 : (g == 2 ? s8 : s16));
    return sum / (float)cnt - x0;
}
template <int TT> __device__ __forceinline__ void pool_tile(Frame& F, int m0, int t0, int seq, bool sample) {
    const bf16* XR = (const bf16*)(F.ws + WS_XR); bf16* PL = (bf16*)(F.ws + WS_PL); const float* spool = F.in[5];
    const int c = 2 * F.tid, g = c >> 8;
    float xa[TT + 15], xb[TT + 15];
    const bf16* zp = XR + ((size_t)m0 - 15) * D + c; const float* sp = spool + ((size_t)seq * 15 + t0) * D + c;
#pragma unroll
    for (int s = -15; s < TT; ++s) {
        asm volatile("" : "+v"(zp), "+v"(sp));
        if (t0 + s >= 0) { const unsigned w = *(const unsigned*)zp; xa[s + 15] = __uint_as_float(w << 16); xb[s + 15] = __uint_as_float(w & 0xffff0000u); }
        else if (sample) { xa[s + 15] = sp[0]; xb[s + 15] = sp[1]; }
        else { xa[s + 15] = 0.f; xb[s + 15] = 0.f; }
        zp += D; sp += D;
    }
    const int wdw = 2 << g;
#pragma unroll
    for (int t = 0; t < TT; ++t) {
        const int cnt = sample ? wdw : min(wdw, t0 + t + 1);
        const float p0 = pool_one<TT>(xa, t, g, cnt), p1 = pool_one<TT>(xb, t, g, cnt);
        *(unsigned*)(PL + (size_t)(m0 + t) * D + c) = pkbf(p0, p1);
    }
}
__device__ __forceinline__ void pool_phase(Frame& F) {
    for (int it = F.vcu; it < 512 + 128; it += F.G) {
        if (it < 512) { const int m0 = it * 32; pool_tile<32>(F, m0, m0 & 2047, m0 >> 11, false); }
        else { const int seq = it - 512; pool_tile<8>(F, TP + seq * 8, 0, seq, true); }
    }
}


#ifndef DIAG_AT
#define DIAG_AT -1
#endif
__device__ __forceinline__ bool dbad(float got, float want) { return !(fabsf(got - want) <= 0.03f * fabsf(want) + 0.02f); }
__device__ __forceinline__ float h2f(h16 x) { return (float)x; }
__device__ __forceinline__ void diag_checks(Frame& F, int at) {
    if (blockIdx.x != 0 || F.wave != 0) return;
    const int lane = F.lane; unsigned char* ws = F.ws;
    unsigned mask = 0;
    const bf16* PA = (const bf16*)(ws + WS_PROJA); const bf16* PB = (const bf16*)(ws + WS_PROJB);
    const h16* SCR = (const h16*)(ws + WS_SCR); const h16* SCK = (const h16*)(ws + WS_SCK); const h16* SCV = (const h16*)(ws + WS_SCV); const h16* SCKK = (const h16*)(ws + WS_SCKK);
    const h16* SCB = (const h16*)(ws + WS_SCB); const h16* SCW = (const h16*)(ws + WS_SCW);
    const int m = 1 + (lane * 131 + 7) % 9000;
    const int t = m & 2047;
    if (at == 3) {
        const int c = (lane * 29 + 5) % 512, h0 = c & ~63;
        auto xm = [&](int col) { const float p = bf2f(PB[(size_t)m * BP + col]); const float pv = t > 0 ? bf2f(PB[(size_t)(m - 1) * BP + col]) : 0.f; return p + F.in[11][col] * (pv - p); };
        float ss = 0.f; for (int j = 0; j < 64; ++j) { const float kx = xm(512 + h0 + j) * F.in[17][h0 + j]; ss += kx * kx; }
        const float kkn = xm(512 + c) * F.in[17][c] / fmaxf(sqrtf(ss), 1e-12f);
        float al = F.in[14][c]; for (int j = 0; j < 64; ++j) al += xm(1600 + j) * F.in[15][(size_t)j * 512 + c];
        const float a = 1.f / (1.f + expf(-al)); const float f = (1.f + (a - 1.f) * F.in[18][c]); const float k0 = xm(512 + c); const float b = kkn * a;
        const float gotk = h2f(SCK[(size_t)m * HW + c]);
        if (__ballot(dbad(gotk, k0 * f))) mask |= 1;
        if (__ballot(dbad(h2f(SCB[(size_t)m * HW + c]) * 10.f, b * 10.f))) mask |= 2;
        { const bf16* LA = (const bf16*)(ws + WS_LA); bool bad = false; for (int j = 0; j < 64; ++j) bad = bad || dbad(bf2f(LA[(size_t)m * 256 + 64 + j]), xm(1600 + j)); if (__ballot(bad)) mask |= 4; }
        { float g = 0.f; for (int j = 0; j < 128; ++j) g += (1.f / (1.f + expf(-xm(1664 + j)))) * F.in[16][(size_t)j * 512 + c];
          const h16* G = (const h16*)(ws + WS_G); if (__ballot(dbad(h2f(G[(size_t)m * HW + c]), g))) mask |= 8; }
        if (__ballot(dbad(gotk, k0 * f * f))) mask |= 16;
        if (__ballot(dbad(gotk, k0))) mask |= 32;
    }
    if (lane == 0) *(unsigned*)(ws + 0) = mask;
}
__device__ __forceinline__ void diag_fill(Frame& F) {
    const unsigned mask = *(const unsigned*)(F.ws + 0);
    const float C = sqrtf(exp2f(1.f + (float)mask));
    const int gt = blockIdx.x * NTHREADS + F.tid, NGT = F.G * NTHREADS;
    for (int i = gt; i < TS * D; i += NGT) F.out[O_Y + (size_t)TP * D + i] = C;
}

#define XB_TMO      128
#define XB_XCNT(j)  (256  + 64 * (j))
#define XB_XSUB(j)  (1280 + 64 * (j))
#define XB_XGEN(j)  (2304 + 64 * (j))
#define XB_TOP      3328
#define XB_TOPGEN   3392
#define XCD_BAR_WORDS 3456
#define XB_SPIN_CAP (1u << 18)

__device__ __forceinline__ unsigned xb_ld(unsigned* p)              { return __hip_atomic_load(p, __ATOMIC_RELAXED, __HIP_MEMORY_SCOPE_AGENT); }
__device__ __forceinline__ unsigned xb_add(unsigned* p, unsigned v) { return __hip_atomic_fetch_add(p, v, __ATOMIC_RELAXED, __HIP_MEMORY_SCOPE_AGENT); }
__device__ __forceinline__ unsigned xb_xcc_id() { return (unsigned)__builtin_amdgcn_s_getreg((3 << 11) | 20) & 0xFu; }
#define XB_SPIN(cond, bar) do { unsigned _sp = 0; while (cond) { __builtin_amdgcn_s_sleep(1); \
    if ((++_sp & 255u) == 0u) { if (xb_ld(&(bar)[XB_TMO])) break; if (_sp > XB_SPIN_CAP) { atomicAdd(&(bar)[XB_TMO], 1u); break; } } } } while (0)

struct XcdBarrier {
    unsigned* bar; unsigned x;
    volatile LAS unsigned* st;
};

__device__ __forceinline__ XcdBarrier xcd_barrier_post(unsigned* bar, volatile LAS unsigned* st) {
    XcdBarrier b; b.bar = bar; b.x = xb_xcc_id(); b.st = st;
    if (threadIdx.x == 0) (void)xb_add(&bar[XB_XCNT(b.x)], 1u);
    return b;
}
__device__ __forceinline__ void xcd_barrier_complete(unsigned* bar, unsigned x, unsigned& nloc, unsigned& nx) {
    const unsigned G = gridDim.x * gridDim.y * gridDim.z;
    unsigned sum, cnt, mine, sp = 0u;
    for (;;) {
        sum = 0u; cnt = 0u; mine = 0u;
#pragma unroll
        for (unsigned j = 0; j < 16; ++j) { const unsigned c = xb_ld(&bar[XB_XCNT(j)]); sum += c; cnt += (c > 0u) ? 1u : 0u; mine = (j == x) ? c : mine; }
        if (sum == G) break;
        __builtin_amdgcn_s_sleep(1);
        if ((++sp & 255u) == 0u) { if (xb_ld(&bar[XB_TMO])) break; if (sp > XB_SPIN_CAP) { atomicAdd(&bar[XB_TMO], 1u); break; } }
    }
    nloc = mine > 0u ? mine : 1u; nx = cnt > 0u ? cnt : 1u;
}

__device__ __forceinline__ void xcd_barrier(const XcdBarrier& b) {
    asm volatile("s_waitcnt vmcnt(0)" ::: "memory");
    __syncthreads();
    if (threadIdx.x == 0) {
        unsigned* bar = b.bar;
        __builtin_amdgcn_s_waitcnt(0);
        unsigned nloc = b.st[0], nx = b.st[1];
        if (nloc == 0u) { xcd_barrier_complete(bar, b.x, nloc, nx); b.st[0] = nloc; b.st[1] = nx; }
        const unsigned old = xb_add(&bar[XB_XSUB(b.x)], 1u);
        const unsigned gen = old / nloc;
        if (old + 1u == (gen + 1u) * nloc) {
            __builtin_amdgcn_fence(__ATOMIC_RELEASE, "agent");
            asm volatile("s_waitcnt vmcnt(0)" ::: "memory");
            const unsigned og = xb_add(&bar[XB_TOP], 1u);
            const unsigned tg = og / nx;
            if (og + 1u == (tg + 1u) * nx) xb_add(&bar[XB_TOPGEN], 1u);
            else XB_SPIN(xb_ld(&bar[XB_TOPGEN]) == tg, bar);
            __builtin_amdgcn_fence(__ATOMIC_ACQUIRE, "agent");
            xb_add(&bar[XB_XGEN(b.x)], 1u);
            asm volatile("s_waitcnt vmcnt(0)" ::: "memory");
        } else {
            XB_SPIN(xb_ld(&bar[XB_XGEN(b.x)]) == gen, bar);
            __builtin_amdgcn_fence(__ATOMIC_ACQUIRE, "agent");
            asm volatile("s_waitcnt vmcnt(0)" ::: "memory");
        }
    }
    __syncthreads();
}

struct Args { const float* in[32]; float* out; unsigned char* ws; int ph_lo, ph_hi, coop, pad; };

__global__ void __launch_bounds__(NTHREADS, 2) mk_fwd(Args args) {
    extern __shared__ __attribute__((aligned(16))) unsigned char lds_raw[];
    Frame F;
    F.lds = (LAS unsigned char*)lds_raw;
    F.tid = threadIdx.x; F.lane = F.tid & 63; F.wave = __builtin_amdgcn_readfirstlane(F.tid >> 6);
    F.G = gridDim.x; { const int bx = blockIdx.x; F.vcu = (F.G % 8 == 0) ? (bx % 8) * (F.G / 8) + bx / 8 : bx; }
    F.in = args.in;
    F.out = args.out; F.ws = args.ws;
    unsigned char* ws = args.ws;
    const int lo = args.ph_lo, hi = args.ph_hi;
    volatile LAS unsigned* MISC = (volatile LAS unsigned*)(F.lds + 131072 + 512);
    if (F.tid < 32) MISC[F.tid] = 0u;
    __syncthreads();
    XcdBarrier bar = xcd_barrier_post((unsigned*)ws, MISC + 8);
#ifndef PHMASK
#define PHMASK 0x3ffff
#endif
#define IN(k) ((((PHMASK) >> (k)) & 1) && lo <= (k) && (k) < hi)
#ifndef PROF
#define PROF 0
#endif
    unsigned long long* tsbuf = (unsigned long long*)(ws + 65536);
#define STAMP(k) do { if (PROF && blockIdx.x == 0 && F.tid == 0) tsbuf[k] = __builtin_amdgcn_s_memrealtime(); } while (0)
#define SEAM(k) do { if (IN(k) && IN((k) + 1)) { xcd_barrier(bar); } STAMP((k) + 1); } while (0)
    STAMP(0);
    typedef pg8::bf16_t gb;

#ifndef DUP0
#define DUP0 0
#endif
#ifndef DUP9
#define DUP9 0
#endif
#ifndef DUP2
#define DUP2 0
#endif
#ifndef DUP6
#define DUP6 0
#endif
#ifndef DUP7
#define DUP7 0
#endif
#ifndef DUP13
#define DUP13 0
#endif
#ifndef DUP12
#define DUP12 0
#endif
#ifndef DUPLN
#define DUPLN 0
#endif
#ifndef DUP10
#define DUP10 0
#endif
#ifndef DUP1
#define DUP1 0
#endif
    if (DUP0) { p0_prologue(F); }
    if (IN(0)) { p0_prologue(F); } SEAM(0);
    if (DUP1) { pg8::Gemm g{(const gb*)(ws + WS_XB), (const gb*)(ws + WS_WIN), T, INP, D, D, D, 0}; pg8::StaticOrder S; S.init(T, INP, F.G, (int)blockIdx.x, D);
        EpiProj E{(bf16*)(ws + WS_PROJA), (bf16*)(ws + WS_PROJB)};
        pg8::gemm_phase<EpiProj, pg8::StaticOrder, true, true>(F.lds, g, S, E); xcd_barrier(bar); }
    if (IN(1)) {
        pg8::Gemm g{(const gb*)(ws + WS_XB), (const gb*)(ws + WS_WIN), T, INP, D, D, D, 0}; pg8::StaticOrder S; S.init(T, INP, F.G, (int)blockIdx.x, D);
        EpiProj E{(bf16*)(ws + WS_PROJA), (bf16*)(ws + WS_PROJB)};
        pg8::gemm_phase<EpiProj, pg8::StaticOrder, true, true>(F.lds, g, S, E);
    } SEAM(1);
    if (DUP2) { p2_rows(F); }
    if (IN(2)) { p2_rows(F); } SEAM(2);
    if (IN(3)) {
        pg8::Gemm g{(const gb*)(ws + WS_LA), (const gb*)(ws + WS_LORAT), T, 1536, 256, 256, 256, 0}; pg8::StaticOrder S; S.init(T, 1536, F.G, (int)blockIdx.x, 256);
        EpiLora E{F.in[12], F.in[14], F.in[18], (h16*)(ws + WS_SCW), (h16*)(ws + WS_SCK), (h16*)(ws + WS_SCKK), (h16*)(ws + WS_SCB), (h16*)(ws + WS_G)};
        pg8::gemm_phase<EpiLora, pg8::StaticOrder, true, true>(F.lds, g, S, E);
    } SEAM(3);
    if (IN(4)) { conv_phase(F); }
    STAMP(5);
#ifndef DUP5
#define DUP5 0
#endif
#ifndef DUP4
#define DUP4 0
#endif
    if (DUP4) { conv_phase(F); }
    if (IN(5)) { scan_phase(F); } SEAM(5);
    if (DUP5) { scan_phase(F); xcd_barrier(bar); }
    if (DUP6) { p6_rows(F); }
    if (IN(6)) { p6_rows(F); } SEAM(6);
    if (DUP7) { pg8::Gemm g{(const gb*)(ws + WS_CAT), (const gb*)(ws + WS_WOUT), T, D, D, D, D, 0}; SplitOrder S; S.init(D, F.G, (int)blockIdx.x, D, 4);
        EpiResid E{F.in[0], F.in[1], (bf16*)(ws + WS_Z), nullptr, nullptr, (h16*)(ws + WS_PART7), nullptr};
        pg8::gemm_phase<EpiResid, SplitOrder, true, true>(F.lds, g, S, E); xcd_barrier(bar); }
    if (IN(7)) {
        pg8::Gemm g{(const gb*)(ws + WS_CAT), (const gb*)(ws + WS_WOUT), T, D, D, D, D, 0}; SplitOrder S; S.init(D, F.G, (int)blockIdx.x, D, 4);
        EpiResid E{F.in[0], F.in[1], (bf16*)(ws + WS_Z), nullptr, nullptr, (h16*)(ws + WS_PART7), nullptr};
        pg8::gemm_phase<EpiResid, SplitOrder, true, true>(F.lds, g, S, E);
    } SEAM(7);
    if (DUPLN) { ln_rows<0, 4>(F, F.in[25], F.in[26], (const h16*)(ws + WS_PART7), nullptr, TP); xcd_barrier(bar); }
    if (IN(8)) { ln_rows<0, 4>(F, F.in[25], F.in[26], (const h16*)(ws + WS_PART7), nullptr); } SEAM(8);
#define FFN_PHASES(layer, pgu, pdn) \
    if (IN(pgu)) { \
        pg8::Gemm g{(const gb*)(ws + WS_XB), (const gb*)(ws + ((layer) ? WS_WGU1 : WS_WGU0)), T, 2 * FF, D, D, D, 0}; pg8::StaticOrder S; S.init(T, 2 * FF, F.G, (int)blockIdx.x, D); \
        EpiGateUp E{(bf16*)(ws + WS_H)}; \
        pg8::gemm_phase<EpiGateUp, pg8::StaticOrder, true, true>(F.lds, g, S, E); \
    } SEAM(pgu); \
    if (IN(pdn)) { \
        pg8::Gemm g{(const gb*)(ws + WS_H), (const gb*)(ws + ((layer) ? WS_WD1 : WS_WD0)), T, D, FF, FF, FF, 0}; SplitOrder S; S.init(D, F.G, (int)blockIdx.x, FF, 11); \
        EpiResid E{nullptr, nullptr, (bf16*)(ws + WS_Z), nullptr, (const bf16*)(ws + WS_XR), (h16*)(ws + WS_PARTA), (h16*)(ws + WS_PARTB)}; \
        pg8::gemm_phase<EpiResid, SplitOrder, true, true>(F.lds, g, S, E); \
    } SEAM(pdn);
    if (DUP9) { pg8::Gemm g{(const gb*)(ws + WS_XB), (const gb*)(ws + WS_WGU0), T, 2 * FF, D, D, D, 0}; pg8::StaticOrder S; S.init(T, 2 * FF, F.G, (int)blockIdx.x, D);
        EpiGateUp E{(bf16*)(ws + WS_H)}; pg8::gemm_phase<EpiGateUp, pg8::StaticOrder, true, true>(F.lds, g, S, E); xcd_barrier(bar); }
    FFN_PHASES(0, 9, 10)
    if (DUP10) { pg8::Gemm g{(const gb*)(ws + WS_H), (const gb*)(ws + WS_WD0), T, D, FF, FF, FF, 0}; SplitOrder S; S.init(D, F.G, (int)blockIdx.x, FF, 11);
        EpiResid E{nullptr, nullptr, (bf16*)(ws + WS_Z), nullptr, (const bf16*)(ws + WS_XR), (h16*)(ws + WS_PARTA), (h16*)(ws + WS_PARTB)};
        pg8::gemm_phase<EpiResid, SplitOrder, true, true>(F.lds, g, S, E); xcd_barrier(bar); }
    if (IN(11)) { ln_rows<1, 11>(F, F.in[30], F.in[31], (const h16*)(ws + WS_PARTA), (const h16*)(ws + WS_PARTB)); } SEAM(11);
    if (DUP12) { pool_phase(F); }
    if (IN(12)) { pool_phase(F); } SEAM(12);
    if (DUP13) { pg8::Gemm g{(const gb*)(ws + WS_PL), (const gb*)(ws + WS_POOLT), T, D, 256, D, 256, 256}; pg8::StaticOrder S; S.init(T, D, F.G, (int)blockIdx.x, 256);
        EpiResid E{nullptr, nullptr, (bf16*)(ws + WS_Z), F.in[24], (const bf16*)(ws + WS_XR), nullptr, nullptr};
        pg8::gemm_phase<EpiResid, pg8::StaticOrder, true, true>(F.lds, g, S, E); xcd_barrier(bar); }
    if (IN(13)) {
        pg8::Gemm g{(const gb*)(ws + WS_PL), (const gb*)(ws + WS_POOLT), T, D, 256, D, 256, 256}; SplitOrder S; S.init(D, F.G, (int)blockIdx.x, 256, 2);
        EpiResid E{nullptr, nullptr, (bf16*)(ws + WS_Z), F.in[24], (const bf16*)(ws + WS_XR), (h16*)(ws + WS_PART7), nullptr};
        pg8::gemm_phase<EpiResid, SplitOrder, true, true>(F.lds, g, S, E);
    } SEAM(13);
    if (IN(14)) { ln_rows<0, 2>(F, F.in[25] + D, F.in[26] + D, (const h16*)(ws + WS_PART7), nullptr); } SEAM(14);
    FFN_PHASES(1, 15, 16)
    if (IN(17)) { ln_rows<2, 11>(F, F.in[30] + D, F.in[31] + D, (const h16*)(ws + WS_PARTA), (const h16*)(ws + WS_PARTB)); }
    if (PROF) {
        STAMP(18);
        xcd_barrier(bar);
        if (blockIdx.x == 0) {
            const size_t obase[10] = {O_Y, O_Y + (size_t)TP * D, O_CONV_P, O_SHIFT_P, O_WKV_P, O_POOL_P, O_CONV_S, O_SHIFT_S, O_WKV_S, O_POOL_S};
#pragma unroll
            for (int k = 0; k < 10; ++k) {
                const int a = PROF == 1 ? k : 10 + k; unsigned long long d;
                if (a < 18) d = (tsbuf[a + 1] - tsbuf[a]) / 10ull; else if (a == 18) d = (tsbuf[18] - tsbuf[0]) / 100ull; else d = 1000ull;
                unsigned n = (unsigned)d; if (n > 14000u) n = 14000u; if (n < 1u) n = 1u;
                for (unsigned i = F.tid; i < n; i += NTHREADS) ((unsigned*)F.out)[obase[k] + i] = 0xAAAAAAAAu;
            }
        }
    }
    if (lo == 100) diag_checks(F, args.pad);
    if (lo == 101) diag_fill(F);
#undef IN
#undef SEAM
}

extern "C" void kernel_launch(void* const* d_in, const int* in_sizes, int n_in, void* d_out, int out_size, void* d_ws, size_t ws_size, hipStream_t stream) {
    static int grid = 0;
    if (grid == 0) {
        if (n_in != 32 || out_size != (int)O_TOTAL || ws_size < WS_END) { fprintf(stderr, "kernel_launch: unexpected shapes: n_in %d out %d ws %zu\n", n_in, out_size, ws_size); grid = -1; return; }
        int dev = 0, cus = 0, per_cu = 0;
        if (hipGetDevice(&dev) != hipSuccess || hipDeviceGetAttribute(&cus, hipDeviceAttributeMultiprocessorCount, dev) != hipSuccess) { grid = -1; return; }
        if (hipFuncSetAttribute((const void*)mk_fwd, hipFuncAttributeMaxDynamicSharedMemorySize, LDS_BYTES) != hipSuccess) { fprintf(stderr, "kernel_launch: hipFuncSetAttribute failed\n"); grid = -1; return; }
        if (hipOccupancyMaxActiveBlocksPerMultiprocessor(&per_cu, (const void*)mk_fwd, NTHREADS, LDS_BYTES) != hipSuccess || per_cu < 1) { fprintf(stderr, "kernel_launch: occupancy query says %d\n", per_cu); (void)hipGetLastError(); per_cu = 1; }
        grid = cus * 1;
        if (per_cu < 1) grid = -1;
    }
    if (grid < 0) return;
    Args a{};
    for (int i = 0; i < 32; ++i) a.in[i] = (const float*)d_in[i];
    a.out = (float*)d_out; a.ws = (unsigned char*)d_ws;
#if MK_SINGLE
    if (hipMemsetAsync(d_ws, 0, 16384, stream) != hipSuccess) { fprintf(stderr, "kernel_launch: memset failed\n"); return; }
    a.ph_lo = 0; a.ph_hi = NPHASE; a.coop = 1;
    void* params[] = {&a};
    hipError_t e = hipLaunchCooperativeKernel((const void*)mk_fwd, dim3(grid), dim3(NTHREADS), params, LDS_BYTES, stream);
    if (e != hipSuccess) fprintf(stderr, "kernel_launch: cooperative launch failed: %s (grid %d)\n", hipGetErrorString(e), grid);
#else
    for (int p = 0; p < NPHASE; ++p) {
        if (DIAG_AT >= 0 && p > DIAG_AT) break;
        a.ph_lo = p; a.ph_hi = p + 1; a.coop = 0;
        hipLaunchKernelGGL(mk_fwd, dim3(grid), dim3(NTHREADS), LDS_BYTES, stream, a);
    }
    if (DIAG_AT >= 0) { a.pad = DIAG_AT; a.ph_lo = 100; a.ph_hi = 101; hipLaunchKernelGGL(mk_fwd, dim3(grid), dim3(NTHREADS), LDS_BYTES, stream, a);
                        a.ph_lo = 101; a.ph_hi = 102; hipLaunchKernelGGL(mk_fwd, dim3(grid), dim3(NTHREADS), LDS_BYTES, stream, a); }
#endif
}
```

```cpp
#include <hip/hip_runtime.h>
#include <hip/hip_cooperative_groups.h>
#include <cstdio>
#include <cstdint>
namespace cg = cooperative_groups;
namespace pg8 {
#define PG8_LAS __attribute__((address_space(3)))
typedef unsigned short bf16_t;
typedef short bf16x8 __attribute__((ext_vector_type(8)));
typedef float f32x4 __attribute__((ext_vector_type(4)));
typedef unsigned u32x4 __attribute__((ext_vector_type(4)));
constexpr int BM = 256, BK = 64, HALF = 128, HTB = HALF * BK * 2  , STAGE_BYTES = 8 * HTB, NXCD = 8, WGM = 8;

__host__ __device__ __forceinline__ int lds_byte(int r, int c) { const int st = (r >> 4) * 2 + (c >> 5), rr = r & 15, cc = c & 31, ob = rr * 64 + cc * 2; return st * 1024 + (ob ^ (((ob >> 9) & 1) << 5)); }
__host__ __device__ __forceinline__ void stage_rc(int b, int& R, int& C) { const int st = b / 1024, sb = b % 1024, swz = sb ^ (((sb >> 9) & 1) << 5); R = (st >> 1) * 16 + swz / 64; C = (st & 1) * 32 + (swz % 64) / 2; }
__host__ __device__ __forceinline__ int perm32(int rho) { const int n = rho >> 4, i = rho & 15; return 8 * (i >> 2) + 4 * n + (i & 3); }

struct Unit { int pm, pn, kt0, nt, mode; };
struct Gemm { const bf16_t* A; const bf16_t* Bt; int M, N, K, lda, ldb, acol; };

struct StaticOrder {
    int nM, nN, nwg, G, c, ntf;
    __host__ __device__ void init(int M, int N, int G_, int c_, int K_) { nM = M / BM; nN = N / BM; nwg = nM * nN; G = G_; c = c_; ntf = K_ / BK; }
    __host__ __device__ bool next(int i, Unit& u) const {
        const long L = (long)i * G + c; if (L >= nwg) return false;
        int wgid = (int)L; { const int q = nwg / NXCD, r = nwg % NXCD, xcd = wgid % NXCD, off = wgid / NXCD; wgid = (xcd < r ? xcd * (q + 1) : r * (q + 1) + (xcd - r) * q) + off; }
        const int nig = WGM * nN, gid = wgid / nig, fm = gid * WGM, gsz = (nM - fm) < WGM ? (nM - fm) : WGM;
        u.pm = fm + ((wgid % nig) % gsz); u.pn = (wgid % nig) / gsz; u.kt0 = 0; u.nt = ntf; u.mode = 0; return true;
    }
    __device__ __forceinline__ void a_ready(const Unit&) const {}
    __device__ __forceinline__ void done(const Unit&) const {}
};

__device__ __forceinline__ unsigned cvt_pk_bf16(float lo, float hi) { unsigned r; asm volatile("v_cvt_pk_bf16_f32 %0, %1, %2" : "=v"(r) : "v"(lo), "v"(hi)); return r; }
template <class Epi, class Sched, bool ALIGN_EPI = false, bool SP2 = false>
__device__ __forceinline__ void gemm_phase(PG8_LAS unsigned char* lds, const Gemm g, const Sched& S, const Epi& E) {
    const int tid = threadIdx.x, wid = __builtin_amdgcn_readfirstlane(tid >> 6), lane = tid & 63, wr = wid >> 2, wc = wid & 3, fr = lane & 15, fq = lane >> 4;
    const int K = g.K; (void)K;
    unsigned voffA[2], voffB[2];
#pragma unroll
    for (int i = 0; i < 2; ++i) { int R, C; stage_rc(tid * 16 + i * 8192, R, C); const int Rb = Epi::PERM ? ((R & ~31) + perm32(R & 31)) : R;
        voffA[i] = (unsigned)(R * g.lda + C) * 2u; voffB[i] = (unsigned)(Rb * g.ldb + C) * 2u; }
    const size_t kstep = (size_t)(BK * 2);
    const size_t hstepA = (size_t)HALF * g.lda * 2, hstepB = (size_t)HALF * g.ldb * 2;
    const size_t tstepA = 2 * hstepA, tstepB = 2 * hstepB; const size_t acolB = (size_t)g.acol * 2;
    const unsigned ldsw = (unsigned)wid * 1024u;
    const int aoff = lds_byte(wr * 64 + fr, fq * 8), boff = lds_byte(wc * 32 + fr, fq * 8);
#define PG8_SA(b, h) (((b) * 2 + (h)) * HTB)
#define PG8_SB(b, h) ((4 + (b) * 2 + (h)) * HTB)
#define PG8_STAGE(bufoff, gbase, voff) do { _Pragma("unroll") for (int _i = 0; _i < 2; ++_i) \
        __builtin_amdgcn_global_load_lds((const unsigned*)((const char*)(gbase) + (voff)[_i]), (PG8_LAS unsigned*)(lds + (bufoff) + ldsw + _i * 8192), 16, 0, 0); } while (0)
#define PG8_LDA(dst, b, h) do { _Pragma("unroll") for (int m = 0; m < 4; ++m) _Pragma("unroll") for (int k = 0; k < 2; ++k) dst[m][k] = *(const PG8_LAS bf16x8*)(lds + PG8_SA(b, h) + aoff + m * 2048 + k * 1024); } while (0)
#define PG8_LDB(dst, b, h) do { _Pragma("unroll") for (int n = 0; n < 2; ++n) _Pragma("unroll") for (int k = 0; k < 2; ++k) dst[n][k] = *(const PG8_LAS bf16x8*)(lds + PG8_SB(b, h) + boff + n * 2048 + k * 1024); } while (0)
#define PG8_MMA(ai, bj, At, Bt) do { __builtin_amdgcn_s_setprio(1); _Pragma("unroll") for (int m = 0; m < 4; ++m) _Pragma("unroll") for (int n = 0; n < 2; ++n) _Pragma("unroll") for (int k = 0; k < 2; ++k) \
        acc[ai][bj][m][n] = __builtin_amdgcn_mfma_f32_16x16x32_bf16(Bt[n][k], At[m][k], acc[ai][bj][m][n], 0, 0, 0); __builtin_amdgcn_s_setprio(0); } while (0)
#define PG8_WAIT_V(n) asm volatile("s_waitcnt vmcnt(" #n ")" ::: "memory")
#define PG8_WAIT_L(n) asm volatile("s_waitcnt lgkmcnt(" #n ")" ::: "memory")
#define PG8_BAR __builtin_amdgcn_s_barrier()
#define PG8_SCHED __builtin_amdgcn_sched_barrier(0)
    Unit cur, nxt; int ui = 0;
    if (!S.next(0, cur)) return;
    f32x4 acc[2][2][4][2];
#pragma unroll
    for (int a = 0; a < 2; ++a)
#pragma unroll
        for (int b = 0; b < 2; ++b)
#pragma unroll
            for (int m = 0; m < 4; ++m)
#pragma unroll
                for (int n = 0; n < 2; ++n) acc[a][b][m][n] = (f32x4){0.f, 0.f, 0.f, 0.f};
    bf16x8 At[4][2], B0[2][2], B1[2][2];
    const char* cA = (const char*)g.A + (size_t)cur.pm * tstepA + (size_t)cur.pn * acolB + (size_t)cur.kt0 * kstep; const char* cB = (const char*)g.Bt + (size_t)cur.pn * tstepB + (size_t)cur.kt0 * kstep;
    S.a_ready(cur);
    if constexpr (SP2) {
        PG8_STAGE(PG8_SB(0, 0), cB, voffB); PG8_STAGE(PG8_SB(0, 1), cB + hstepB, voffB); PG8_STAGE(PG8_SA(0, 0), cA, voffA); PG8_STAGE(PG8_SA(0, 1), cA + hstepA, voffA);
        if (wr == 1) PG8_BAR;
        PG8_WAIT_V(2); PG8_BAR;
        PG8_STAGE(PG8_SB(1, 0), cB + kstep, voffB); PG8_STAGE(PG8_SA(1, 0), cA + kstep, voffA); PG8_STAGE(PG8_SB(1, 1), cB + hstepB + kstep, voffB);
        PG8_WAIT_V(6); PG8_BAR;
    } else {
        PG8_STAGE(PG8_SB(0, 0), cB, voffB); PG8_STAGE(PG8_SA(0, 0), cA, voffA); PG8_STAGE(PG8_SB(0, 1), cB + hstepB, voffB); PG8_STAGE(PG8_SA(0, 1), cA + hstepA, voffA);
        if (wr == 1) PG8_BAR;
        PG8_WAIT_V(4); PG8_BAR;
        PG8_STAGE(PG8_SB(1, 0), cB + kstep, voffB); PG8_STAGE(PG8_SA(1, 0), cA + kstep, voffA); PG8_STAGE(PG8_SB(1, 1), cB + hstepB + kstep, voffB);
        PG8_WAIT_V(6); PG8_BAR;
    }
    for (;;) {
        const bool has_next = S.next(ui + 1, nxt);
        const char* nA = has_next ? (const char*)g.A + (size_t)nxt.pm * tstepA + (size_t)nxt.pn * acolB + (size_t)nxt.kt0 * kstep : cA; const char* nB = has_next ? (const char*)g.Bt + (size_t)nxt.pn * tstepB + (size_t)nxt.kt0 * kstep : cB;
        const int nt = cur.nt;
        _Pragma("unroll 1") for (int t = 0; t < nt; t += 2) {
            const bool last = (t == nt - 2);
            const char* a1 = cA + (size_t)(t + 1) * kstep;
            const char* a2 = last ? nA : cA + (size_t)(t + 2) * kstep; const char* b2 = last ? nB : cB + (size_t)(t + 2) * kstep;
            const char* a3 = a2 + kstep; const char* b3 = b2 + kstep;
            if (last && has_next) S.a_ready(nxt);
            if constexpr (SP2) {
            PG8_LDB(B0, 0, 0); PG8_LDB(B1, 0, 1); PG8_SCHED; PG8_LDA(At, 0, 0); PG8_STAGE(PG8_SA(1, 1), a1 + hstepA, voffA);
            PG8_WAIT_V(8); PG8_WAIT_L(0); PG8_BAR; PG8_MMA(0, 0, At, B0); PG8_MMA(0, 1, At, B1); PG8_BAR; PG8_SCHED;
            PG8_LDA(At, 0, 1); PG8_STAGE(PG8_SB(0, 0), b2, voffB); PG8_STAGE(PG8_SB(0, 1), b2 + hstepB, voffB); PG8_STAGE(PG8_SA(0, 0), a2, voffA);
            PG8_WAIT_V(8); PG8_WAIT_L(0); PG8_BAR; PG8_MMA(1, 0, At, B0); PG8_MMA(1, 1, At, B1); PG8_BAR; PG8_SCHED;
            PG8_LDB(B0, 1, 0); PG8_LDB(B1, 1, 1); PG8_SCHED; PG8_LDA(At, 1, 0); PG8_STAGE(PG8_SA(0, 1), a2 + hstepA, voffA);
            PG8_WAIT_V(8); PG8_WAIT_L(0); PG8_BAR; PG8_MMA(0, 0, At, B0); PG8_MMA(0, 1, At, B1); PG8_BAR; PG8_SCHED;
            PG8_LDA(At, 1, 1); PG8_STAGE(PG8_SB(1, 0), b3, voffB); PG8_STAGE(PG8_SB(1, 1), b3 + hstepB, voffB); PG8_STAGE(PG8_SA(1, 0), a3, voffA);
            PG8_WAIT_V(8); PG8_WAIT_L(0); PG8_BAR; PG8_MMA(1, 0, At, B0); PG8_MMA(1, 1, At, B1); PG8_BAR; PG8_SCHED;
            } else {
            PG8_LDB(B0, 0, 0); PG8_SCHED; PG8_LDA(At, 0, 0); PG8_STAGE(PG8_SA(1, 1), a1 + hstepA, voffA);
            PG8_WAIT_L(8); PG8_BAR; PG8_WAIT_L(0); PG8_MMA(0, 0, At, B0); PG8_BAR; PG8_SCHED;
            PG8_LDB(B1, 0, 1); PG8_STAGE(PG8_SB(0, 0), b2, voffB);
            PG8_BAR; PG8_WAIT_L(0); PG8_MMA(0, 1, At, B1); PG8_BAR;
            PG8_LDA(At, 0, 1); PG8_STAGE(PG8_SA(0, 0), a2, voffA);
            PG8_BAR; PG8_WAIT_L(0); PG8_MMA(1, 0, At, B0); PG8_BAR; PG8_SCHED;
            PG8_STAGE(PG8_SB(0, 1), b2 + hstepB, voffB);
            PG8_WAIT_V(6); PG8_BAR; PG8_MMA(1, 1, At, B1); PG8_BAR;
            PG8_LDB(B0, 1, 0); PG8_SCHED; PG8_LDA(At, 1, 0); PG8_STAGE(PG8_SA(0, 1), a2 + hstepA, voffA);
            PG8_WAIT_L(8); PG8_BAR; PG8_WAIT_L(0); PG8_MMA(0, 0, At, B0); PG8_BAR; PG8_SCHED;
            PG8_LDB(B1, 1, 1); PG8_STAGE(PG8_SB(1, 0), b3, voffB);
            PG8_BAR; PG8_WAIT_L(0); PG8_MMA(0, 1, At, B1); PG8_BAR;
            PG8_LDA(At, 1, 1); PG8_STAGE(PG8_SA(1, 0), a3, voffA);
            PG8_BAR; PG8_WAIT_L(0); PG8_MMA(1, 0, At, B0); PG8_BAR; PG8_SCHED;
            PG8_STAGE(PG8_SB(1, 1), b3 + hstepB, voffB);
            PG8_WAIT_V(6); PG8_BAR; PG8_MMA(1, 1, At, B1); PG8_BAR;
            }
        }
        if constexpr (ALIGN_EPI) { if (wr == 0) PG8_BAR; }
        if constexpr (!Epi::AFTER_DRAIN) { E(acc, cur, wr, wc, fr, fq); S.done(cur); }
        if (!has_next) break;
#pragma unroll
        for (int a = 0; a < 2; ++a)
#pragma unroll
            for (int b = 0; b < 2; ++b)
#pragma unroll
                for (int m = 0; m < 4; ++m)
#pragma unroll
                    for (int n = 0; n < 2; ++n) acc[a][b][m][n] = (f32x4){0.f, 0.f, 0.f, 0.f};
        cur = nxt; cA = nA; cB = nB; ++ui;
        if constexpr (ALIGN_EPI) { if (wr == 1) PG8_BAR; }
    }
    PG8_WAIT_V(0);
    if constexpr (!ALIGN_EPI) { if (wr == 0) PG8_BAR; }
    PG8_BAR;
    if constexpr (Epi::AFTER_DRAIN) { E.fused(acc, cur, wr, wc, fr, fq, lds, wid, lane); S.done(cur); }
#undef PG8_SA
#undef PG8_SB
#undef PG8_STAGE
#undef PG8_LDA
#undef PG8_LDB
#undef PG8_MMA
#undef PG8_WAIT_V
#undef PG8_WAIT_L
#undef PG8_BAR
#undef PG8_SCHED
}
}

#define GAS __attribute__((address_space(1)))
#define LAS __attribute__((address_space(3)))
typedef unsigned short bf16;
typedef unsigned v4u __attribute__((ext_vector_type(4)));
typedef unsigned v2u __attribute__((ext_vector_type(2)));
typedef float f32x4 __attribute__((ext_vector_type(4)));
typedef _Float16 h16;
typedef _Float16 h16x2 __attribute__((ext_vector_type(2)));

#ifndef MK_SINGLE
#define MK_SINGLE 1
#endif

constexpr int NWAVES = 8, NTHREADS = NWAVES * 64;
constexpr int D = 1024, TP = 16384, TS = 1024, T = TP + TS, LP = 2048, LS = 8, NPB = 8, NSB = 128;
constexpr int INP = 2816, BP = 1792, FF = 2816, HW = 512;
constexpr float ALPHA = 1.41421356237309515f, LN_EPS = 1e-5f, GN_EPS = 64e-5f;
constexpr int NPHASE = 18;

constexpr size_t MiB = 1u << 20;
constexpr size_t WS_WIN = 1 * MiB, WS_WOUT = WS_WIN + 5632 * 1024, WS_WGU0 = WS_WOUT + 2 * MiB, WS_WGU1 = WS_WGU0 + 11 * MiB, WS_WD0 = WS_WGU1 + 11 * MiB, WS_WD1 = WS_WD0 + 5632 * 1024,
                 WS_POOLT = WS_WD1 + 5632 * 1024, WS_LORAT = WS_POOLT + 512 * 1024;
constexpr size_t WS_XB = 43 * MiB;
constexpr size_t WS_SCW = 43 * MiB, WS_G = 60 * MiB;
constexpr size_t WS_PROJA = 77 * MiB;
constexpr size_t WS_PROJB = 111 * MiB;
constexpr size_t WS_CAT = 111 * MiB, WS_SCB = 145 * MiB, WS_O = 162 * MiB;
constexpr size_t WS_LA = 170 * MiB + 512 * 1024;
constexpr size_t WS_SCR = 179 * MiB, WS_SCV = 196 * MiB, WS_SCK = 213 * MiB, WS_SCKK = 230 * MiB;
constexpr size_t WS_Z = 222 * MiB;
constexpr size_t WS_H = 77 * MiB;
constexpr size_t WS_PL = 77 * MiB;
constexpr size_t WS_PART7 = 145 * MiB;
constexpr size_t WS_PARTA = 170 * MiB + 512 * 1024, WS_PARTB = 1 * MiB;
constexpr size_t WS_XR = 43 * MiB;
constexpr size_t WS_END = 256 * MiB;
static_assert(WS_LORAT + 1536 * 256 * 2 <= WS_XB, "weights");
static_assert(WS_PROJB + (size_t)T * BP * 2 <= WS_LA, "projb");
static_assert(WS_H + (size_t)T * FF * 2 <= WS_Z, "h");
static_assert(WS_Z + (size_t)T * D * 2 <= WS_END, "z");

constexpr size_t O_Y = 0, O_CONV_P = 17825792, O_SHIFT_P = 17948672, O_WKV_P = 17963008, O_POOL_P = 18225152,
                 O_CONV_S = 18348032, O_SHIFT_S = 20314112, O_WKV_S = 20543488, O_POOL_S = 24737792, O_TOTAL = 26703872;

constexpr int LDS_BYTES = 147456;

struct Frame {
    LAS unsigned char* lds;
    int tid, lane, wave, vcu, G;
    const float* const* in;
    float* out; unsigned char* ws;
};

__device__ __forceinline__ float bf2f(unsigned b) { return __uint_as_float(b << 16); }
__device__ __forceinline__ unsigned pkbf(float lo, float hi) { return pg8::cvt_pk_bf16(lo, hi); }
__device__ __forceinline__ unsigned pkh(float lo, float hi) { const unsigned short a = __builtin_bit_cast(unsigned short, (h16)lo), b = __builtin_bit_cast(unsigned short, (h16)hi); return (unsigned)a | ((unsigned)b << 16); }
__device__ __forceinline__ float hlo(unsigned u) { return (float)__builtin_bit_cast(h16, (unsigned short)(u & 0xffffu)); }
__device__ __forceinline__ float hhi(unsigned u) { return (float)__builtin_bit_cast(h16, (unsigned short)(u >> 16)); }
__device__ __forceinline__ void unpack_bf8(v4u w, float (&f)[8]) { const unsigned u0 = w.x, u1 = w.y, u2 = w.z, u3 = w.w;
    f[0] = __uint_as_float(u0 << 16); f[1] = __uint_as_float(u0 & 0xffff0000u); f[2] = __uint_as_float(u1 << 16); f[3] = __uint_as_float(u1 & 0xffff0000u);
    f[4] = __uint_as_float(u2 << 16); f[5] = __uint_as_float(u2 & 0xffff0000u); f[6] = __uint_as_float(u3 << 16); f[7] = __uint_as_float(u3 & 0xffff0000u); }
__device__ __forceinline__ void unpack_h8(v4u w, float (&f)[8]) { const unsigned u0 = w.x, u1 = w.y, u2 = w.z, u3 = w.w; f[0] = hlo(u0); f[1] = hhi(u0); f[2] = hlo(u1); f[3] = hhi(u1); f[4] = hlo(u2); f[5] = hhi(u2); f[6] = hlo(u3); f[7] = hhi(u3); }
__device__ __forceinline__ v4u pack_bf8(const float (&f)[8]) { v4u w; w.x = pkbf(f[0], f[1]); w.y = pkbf(f[2], f[3]); w.z = pkbf(f[4], f[5]); w.w = pkbf(f[6], f[7]); return w; }
__device__ __forceinline__ v4u pack_h8(const float (&f)[8]) { v4u w; w.x = pkh(f[0], f[1]); w.y = pkh(f[2], f[3]); w.z = pkh(f[4], f[5]); w.w = pkh(f[6], f[7]); return w; }
__device__ __forceinline__ void load_f8(const float* p, float (&f)[8]) { const f32x4 a = *(const f32x4*)p, b = *(const f32x4*)(p + 4); f[0] = a.x; f[1] = a.y; f[2] = a.z; f[3] = a.w; f[4] = b.x; f[5] = b.y; f[6] = b.z; f[7] = b.w; }
__device__ __forceinline__ void store_f8(float* p, const float (&f)[8]) { *(f32x4*)p = (f32x4){f[0], f[1], f[2], f[3]}; *(f32x4*)(p + 4) = (f32x4){f[4], f[5], f[6], f[7]}; }
__device__ __forceinline__ float sigmoid_(float x) { return __builtin_amdgcn_rcpf(1.f + __expf(-x)); }
__device__ __forceinline__ float silu_(float x) { return x * sigmoid_(x); }
__device__ __forceinline__ float wave_sum(float v) {
#pragma unroll
    for (int o = 1; o < 64; o <<= 1) v += __shfl_xor(v, o);
    return v;
}
__device__ __forceinline__ float sum8(float v) { v += __shfl_xor(v, 1); v += __shfl_xor(v, 2); v += __shfl_xor(v, 4); return v; }
template <int CTRL> __device__ __forceinline__ float dppf(float x) { return __builtin_bit_cast(float, __builtin_amdgcn_update_dpp(0, __builtin_bit_cast(int, x), CTRL, 0xF, 0xF, true)); }
__device__ __forceinline__ float dpp_sum16(float x) {
    x += dppf<0xB1>(x);
    x += dppf<0x4E>(x);
    x += dppf<0x141>(x);
    x += dppf<0x140>(x);
    return x;
}
__device__ __forceinline__ void h4(v2u x, float (&f)[4]) { const unsigned u0 = x.x, u1 = x.y; f[0] = hlo(u0); f[1] = hhi(u0); f[2] = hlo(u1); f[3] = hhi(u1); }
__device__ __forceinline__ const float* xrow_ptr(const Frame& F, int m) { return m < TP ? F.in[0] + (size_t)m * D : F.in[1] + (size_t)(m - TP) * D; }

using pg8::Unit; using pg8::HALF; using pg8::BM;
typedef pg8::u32x4 u32x4;
struct EpiProj {
    static constexpr bool PERM = true, AFTER_DRAIN = false;
    bf16* PA; bf16* PB;
    __device__ __forceinline__ void operator()(const pg8::f32x4 (&acc)[2][2][4][2], const Unit& u, int wr, int wc, int fr, int fq) const {
        const int row0 = u.pm * BM + wr * 64 + fr;
        if (u.pn < 4) {
            const int col0 = u.pn * HALF + wc * 32 + 8 * fq;
#pragma unroll
            for (int ai = 0; ai < 2; ++ai)
#pragma unroll
                for (int m = 0; m < 4; ++m) {
                    const pg8::f32x4 v0 = acc[ai][0][m][0], v1 = acc[ai][0][m][1], g0 = acc[ai][1][m][0], g1 = acc[ai][1][m][1];
                    u32x4 w; w.x = pkbf(v0[0] * sigmoid_(g0[0]), v0[1] * sigmoid_(g0[1])); w.y = pkbf(v0[2] * sigmoid_(g0[2]), v0[3] * sigmoid_(g0[3]));
                    w.z = pkbf(v1[0] * sigmoid_(g1[0]), v1[1] * sigmoid_(g1[1])); w.w = pkbf(v1[2] * sigmoid_(g1[2]), v1[3] * sigmoid_(g1[3]));
                    *(u32x4*)(PA + (size_t)(row0 + ai * HALF + m * 16) * 512 + col0) = w;
                }
        } else {
            const int col0 = (u.pn - 4) * BM + wc * 32 + 8 * fq;
#pragma unroll
            for (int ai = 0; ai < 2; ++ai)
#pragma unroll
                for (int m = 0; m < 4; ++m) { bf16* rowp = PB + (size_t)(row0 + ai * HALF + m * 16) * BP + col0;
#pragma unroll
                    for (int bj = 0; bj < 2; ++bj) { const pg8::f32x4 v0 = acc[ai][bj][m][0], v1 = acc[ai][bj][m][1];
                        u32x4 w; w.x = pkbf(v0[0], v0[1]); w.y = pkbf(v0[2], v0[3]); w.z = pkbf(v1[0], v1[1]); w.w = pkbf(v1[2], v1[3]);
                        *(u32x4*)(rowp + bj * HALF) = w; } }
        }
    }
};
struct EpiLora {
    static constexpr bool PERM = true, AFTER_DRAIN = false;
    const float* w0; const float* a0; const float* ka;
    h16* SCW; h16* SCK; h16* SCKK; h16* SCB; h16* G;
    __device__ __forceinline__ void operator()(const pg8::f32x4 (&acc)[2][2][4][2], const Unit& u, int wr, int wc, int fr, int fq) const {
        const int row0 = u.pm * BM + wr * 64 + fr; const int sec = u.pn >> 1;
        const int c0 = (u.pn & 1) * BM + wc * 32 + 8 * fq;
#pragma unroll
        for (int bj = 0; bj < 2; ++bj) {
            const int c = c0 + bj * HALF;
            float p0[8], p1[8];
            if (sec == 0) load_f8(w0 + c, p0); else if (sec == 1) { load_f8(a0 + c, p0); load_f8(ka + c, p1); }
#pragma unroll
            for (int ai = 0; ai < 2; ++ai) {
                v4u kxr[4], kkr[4];
                if (sec == 1) {
#pragma unroll
                    for (int m = 0; m < 4; ++m) { const size_t off = (size_t)(row0 + ai * HALF + m * 16) * HW + c; kxr[m] = *(const v4u*)(SCK + off); kkr[m] = *(const v4u*)(SCKK + off); }
                }
#pragma unroll
                for (int m = 0; m < 4; ++m) {
                    const size_t off = (size_t)(row0 + ai * HALF + m * 16) * HW + c;
                    const pg8::f32x4 v0 = acc[ai][bj][m][0], v1 = acc[ai][bj][m][1];
                    const float v[8] = {v0[0], v0[1], v0[2], v0[3], v1[0], v1[1], v1[2], v1[3]};
                    if (sec == 0) {
                        float o[8];
#pragma unroll
                        for (int i = 0; i < 8; ++i) { const float e = 0.60653065971f * sigmoid_(p0[i] + v[i]); o[i] = 1.f - __expf(-e); }
                        *(v4u*)(SCW + off) = pack_h8(o);
                    } else if (sec == 1) {
                        float kx[8], kk[8], ko[8], bo[8];
                        unpack_h8(kxr[m], kx); unpack_h8(kkr[m], kk);
#pragma unroll
                        for (int i = 0; i < 8; ++i) { const float a = sigmoid_(p0[i] + v[i]); ko[i] = kx[i] * (1.f + (a - 1.f) * p1[i]); bo[i] = kk[i] * a; }
                        *(v4u*)(SCK + off) = pack_h8(ko); *(v4u*)(SCB + off) = pack_h8(bo);
                    } else {
                        *(v4u*)(G + off) = pack_h8(v);
                    }
                }
                asm volatile("" ::: "memory");
            }
        }
    }
};
struct EpiGateUp {
    static constexpr bool PERM = true, AFTER_DRAIN = false;
    bf16* H;
    __device__ __forceinline__ void operator()(const pg8::f32x4 (&acc)[2][2][4][2], const Unit& u, int wr, int wc, int fr, int fq) const {
        const int row0 = u.pm * BM + wr * 64 + fr; const int col0 = u.pn * HALF + wc * 32 + 8 * fq;
#pragma unroll
        for (int ai = 0; ai < 2; ++ai)
#pragma unroll
            for (int m = 0; m < 4; ++m) {
                const pg8::f32x4 g0 = acc[ai][0][m][0], g1 = acc[ai][0][m][1], u0 = acc[ai][1][m][0], u1 = acc[ai][1][m][1];
                u32x4 w; w.x = pkbf(silu_(g0[0]) * u0[0], silu_(g0[1]) * u0[1]); w.y = pkbf(silu_(g0[2]) * u0[2], silu_(g0[3]) * u0[3]);
                w.z = pkbf(silu_(g1[0]) * u1[0], silu_(g1[1]) * u1[1]); w.w = pkbf(silu_(g1[2]) * u1[2], silu_(g1[3]) * u1[3]);
                *(u32x4*)(H + (size_t)(row0 + ai * HALF + m * 16) * FF + col0) = w;
            }
    }
};
struct EpiResid {
    static constexpr bool PERM = true, AFTER_DRAIN = false;
    const float* xp; const float* xs; bf16* Z; const float* scale;
    const bf16* XBr;
    h16* pa; h16* pb;
    __device__ __forceinline__ void operator()(const pg8::f32x4 (&acc)[2][2][4][2], const Unit& u, int wr, int wc, int fr, int fq) const {
        const int col0 = u.pn * BM + wc * 32 + 8 * fq;
        float sc[2][8];
#pragma unroll
        for (int bj = 0; bj < 2; ++bj) { if (scale) load_f8(scale + col0 + bj * HALF, sc[bj]); else {
#pragma unroll
                for (int i = 0; i < 8; ++i) sc[bj][i] = 1.f; } }
#pragma unroll
        for (int ai = 0; ai < 2; ++ai)
#pragma unroll
            for (int m = 0; m < 4; ++m) {
                const int row = u.pm * BM + ai * HALF + wr * 64 + m * 16 + fr;
#pragma unroll
                for (int bj = 0; bj < 2; ++bj) {
                    const int c = col0 + bj * HALF;
                    const pg8::f32x4 a0 = acc[ai][bj][m][0], a1 = acc[ai][bj][m][1];
                    float a[8] = {a0[0] * sc[bj][0], a0[1] * sc[bj][1], a0[2] * sc[bj][2], a0[3] * sc[bj][3], a1[0] * sc[bj][4], a1[1] * sc[bj][5], a1[2] * sc[bj][6], a1[3] * sc[bj][7]};
                    if (u.mode == 1) {
                        const int sp = u.kt0 / u.nt;
                        h16* pr = (sp < 8 ? pa + (size_t)sp * (1u << 20) : pb + (size_t)(sp - 8) * (1u << 20)) + (size_t)(row - TP) * D + c;
                        *(v4u*)pr = pack_h8(a);
                    } else {
                        float b[8];
                        if (xp) load_f8((row < TP ? xp + (size_t)row * D : xs + (size_t)(row - TP) * D) + c, b);
                        else unpack_bf8(*(const v4u*)(XBr + (size_t)row * D + c), b);
#pragma unroll
                        for (int i = 0; i < 8; ++i) a[i] = ALPHA * b[i] + a[i];
                        *(v4u*)(Z + (size_t)row * D + c) = pack_bf8(a);
                    }
                }
            }
    }
};

struct SplitOrder {
    pg8::StaticOrder base; int NS, ntc, c;
    __device__ void init(int N, int G, int c_, int K, int NS_) { base.init(TP, N, G, c_, K); NS = NS_; ntc = (K / pg8::BK) / NS_; c = c_; }
    __device__ bool next(int i, Unit& u) const {
        if (i == 0) return base.next(0, u);
        if (i == 1) { if (c >= 16 * NS) return false; const int unit = c / NS, sp = c % NS; u.pm = 64 + (unit >> 2); u.pn = unit & 3; u.kt0 = sp * ntc; u.nt = ntc; u.mode = 1; return true; }
        return false;
    }
    __device__ __forceinline__ void a_ready(const Unit&) const {}
    __device__ __forceinline__ void done(const Unit&) const {}
};

__device__ __forceinline__ void transpose_item(const float* W, int K, int N, bf16* WT, int mode, LAS float* scr, int item, int lane) {
    const int nblk = N / 32, kb = item / nblk, nb = item % nblk, k0 = 64 * kb, n0 = 32 * nb;
    int drow0;
    if (mode == 0) drow0 = n0;
    else if (mode == 3) drow0 = n0 >= 1024 ? n0 : (n0 < 512 ? ((n0 >> 7) * 256 + (n0 & 127)) : ((((n0 - 512) >> 7) * 256) + 128 + ((n0 - 512) & 127)));
    else drow0 = (n0 >> 7) * 256 + (mode == 2 ? 128 : 0) + (n0 & 127);
    float tv[32];
#pragma unroll
    for (int i = 0; i < 32; ++i) { const int kk = 2 * i + (lane >> 5); tv[i] = __builtin_nontemporal_load(W + (size_t)(k0 + kk) * N + n0 + (lane & 31)); }
#pragma unroll
    for (int i = 0; i < 32; ++i) { const int kk = 2 * i + (lane >> 5); scr[kk * 33 + (lane & 31)] = tv[i]; }
    asm volatile("s_waitcnt lgkmcnt(0)" ::: "memory");
    const int c = lane & 7;
#pragma unroll
    for (int j = 0; j < 4; ++j) { const int n = (lane >> 3) + 8 * j; const LAS float* s = scr + (8 * c) * 33 + n;
        v4u o; o.x = pkbf(s[0 * 33], s[1 * 33]); o.y = pkbf(s[2 * 33], s[3 * 33]); o.z = pkbf(s[4 * 33], s[5 * 33]); o.w = pkbf(s[6 * 33], s[7 * 33]);
        *(v4u*)(WT + (size_t)(drow0 + n) * K + k0 + 8 * c) = o; }
    asm volatile("s_waitcnt lgkmcnt(0)" ::: "memory");
}
__device__ __forceinline__ void p0_prologue(Frame& F) {
    LAS float* scr = (LAS float*)(F.lds + F.wave * 16384);
    const int gw = F.vcu * NWAVES + F.wave, NGW = F.G * NWAVES;
    unsigned char* ws = F.ws;
    constexpr int I_IN = 16 * 88, I_OUT = 16 * 32, I_GU = 16 * 88, I_DN = 44 * 32, I_PL = 4 * 8;
    constexpr int NITEMS = I_IN + I_OUT + 2 * (2 * I_GU + I_DN) + 4 * I_PL;
    for (int it = gw; it < NITEMS; it += NGW) {
        int r = it;
        if (r < I_IN) { transpose_item(F.in[6], D, INP, (bf16*)(ws + WS_WIN), 3, scr, r, F.lane); continue; } r -= I_IN;
        if (r < I_OUT) { transpose_item(F.in[22], D, D, (bf16*)(ws + WS_WOUT), 0, scr, r, F.lane); continue; } r -= I_OUT;
        constexpr int I_LAYER = 2 * I_GU + I_DN;
        if (r < 2 * I_LAYER) {
            const int l = r / I_LAYER; int q = r % I_LAYER;
            bf16* gu = (bf16*)(ws + (l ? WS_WGU1 : WS_WGU0)); bf16* dn = (bf16*)(ws + (l ? WS_WD1 : WS_WD0));
            if (q < I_GU) { transpose_item(F.in[27] + (size_t)l * D * FF, D, FF, gu, 1, scr, q, F.lane); continue; } q -= I_GU;
            if (q < I_GU) { transpose_item(F.in[28] + (size_t)l * D * FF, D, FF, gu, 2, scr, q, F.lane); continue; } q -= I_GU;
            transpose_item(F.in[29] + (size_t)l * FF * D, FF, D, dn, 0, scr, q, F.lane); continue;
        }
        r -= 2 * I_LAYER;
        { const int g = r / I_PL, ri = r % I_PL; transpose_item(F.in[23] + (size_t)g * 65536, 256, 256, (bf16*)(ws + WS_POOLT) + (size_t)g * 65536, 0, scr, ri, F.lane); }
    }
    const int gt = F.vcu * NTHREADS + F.tid, NGT = F.G * NTHREADS;
    bf16* XB = (bf16*)(ws + WS_XB);
    bf16* Zp = (bf16*)(ws + WS_Z);
    for (int i0 = gt; i0 < T * D / 8; i0 += 4 * NGT) {
        float f[4][8];
#pragma unroll
        for (int u = 0; u < 4; ++u) { const int i = i0 + u * NGT; if (i < T * D / 8) { const int m = i >> 7, c8 = (i & 127) * 8; const f32x4* xp4 = (const f32x4*)(xrow_ptr(F, m) + c8); const f32x4 a = __builtin_nontemporal_load(xp4), b = __builtin_nontemporal_load(xp4 + 1);
            f[u][0] = a.x; f[u][1] = a.y; f[u][2] = a.z; f[u][3] = a.w; f[u][4] = b.x; f[u][5] = b.y; f[u][6] = b.z; f[u][7] = b.w; } }
#pragma unroll
        for (int u = 0; u < 4; ++u) { const int i = i0 + u * NGT; if (i < T * D / 8) { const int m = i >> 7, c8 = (i & 127) * 8;
            *(v4u*)(XB + (size_t)m * D + c8) = pack_bf8(f[u]);
            if (m >= TP) { float z[8];
#pragma unroll
                for (int e = 0; e < 8; ++e) z[e] = ALPHA * f[u][e];
                *(v4u*)(Zp + (size_t)m * D + c8) = pack_bf8(z); } } }
    }
    bf16* LT = (bf16*)(ws + WS_LORAT);
    for (int i = gt; i < 1536 * 256 / 2; i += NGT) { const int j = i >> 7, k = (i & 127) * 2; float v[2];
#pragma unroll
        for (int e = 0; e < 2; ++e) { const int kk = k + e; float x = 0.f;
            if (j < 512) { if (kk < 64) x = F.in[13][(size_t)kk * 512 + j]; }
            else if (j < 1024) { if (kk >= 64 && kk < 128) x = F.in[15][(size_t)(kk - 64) * 512 + (j - 512)]; }
            else { if (kk >= 128) x = F.in[16][(size_t)(kk - 128) * 512 + (j - 1024)]; }
            v[e] = x; }
        *(unsigned*)(LT + (size_t)j * 256 + k) = pkbf(v[0], v[1]); }
}

struct P2In { v4u cur[4], prv[4]; };
__device__ __forceinline__ void p2_load(P2In& X, const bf16* PB, int m, int lane) {
    const bool sample = m >= TP; const int t = sample ? (m - TP) & 7 : m & 2047;
    const bf16* pb = PB + (size_t)m * BP;
#pragma unroll
    for (int sec = 0; sec < 4; ++sec) {
        const int col = sec * 512 + lane * 8;
        if (sec < 3 || lane < 32) { X.cur[sec] = *(const v4u*)(pb + col); X.prv[sec] = t > 0 ? *(const v4u*)(pb - BP + col) : (v4u){0u, 0u, 0u, 0u}; }
        else { X.cur[sec] = (v4u){0u, 0u, 0u, 0u}; X.prv[sec] = (v4u){0u, 0u, 0u, 0u}; }
    }
}
__device__ __forceinline__ void p2_finish(const P2In& X, Frame& F, int m, int lane, const float (&mu)[4][8], const float (&kw)[8]) {
    unsigned char* ws = F.ws;
    h16* SCR = (h16*)(ws + WS_SCR); h16* SCK = (h16*)(ws + WS_SCK); h16* SCV = (h16*)(ws + WS_SCV); h16* SCKK = (h16*)(ws + WS_SCKK);
    bf16* LA = (bf16*)(ws + WS_LA);
    const bool sample = m >= TP; const int seq = sample ? (m - TP) >> 3 : m >> 11, t = sample ? (m - TP) & 7 : m & 2047, L = sample ? LS : LP;
    float* oshift = F.out + (sample ? O_SHIFT_S : O_SHIFT_P) + (size_t)seq * BP;
    const bool last = (t == L - 1);
#pragma unroll
    for (int sec = 0; sec < 4; ++sec) {
        if (sec == 3 && lane >= 32) break;
        const int col = sec * 512 + lane * 8;
        float p[8], pv[8], xm[8];
        unpack_bf8(X.cur[sec], p);
        if (t == 0 && sample) load_f8(F.in[3] + (size_t)seq * BP + col, pv); else unpack_bf8(X.prv[sec], pv);
#pragma unroll
        for (int i = 0; i < 8; ++i) xm[i] = p[i] + mu[sec][i] * (pv[i] - p[i]);
        if (last) store_f8(oshift + col, p);
        const size_t off = (size_t)m * HW + lane * 8;
        if (sec == 0) *(v4u*)(SCR + off) = pack_h8(xm);
        else if (sec == 1) {
            *(v4u*)(SCK + off) = pack_h8(xm);
            float kx[8]; float ss = 0.f;
#pragma unroll
            for (int i = 0; i < 8; ++i) { kx[i] = xm[i] * kw[i]; ss += kx[i] * kx[i]; }
            ss = sum8(ss);
            const float inv = 1.f / fmaxf(sqrtf(ss), 1e-12f);
#pragma unroll
            for (int i = 0; i < 8; ++i) kx[i] *= inv;
            *(v4u*)(SCKK + off) = pack_h8(kx);
        } else if (sec == 2) *(v4u*)(SCV + off) = pack_h8(xm);
        else {
            float o[8];
#pragma unroll
            for (int i = 0; i < 8; ++i) {
                if (lane < 8) { const float e = __expf(2.f * xm[i]); o[i] = 1.f - 2.f * __builtin_amdgcn_rcpf(e + 1.f); }
                else if (lane < 16) o[i] = xm[i];
                else o[i] = sigmoid_(xm[i]);
            }
            *(v4u*)(LA + (size_t)m * 256 + lane * 8) = pack_bf8(o);
        }
    }
}
__device__ __forceinline__ void p2_rows(Frame& F) {
    const int gw = F.vcu * NWAVES + F.wave, NGW = F.G * NWAVES, lane = F.lane;
    const bf16* PB = (const bf16*)(F.ws + WS_PROJB);
    float mu[4][8], kw[8];
#pragma unroll
    for (int sec = 0; sec < 4; ++sec) { if (sec < 3 || lane < 32) load_f8(F.in[11] + sec * 512 + lane * 8, mu[sec]); else {
#pragma unroll
            for (int i = 0; i < 8; ++i) mu[sec][i] = 0.f; } }
    load_f8(F.in[17] + lane * 8, kw);
    for (int m = gw; m < T; m += 2 * NGW) {
        const int m2 = m + NGW; const bool has2 = m2 < T;
        P2In A, B;
        p2_load(A, PB, m, lane);
        if (has2) p2_load(B, PB, m2, lane);
        p2_finish(A, F, m, lane, mu, kw);
        if (has2) p2_finish(B, F, m2, lane, mu, kw);
    }
}

template <int TT, bool FAST> __device__ __forceinline__ void conv_tile(Frame& F, int m0, int t0, int seq, bool sample) {
    const int c = F.tid;
    unsigned char* ws = F.ws;
    const bf16* PA = (const bf16*)(ws + WS_PROJA); bf16* CAT = (bf16*)(ws + WS_CAT);
    const float* cw = F.in[7]; const float* sconv = F.in[2];
    LAS float* ylds = (LAS float*)F.lds;
    float w[31];
#pragma unroll
    for (int j = 0; j < 31; ++j) w[j] = cw[j * 512 + c];
    float y[TT]; const float bias = F.in[8][c];
#pragma unroll
    for (int t = 0; t < TT; ++t) y[t] = bias;
    const bool lastp = (!sample) && (t0 + TT == LP);
    float* oconv = F.out + (sample ? O_CONV_S : O_CONV_P) + (size_t)seq * 30 * 512 + c;
    const bf16* pp = PA + ((size_t)m0 - 30) * 512 + c; const float* scp = sconv + ((size_t)seq * 30 + t0) * 512 + c;
    constexpr int NR = TT + 30, H1 = (NR + 1) / 2;
#pragma unroll
    for (int hh = 0; hh < 2; ++hh) {
        const int r0 = hh ? H1 : 0, r1 = hh ? NR : H1;
        unsigned rv[H1];
#pragma unroll
        for (int ri = r0; ri < r1; ++ri) {
            const int s2 = ri - 30;
            asm volatile("" : "+v"(pp), "+v"(scp));
            if (FAST || t0 + s2 >= 0) rv[ri - r0] = pp[0];
            else rv[ri - r0] = sample ? __float_as_uint(*scp) : 0u;
            pp += 512; scp += 512;
        }
#pragma unroll
        for (int ri = r0; ri < r1; ++ri) {
            const int s2 = ri - 30;
            float u;
            if (FAST || t0 + s2 >= 0) u = bf2f(rv[ri - r0]);
            else u = __uint_as_float(rv[ri - r0]);
#pragma unroll
            for (int t = 0; t < TT; ++t) { const int j = s2 - t + 30; if (j >= 0 && j <= 30) y[t] += u * w[j]; }
            if (sample) { if (s2 + 22 >= 0) oconv[(size_t)(s2 + 22) * 512] = u; }
            else if (lastp && s2 >= TT - 30) oconv[(size_t)(s2 - (TT - 30)) * 512] = u;
        }
        asm volatile("" ::: "memory");
    }
#pragma unroll
    for (int t = 0; t < TT; ++t) ylds[t * 512 + c] = y[t];
    __syncthreads();
    const float* lg = F.in[9]; const float* lb = F.in[10];
    for (int t = F.wave; t < TT; t += NWAVES) {
        const LAS float* yr = ylds + t * 512 + F.lane * 8;
        float v[8];
        { const f32x4 a = *(const LAS f32x4*)yr, b = *(const LAS f32x4*)(yr + 4); v[0] = a.x; v[1] = a.y; v[2] = a.z; v[3] = a.w; v[4] = b.x; v[5] = b.y; v[6] = b.z; v[7] = b.w; }
        float s = 0.f;
#pragma unroll
        for (int i = 0; i < 8; ++i) s += v[i];
        const float mean = wave_sum(s) * (1.f / 512.f); float q = 0.f;
#pragma unroll
        for (int i = 0; i < 8; ++i) { v[i] -= mean; q += v[i] * v[i]; }
        const float rstd = rsqrtf(wave_sum(q) * (1.f / 512.f) + LN_EPS);
        float g8[8], b8[8], o[8]; load_f8(lg + F.lane * 8, g8); load_f8(lb + F.lane * 8, b8);
#pragma unroll
        for (int i = 0; i < 8; ++i) o[i] = silu_(v[i] * rstd * g8[i] + b8[i]);
        *(v4u*)(CAT + (size_t)(m0 + t) * 1024 + F.lane * 8) = pack_bf8(o);
    }
    __syncthreads();
}
__device__ __forceinline__ void conv_phase(Frame& F) {
    for (int it = F.vcu; it < 512 + 128; it += F.G) {
        if (it < 512) { const int m0 = it * 32, t0 = m0 & 2047; if (t0 >= 32) conv_tile<32, true>(F, m0, t0, m0 >> 11, false); else conv_tile<32, false>(F, m0, t0, m0 >> 11, false); }
        else { const int seq = it - 512; conv_tile<8, false>(F, TP + seq * 8, 0, seq, true); }
    }
}

constexpr int SU = 8;
struct ScanPtrs { const h16* R; const h16* K; const h16* V; const h16* KK; const h16* B; const h16* W; h16* O; };
struct ScanBuf { v2u r[SU], k[SU], kk[SU], b[SU], w[SU]; unsigned short v[SU]; };
__device__ __forceinline__ void scan_load(ScanBuf& Bf, const ScanPtrs& P, size_t off, int ks, int row) {
#pragma unroll
    for (int i = 0; i < SU; ++i) { const size_t o = off + (size_t)i * HW;
        Bf.r[i] = *(const v2u*)(P.R + o + ks); Bf.k[i] = *(const v2u*)(P.K + o + ks); Bf.kk[i] = *(const v2u*)(P.KK + o + ks);
        Bf.b[i] = *(const v2u*)(P.B + o + ks); Bf.w[i] = *(const v2u*)(P.W + o + ks); Bf.v[i] = *(const unsigned short*)(P.V + o + row); }
}
__device__ __forceinline__ void scan_compute(const ScanBuf& Bf, float (&S)[4], const ScanPtrs& P, size_t off, int row, bool writer) {
#pragma unroll
    for (int i = 0; i < SU; ++i) {
        float r[4], k[4], kk[4], b[4], w[4]; h4(Bf.r[i], r); h4(Bf.k[i], k); h4(Bf.kk[i], kk); h4(Bf.b[i], b); h4(Bf.w[i], w);
        const float v = (float)__builtin_bit_cast(h16, Bf.v[i]);
        float d = (S[0] * kk[0] + S[1] * kk[1]) + (S[2] * kk[2] + S[3] * kk[3]);
        float pj[4];
#pragma unroll
        for (int j = 0; j < 4; ++j) pj[j] = fmaf(v, k[j], fmaf(-S[j], w[j], S[j]));
        d = dpp_sum16(d);
#pragma unroll
        for (int j = 0; j < 4; ++j) S[j] = fmaf(-d, b[j], pj[j]);
        float o = (S[0] * r[0] + S[1] * r[1]) + (S[2] * r[2] + S[3] * r[3]);
        o = dpp_sum16(o);
        if (writer) P.O[off + (size_t)i * HW + row] = (h16)o;
    }
}
template <int L> __device__ __forceinline__ void scan_task(const ScanPtrs& P, int mbase, int h, int v0, const float* s_in, float* s_out, int lane) {
    const int rl = lane >> 4, ks = (lane & 15) * 4, row = v0 + rl; const bool writer = (lane & 15) == 0;
    float S[4] = {0.f, 0.f, 0.f, 0.f};
    if (s_in) { const f32x4 s = *(const f32x4*)(s_in + (size_t)row * 64 + ks); S[0] = s.x; S[1] = s.y; S[2] = s.z; S[3] = s.w; }
    size_t off = (size_t)mbase * HW + h * 64;
    ScanBuf A;
    scan_load(A, P, off, ks, row);
    if constexpr (L == SU) { scan_compute(A, S, P, off, row, writer); }
    else {
        ScanBuf Bf;
        for (int t = 0; t < L; t += 2 * SU) {
            scan_load(Bf, P, off + (size_t)SU * HW, ks, row);
            scan_compute(A, S, P, off, row, writer);
            if (t + 2 * SU < L) scan_load(A, P, off + (size_t)2 * SU * HW, ks, row);
            scan_compute(Bf, S, P, off + (size_t)SU * HW, row, writer);
            off += (size_t)2 * SU * HW;
        }
    }
    *(f32x4*)(s_out + (size_t)row * 64 + ks) = (f32x4){S[0], S[1], S[2], S[3]};
}
constexpr int RING_SLOTS = 64, SLOT_BYTES = 1536, FLAG_OFF = 131072 + 1024;
constexpr unsigned SPIN_CAP = 1u << 22;
struct StepF { f32x4 r, k, kk, b, w; float v; };
__device__ __forceinline__ void ld_stepf(StepF& X, const LAS unsigned char* slot, unsigned rd, unsigned vd) {
    X.r = *(const LAS f32x4*)(slot + 0 * 256 + rd); X.k = *(const LAS f32x4*)(slot + 1 * 256 + rd); X.kk = *(const LAS f32x4*)(slot + 2 * 256 + rd);
    X.b = *(const LAS f32x4*)(slot + 3 * 256 + rd); X.w = *(const LAS f32x4*)(slot + 4 * 256 + rd); X.v = *(const LAS float*)(slot + vd);
}
typedef float f32x2 __attribute__((ext_vector_type(2)));
__device__ __forceinline__ float step_computef(const StepF& X, f32x2& S01, f32x2& S23) {
    const f32x2 kk01 = {X.kk.x, X.kk.y}, kk23 = {X.kk.z, X.kk.w}, w01 = {X.w.x, X.w.y}, w23 = {X.w.z, X.w.w};
    const f32x2 k01 = {X.k.x, X.k.y}, k23 = {X.k.z, X.k.w}, b01 = {X.b.x, X.b.y}, b23 = {X.b.z, X.b.w}, r01 = {X.r.x, X.r.y}, r23 = {X.r.z, X.r.w};
    f32x2 p = S01 * kk01; p = S23 * kk23 + p;
    float d = p.x + p.y;
    const f32x2 vv = {X.v, X.v};
    const f32x2 pj01 = vv * k01 + (S01 - S01 * w01), pj23 = vv * k23 + (S23 - S23 * w23);
    d = dpp_sum16(d);
    const f32x2 dd = {d, d};
    S01 = pj01 - dd * b01; S23 = pj23 - dd * b23;
    f32x2 q = S01 * r01; q = S23 * r23 + q;
    return dpp_sum16(q.x + q.y);
}
__device__ __forceinline__ unsigned min4(const volatile LAS unsigned* p) { const unsigned a = p[0], b = p[1], c = p[2], d = p[3]; return min(min(a, b), min(c, d)); }
__device__ __forceinline__ void scan_prompt_consumer(Frame& F, int mbase, int h, int v0, float* s_out) {
    const int lane = F.lane, rl = lane >> 4, l16 = lane & 15, ks = l16 * 4, row = v0 + rl;
    const LAS unsigned char* ring = F.lds;
    volatile LAS unsigned* prod = (volatile LAS unsigned*)(F.lds + FLAG_OFF); volatile LAS unsigned* cons = prod + 4;
    h16* O = (h16*)(F.ws + WS_O) + (size_t)mbase * HW + h * 64 + row;
    const unsigned rd = ks * 4, vd = 5 * 256 + row * 4;
    constexpr int L = LP;
    f32x2 S01 = {0.f, 0.f}, S23 = {0.f, 0.f};
    StepF Q[4];
    __builtin_amdgcn_s_setprio(2);
    { unsigned sp = 0; while (min4(prod) < 2u && ++sp < SPIN_CAP) __builtin_amdgcn_s_sleep(1); }
    asm volatile("" ::: "memory");
    ld_stepf(Q[0], ring, rd, vd);
    ld_stepf(Q[1], ring + SLOT_BYTES, rd, vd);
    ld_stepf(Q[2], ring + 2 * SLOT_BYTES, rd, vd);
    float okeep = 0.f;
#pragma unroll 1
    for (int tb = 0; tb < L; tb += 16) {
#pragma unroll
        for (int j = 0; j < 16; ++j) {
            const int t = tb + j;
            if (j == 0) {
                const unsigned need = (unsigned)min(t / 4 + 5, L / 4);
                unsigned sp = 0; while (min4(prod) < need && ++sp < SPIN_CAP) __builtin_amdgcn_s_sleep(1);
                asm volatile("" ::: "memory");
            }
            __builtin_amdgcn_sched_barrier(0x7);
            ld_stepf(Q[(j + 3) & 3], ring + ((t + 3) & (RING_SLOTS - 1)) * SLOT_BYTES, rd, vd);
            __builtin_amdgcn_sched_barrier(0x7);
            const float o = step_computef(Q[j & 3], S01, S23);
            okeep = (l16 == j) ? o : okeep;
            if (j == 15) { asm volatile("s_waitcnt lgkmcnt(0)" ::: "memory"); if (lane == 0) cons[F.wave] = (unsigned)(t + 1); }
        }
        O[(size_t)(tb + l16) * HW] = (h16)okeep;
    }
    *(f32x4*)(s_out + (size_t)row * 64 + ks) = (f32x4){S01.x, S01.y, S23.x, S23.y};
    __builtin_amdgcn_s_setprio(0);
}
__device__ __forceinline__ void scan_prompt_loader(Frame& F, int mbase, int h) {
    const int lane = F.lane, w = F.wave - 4;
    LAS unsigned char* ring = F.lds;
    volatile LAS unsigned* prod = (volatile LAS unsigned*)(F.lds + FLAG_OFF); volatile LAS unsigned* cons = prod + 4;
    const int arr = lane < 40 ? (lane >> 3) : 5, part = lane & 7;
    const size_t abase = arr == 0 ? WS_SCR : arr == 1 ? WS_SCK : arr == 2 ? WS_SCKK : arr == 3 ? WS_SCB : arr == 4 ? WS_SCW : WS_SCV;
    const unsigned char* src = F.ws + abase + ((size_t)mbase * HW + h * 64) * 2 + part * 16;
    const bool active = lane < 48;
    const unsigned dst = arr * 256 + part * 32;
    constexpr int L = LP, PF = 16;
    v4u buf[PF]; unsigned cmin = 0u;
    const unsigned char* lp = src + (size_t)w * 1024;
#pragma unroll
    for (int i = 0; i < PF; ++i) { asm volatile("" : "+v"(lp)); buf[i] = active ? *(const v4u*)lp : (v4u){0u, 0u, 0u, 0u}; lp += 4096; }
    unsigned slot = (unsigned)w;
#pragma unroll 1
    for (int sb = w; sb < L; sb += 4 * PF) {
#pragma unroll
        for (int i = 0; i < PF; ++i) {
            const int st = sb + 4 * i;
            if (st >= RING_SLOTS && cmin < (unsigned)(st - RING_SLOTS + 1)) { unsigned sp = 0; while ((cmin = min4(cons)) < (unsigned)(st - RING_SLOTS + 1) && ++sp < SPIN_CAP) __builtin_amdgcn_s_sleep(1); }
            asm volatile("" ::: "memory");
            float f[8]; unpack_h8(buf[i], f);
            { asm volatile("" : "+v"(lp)); if (st + 4 * PF < L) buf[i] = active ? *(const v4u*)lp : (v4u){0u, 0u, 0u, 0u}; lp += 4096; }
            if (active) { LAS unsigned char* p = ring + slot * SLOT_BYTES + dst;
                *(LAS f32x4*)p = (f32x4){f[0], f[1], f[2], f[3]}; *(LAS f32x4*)(p + 16) = (f32x4){f[4], f[5], f[6], f[7]}; }
            slot = (slot + 4) & (RING_SLOTS - 1);
            asm volatile("s_waitcnt lgkmcnt(0)" ::: "memory");
            if (lane == 0) prod[w] = (unsigned)(st >> 2) + 1u;
        }
    }
}
__device__ __forceinline__ void scan_sample_pair(Frame& F, int pair) {
    const int lane = F.lane, n = pair >> 3, h = pair & 7;
    const unsigned char* ws = F.ws;
    LAS float* st = (LAS float*)(F.lds + F.wave * 12288);
    const size_t eoff = (size_t)(TP + n * LS) * HW + h * 64;
    v4u raw[5];
#pragma unroll
    for (int q = 0; q < 5; ++q) { const int id = lane + 64 * q, stp = id / 40, rem = id % 40, arr = rem >> 3, part = rem & 7;
        const size_t ab = arr == 0 ? WS_SCR : arr == 1 ? WS_SCK : arr == 2 ? WS_SCKK : arr == 3 ? WS_SCB : WS_SCW;
        raw[q] = *(const v4u*)(ws + ab + (eoff + (size_t)stp * HW) * 2 + part * 16); }
    unsigned short vr[8];
#pragma unroll
    for (int t = 0; t < 8; ++t) vr[t] = *(const unsigned short*)(ws + WS_SCV + (eoff + (size_t)t * HW + lane) * 2);
    float S[64];
    const float* sin = F.in[4] + (size_t)pair * 4096 + lane * 64;
#pragma unroll
    for (int c = 0; c < 16; ++c) { const f32x4 x = *(const f32x4*)(sin + 4 * c); S[4 * c] = x.x; S[4 * c + 1] = x.y; S[4 * c + 2] = x.z; S[4 * c + 3] = x.w; }
#pragma unroll
    for (int q = 0; q < 5; ++q) { const int id = lane + 64 * q, stp = id / 40, rem = id % 40, arr = rem >> 3, part = rem & 7;
        float f[8]; unpack_h8(raw[q], f); LAS float* d = st + (stp * 5 + arr) * 64 + part * 8;
        *(LAS f32x4*)d = (f32x4){f[0], f[1], f[2], f[3]}; *(LAS f32x4*)(d + 4) = (f32x4){f[4], f[5], f[6], f[7]}; }
#pragma unroll
    for (int t = 0; t < 8; ++t) st[2560 + t * 64 + lane] = (float)__builtin_bit_cast(h16, vr[t]);
    asm volatile("s_waitcnt lgkmcnt(0)" ::: "memory");
    h16* O = (h16*)(F.ws + WS_O) + eoff + lane;
#pragma unroll 1
    for (int t = 0; t < 8; ++t) {
        const LAS float* q = st + t * 320;
        float d0 = 0.f, d1 = 0.f, d2 = 0.f, d3 = 0.f;
#pragma unroll
        for (int c = 0; c < 16; ++c) { const f32x4 kk = *(const LAS f32x4*)(q + 128 + 4 * c);
            d0 = fmaf(S[4 * c], kk.x, d0); d1 = fmaf(S[4 * c + 1], kk.y, d1); d2 = fmaf(S[4 * c + 2], kk.z, d2); d3 = fmaf(S[4 * c + 3], kk.w, d3); }
        const float d = (d0 + d1) + (d2 + d3), v = st[2560 + t * 64 + lane];
        float o0 = 0.f, o1 = 0.f, o2 = 0.f, o3 = 0.f;
#pragma unroll
        for (int c = 0; c < 16; ++c) {
            const f32x4 r = *(const LAS f32x4*)(q + 4 * c), k = *(const LAS f32x4*)(q + 64 + 4 * c), b = *(const LAS f32x4*)(q + 192 + 4 * c), w = *(const LAS f32x4*)(q + 256 + 4 * c);
            float s0 = S[4 * c], s1 = S[4 * c + 1], s2 = S[4 * c + 2], s3 = S[4 * c + 3];
            s0 = fmaf(-d, b.x, fmaf(v, k.x, fmaf(-s0, w.x, s0))); s1 = fmaf(-d, b.y, fmaf(v, k.y, fmaf(-s1, w.y, s1)));
            s2 = fmaf(-d, b.z, fmaf(v, k.z, fmaf(-s2, w.z, s2))); s3 = fmaf(-d, b.w, fmaf(v, k.w, fmaf(-s3, w.w, s3)));
            S[4 * c] = s0; S[4 * c + 1] = s1; S[4 * c + 2] = s2; S[4 * c + 3] = s3;
            o0 = fmaf(s0, r.x, o0); o1 = fmaf(s1, r.y, o1); o2 = fmaf(s2, r.z, o2); o3 = fmaf(s3, r.w, o3);
        }
        O[(size_t)t * HW] = (h16)((o0 + o1) + (o2 + o3));
    }
    float* sout = F.out + O_WKV_S + (size_t)pair * 4096 + lane * 64;
#pragma unroll
    for (int c = 0; c < 16; ++c) *(f32x4*)(sout + 4 * c) = (f32x4){S[4 * c], S[4 * c + 1], S[4 * c + 2], S[4 * c + 3]};
}
__device__ __forceinline__ void scan_phase(Frame& F) {
    unsigned char* ws = F.ws;
    ScanPtrs P{(const h16*)(ws + WS_SCR), (const h16*)(ws + WS_SCK), (const h16*)(ws + WS_SCV), (const h16*)(ws + WS_SCKK), (const h16*)(ws + WS_SCB), (const h16*)(ws + WS_SCW), (h16*)(ws + WS_O)};
    for (int task = F.vcu; task < 256; task += F.G) {
        if (F.tid < 8) ((volatile LAS unsigned*)(F.lds + FLAG_OFF))[F.tid] = 0u;
        __syncthreads();
        const int pair = task >> 2, q = task & 3, n = pair >> 3, h = pair & 7;
        if (F.wave < 4) scan_prompt_consumer(F, n * LP, h, q * 16 + F.wave * 4, F.out + O_WKV_P + (size_t)pair * 4096);
        else scan_prompt_loader(F, n * LP, h);
        __syncthreads();
    }
    if (F.wave < 4) { for (int pair = F.wave * F.G + F.vcu; pair < NSB * 8; pair += 4 * F.G) scan_sample_pair(F, pair); }
}

struct P6In { v4u o, r, k, v, g; };
__device__ __forceinline__ void p6_load(P6In& X, const unsigned char* ws, int m, int lane) {
    const size_t off = ((size_t)m * HW + lane * 8) * 2;
    X.o = *(const v4u*)(ws + WS_O + off); X.r = *(const v4u*)(ws + WS_SCR + off); X.k = *(const v4u*)(ws + WS_SCK + off); X.v = *(const v4u*)(ws + WS_SCV + off); X.g = *(const v4u*)(ws + WS_G + off);
}
__device__ __forceinline__ void p6_finish(const P6In& X, bf16* CAT, int m, int lane, const float (&rk)[8], const float (&lg)[8], const float (&lb)[8]) {
    float o[8], r[8], k[8], v[8], g[8];
    unpack_h8(X.o, o); unpack_h8(X.r, r); unpack_h8(X.k, k); unpack_h8(X.v, v); unpack_h8(X.g, g);
    float s = 0.f, bs = 0.f;
#pragma unroll
    for (int i = 0; i < 8; ++i) { s += o[i]; bs += r[i] * k[i] * rk[i]; }
    const float mean = sum8(s) * (1.f / 64.f); bs = sum8(bs); float q = 0.f;
#pragma unroll
    for (int i = 0; i < 8; ++i) { o[i] -= mean; q += o[i] * o[i]; }
    const float rstd = rsqrtf(sum8(q) * (1.f / 64.f) + GN_EPS);
    float res[8];
#pragma unroll
    for (int i = 0; i < 8; ++i) res[i] = (o[i] * rstd * lg[i] + lb[i] + bs * v[i]) * g[i];
    *(v4u*)(CAT + (size_t)m * 1024 + 512 + lane * 8) = pack_bf8(res);
}
__device__ __forceinline__ void p6_rows(Frame& F) {
    const int gw = F.vcu * NWAVES + F.wave, NGW = F.G * NWAVES, lane = F.lane;
    const unsigned char* ws = F.ws; bf16* CAT = (bf16*)(F.ws + WS_CAT);
    float rk[8], lg[8], lb[8]; load_f8(F.in[19] + lane * 8, rk); load_f8(F.in[20] + lane * 8, lg); load_f8(F.in[21] + lane * 8, lb);
    for (int m = gw; m < T; m += 4 * NGW) {
        P6In X[4];
#pragma unroll
        for (int u = 0; u < 4; ++u) { const int mm = m + u * NGW; if (mm < T) p6_load(X[u], ws, mm, lane); }
#pragma unroll
        for (int u = 0; u < 4; ++u) { const int mm = m + u * NGW; if (mm < T) p6_finish(X[u], CAT, mm, lane, rk, lg, lb); }
    }
}

template <int MODE> __device__ __forceinline__ void ln_finish(Frame& F, int m, f32x4 (&v)[4], const f32x4 (&gv)[4], const f32x4 (&bv)[4], int nparts, const h16* pa, const h16* pb) {
    const int lane = F.lane;
    bf16* zr = (bf16*)(F.ws + WS_Z) + (size_t)m * D; bf16* XB = (bf16*)(F.ws + WS_XB);
    float s = 0.f;
    if (m >= TP) {
#pragma unroll 2
        for (int sp = 0; sp < nparts; ++sp) { const h16* pr = (sp < 8 ? pa + (size_t)sp * (1u << 20) : pb + (size_t)(sp - 8) * (1u << 20)) + (size_t)(m - TP) * D;
#pragma unroll
            for (int j = 0; j < 4; ++j) { float f[4]; h4(*(const v2u*)(pr + 4 * (lane + 64 * j)), f); v[j] = v[j] + (f32x4){f[0], f[1], f[2], f[3]}; } }
    }
#pragma unroll
    for (int j = 0; j < 4; ++j) s += (v[j].x + v[j].y) + (v[j].z + v[j].w);
    const float mean = wave_sum(s) * (1.f / D); float s2 = 0.f;
#pragma unroll
    for (int j = 0; j < 4; ++j) { v[j] = v[j] - mean; s2 += (v[j].x * v[j].x + v[j].y * v[j].y) + (v[j].z * v[j].z + v[j].w * v[j].w); }
    const float rstd = rsqrtf(wave_sum(s2) * (1.f / D) + LN_EPS);
#pragma unroll
    for (int j = 0; j < 4; ++j) v[j] = v[j] * rstd * gv[j] + bv[j];
    if (MODE == 2) {
#pragma unroll
        for (int j = 0; j < 4; ++j) *(f32x4*)(F.out + O_Y + (size_t)m * D + 4 * (lane + 64 * j)) = v[j];
    } else {
        if ((MODE == 0 || MODE == 1) && m >= TP) {
#pragma unroll
            for (int j = 0; j < 4; ++j) { v2u w; w.x = pkbf(v[j].x * ALPHA, v[j].y * ALPHA); w.y = pkbf(v[j].z * ALPHA, v[j].w * ALPHA); *(v2u*)(zr + 4 * (lane + 64 * j)) = w; }
        }
#pragma unroll
        for (int j = 0; j < 4; ++j) { v2u w; w.x = pkbf(v[j].x, v[j].y); w.y = pkbf(v[j].z, v[j].w); *(v2u*)(XB + (size_t)m * D + 4 * (lane + 64 * j)) = w; }
    }
    if (MODE == 1) {
        const bool sample = m >= TP; const int seq = sample ? (m - TP) >> 3 : m >> 11, t = sample ? (m - TP) & 7 : m & 2047;
        if (sample) {
            float* op = F.out + O_POOL_S + ((size_t)seq * 15 + 7 + t) * D;
#pragma unroll
            for (int j = 0; j < 4; ++j) *(f32x4*)(op + 4 * (lane + 64 * j)) = v[j];
            if (t == 0) { const float* sp = F.in[5] + ((size_t)seq * 15 + 8) * D; float* o0 = F.out + O_POOL_S + (size_t)seq * 15 * D;
                for (int i = lane; i < 7 * D / 4; i += 64) *(f32x4*)(o0 + 4 * i) = *(const f32x4*)(sp + 4 * i); }
        } else if (t >= LP - 15) {
            float* op = F.out + O_POOL_P + ((size_t)seq * 15 + (t - (LP - 15))) * D;
#pragma unroll
            for (int j = 0; j < 4; ++j) *(f32x4*)(op + 4 * (lane + 64 * j)) = v[j];
        }
    }
}
template <int MODE> __device__ __forceinline__ void ln_rows(Frame& F, const float* g, const float* b, int nparts, const h16* pa, const h16* pb, int TL = T) {
    const int gw = F.vcu * NWAVES + F.wave, NGW = F.G * NWAVES, lane = F.lane;
    const bf16* Z = (const bf16*)(F.ws + WS_Z);
    f32x4 gv[4], bv[4];
#pragma unroll
    for (int j = 0; j < 4; ++j) { gv[j] = *(const f32x4*)(g + 4 * (lane + 64 * j)); bv[j] = *(const f32x4*)(b + 4 * (lane + 64 * j)); }
    constexpr int LU = 4;
    for (int m = gw; m < TL; m += LU * NGW) {
        f32x4 v[LU][4];
#pragma unroll
        for (int u = 0; u < LU; ++u) { const int mm = m + u * NGW; if (mm < TL) {
#pragma unroll
                for (int j = 0; j < 4; ++j) { const v2u w = *(const v2u*)(Z + (size_t)mm * D + 4 * (lane + 64 * j)); const unsigned w0 = w.x, w1 = w.y;
                    v[u][j] = (f32x4){__uint_as_float(w0 << 16), __uint_as_float(w0 & 0xffff0000u), __uint_as_float(w1 << 16), __uint_as_float(w1 & 0xffff0000u)}; } } }
#pragma unroll
        for (int u = 0; u < LU; ++u) { const int mm = m + u * NGW; if (mm < TL) ln_finish<MODE>(F, mm, v[u], gv, bv, nparts, pa, pb); }
    }
}

template <int TT> __device__ __forceinline__ float pool_one(const float (&xs)[TT + 15], int t, int g, int cnt) {
    const float x0 = xs[t + 15];
    const float s2 = x0 + xs[t + 14];
    const float s4 = s2 + (xs[t + 13] + xs[t + 12]);
    const float s8 = s4 + ((xs[t + 11] + xs[t + 10]) + (xs[t + 9] + xs[t + 8]));
    const float s16 = s8 + (((xs[t + 7] + xs[t + 6]) + (xs[t + 5] + xs[t + 4])) + ((xs[t + 3] + xs[t + 2]) + (xs[t + 1] + xs[t + 0])));
    const float sum = g == 0 ? s2 : (g == 1 ? s4 : (g == 2 ? s8 : s16));
    return sum / (float)cnt - x0;
}
template <int TT> __device__ __forceinline__ void pool_tile(Frame& F, int m0, int t0, int seq, bool sample) {
    const bf16* XR = (const bf16*)(F.ws + WS_XR); bf16* PL = (bf16*)(F.ws + WS_PL); const float* spool = F.in[5];
    const int c = 2 * F.tid, g = c >> 8;
    float xa[TT + 15], xb[TT + 15];
    const bf16* zp = XR + ((size_t)m0 - 15) * D + c; const float* sp = spool + ((size_t)seq * 15 + t0) * D + c;
#pragma unroll
    for (int s = -15; s < TT; ++s) {
        asm volatile("" : "+v"(zp), "+v"(sp));
        if (t0 + s >= 0) { const unsigned w = *(const unsigned*)zp; xa[s + 15] = __uint_as_float(w << 16); xb[s + 15] = __uint_as_float(w & 0xffff0000u); }
        else if (sample) { xa[s + 15] = sp[0]; xb[s + 15] = sp[1]; }
        else { xa[s + 15] = 0.f; xb[s + 15] = 0.f; }
        zp += D; sp += D;
    }
    const int wdw = 2 << g;
#pragma unroll
    for (int t = 0; t < TT; ++t) {
        const int cnt = sample ? wdw : min(wdw, t0 + t + 1);
        const float p0 = pool_one<TT>(xa, t, g, cnt), p1 = pool_one<TT>(xb, t, g, cnt);
        *(unsigned*)(PL + (size_t)(m0 + t) * D + c) = pkbf(p0, p1);
    }
}
__device__ __forceinline__ void pool_phase(Frame& F) {
    for (int it = F.vcu; it < 512 + 128; it += F.G) {
        if (it < 512) { const int m0 = it * 32; pool_tile<32>(F, m0, m0 & 2047, m0 >> 11, false); }
        else { const int seq = it - 512; pool_tile<8>(F, TP + seq * 8, 0, seq, true); }
    }
}


#ifndef DIAG_AT
#define DIAG_AT -1
#endif
__device__ __forceinline__ bool dbad(float got, float want) { return !(fabsf(got - want) <= 0.03f * fabsf(want) + 0.02f); }
__device__ __forceinline__ float h2f(h16 x) { return (float)x; }
__device__ __forceinline__ void diag_checks(Frame& F, int at) {
    if (blockIdx.x != 0 || F.wave != 0) return;
    const int lane = F.lane; unsigned char* ws = F.ws;
    unsigned mask = 0;
    const bf16* PA = (const bf16*)(ws + WS_PROJA); const bf16* PB = (const bf16*)(ws + WS_PROJB);
    const h16* SCR = (const h16*)(ws + WS_SCR); const h16* SCK = (const h16*)(ws + WS_SCK); const h16* SCV = (const h16*)(ws + WS_SCV); const h16* SCKK = (const h16*)(ws + WS_SCKK);
    const h16* SCB = (const h16*)(ws + WS_SCB); const h16* SCW = (const h16*)(ws + WS_SCW);
    const int m = 1 + (lane * 131 + 7) % 9000;
    const int t = m & 2047;
    if (at == 3) {
        const int c = (lane * 29 + 5) % 512, h0 = c & ~63;
        auto xm = [&](int col) { const float p = bf2f(PB[(size_t)m * BP + col]); const float pv = t > 0 ? bf2f(PB[(size_t)(m - 1) * BP + col]) : 0.f; return p + F.in[11][col] * (pv - p); };
        float ss = 0.f; for (int j = 0; j < 64; ++j) { const float kx = xm(512 + h0 + j) * F.in[17][h0 + j]; ss += kx * kx; }
        const float kkn = xm(512 + c) * F.in[17][c] / fmaxf(sqrtf(ss), 1e-12f);
        float al = F.in[14][c]; for (int j = 0; j < 64; ++j) al += xm(1600 + j) * F.in[15][(size_t)j * 512 + c];
        const float a = 1.f / (1.f + expf(-al)); const float f = (1.f + (a - 1.f) * F.in[18][c]); const float k0 = xm(512 + c); const float b = kkn * a;
        const float gotk = h2f(SCK[(size_t)m * HW + c]);
        if (__ballot(dbad(gotk, k0 * f))) mask |= 1;
        if (__ballot(dbad(h2f(SCB[(size_t)m * HW + c]) * 10.f, b * 10.f))) mask |= 2;
        { const bf16* LA = (const bf16*)(ws + WS_LA); bool bad = false; for (int j = 0; j < 64; ++j) bad = bad || dbad(bf2f(LA[(size_t)m * 256 + 64 + j]), xm(1600 + j)); if (__ballot(bad)) mask |= 4; }
        { float g = 0.f; for (int j = 0; j < 128; ++j) g += (1.f / (1.f + expf(-xm(1664 + j)))) * F.in[16][(size_t)j * 512 + c];
          const h16* G = (const h16*)(ws + WS_G); if (__ballot(dbad(h2f(G[(size_t)m * HW + c]), g))) mask |= 8; }
        if (__ballot(dbad(gotk, k0 * f * f))) mask |= 16;
        if (__ballot(dbad(gotk, k0))) mask |= 32;
    }
    if (lane == 0) *(unsigned*)(ws + 0) = mask;
}
__device__ __forceinline__ void diag_fill(Frame& F) {
    const unsigned mask = *(const unsigned*)(F.ws + 0);
    const float C = sqrtf(exp2f(1.f + (float)mask));
    const int gt = blockIdx.x * NTHREADS + F.tid, NGT = F.G * NTHREADS;
    for (int i = gt; i < TS * D; i += NGT) F.out[O_Y + (size_t)TP * D + i] = C;
}

#define XB_TMO      128
#define XB_XCNT(j)  (256  + 64 * (j))
#define XB_XSUB(j)  (1280 + 64 * (j))
#define XB_XGEN(j)  (2304 + 64 * (j))
#define XB_TOP      3328
#define XB_TOPGEN   3392
#define XCD_BAR_WORDS 3456
#define XB_SPIN_CAP (1u << 18)

__device__ __forceinline__ unsigned xb_ld(unsigned* p)              { return __hip_atomic_load(p, __ATOMIC_RELAXED, __HIP_MEMORY_SCOPE_AGENT); }
__device__ __forceinline__ unsigned xb_add(unsigned* p, unsigned v) { return __hip_atomic_fetch_add(p, v, __ATOMIC_RELAXED, __HIP_MEMORY_SCOPE_AGENT); }
__device__ __forceinline__ unsigned xb_xcc_id() { return (unsigned)__builtin_amdgcn_s_getreg((3 << 11) | 20) & 0xFu; }
#define XB_SPIN(cond, bar) do { unsigned _sp = 0; while (cond) { __builtin_amdgcn_s_sleep(1); \
    if ((++_sp & 255u) == 0u) { if (xb_ld(&(bar)[XB_TMO])) break; if (_sp > XB_SPIN_CAP) { atomicAdd(&(bar)[XB_TMO], 1u); break; } } } } while (0)

struct XcdBarrier {
    unsigned* bar; unsigned x;
    volatile LAS unsigned* st;
};

__device__ __forceinline__ XcdBarrier xcd_barrier_post(unsigned* bar, volatile LAS unsigned* st) {
    XcdBarrier b; b.bar = bar; b.x = xb_xcc_id(); b.st = st;
    if (threadIdx.x == 0) (void)xb_add(&bar[XB_XCNT(b.x)], 1u);
    return b;
}
__device__ __forceinline__ void xcd_barrier_complete(unsigned* bar, unsigned x, unsigned& nloc, unsigned& nx) {
    const unsigned G = gridDim.x * gridDim.y * gridDim.z;
    unsigned sum, cnt, mine, sp = 0u;
    for (;;) {
        sum = 0u; cnt = 0u; mine = 0u;
#pragma unroll
        for (unsigned j = 0; j < 16; ++j) { const unsigned c = xb_ld(&bar[XB_XCNT(j)]); sum += c; cnt += (c > 0u) ? 1u : 0u; mine = (j == x) ? c : mine; }
        if (sum == G) break;
        __builtin_amdgcn_s_sleep(1);
        if ((++sp & 255u) == 0u) { if (xb_ld(&bar[XB_TMO])) break; if (sp > XB_SPIN_CAP) { atomicAdd(&bar[XB_TMO], 1u); break; } }
    }
    nloc = mine > 0u ? mine : 1u; nx = cnt > 0u ? cnt : 1u;
}

__device__ __forceinline__ void xcd_barrier(const XcdBarrier& b) {
    asm volatile("s_waitcnt vmcnt(0)" ::: "memory");
    __syncthreads();
    if (threadIdx.x == 0) {
        unsigned* bar = b.bar;
        __builtin_amdgcn_s_waitcnt(0);
        unsigned nloc = b.st[0], nx = b.st[1];
        if (nloc == 0u) { xcd_barrier_complete(bar, b.x, nloc, nx); b.st[0] = nloc; b.st[1] = nx; }
        const unsigned old = xb_add(&bar[XB_XSUB(b.x)], 1u);
        const unsigned gen = old / nloc;
        if (old + 1u == (gen + 1u) * nloc) {
            __builtin_amdgcn_fence(__ATOMIC_RELEASE, "agent");
            asm volatile("s_waitcnt vmcnt(0)" ::: "memory");
            const unsigned og = xb_add(&bar[XB_TOP], 1u);
            const unsigned tg = og / nx;
            if (og + 1u == (tg + 1u) * nx) xb_add(&bar[XB_TOPGEN], 1u);
            else XB_SPIN(xb_ld(&bar[XB_TOPGEN]) == tg, bar);
            __builtin_amdgcn_fence(__ATOMIC_ACQUIRE, "agent");
            xb_add(&bar[XB_XGEN(b.x)], 1u);
            asm volatile("s_waitcnt vmcnt(0)" ::: "memory");
        } else {
            XB_SPIN(xb_ld(&bar[XB_XGEN(b.x)]) == gen, bar);
            __builtin_amdgcn_fence(__ATOMIC_ACQUIRE, "agent");
            asm volatile("s_waitcnt vmcnt(0)" ::: "memory");
        }
    }
    __syncthreads();
}

struct Args { const float* in[32]; float* out; unsigned char* ws; int ph_lo, ph_hi, coop, pad; };

__global__ void __launch_bounds__(NTHREADS, 2) mk_fwd(Args args) {
    extern __shared__ __attribute__((aligned(16))) unsigned char lds_raw[];
    Frame F;
    F.lds = (LAS unsigned char*)lds_raw;
    F.tid = threadIdx.x; F.lane = F.tid & 63; F.wave = __builtin_amdgcn_readfirstlane(F.tid >> 6);
    F.G = gridDim.x; { const int bx = blockIdx.x; F.vcu = (F.G % 8 == 0) ? (bx % 8) * (F.G / 8) + bx / 8 : bx; }
    F.in = args.in;
    F.out = args.out; F.ws = args.ws;
    unsigned char* ws = args.ws;
    const int lo = args.ph_lo, hi = args.ph_hi;
    volatile LAS unsigned* MISC = (volatile LAS unsigned*)(F.lds + 131072 + 512);
    if (F.tid < 32) MISC[F.tid] = 0u;
    __syncthreads();
    XcdBarrier bar = xcd_barrier_post((unsigned*)ws, MISC + 8);
#ifndef PHMASK
#define PHMASK 0x3ffff
#endif
#define IN(k) ((((PHMASK) >> (k)) & 1) && lo <= (k) && (k) < hi)
#ifndef PROF
#define PROF 0
#endif
    unsigned long long* tsbuf = (unsigned long long*)(ws + 65536);
#define STAMP(k) do { if (PROF && blockIdx.x == 0 && F.tid == 0) tsbuf[k] = __builtin_amdgcn_s_memrealtime(); } while (0)
#define SEAM(k) do { if (IN(k) && IN((k) + 1)) { xcd_barrier(bar); } STAMP((k) + 1); } while (0)
    STAMP(0);
    typedef pg8::bf16_t gb;

#ifndef DUP0
#define DUP0 0
#endif
#ifndef DUP9
#define DUP9 0
#endif
#ifndef DUP2
#define DUP2 0
#endif
#ifndef DUP6
#define DUP6 0
#endif
#ifndef DUP7
#define DUP7 0
#endif
#ifndef DUP13
#define DUP13 0
#endif
#ifndef DUP12
#define DUP12 0
#endif
#ifndef DUPLN
#define DUPLN 0
#endif
#ifndef DUP10
#define DUP10 0
#endif
#ifndef DUP1
#define DUP1 0
#endif
    if (DUP0) { p0_prologue(F); }
    if (IN(0)) { p0_prologue(F); } SEAM(0);
    if (DUP1) { pg8::Gemm g{(const gb*)(ws + WS_XB), (const gb*)(ws + WS_WIN), T, INP, D, D, D, 0}; pg8::StaticOrder S; S.init(T, INP, F.G, (int)blockIdx.x, D);
        EpiProj E{(bf16*)(ws + WS_PROJA), (bf16*)(ws + WS_PROJB)};
        pg8::gemm_phase<EpiProj, pg8::StaticOrder, true, true>(F.lds, g, S, E); xcd_barrier(bar); }
    if (IN(1)) {
        pg8::Gemm g{(const gb*)(ws + WS_XB), (const gb*)(ws + WS_WIN), T, INP, D, D, D, 0}; pg8::StaticOrder S; S.init(T, INP, F.G, (int)blockIdx.x, D);
        EpiProj E{(bf16*)(ws + WS_PROJA), (bf16*)(ws + WS_PROJB)};
        pg8::gemm_phase<EpiProj, pg8::StaticOrder, true, true>(F.lds, g, S, E);
    } SEAM(1);
    if (DUP2) { p2_rows(F); }
    if (IN(2)) { p2_rows(F); } SEAM(2);
    if (IN(3)) {
        pg8::Gemm g{(const gb*)(ws + WS_LA), (const gb*)(ws + WS_LORAT), T, 1536, 256, 256, 256, 0}; pg8::StaticOrder S; S.init(T, 1536, F.G, (int)blockIdx.x, 256);
        EpiLora E{F.in[12], F.in[14], F.in[18], (h16*)(ws + WS_SCW), (h16*)(ws + WS_SCK), (h16*)(ws + WS_SCKK), (h16*)(ws + WS_SCB), (h16*)(ws + WS_G)};
        pg8::gemm_phase<EpiLora, pg8::StaticOrder, true, true>(F.lds, g, S, E);
    } SEAM(3);
    if (IN(4)) { conv_phase(F); }
    STAMP(5);
#ifndef DUP5
#define DUP5 0
#endif
#ifndef DUP4
#define DUP4 0
#endif
    if (DUP4) { conv_phase(F); }
    if (IN(5)) { scan_phase(F); } SEAM(5);
    if (DUP5) { scan_phase(F); xcd_barrier(bar); }
    if (DUP6) { p6_rows(F); }
    if (IN(6)) { p6_rows(F); } SEAM(6);
    if (DUP7) { pg8::Gemm g{(const gb*)(ws + WS_CAT), (const gb*)(ws + WS_WOUT), T, D, D, D, D, 0}; SplitOrder S; S.init(D, F.G, (int)blockIdx.x, D, 4);
        EpiResid E{F.in[0], F.in[1], (bf16*)(ws + WS_Z), nullptr, nullptr, (h16*)(ws + WS_PART7), nullptr};
        pg8::gemm_phase<EpiResid, SplitOrder, true, true>(F.lds, g, S, E); xcd_barrier(bar); }
    if (IN(7)) {
        pg8::Gemm g{(const gb*)(ws + WS_CAT), (const gb*)(ws + WS_WOUT), T, D, D, D, D, 0}; SplitOrder S; S.init(D, F.G, (int)blockIdx.x, D, 4);
        EpiResid E{F.in[0], F.in[1], (bf16*)(ws + WS_Z), nullptr, nullptr, (h16*)(ws + WS_PART7), nullptr};
        pg8::gemm_phase<EpiResid, SplitOrder, true, true>(F.lds, g, S, E);
    } SEAM(7);
    if (DUPLN) { ln_rows<0>(F, F.in[25], F.in[26], 4, (const h16*)(ws + WS_PART7), nullptr, TP); xcd_barrier(bar); }
    if (IN(8)) { ln_rows<0>(F, F.in[25], F.in[26], 4, (const h16*)(ws + WS_PART7), nullptr); } SEAM(8);
#define FFN_PHASES(layer, pgu, pdn) \
    if (IN(pgu)) { \
        pg8::Gemm g{(const gb*)(ws + WS_XB), (const gb*)(ws + ((layer) ? WS_WGU1 : WS_WGU0)), T, 2 * FF, D, D, D, 0}; pg8::StaticOrder S; S.init(T, 2 * FF, F.G, (int)blockIdx.x, D); \
        EpiGateUp E{(bf16*)(ws + WS_H)}; \
        pg8::gemm_phase<EpiGateUp, pg8::StaticOrder, true, true>(F.lds, g, S, E); \
    } SEAM(pgu); \
    if (IN(pdn)) { \
        pg8::Gemm g{(const gb*)(ws + WS_H), (const gb*)(ws + ((layer) ? WS_WD1 : WS_WD0)), T, D, FF, FF, FF, 0}; SplitOrder S; S.init(D, F.G, (int)blockIdx.x, FF, 11); \
        EpiResid E{nullptr, nullptr, (bf16*)(ws + WS_Z), nullptr, (const bf16*)(ws + WS_XR), (h16*)(ws + WS_PARTA), (h16*)(ws + WS_PARTB)}; \
        pg8::gemm_phase<EpiResid, SplitOrder, true, true>(F.lds, g, S, E); \
    } SEAM(pdn);
    if (DUP9) { pg8::Gemm g{(const gb*)(ws + WS_XB), (const gb*)(ws + WS_WGU0), T, 2 * FF, D, D, D, 0}; pg8::StaticOrder S; S.init(T, 2 * FF, F.G, (int)blockIdx.x, D);
        EpiGateUp E{(bf16*)(ws + WS_H)}; pg8::gemm_phase<EpiGateUp, pg8::StaticOrder, true, true>(F.lds, g, S, E); xcd_barrier(bar); }
    FFN_PHASES(0, 9, 10)
    if (DUP10) { pg8::Gemm g{(const gb*)(ws + WS_H), (const gb*)(ws + WS_WD0), T, D, FF, FF, FF, 0}; SplitOrder S; S.init(D, F.G, (int)blockIdx.x, FF, 11);
        EpiResid E{nullptr, nullptr, (bf16*)(ws + WS_Z), nullptr, (const bf16*)(ws + WS_XR), (h16*)(ws + WS_PARTA), (h16*)(ws + WS_PARTB)};
        pg8::gemm_phase<EpiResid, SplitOrder, true, true>(F.lds, g, S, E); xcd_barrier(bar); }
    if (IN(11)) { ln_rows<1>(F, F.in[30], F.in[31], 11, (const h16*)(ws + WS_PARTA), (const h16*)(ws + WS_PARTB)); } SEAM(11);
    if (DUP12) { pool_phase(F); }
    if (IN(12)) { pool_phase(F); } SEAM(12);
    if (DUP13) { pg8::Gemm g{(const gb*)(ws + WS_PL), (const gb*)(ws + WS_POOLT), T, D, 256, D, 256, 256}; pg8::StaticOrder S; S.init(T, D, F.G, (int)blockIdx.x, 256);
        EpiResid E{nullptr, nullptr, (bf16*)(ws + WS_Z), F.in[24], (const bf16*)(ws + WS_XR), nullptr, nullptr};
        pg8::gemm_phase<EpiResid, pg8::StaticOrder, true, true>(F.lds, g, S, E); xcd_barrier(bar); }
    if (IN(13)) {
        pg8::Gemm g{(const gb*)(ws + WS_PL), (const gb*)(ws + WS_POOLT), T, D, 256, D, 256, 256}; SplitOrder S; S.init(D, F.G, (int)blockIdx.x, 256, 2);
        EpiResid E{nullptr, nullptr, (bf16*)(ws + WS_Z), F.in[24], (const bf16*)(ws + WS_XR), (h16*)(ws + WS_PART7), nullptr};
        pg8::gemm_phase<EpiResid, SplitOrder, true, true>(F.lds, g, S, E);
    } SEAM(13);
    if (IN(14)) { ln_rows<0>(F, F.in[25] + D, F.in[26] + D, 2, (const h16*)(ws + WS_PART7), nullptr); } SEAM(14);
    FFN_PHASES(1, 15, 16)
    if (IN(17)) { ln_rows<2>(F, F.in[30] + D, F.in[31] + D, 11, (const h16*)(ws + WS_PARTA), (const h16*)(ws + WS_PARTB)); }
    if (PROF) {
        STAMP(18);
        xcd_barrier(bar);
        if (blockIdx.x == 0) {
            const size_t obase[10] = {O_Y, O_Y + (size_t)TP * D, O_CONV_P, O_SHIFT_P, O_WKV_P, O_POOL_P, O_CONV_S, O_SHIFT_S, O_WKV_S, O_POOL_S};
#pragma unroll
            for (int k = 0; k < 10; ++k) {
                const int a = PROF == 1 ? k : 10 + k; unsigned long long d;
                if (a < 18) d = (tsbuf[a + 1] - tsbuf[a]) / 10ull; else if (a == 18) d = (tsbuf[18] - tsbuf[0]) / 100ull; else d = 1000ull;
                unsigned n = (unsigned)d; if (n > 14000u) n = 14000u; if (n < 1u) n = 1u;
                for (unsigned i = F.tid; i < n; i += NTHREADS) ((unsigned*)F.out)[obase[k] + i] = 0xAAAAAAAAu;
            }
        }
    }
    if (lo == 100) diag_checks(F, args.pad);
    if (lo == 101) diag_fill(F);
#undef IN
#undef SEAM
}

extern "C" void kernel_launch(void* const* d_in, const int* in_sizes, int n_in, void* d_out, int out_size, void* d_ws, size_t ws_size, hipStream_t stream) {
    static int grid = 0;
    if (grid == 0) {
        if (n_in != 32 || out_size != (int)O_TOTAL || ws_size < WS_END) { fprintf(stderr, "kernel_launch: unexpected shapes: n_in %d out %d ws %zu\n", n_in, out_size, ws_size); grid = -1; return; }
        int dev = 0, cus = 0, per_cu = 0;
        if (hipGetDevice(&dev) != hipSuccess || hipDeviceGetAttribute(&cus, hipDeviceAttributeMultiprocessorCount, dev) != hipSuccess) { grid = -1; return; }
        if (hipFuncSetAttribute((const void*)mk_fwd, hipFuncAttributeMaxDynamicSharedMemorySize, LDS_BYTES) != hipSuccess) { fprintf(stderr, "kernel_launch: hipFuncSetAttribute failed\n"); grid = -1; return; }
        if (hipOccupancyMaxActiveBlocksPerMultiprocessor(&per_cu, (const void*)mk_fwd, NTHREADS, LDS_BYTES) != hipSuccess || per_cu < 1) { fprintf(stderr, "kernel_launch: occupancy query says %d\n", per_cu); (void)hipGetLastError(); per_cu = 1; }
        grid = cus * 1;
        if (per_cu < 1) grid = -1;
    }
    if (grid < 0) return;
    Args a{};
    for (int i = 0; i < 32; ++i) a.in[i] = (const float*)d_in[i];
    a.out = (float*)d_out; a.ws = (unsigned char*)d_ws;
#if MK_SINGLE
    if (hipMemsetAsync(d_ws, 0, 16384, stream) != hipSuccess) { fprintf(stderr, "kernel_launch: memset failed\n"); return; }
    a.ph_lo = 0; a.ph_hi = NPHASE; a.coop = 1;
    void* params[] = {&a};
    hipError_t e = hipLaunchCooperativeKernel((const void*)mk_fwd, dim3(grid), dim3(NTHREADS), params, LDS_BYTES, stream);
    if (e != hipSuccess) fprintf(stderr, "kernel_launch: cooperative launch failed: %s (grid %d)\n", hipGetErrorString(e), grid);
#else
    for (int p = 0; p < NPHASE; ++p) {
        if (DIAG_AT >= 0 && p > DIAG_AT) break;
        a.ph_lo = p; a.ph_hi = p + 1; a.coop = 0;
        hipLaunchKernelGGL(mk_fwd, dim3(grid), dim3(NTHREADS), LDS_BYTES, stream, a);
    }
    if (DIAG_AT >= 0) { a.pad = DIAG_AT; a.ph_lo = 100; a.ph_hi = 101; hipLaunchKernelGGL(mk_fwd, dim3(grid), dim3(NTHREADS), LDS_BYTES, stream, a);
                        a.ph_lo = 101; a.ph_hi = 102; hipLaunchKernelGGL(mk_fwd, dim3(grid), dim3(NTHREADS), LDS_BYTES, stream, a); }
#endif
}
```

```cpp
#include <hip/hip_runtime.h>
#include <hip/hip_cooperative_groups.h>
#include <cstdio>
#include <cstdint>
namespace cg = cooperative_groups;
namespace pg8 {
#define PG8_LAS __attribute__((address_space(3)))
typedef unsigned short bf16_t;
typedef short bf16x8 __attribute__((ext_vector_type(8)));
typedef float f32x4 __attribute__((ext_vector_type(4)));
typedef unsigned u32x4 __attribute__((ext_vector_type(4)));
constexpr int BM = 256, BK = 64, HALF = 128, HTB = HALF * BK * 2  , STAGE_BYTES = 8 * HTB, NXCD = 8, WGM = 8;

__host__ __device__ __forceinline__ int lds_byte(int r, int c) { const int st = (r >> 4) * 2 + (c >> 5), rr = r & 15, cc = c & 31, ob = rr * 64 + cc * 2; return st * 1024 + (ob ^ (((ob >> 9) & 1) << 5)); }
__host__ __device__ __forceinline__ void stage_rc(int b, int& R, int& C) { const int st = b / 1024, sb = b % 1024, swz = sb ^ (((sb >> 9) & 1) << 5); R = (st >> 1) * 16 + swz / 64; C = (st & 1) * 32 + (swz % 64) / 2; }
__host__ __device__ __forceinline__ int perm32(int rho) { const int n = rho >> 4, i = rho & 15; return 8 * (i >> 2) + 4 * n + (i & 3); }

struct Unit { int pm, pn, kt0, nt, mode; };
struct Gemm { const bf16_t* A; const bf16_t* Bt; int M, N, K, lda, ldb, acol; };

struct StaticOrder {
    int nM, nN, nwg, G, c, ntf;
    __host__ __device__ void init(int M, int N, int G_, int c_, int K_) { nM = M / BM; nN = N / BM; nwg = nM * nN; G = G_; c = c_; ntf = K_ / BK; }
    __host__ __device__ bool next(int i, Unit& u) const {
        const long L = (long)i * G + c; if (L >= nwg) return false;
        int wgid = (int)L; { const int q = nwg / NXCD, r = nwg % NXCD, xcd = wgid % NXCD, off = wgid / NXCD; wgid = (xcd < r ? xcd * (q + 1) : r * (q + 1) + (xcd - r) * q) + off; }
        const int nig = WGM * nN, gid = wgid / nig, fm = gid * WGM, gsz = (nM - fm) < WGM ? (nM - fm) : WGM;
        u.pm = fm + ((wgid % nig) % gsz); u.pn = (wgid % nig) / gsz; u.kt0 = 0; u.nt = ntf; u.mode = 0; return true;
    }
    __device__ __forceinline__ void a_ready(const Unit&) const {}
    __device__ __forceinline__ void done(const Unit&) const {}
};

__device__ __forceinline__ unsigned cvt_pk_bf16(float lo, float hi) { unsigned r; asm volatile("v_cvt_pk_bf16_f32 %0, %1, %2" : "=v"(r) : "v"(lo), "v"(hi)); return r; }
template <class Epi, class Sched, bool ALIGN_EPI = false, bool SP2 = false>
__device__ __forceinline__ void gemm_phase(PG8_LAS unsigned char* lds, const Gemm g, const Sched& S, const Epi& E) {
    const int tid = threadIdx.x, wid = __builtin_amdgcn_readfirstlane(tid >> 6), lane = tid & 63, wr = wid >> 2, wc = wid & 3, fr = lane & 15, fq = lane >> 4;
    const int K = g.K; (void)K;
    unsigned voffA[2], voffB[2];
#pragma unroll
    for (int i = 0; i < 2; ++i) { int R, C; stage_rc(tid * 16 + i * 8192, R, C); const int Rb = Epi::PERM ? ((R & ~31) + perm32(R & 31)) : R;
        voffA[i] = (unsigned)(R * g.lda + C) * 2u; voffB[i] = (unsigned)(Rb * g.ldb + C) * 2u; }
    const size_t kstep = (size_t)(BK * 2);
    const size_t hstepA = (size_t)HALF * g.lda * 2, hstepB = (size_t)HALF * g.ldb * 2;
    const size_t tstepA = 2 * hstepA, tstepB = 2 * hstepB; const size_t acolB = (size_t)g.acol * 2;
    const unsigned ldsw = (unsigned)wid * 1024u;
    const int aoff = lds_byte(wr * 64 + fr, fq * 8), boff = lds_byte(wc * 32 + fr, fq * 8);
#define PG8_SA(b, h) (((b) * 2 + (h)) * HTB)
#define PG8_SB(b, h) ((4 + (b) * 2 + (h)) * HTB)
#define PG8_STAGE(bufoff, gbase, voff) do { _Pragma("unroll") for (int _i = 0; _i < 2; ++_i) \
        __builtin_amdgcn_global_load_lds((const unsigned*)((const char*)(gbase) + (voff)[_i]), (PG8_LAS unsigned*)(lds + (bufoff) + ldsw + _i * 8192), 16, 0, 0); } while (0)
#define PG8_LDA(dst, b, h) do { _Pragma("unroll") for (int m = 0; m < 4; ++m) _Pragma("unroll") for (int k = 0; k < 2; ++k) dst[m][k] = *(const PG8_LAS bf16x8*)(lds + PG8_SA(b, h) + aoff + m * 2048 + k * 1024); } while (0)
#define PG8_LDB(dst, b, h) do { _Pragma("unroll") for (int n = 0; n < 2; ++n) _Pragma("unroll") for (int k = 0; k < 2; ++k) dst[n][k] = *(const PG8_LAS bf16x8*)(lds + PG8_SB(b, h) + boff + n * 2048 + k * 1024); } while (0)
#define PG8_MMA(ai, bj, At, Bt) do { __builtin_amdgcn_s_setprio(1); _Pragma("unroll") for (int m = 0; m < 4; ++m) _Pragma("unroll") for (int n = 0; n < 2; ++n) _Pragma("unroll") for (int k = 0; k < 2; ++k) \
        acc[ai][bj][m][n] = __builtin_amdgcn_mfma_f32_16x16x32_bf16(Bt[n][k], At[m][k], acc[ai][bj][m][n], 0, 0, 0); __builtin_amdgcn_s_setprio(0); } while (0)
#define PG8_WAIT_V(n) asm volatile("s_waitcnt vmcnt(" #n ")" ::: "memory")
#define PG8_WAIT_L(n) asm volatile("s_waitcnt lgkmcnt(" #n ")" ::: "memory")
#define PG8_BAR __builtin_amdgcn_s_barrier()
#define PG8_SCHED __builtin_amdgcn_sched_barrier(0)
    Unit cur, nxt; int ui = 0;
    if (!S.next(0, cur)) return;
    f32x4 acc[2][2][4][2];
#pragma unroll
    for (int a = 0; a < 2; ++a)
#pragma unroll
        for (int b = 0; b < 2; ++b)
#pragma unroll
            for (int m = 0; m < 4; ++m)
#pragma unroll
                for (int n = 0; n < 2; ++n) acc[a][b][m][n] = (f32x4){0.f, 0.f, 0.f, 0.f};
    bf16x8 At[4][2], B0[2][2], B1[2][2];
    const char* cA = (const char*)g.A + (size_t)cur.pm * tstepA + (size_t)cur.pn * acolB + (size_t)cur.kt0 * kstep; const char* cB = (const char*)g.Bt + (size_t)cur.pn * tstepB + (size_t)cur.kt0 * kstep;
    S.a_ready(cur);
    if constexpr (SP2) {
        PG8_STAGE(PG8_SB(0, 0), cB, voffB); PG8_STAGE(PG8_SB(0, 1), cB + hstepB, voffB); PG8_STAGE(PG8_SA(0, 0), cA, voffA); PG8_STAGE(PG8_SA(0, 1), cA + hstepA, voffA);
        if (wr == 1) PG8_BAR;
        PG8_WAIT_V(2); PG8_BAR;
        PG8_STAGE(PG8_SB(1, 0), cB + kstep, voffB); PG8_STAGE(PG8_SA(1, 0), cA + kstep, voffA); PG8_STAGE(PG8_SB(1, 1), cB + hstepB + kstep, voffB);
        PG8_WAIT_V(6); PG8_BAR;
    } else {
        PG8_STAGE(PG8_SB(0, 0), cB, voffB); PG8_STAGE(PG8_SA(0, 0), cA, voffA); PG8_STAGE(PG8_SB(0, 1), cB + hstepB, voffB); PG8_STAGE(PG8_SA(0, 1), cA + hstepA, voffA);
        if (wr == 1) PG8_BAR;
        PG8_WAIT_V(4); PG8_BAR;
        PG8_STAGE(PG8_SB(1, 0), cB + kstep, voffB); PG8_STAGE(PG8_SA(1, 0), cA + kstep, voffA); PG8_STAGE(PG8_SB(1, 1), cB + hstepB + kstep, voffB);
        PG8_WAIT_V(6); PG8_BAR;
    }
    for (;;) {
        const bool has_next = S.next(ui + 1, nxt);
        const char* nA = has_next ? (const char*)g.A + (size_t)nxt.pm * tstepA + (size_t)nxt.pn * acolB + (size_t)nxt.kt0 * kstep : cA; const char* nB = has_next ? (const char*)g.Bt + (size_t)nxt.pn * tstepB + (size_t)nxt.kt0 * kstep : cB;
        const int nt = cur.nt;
        _Pragma("unroll 1") for (int t = 0; t < nt; t += 2) {
            const bool last = (t == nt - 2);
            const char* a1 = cA + (size_t)(t + 1) * kstep;
            const char* a2 = last ? nA : cA + (size_t)(t + 2) * kstep; const char* b2 = last ? nB : cB + (size_t)(t + 2) * kstep;
            const char* a3 = a2 + kstep; const char* b3 = b2 + kstep;
            if (last && has_next) S.a_ready(nxt);
            if constexpr (SP2) {
            PG8_LDB(B0, 0, 0); PG8_LDB(B1, 0, 1); PG8_SCHED; PG8_LDA(At, 0, 0); PG8_STAGE(PG8_SA(1, 1), a1 + hstepA, voffA);
            PG8_WAIT_V(8); PG8_WAIT_L(0); PG8_BAR; PG8_MMA(0, 0, At, B0); PG8_MMA(0, 1, At, B1); PG8_BAR; PG8_SCHED;
            PG8_LDA(At, 0, 1); PG8_STAGE(PG8_SB(0, 0), b2, voffB); PG8_STAGE(PG8_SB(0, 1), b2 + hstepB, voffB); PG8_STAGE(PG8_SA(0, 0), a2, voffA);
            PG8_WAIT_V(8); PG8_WAIT_L(0); PG8_BAR; PG8_MMA(1, 0, At, B0); PG8_MMA(1, 1, At, B1); PG8_BAR; PG8_SCHED;
            PG8_LDB(B0, 1, 0); PG8_LDB(B1, 1, 1); PG8_SCHED; PG8_LDA(At, 1, 0); PG8_STAGE(PG8_SA(0, 1), a2 + hstepA, voffA);
            PG8_WAIT_V(8); PG8_WAIT_L(0); PG8_BAR; PG8_MMA(0, 0, At, B0); PG8_MMA(0, 1, At, B1); PG8_BAR; PG8_SCHED;
            PG8_LDA(At, 1, 1); PG8_STAGE(PG8_SB(1, 0), b3, voffB); PG8_STAGE(PG8_SB(1, 1), b3 + hstepB, voffB); PG8_STAGE(PG8_SA(1, 0), a3, voffA);
            PG8_WAIT_V(8); PG8_WAIT_L(0); PG8_BAR; PG8_MMA(1, 0, At, B0); PG8_MMA(1, 1, At, B1); PG8_BAR; PG8_SCHED;
            } else {
            PG8_LDB(B0, 0, 0); PG8_SCHED; PG8_LDA(At, 0, 0); PG8_STAGE(PG8_SA(1, 1), a1 + hstepA, voffA);
            PG8_WAIT_L(8); PG8_BAR; PG8_WAIT_L(0); PG8_MMA(0, 0, At, B0); PG8_BAR; PG8_SCHED;
            PG8_LDB(B1, 0, 1); PG8_STAGE(PG8_SB(0, 0), b2, voffB);
            PG8_BAR; PG8_WAIT_L(0); PG8_MMA(0, 1, At, B1); PG8_BAR;
            PG8_LDA(At, 0, 1); PG8_STAGE(PG8_SA(0, 0), a2, voffA);
            PG8_BAR; PG8_WAIT_L(0); PG8_MMA(1, 0, At, B0); PG8_BAR; PG8_SCHED;
            PG8_STAGE(PG8_SB(0, 1), b2 + hstepB, voffB);
            PG8_WAIT_V(6); PG8_BAR; PG8_MMA(1, 1, At, B1); PG8_BAR;
            PG8_LDB(B0, 1, 0); PG8_SCHED; PG8_LDA(At, 1, 0); PG8_STAGE(PG8_SA(0, 1), a2 + hstepA, voffA);
            PG8_WAIT_L(8); PG8_BAR; PG8_WAIT_L(0); PG8_MMA(0, 0, At, B0); PG8_BAR; PG8_SCHED;
            PG8_LDB(B1, 1, 1); PG8_STAGE(PG8_SB(1, 0), b3, voffB);
            PG8_BAR; PG8_WAIT_L(0); PG8_MMA(0, 1, At, B1); PG8_BAR;
            PG8_LDA(At, 1, 1); PG8_STAGE(PG8_SA(1, 0), a3, voffA);
            PG8_BAR; PG8_WAIT_L(0); PG8_MMA(1, 0, At, B0); PG8_BAR; PG8_SCHED;
            PG8_STAGE(PG8_SB(1, 1), b3 + hstepB, voffB);
            PG8_WAIT_V(6); PG8_BAR; PG8_MMA(1, 1, At, B1); PG8_BAR;
            }
        }
        if constexpr (ALIGN_EPI) { if (wr == 0) PG8_BAR; }
        if constexpr (!Epi::AFTER_DRAIN) { E(acc, cur, wr, wc, fr, fq); S.done(cur); }
        if (!has_next) break;
#pragma unroll
        for (int a = 0; a < 2; ++a)
#pragma unroll
            for (int b = 0; b < 2; ++b)
#pragma unroll
                for (int m = 0; m < 4; ++m)
#pragma unroll
                    for (int n = 0; n < 2; ++n) acc[a][b][m][n] = (f32x4){0.f, 0.f, 0.f, 0.f};
        cur = nxt; cA = nA; cB = nB; ++ui;
        if constexpr (ALIGN_EPI) { if (wr == 1) PG8_BAR; }
    }
    PG8_WAIT_V(0);
    if constexpr (!ALIGN_EPI) { if (wr == 0) PG8_BAR; }
    PG8_BAR;
    if constexpr (Epi::AFTER_DRAIN) { E.fused(acc, cur, wr, wc, fr, fq, lds, wid, lane); S.done(cur); }
#undef PG8_SA
#undef PG8_SB
#undef PG8_STAGE
#undef PG8_LDA
#undef PG8_LDB
#undef PG8_MMA
#undef PG8_WAIT_V
#undef PG8_WAIT_L
#undef PG8_BAR
#undef PG8_SCHED
}
}

#define GAS __attribute__((address_space(1)))
#define LAS __attribute__((address_space(3)))
typedef unsigned short bf16;
typedef unsigned v4u __attribute__((ext_vector_type(4)));
typedef unsigned v2u __attribute__((ext_vector_type(2)));
typedef float f32x4 __attribute__((ext_vector_type(4)));
typedef _Float16 h16;
typedef _Float16 h16x2 __attribute__((ext_vector_type(2)));

#ifndef MK_SINGLE
#define MK_SINGLE 1
#endif

constexpr int NWAVES = 8, NTHREADS = NWAVES * 64;
constexpr int D = 1024, TP = 16384, TS = 1024, T = TP + TS, LP = 2048, LS = 8, NPB = 8, NSB = 128;
constexpr int INP = 2816, BP = 1792, FF = 2816, HW = 512;
constexpr float ALPHA = 1.41421356237309515f, LN_EPS = 1e-5f, GN_EPS = 64e-5f;
constexpr int NPHASE = 18;

constexpr size_t MiB = 1u << 20;
constexpr size_t WS_WIN = 1 * MiB, WS_WOUT = WS_WIN + 5632 * 1024, WS_WGU0 = WS_WOUT + 2 * MiB, WS_WGU1 = WS_WGU0 + 11 * MiB, WS_WD0 = WS_WGU1 + 11 * MiB, WS_WD1 = WS_WD0 + 5632 * 1024,
                 WS_POOLT = WS_WD1 + 5632 * 1024, WS_LORAT = WS_POOLT + 512 * 1024;
constexpr size_t WS_XB = 43 * MiB;
constexpr size_t WS_SCW = 43 * MiB, WS_G = 60 * MiB;
constexpr size_t WS_PROJA = 77 * MiB;
constexpr size_t WS_PROJB = 111 * MiB;
constexpr size_t WS_CAT = 111 * MiB, WS_SCB = 145 * MiB, WS_O = 162 * MiB;
constexpr size_t WS_LA = 170 * MiB + 512 * 1024;
constexpr size_t WS_SCR = 179 * MiB, WS_SCV = 196 * MiB, WS_SCK = 213 * MiB, WS_SCKK = 230 * MiB;
constexpr size_t WS_Z = 222 * MiB;
constexpr size_t WS_H = 77 * MiB;
constexpr size_t WS_PL = 77 * MiB;
constexpr size_t WS_PART7 = 145 * MiB;
constexpr size_t WS_PARTA = 170 * MiB + 512 * 1024, WS_PARTB = 1 * MiB;
constexpr size_t WS_XR = 43 * MiB;
constexpr size_t WS_END = 256 * MiB;
static_assert(WS_LORAT + 1536 * 256 * 2 <= WS_XB, "weights");
static_assert(WS_PROJB + (size_t)T * BP * 2 <= WS_LA, "projb");
static_assert(WS_H + (size_t)T * FF * 2 <= WS_Z, "h");
static_assert(WS_Z + (size_t)T * D * 2 <= WS_END, "z");

constexpr size_t O_Y = 0, O_CONV_P = 17825792, O_SHIFT_P = 17948672, O_WKV_P = 17963008, O_POOL_P = 18225152,
                 O_CONV_S = 18348032, O_SHIFT_S = 20314112, O_WKV_S = 20543488, O_POOL_S = 24737792, O_TOTAL = 26703872;

constexpr int LDS_BYTES = 147456;

struct Frame {
    LAS unsigned char* lds;
    int tid, lane, wave, vcu, G;
    const float* const* in;
    float* out; unsigned char* ws;
};

__device__ __forceinline__ float bf2f(unsigned b) { return __uint_as_float(b << 16); }
__device__ __forceinline__ unsigned pkbf(float lo, float hi) { return pg8::cvt_pk_bf16(lo, hi); }
__device__ __forceinline__ unsigned pkh(float lo, float hi) { const unsigned short a = __builtin_bit_cast(unsigned short, (h16)lo), b = __builtin_bit_cast(unsigned short, (h16)hi); return (unsigned)a | ((unsigned)b << 16); }
__device__ __forceinline__ float hlo(unsigned u) { return (float)__builtin_bit_cast(h16, (unsigned short)(u & 0xffffu)); }
__device__ __forceinline__ float hhi(unsigned u) { return (float)__builtin_bit_cast(h16, (unsigned short)(u >> 16)); }
__device__ __forceinline__ void unpack_bf8(v4u w, float (&f)[8]) { const unsigned u0 = w.x, u1 = w.y, u2 = w.z, u3 = w.w;
    f[0] = __uint_as_float(u0 << 16); f[1] = __uint_as_float(u0 & 0xffff0000u); f[2] = __uint_as_float(u1 << 16); f[3] = __uint_as_float(u1 & 0xffff0000u);
    f[4] = __uint_as_float(u2 << 16); f[5] = __uint_as_float(u2 & 0xffff0000u); f[6] = __uint_as_float(u3 << 16); f[7] = __uint_as_float(u3 & 0xffff0000u); }
__device__ __forceinline__ void unpack_h8(v4u w, float (&f)[8]) { const unsigned u0 = w.x, u1 = w.y, u2 = w.z, u3 = w.w; f[0] = hlo(u0); f[1] = hhi(u0); f[2] = hlo(u1); f[3] = hhi(u1); f[4] = hlo(u2); f[5] = hhi(u2); f[6] = hlo(u3); f[7] = hhi(u3); }
__device__ __forceinline__ v4u pack_bf8(const float (&f)[8]) { v4u w; w.x = pkbf(f[0], f[1]); w.y = pkbf(f[2], f[3]); w.z = pkbf(f[4], f[5]); w.w = pkbf(f[6], f[7]); return w; }
__device__ __forceinline__ v4u pack_h8(const float (&f)[8]) { v4u w; w.x = pkh(f[0], f[1]); w.y = pkh(f[2], f[3]); w.z = pkh(f[4], f[5]); w.w = pkh(f[6], f[7]); return w; }
__device__ __forceinline__ void load_f8(const float* p, float (&f)[8]) { const f32x4 a = *(const f32x4*)p, b = *(const f32x4*)(p + 4); f[0] = a.x; f[1] = a.y; f[2] = a.z; f[3] = a.w; f[4] = b.x; f[5] = b.y; f[6] = b.z; f[7] = b.w; }
__device__ __forceinline__ void store_f8(float* p, const float (&f)[8]) { *(f32x4*)p = (f32x4){f[0], f[1], f[2], f[3]}; *(f32x4*)(p + 4) = (f32x4){f[4], f[5], f[6], f[7]}; }
__device__ __forceinline__ float sigmoid_(float x) { return __builtin_amdgcn_rcpf(1.f + __expf(-x)); }
__device__ __forceinline__ float silu_(float x) { return x * sigmoid_(x); }
__device__ __forceinline__ float wave_sum(float v) {
#pragma unroll
    for (int o = 1; o < 64; o <<= 1) v += __shfl_xor(v, o);
    return v;
}
__device__ __forceinline__ float sum8(float v) { v += __shfl_xor(v, 1); v += __shfl_xor(v, 2); v += __shfl_xor(v, 4); return v; }
template <int CTRL> __device__ __forceinline__ float dppf(float x) { return __builtin_bit_cast(float, __builtin_amdgcn_update_dpp(0, __builtin_bit_cast(int, x), CTRL, 0xF, 0xF, true)); }
__device__ __forceinline__ float dpp_sum16(float x) {
    x += dppf<0xB1>(x);
    x += dppf<0x4E>(x);
    x += dppf<0x141>(x);
    x += dppf<0x140>(x);
    return x;
}
__device__ __forceinline__ void h4(v2u x, float (&f)[4]) { const unsigned u0 = x.x, u1 = x.y; f[0] = hlo(u0); f[1] = hhi(u0); f[2] = hlo(u1); f[3] = hhi(u1); }
__device__ __forceinline__ const float* xrow_ptr(const Frame& F, int m) { return m < TP ? F.in[0] + (size_t)m * D : F.in[1] + (size_t)(m - TP) * D; }

using pg8::Unit; using pg8::HALF; using pg8::BM;
typedef pg8::u32x4 u32x4;
struct EpiProj {
    static constexpr bool PERM = true, AFTER_DRAIN = false;
    bf16* PA; bf16* PB;
    __device__ __forceinline__ void operator()(const pg8::f32x4 (&acc)[2][2][4][2], const Unit& u, int wr, int wc, int fr, int fq) const {
        const int row0 = u.pm * BM + wr * 64 + fr;
        if (u.pn < 4) {
            const int col0 = u.pn * HALF + wc * 32 + 8 * fq;
#pragma unroll
            for (int ai = 0; ai < 2; ++ai)
#pragma unroll
                for (int m = 0; m < 4; ++m) {
                    const pg8::f32x4 v0 = acc[ai][0][m][0], v1 = acc[ai][0][m][1], g0 = acc[ai][1][m][0], g1 = acc[ai][1][m][1];
                    u32x4 w; w.x = pkbf(v0[0] * sigmoid_(g0[0]), v0[1] * sigmoid_(g0[1])); w.y = pkbf(v0[2] * sigmoid_(g0[2]), v0[3] * sigmoid_(g0[3]));
                    w.z = pkbf(v1[0] * sigmoid_(g1[0]), v1[1] * sigmoid_(g1[1])); w.w = pkbf(v1[2] * sigmoid_(g1[2]), v1[3] * sigmoid_(g1[3]));
                    *(u32x4*)(PA + (size_t)(row0 + ai * HALF + m * 16) * 512 + col0) = w;
                }
        } else {
            const int col0 = (u.pn - 4) * BM + wc * 32 + 8 * fq;
#pragma unroll
            for (int ai = 0; ai < 2; ++ai)
#pragma unroll
                for (int m = 0; m < 4; ++m) { bf16* rowp = PB + (size_t)(row0 + ai * HALF + m * 16) * BP + col0;
#pragma unroll
                    for (int bj = 0; bj < 2; ++bj) { const pg8::f32x4 v0 = acc[ai][bj][m][0], v1 = acc[ai][bj][m][1];
                        u32x4 w; w.x = pkbf(v0[0], v0[1]); w.y = pkbf(v0[2], v0[3]); w.z = pkbf(v1[0], v1[1]); w.w = pkbf(v1[2], v1[3]);
                        *(u32x4*)(rowp + bj * HALF) = w; } }
        }
    }
};
struct EpiLora {
    static constexpr bool PERM = true, AFTER_DRAIN = false;
    const float* w0; const float* a0; const float* ka;
    h16* SCW; h16* SCK; h16* SCKK; h16* SCB; h16* G;
    __device__ __forceinline__ void operator()(const pg8::f32x4 (&acc)[2][2][4][2], const Unit& u, int wr, int wc, int fr, int fq) const {
        const int row0 = u.pm * BM + wr * 64 + fr; const int sec = u.pn >> 1;
        const int c0 = (u.pn & 1) * BM + wc * 32 + 8 * fq;
#pragma unroll
        for (int bj = 0; bj < 2; ++bj) {
            const int c = c0 + bj * HALF;
            float p0[8], p1[8];
            if (sec == 0) load_f8(w0 + c, p0); else if (sec == 1) { load_f8(a0 + c, p0); load_f8(ka + c, p1); }
#pragma unroll
            for (int ai = 0; ai < 2; ++ai) {
                v4u kxr[4], kkr[4];
                if (sec == 1) {
#pragma unroll
                    for (int m = 0; m < 4; ++m) { const size_t off = (size_t)(row0 + ai * HALF + m * 16) * HW + c; kxr[m] = *(const v4u*)(SCK + off); kkr[m] = *(const v4u*)(SCKK + off); }
                }
#pragma unroll
                for (int m = 0; m < 4; ++m) {
                    const size_t off = (size_t)(row0 + ai * HALF + m * 16) * HW + c;
                    const pg8::f32x4 v0 = acc[ai][bj][m][0], v1 = acc[ai][bj][m][1];
                    const float v[8] = {v0[0], v0[1], v0[2], v0[3], v1[0], v1[1], v1[2], v1[3]};
                    if (sec == 0) {
                        float o[8];
#pragma unroll
                        for (int i = 0; i < 8; ++i) { const float e = 0.60653065971f * sigmoid_(p0[i] + v[i]); o[i] = 1.f - __expf(-e); }
                        *(v4u*)(SCW + off) = pack_h8(o);
                    } else if (sec == 1) {
                        float kx[8], kk[8], ko[8], bo[8];
                        unpack_h8(kxr[m], kx); unpack_h8(kkr[m], kk);
#pragma unroll
                        for (int i = 0; i < 8; ++i) { const float a = sigmoid_(p0[i] + v[i]); ko[i] = kx[i] * (1.f + (a - 1.f) * p1[i]); bo[i] = kk[i] * a; }
                        *(v4u*)(SCK + off) = pack_h8(ko); *(v4u*)(SCB + off) = pack_h8(bo);
                    } else {
                        *(v4u*)(G + off) = pack_h8(v);
                    }
                }
                asm volatile("" ::: "memory");
            }
        }
    }
};
struct EpiGateUp {
    static constexpr bool PERM = true, AFTER_DRAIN = false;
    bf16* H;
    __device__ __forceinline__ void operator()(const pg8::f32x4 (&acc)[2][2][4][2], const Unit& u, int wr, int wc, int fr, int fq) const {
        const int row0 = u.pm * BM + wr * 64 + fr; const int col0 = u.pn * HALF + wc * 32 + 8 * fq;
#pragma unroll
        for (int ai = 0; ai < 2; ++ai)
#pragma unroll
            for (int m = 0; m < 4; ++m) {
                const pg8::f32x4 g0 = acc[ai][0][m][0], g1 = acc[ai][0][m][1], u0 = acc[ai][1][m][0], u1 = acc[ai][1][m][1];
                u32x4 w; w.x = pkbf(silu_(g0[0]) * u0[0], silu_(g0[1]) * u0[1]); w.y = pkbf(silu_(g0[2]) * u0[2], silu_(g0[3]) * u0[3]);
                w.z = pkbf(silu_(g1[0]) * u1[0], silu_(g1[1]) * u1[1]); w.w = pkbf(silu_(g1[2]) * u1[2], silu_(g1[3]) * u1[3]);
                *(u32x4*)(H + (size_t)(row0 + ai * HALF + m * 16) * FF + col0) = w;
            }
    }
};
struct EpiResid {
    static constexpr bool PERM = true, AFTER_DRAIN = false;
    const float* xp; const float* xs; bf16* Z; const float* scale;
    const bf16* XBr;
    h16* pa; h16* pb;
    __device__ __forceinline__ void operator()(const pg8::f32x4 (&acc)[2][2][4][2], const Unit& u, int wr, int wc, int fr, int fq) const {
        const int col0 = u.pn * BM + wc * 32 + 8 * fq;
        float sc[2][8];
#pragma unroll
        for (int bj = 0; bj < 2; ++bj) { if (scale) load_f8(scale + col0 + bj * HALF, sc[bj]); else {
#pragma unroll
                for (int i = 0; i < 8; ++i) sc[bj][i] = 1.f; } }
#pragma unroll
        for (int ai = 0; ai < 2; ++ai)
#pragma unroll
            for (int m = 0; m < 4; ++m) {
                const int row = u.pm * BM + ai * HALF + wr * 64 + m * 16 + fr;
#pragma unroll
                for (int bj = 0; bj < 2; ++bj) {
                    const int c = col0 + bj * HALF;
                    const pg8::f32x4 a0 = acc[ai][bj][m][0], a1 = acc[ai][bj][m][1];
                    float a[8] = {a0[0] * sc[bj][0], a0[1] * sc[bj][1], a0[2] * sc[bj][2], a0[3] * sc[bj][3], a1[0] * sc[bj][4], a1[1] * sc[bj][5], a1[2] * sc[bj][6], a1[3] * sc[bj][7]};
                    if (u.mode == 1) {
                        const int sp = u.kt0 / u.nt;
                        h16* pr = (sp < 8 ? pa + (size_t)sp * (1u << 20) : pb + (size_t)(sp - 8) * (1u << 20)) + (size_t)(row - TP) * D + c;
                        *(v4u*)pr = pack_h8(a);
                    } else {
                        float b[8];
                        if (xp) { const f32x4* bp = (const f32x4*)((row < TP ? xp + (size_t)row * D : xs + (size_t)(row - TP) * D) + c); const f32x4 b0 = __builtin_nontemporal_load(bp), b1 = __builtin_nontemporal_load(bp + 1);
                            b[0] = b0.x; b[1] = b0.y; b[2] = b0.z; b[3] = b0.w; b[4] = b1.x; b[5] = b1.y; b[6] = b1.z; b[7] = b1.w; }
                        else unpack_bf8(*(const v4u*)(XBr + (size_t)row * D + c), b);
#pragma unroll
                        for (int i = 0; i < 8; ++i) a[i] = ALPHA * b[i] + a[i];
                        *(v4u*)(Z + (size_t)row * D + c) = pack_bf8(a);
                    }
                }
            }
    }
};

struct SplitOrder {
    pg8::StaticOrder base; int NS, ntc, c;
    __device__ void init(int N, int G, int c_, int K, int NS_) { base.init(TP, N, G, c_, K); NS = NS_; ntc = (K / pg8::BK) / NS_; c = c_; }
    __device__ bool next(int i, Unit& u) const {
        if (i == 0) return base.next(0, u);
        if (i == 1) { if (c >= 16 * NS) return false; const int unit = c / NS, sp = c % NS; u.pm = 64 + (unit >> 2); u.pn = unit & 3; u.kt0 = sp * ntc; u.nt = ntc; u.mode = 1; return true; }
        return false;
    }
    __device__ __forceinline__ void a_ready(const Unit&) const {}
    __device__ __forceinline__ void done(const Unit&) const {}
};

__device__ __forceinline__ void transpose_item(const float* W, int K, int N, bf16* WT, int mode, LAS float* scr, int item, int lane) {
    const int nblk = N / 32, kb = item / nblk, nb = item % nblk, k0 = 64 * kb, n0 = 32 * nb;
    int drow0;
    if (mode == 0) drow0 = n0;
    else if (mode == 3) drow0 = n0 >= 1024 ? n0 : (n0 < 512 ? ((n0 >> 7) * 256 + (n0 & 127)) : ((((n0 - 512) >> 7) * 256) + 128 + ((n0 - 512) & 127)));
    else drow0 = (n0 >> 7) * 256 + (mode == 2 ? 128 : 0) + (n0 & 127);
    float tv[32];
#pragma unroll
    for (int i = 0; i < 32; ++i) { const int kk = 2 * i + (lane >> 5); tv[i] = __builtin_nontemporal_load(W + (size_t)(k0 + kk) * N + n0 + (lane & 31)); }
#pragma unroll
    for (int i = 0; i < 32; ++i) { const int kk = 2 * i + (lane >> 5); scr[kk * 33 + (lane & 31)] = tv[i]; }
    asm volatile("s_waitcnt lgkmcnt(0)" ::: "memory");
    const int c = lane & 7;
#pragma unroll
    for (int j = 0; j < 4; ++j) { const int n = (lane >> 3) + 8 * j; const LAS float* s = scr + (8 * c) * 33 + n;
        v4u o; o.x = pkbf(s[0 * 33], s[1 * 33]); o.y = pkbf(s[2 * 33], s[3 * 33]); o.z = pkbf(s[4 * 33], s[5 * 33]); o.w = pkbf(s[6 * 33], s[7 * 33]);
        *(v4u*)(WT + (size_t)(drow0 + n) * K + k0 + 8 * c) = o; }
    asm volatile("s_waitcnt lgkmcnt(0)" ::: "memory");
}
__device__ __forceinline__ void p0_prologue(Frame& F) {
    LAS float* scr = (LAS float*)(F.lds + F.wave * 16384);
    const int gw = F.vcu * NWAVES + F.wave, NGW = F.G * NWAVES;
    unsigned char* ws = F.ws;
    constexpr int I_IN = 16 * 88, I_OUT = 16 * 32, I_GU = 16 * 88, I_DN = 44 * 32, I_PL = 4 * 8;
    constexpr int NITEMS = I_IN + I_OUT + 2 * (2 * I_GU + I_DN) + 4 * I_PL;
    for (int it = gw; it < NITEMS; it += NGW) {
        int r = it;
        if (r < I_IN) { transpose_item(F.in[6], D, INP, (bf16*)(ws + WS_WIN), 3, scr, r, F.lane); continue; } r -= I_IN;
        if (r < I_OUT) { transpose_item(F.in[22], D, D, (bf16*)(ws + WS_WOUT), 0, scr, r, F.lane); continue; } r -= I_OUT;
        constexpr int I_LAYER = 2 * I_GU + I_DN;
        if (r < 2 * I_LAYER) {
            const int l = r / I_LAYER; int q = r % I_LAYER;
            bf16* gu = (bf16*)(ws + (l ? WS_WGU1 : WS_WGU0)); bf16* dn = (bf16*)(ws + (l ? WS_WD1 : WS_WD0));
            if (q < I_GU) { transpose_item(F.in[27] + (size_t)l * D * FF, D, FF, gu, 1, scr, q, F.lane); continue; } q -= I_GU;
            if (q < I_GU) { transpose_item(F.in[28] + (size_t)l * D * FF, D, FF, gu, 2, scr, q, F.lane); continue; } q -= I_GU;
            transpose_item(F.in[29] + (size_t)l * FF * D, FF, D, dn, 0, scr, q, F.lane); continue;
        }
        r -= 2 * I_LAYER;
        { const int g = r / I_PL, ri = r % I_PL; transpose_item(F.in[23] + (size_t)g * 65536, 256, 256, (bf16*)(ws + WS_POOLT) + (size_t)g * 65536, 0, scr, ri, F.lane); }
    }
    const int gt = F.vcu * NTHREADS + F.tid, NGT = F.G * NTHREADS;
    bf16* XB = (bf16*)(ws + WS_XB);
    bf16* Zp = (bf16*)(ws + WS_Z);
    for (int i0 = gt; i0 < T * D / 8; i0 += 4 * NGT) {
        float f[4][8];
#pragma unroll
        for (int u = 0; u < 4; ++u) { const int i = i0 + u * NGT; if (i < T * D / 8) { const int m = i >> 7, c8 = (i & 127) * 8; const f32x4* xp4 = (const f32x4*)(xrow_ptr(F, m) + c8); const f32x4 a = __builtin_nontemporal_load(xp4), b = __builtin_nontemporal_load(xp4 + 1);
            f[u][0] = a.x; f[u][1] = a.y; f[u][2] = a.z; f[u][3] = a.w; f[u][4] = b.x; f[u][5] = b.y; f[u][6] = b.z; f[u][7] = b.w; } }
#pragma unroll
        for (int u = 0; u < 4; ++u) { const int i = i0 + u * NGT; if (i < T * D / 8) { const int m = i >> 7, c8 = (i & 127) * 8;
            *(v4u*)(XB + (size_t)m * D + c8) = pack_bf8(f[u]);
            if (m >= TP) { float z[8];
#pragma unroll
                for (int e = 0; e < 8; ++e) z[e] = ALPHA * f[u][e];
                *(v4u*)(Zp + (size_t)m * D + c8) = pack_bf8(z); } } }
    }
    bf16* LT = (bf16*)(ws + WS_LORAT);
    for (int i = gt; i < 1536 * 256 / 2; i += NGT) { const int j = i >> 7, k = (i & 127) * 2; float v[2];
#pragma unroll
        for (int e = 0; e < 2; ++e) { const int kk = k + e; float x = 0.f;
            if (j < 512) { if (kk < 64) x = F.in[13][(size_t)kk * 512 + j]; }
            else if (j < 1024) { if (kk >= 64 && kk < 128) x = F.in[15][(size_t)(kk - 64) * 512 + (j - 512)]; }
            else { if (kk >= 128) x = F.in[16][(size_t)(kk - 128) * 512 + (j - 1024)]; }
            v[e] = x; }
        *(unsigned*)(LT + (size_t)j * 256 + k) = pkbf(v[0], v[1]); }
}

struct P2In { v4u cur[4], prv[4]; };
__device__ __forceinline__ void p2_load(P2In& X, const bf16* PB, int m, int lane) {
    const bool sample = m >= TP; const int t = sample ? (m - TP) & 7 : m & 2047;
    const bf16* pb = PB + (size_t)m * BP;
#pragma unroll
    for (int sec = 0; sec < 4; ++sec) {
        const int col = sec * 512 + lane * 8;
        if (sec < 3 || lane < 32) { X.cur[sec] = *(const v4u*)(pb + col); X.prv[sec] = t > 0 ? *(const v4u*)(pb - BP + col) : (v4u){0u, 0u, 0u, 0u}; }
        else { X.cur[sec] = (v4u){0u, 0u, 0u, 0u}; X.prv[sec] = (v4u){0u, 0u, 0u, 0u}; }
    }
}
__device__ __forceinline__ void p2_finish(const P2In& X, Frame& F, int m, int lane, const float (&mu)[4][8], const float (&kw)[8]) {
    unsigned char* ws = F.ws;
    h16* SCR = (h16*)(ws + WS_SCR); h16* SCK = (h16*)(ws + WS_SCK); h16* SCV = (h16*)(ws + WS_SCV); h16* SCKK = (h16*)(ws + WS_SCKK);
    bf16* LA = (bf16*)(ws + WS_LA);
    const bool sample = m >= TP; const int seq = sample ? (m - TP) >> 3 : m >> 11, t = sample ? (m - TP) & 7 : m & 2047, L = sample ? LS : LP;
    float* oshift = F.out + (sample ? O_SHIFT_S : O_SHIFT_P) + (size_t)seq * BP;
    const bool last = (t == L - 1);
#pragma unroll
    for (int sec = 0; sec < 4; ++sec) {
        if (sec == 3 && lane >= 32) break;
        const int col = sec * 512 + lane * 8;
        float p[8], pv[8], xm[8];
        unpack_bf8(X.cur[sec], p);
        if (t == 0 && sample) load_f8(F.in[3] + (size_t)seq * BP + col, pv); else unpack_bf8(X.prv[sec], pv);
#pragma unroll
        for (int i = 0; i < 8; ++i) xm[i] = p[i] + mu[sec][i] * (pv[i] - p[i]);
        if (last) store_f8(oshift + col, p);
        const size_t off = (size_t)m * HW + lane * 8;
        if (sec == 0) *(v4u*)(SCR + off) = pack_h8(xm);
        else if (sec == 1) {
            *(v4u*)(SCK + off) = pack_h8(xm);
            float kx[8]; float ss = 0.f;
#pragma unroll
            for (int i = 0; i < 8; ++i) { kx[i] = xm[i] * kw[i]; ss += kx[i] * kx[i]; }
            ss = sum8(ss);
            const float inv = 1.f / fmaxf(sqrtf(ss), 1e-12f);
#pragma unroll
            for (int i = 0; i < 8; ++i) kx[i] *= inv;
            *(v4u*)(SCKK + off) = pack_h8(kx);
        } else if (sec == 2) *(v4u*)(SCV + off) = pack_h8(xm);
        else {
            float o[8];
#pragma unroll
            for (int i = 0; i < 8; ++i) {
                if (lane < 8) { const float e = __expf(2.f * xm[i]); o[i] = 1.f - 2.f * __builtin_amdgcn_rcpf(e + 1.f); }
                else if (lane < 16) o[i] = xm[i];
                else o[i] = sigmoid_(xm[i]);
            }
            *(v4u*)(LA + (size_t)m * 256 + lane * 8) = pack_bf8(o);
        }
    }
}
__device__ __forceinline__ void p2_rows(Frame& F) {
    const int gw = F.vcu * NWAVES + F.wave, NGW = F.G * NWAVES, lane = F.lane;
    const bf16* PB = (const bf16*)(F.ws + WS_PROJB);
    float mu[4][8], kw[8];
#pragma unroll
    for (int sec = 0; sec < 4; ++sec) { if (sec < 3 || lane < 32) load_f8(F.in[11] + sec * 512 + lane * 8, mu[sec]); else {
#pragma unroll
            for (int i = 0; i < 8; ++i) mu[sec][i] = 0.f; } }
    load_f8(F.in[17] + lane * 8, kw);
    for (int m = gw; m < T; m += 2 * NGW) {
        const int m2 = m + NGW; const bool has2 = m2 < T;
        P2In A, B;
        p2_load(A, PB, m, lane);
        if (has2) p2_load(B, PB, m2, lane);
        p2_finish(A, F, m, lane, mu, kw);
        if (has2) p2_finish(B, F, m2, lane, mu, kw);
    }
}

template <int TT, bool FAST> __device__ __forceinline__ void conv_tile(Frame& F, int m0, int t0, int seq, bool sample) {
    const int c = F.tid;
    unsigned char* ws = F.ws;
    const bf16* PA = (const bf16*)(ws + WS_PROJA); bf16* CAT = (bf16*)(ws + WS_CAT);
    const float* cw = F.in[7]; const float* sconv = F.in[2];
    LAS float* ylds = (LAS float*)F.lds;
    float w[31];
#pragma unroll
    for (int j = 0; j < 31; ++j) w[j] = cw[j * 512 + c];
    float y[TT]; const float bias = F.in[8][c];
#pragma unroll
    for (int t = 0; t < TT; ++t) y[t] = bias;
    const bool lastp = (!sample) && (t0 + TT == LP);
    float* oconv = F.out + (sample ? O_CONV_S : O_CONV_P) + (size_t)seq * 30 * 512 + c;
    const bf16* pp = PA + ((size_t)m0 - 30) * 512 + c; const float* scp = sconv + ((size_t)seq * 30 + t0) * 512 + c;
    constexpr int NR = TT + 30, H1 = (NR + 1) / 2;
#pragma unroll
    for (int hh = 0; hh < 2; ++hh) {
        const int r0 = hh ? H1 : 0, r1 = hh ? NR : H1;
        unsigned rv[H1];
#pragma unroll
        for (int ri = r0; ri < r1; ++ri) {
            const int s2 = ri - 30;
            asm volatile("" : "+v"(pp), "+v"(scp));
            if (FAST || t0 + s2 >= 0) rv[ri - r0] = pp[0];
            else rv[ri - r0] = sample ? __float_as_uint(*scp) : 0u;
            pp += 512; scp += 512;
        }
#pragma unroll
        for (int ri = r0; ri < r1; ++ri) {
            const int s2 = ri - 30;
            float u;
            if (FAST || t0 + s2 >= 0) u = bf2f(rv[ri - r0]);
            else u = __uint_as_float(rv[ri - r0]);
#pragma unroll
            for (int t = 0; t < TT; ++t) { const int j = s2 - t + 30; if (j >= 0 && j <= 30) y[t] += u * w[j]; }
            if (sample) { if (s2 + 22 >= 0) oconv[(size_t)(s2 + 22) * 512] = u; }
            else if (lastp && s2 >= TT - 30) oconv[(size_t)(s2 - (TT - 30)) * 512] = u;
        }
        asm volatile("" ::: "memory");
    }
#pragma unroll
    for (int t = 0; t < TT; ++t) ylds[t * 512 + c] = y[t];
    __syncthreads();
    const float* lg = F.in[9]; const float* lb = F.in[10];
    for (int t = F.wave; t < TT; t += NWAVES) {
        const LAS float* yr = ylds + t * 512 + F.lane * 8;
        float v[8];
        { const f32x4 a = *(const LAS f32x4*)yr, b = *(const LAS f32x4*)(yr + 4); v[0] = a.x; v[1] = a.y; v[2] = a.z; v[3] = a.w; v[4] = b.x; v[5] = b.y; v[6] = b.z; v[7] = b.w; }
        float s = 0.f;
#pragma unroll
        for (int i = 0; i < 8; ++i) s += v[i];
        const float mean = wave_sum(s) * (1.f / 512.f); float q = 0.f;
#pragma unroll
        for (int i = 0; i < 8; ++i) { v[i] -= mean; q += v[i] * v[i]; }
        const float rstd = rsqrtf(wave_sum(q) * (1.f / 512.f) + LN_EPS);
        float g8[8], b8[8], o[8]; load_f8(lg + F.lane * 8, g8); load_f8(lb + F.lane * 8, b8);
#pragma unroll
        for (int i = 0; i < 8; ++i) o[i] = silu_(v[i] * rstd * g8[i] + b8[i]);
        *(v4u*)(CAT + (size_t)(m0 + t) * 1024 + F.lane * 8) = pack_bf8(o);
    }
    __syncthreads();
}
__device__ __forceinline__ void conv_phase(Frame& F) {
    for (int it = F.vcu; it < 512 + 128; it += F.G) {
        if (it < 512) { const int m0 = it * 32, t0 = m0 & 2047; if (t0 >= 32) conv_tile<32, true>(F, m0, t0, m0 >> 11, false); else conv_tile<32, false>(F, m0, t0, m0 >> 11, false); }
        else { const int seq = it - 512; conv_tile<8, false>(F, TP + seq * 8, 0, seq, true); }
    }
}

constexpr int SU = 8;
struct ScanPtrs { const h16* R; const h16* K; const h16* V; const h16* KK; const h16* B; const h16* W; h16* O; };
struct ScanBuf { v2u r[SU], k[SU], kk[SU], b[SU], w[SU]; unsigned short v[SU]; };
__device__ __forceinline__ void scan_load(ScanBuf& Bf, const ScanPtrs& P, size_t off, int ks, int row) {
#pragma unroll
    for (int i = 0; i < SU; ++i) { const size_t o = off + (size_t)i * HW;
        Bf.r[i] = *(const v2u*)(P.R + o + ks); Bf.k[i] = *(const v2u*)(P.K + o + ks); Bf.kk[i] = *(const v2u*)(P.KK + o + ks);
        Bf.b[i] = *(const v2u*)(P.B + o + ks); Bf.w[i] = *(const v2u*)(P.W + o + ks); Bf.v[i] = *(const unsigned short*)(P.V + o + row); }
}
__device__ __forceinline__ void scan_compute(const ScanBuf& Bf, float (&S)[4], const ScanPtrs& P, size_t off, int row, bool writer) {
#pragma unroll
    for (int i = 0; i < SU; ++i) {
        float r[4], k[4], kk[4], b[4], w[4]; h4(Bf.r[i], r); h4(Bf.k[i], k); h4(Bf.kk[i], kk); h4(Bf.b[i], b); h4(Bf.w[i], w);
        const float v = (float)__builtin_bit_cast(h16, Bf.v[i]);
        float d = (S[0] * kk[0] + S[1] * kk[1]) + (S[2] * kk[2] + S[3] * kk[3]);
        float pj[4];
#pragma unroll
        for (int j = 0; j < 4; ++j) pj[j] = fmaf(v, k[j], fmaf(-S[j], w[j], S[j]));
        d = dpp_sum16(d);
#pragma unroll
        for (int j = 0; j < 4; ++j) S[j] = fmaf(-d, b[j], pj[j]);
        float o = (S[0] * r[0] + S[1] * r[1]) + (S[2] * r[2] + S[3] * r[3]);
        o = dpp_sum16(o);
        if (writer) P.O[off + (size_t)i * HW + row] = (h16)o;
    }
}
template <int L> __device__ __forceinline__ void scan_task(const ScanPtrs& P, int mbase, int h, int v0, const float* s_in, float* s_out, int lane) {
    const int rl = lane >> 4, ks = (lane & 15) * 4, row = v0 + rl; const bool writer = (lane & 15) == 0;
    float S[4] = {0.f, 0.f, 0.f, 0.f};
    if (s_in) { const f32x4 s = *(const f32x4*)(s_in + (size_t)row * 64 + ks); S[0] = s.x; S[1] = s.y; S[2] = s.z; S[3] = s.w; }
    size_t off = (size_t)mbase * HW + h * 64;
    ScanBuf A;
    scan_load(A, P, off, ks, row);
    if constexpr (L == SU) { scan_compute(A, S, P, off, row, writer); }
    else {
        ScanBuf Bf;
        for (int t = 0; t < L; t += 2 * SU) {
            scan_load(Bf, P, off + (size_t)SU * HW, ks, row);
            scan_compute(A, S, P, off, row, writer);
            if (t + 2 * SU < L) scan_load(A, P, off + (size_t)2 * SU * HW, ks, row);
            scan_compute(Bf, S, P, off + (size_t)SU * HW, row, writer);
            off += (size_t)2 * SU * HW;
        }
    }
    *(f32x4*)(s_out + (size_t)row * 64 + ks) = (f32x4){S[0], S[1], S[2], S[3]};
}
constexpr int RING_SLOTS = 64, SLOT_BYTES = 1536, FLAG_OFF = 131072 + 1024;
constexpr unsigned SPIN_CAP = 1u << 22;
struct StepF { f32x4 r, k, kk, b, w; float v; };
__device__ __forceinline__ void ld_stepf(StepF& X, const LAS unsigned char* slot, unsigned rd, unsigned vd) {
    X.r = *(const LAS f32x4*)(slot + 0 * 256 + rd); X.k = *(const LAS f32x4*)(slot + 1 * 256 + rd); X.kk = *(const LAS f32x4*)(slot + 2 * 256 + rd);
    X.b = *(const LAS f32x4*)(slot + 3 * 256 + rd); X.w = *(const LAS f32x4*)(slot + 4 * 256 + rd); X.v = *(const LAS float*)(slot + vd);
}
typedef float f32x2 __attribute__((ext_vector_type(2)));
__device__ __forceinline__ float step_computef(const StepF& X, f32x2& S01, f32x2& S23) {
    const f32x2 kk01 = {X.kk.x, X.kk.y}, kk23 = {X.kk.z, X.kk.w}, w01 = {X.w.x, X.w.y}, w23 = {X.w.z, X.w.w};
    const f32x2 k01 = {X.k.x, X.k.y}, k23 = {X.k.z, X.k.w}, b01 = {X.b.x, X.b.y}, b23 = {X.b.z, X.b.w}, r01 = {X.r.x, X.r.y}, r23 = {X.r.z, X.r.w};
    f32x2 p = S01 * kk01; p = S23 * kk23 + p;
    float d = p.x + p.y;
    const f32x2 vv = {X.v, X.v};
    const f32x2 pj01 = vv * k01 + (S01 - S01 * w01), pj23 = vv * k23 + (S23 - S23 * w23);
    d = dpp_sum16(d);
    const f32x2 dd = {d, d};
    S01 = pj01 - dd * b01; S23 = pj23 - dd * b23;
    f32x2 q = S01 * r01; q = S23 * r23 + q;
    return dpp_sum16(q.x + q.y);
}
__device__ __forceinline__ unsigned min4(const volatile LAS unsigned* p) { const unsigned a = p[0], b = p[1], c = p[2], d = p[3]; return min(min(a, b), min(c, d)); }
__device__ __forceinline__ void scan_prompt_consumer(Frame& F, int mbase, int h, int v0, float* s_out) {
    const int lane = F.lane, rl = lane >> 4, l16 = lane & 15, ks = l16 * 4, row = v0 + rl;
    const LAS unsigned char* ring = F.lds;
    volatile LAS unsigned* prod = (volatile LAS unsigned*)(F.lds + FLAG_OFF); volatile LAS unsigned* cons = prod + 4;
    h16* O = (h16*)(F.ws + WS_O) + (size_t)mbase * HW + h * 64 + row;
    const unsigned rd = ks * 4, vd = 5 * 256 + row * 4;
    constexpr int L = LP;
    f32x2 S01 = {0.f, 0.f}, S23 = {0.f, 0.f};
    StepF Q[4];
    __builtin_amdgcn_s_setprio(2);
    { unsigned sp = 0; while (min4(prod) < 2u && ++sp < SPIN_CAP) __builtin_amdgcn_s_sleep(1); }
    asm volatile("" ::: "memory");
    ld_stepf(Q[0], ring, rd, vd);
    ld_stepf(Q[1], ring + SLOT_BYTES, rd, vd);
    ld_stepf(Q[2], ring + 2 * SLOT_BYTES, rd, vd);
    float okeep = 0.f;
#pragma unroll 1
    for (int tb = 0; tb < L; tb += 16) {
#pragma unroll
        for (int j = 0; j < 16; ++j) {
            const int t = tb + j;
            if (j == 0) {
                const unsigned need = (unsigned)min(t / 4 + 5, L / 4);
                unsigned sp = 0; while (min4(prod) < need && ++sp < SPIN_CAP) __builtin_amdgcn_s_sleep(1);
                asm volatile("" ::: "memory");
            }
            __builtin_amdgcn_sched_barrier(0x7);
            ld_stepf(Q[(j + 3) & 3], ring + ((t + 3) & (RING_SLOTS - 1)) * SLOT_BYTES, rd, vd);
            __builtin_amdgcn_sched_barrier(0x7);
            const float o = step_computef(Q[j & 3], S01, S23);
            okeep = (l16 == j) ? o : okeep;
            if (j == 15) { asm volatile("s_waitcnt lgkmcnt(0)" ::: "memory"); if (lane == 0) cons[F.wave] = (unsigned)(t + 1); }
        }
        O[(size_t)(tb + l16) * HW] = (h16)okeep;
    }
    *(f32x4*)(s_out + (size_t)row * 64 + ks) = (f32x4){S01.x, S01.y, S23.x, S23.y};
    __builtin_amdgcn_s_setprio(0);
}
__device__ __forceinline__ void scan_prompt_loader(Frame& F, int mbase, int h) {
    const int lane = F.lane, w = F.wave - 4;
    LAS unsigned char* ring = F.lds;
    volatile LAS unsigned* prod = (volatile LAS unsigned*)(F.lds + FLAG_OFF); volatile LAS unsigned* cons = prod + 4;
    const int arr = lane < 40 ? (lane >> 3) : 5, part = lane & 7;
    const size_t abase = arr == 0 ? WS_SCR : arr == 1 ? WS_SCK : arr == 2 ? WS_SCKK : arr == 3 ? WS_SCB : arr == 4 ? WS_SCW : WS_SCV;
    const unsigned char* src = F.ws + abase + ((size_t)mbase * HW + h * 64) * 2 + part * 16;
    const bool active = lane < 48;
    const unsigned dst = arr * 256 + part * 32;
    constexpr int L = LP, PF = 16;
    v4u buf[PF]; unsigned cmin = 0u;
    const unsigned char* lp = src + (size_t)w * 1024;
#pragma unroll
    for (int i = 0; i < PF; ++i) { asm volatile("" : "+v"(lp)); buf[i] = active ? *(const v4u*)lp : (v4u){0u, 0u, 0u, 0u}; lp += 4096; }
    unsigned slot = (unsigned)w;
#pragma unroll 1
    for (int sb = w; sb < L; sb += 4 * PF) {
#pragma unroll
        for (int i = 0; i < PF; ++i) {
            const int st = sb + 4 * i;
            if (st >= RING_SLOTS && cmin < (unsigned)(st - RING_SLOTS + 1)) { unsigned sp = 0; while ((cmin = min4(cons)) < (unsigned)(st - RING_SLOTS + 1) && ++sp < SPIN_CAP) __builtin_amdgcn_s_sleep(1); }
            asm volatile("" ::: "memory");
            float f[8]; unpack_h8(buf[i], f);
            { asm volatile("" : "+v"(lp)); if (st + 4 * PF < L) buf[i] = active ? *(const v4u*)lp : (v4u){0u, 0u, 0u, 0u}; lp += 4096; }
            if (active) { LAS unsigned char* p = ring + slot * SLOT_BYTES + dst;
                *(LAS f32x4*)p = (f32x4){f[0], f[1], f[2], f[3]}; *(LAS f32x4*)(p + 16) = (f32x4){f[4], f[5], f[6], f[7]}; }
            slot = (slot + 4) & (RING_SLOTS - 1);
            asm volatile("s_waitcnt lgkmcnt(0)" ::: "memory");
            if (lane == 0) prod[w] = (unsigned)(st >> 2) + 1u;
        }
    }
}
__device__ __forceinline__ void scan_sample_pair(Frame& F, int pair) {
    const int lane = F.lane, n = pair >> 3, h = pair & 7;
    const unsigned char* ws = F.ws;
    LAS float* st = (LAS float*)(F.lds + F.wave * 12288);
    const size_t eoff = (size_t)(TP + n * LS) * HW + h * 64;
    v4u raw[5];
#pragma unroll
    for (int q = 0; q < 5; ++q) { const int id = lane + 64 * q, stp = id / 40, rem = id % 40, arr = rem >> 3, part = rem & 7;
        const size_t ab = arr == 0 ? WS_SCR : arr == 1 ? WS_SCK : arr == 2 ? WS_SCKK : arr == 3 ? WS_SCB : WS_SCW;
        raw[q] = *(const v4u*)(ws + ab + (eoff + (size_t)stp * HW) * 2 + part * 16); }
    unsigned short vr[8];
#pragma unroll
    for (int t = 0; t < 8; ++t) vr[t] = *(const unsigned short*)(ws + WS_SCV + (eoff + (size_t)t * HW + lane) * 2);
    float S[64];
    const float* sin = F.in[4] + (size_t)pair * 4096 + lane * 64;
#pragma unroll
    for (int c = 0; c < 16; ++c) { const f32x4 x = __builtin_nontemporal_load((const f32x4*)(sin + 4 * c)); S[4 * c] = x.x; S[4 * c + 1] = x.y; S[4 * c + 2] = x.z; S[4 * c + 3] = x.w; }
#pragma unroll
    for (int q = 0; q < 5; ++q) { const int id = lane + 64 * q, stp = id / 40, rem = id % 40, arr = rem >> 3, part = rem & 7;
        float f[8]; unpack_h8(raw[q], f); LAS float* d = st + (stp * 5 + arr) * 64 + part * 8;
        *(LAS f32x4*)d = (f32x4){f[0], f[1], f[2], f[3]}; *(LAS f32x4*)(d + 4) = (f32x4){f[4], f[5], f[6], f[7]}; }
#pragma unroll
    for (int t = 0; t < 8; ++t) st[2560 + t * 64 + lane] = (float)__builtin_bit_cast(h16, vr[t]);
    asm volatile("s_waitcnt lgkmcnt(0)" ::: "memory");
    h16* O = (h16*)(F.ws + WS_O) + eoff + lane;
#pragma unroll 1
    for (int t = 0; t < 8; ++t) {
        const LAS float* q = st + t * 320;
        float d0 = 0.f, d1 = 0.f, d2 = 0.f, d3 = 0.f;
#pragma unroll
        for (int c = 0; c < 16; ++c) { const f32x4 kk = *(const LAS f32x4*)(q + 128 + 4 * c);
            d0 = fmaf(S[4 * c], kk.x, d0); d1 = fmaf(S[4 * c + 1], kk.y, d1); d2 = fmaf(S[4 * c + 2], kk.z, d2); d3 = fmaf(S[4 * c + 3], kk.w, d3); }
        const float d = (d0 + d1) + (d2 + d3), v = st[2560 + t * 64 + lane];
        float o0 = 0.f, o1 = 0.f, o2 = 0.f, o3 = 0.f;
#pragma unroll
        for (int c = 0; c < 16; ++c) {
            const f32x4 r = *(const LAS f32x4*)(q + 4 * c), k = *(const LAS f32x4*)(q + 64 + 4 * c), b = *(const LAS f32x4*)(q + 192 + 4 * c), w = *(const LAS f32x4*)(q + 256 + 4 * c);
            float s0 = S[4 * c], s1 = S[4 * c + 1], s2 = S[4 * c + 2], s3 = S[4 * c + 3];
            s0 = fmaf(-d, b.x, fmaf(v, k.x, fmaf(-s0, w.x, s0))); s1 = fmaf(-d, b.y, fmaf(v, k.y, fmaf(-s1, w.y, s1)));
            s2 = fmaf(-d, b.z, fmaf(v, k.z, fmaf(-s2, w.z, s2))); s3 = fmaf(-d, b.w, fmaf(v, k.w, fmaf(-s3, w.w, s3)));
            S[4 * c] = s0; S[4 * c + 1] = s1; S[4 * c + 2] = s2; S[4 * c + 3] = s3;
            o0 = fmaf(s0, r.x, o0); o1 = fmaf(s1, r.y, o1); o2 = fmaf(s2, r.z, o2); o3 = fmaf(s3, r.w, o3);
        }
        O[(size_t)t * HW] = (h16)((o0 + o1) + (o2 + o3));
    }
    float* sout = F.out + O_WKV_S + (size_t)pair * 4096 + lane * 64;
#pragma unroll
    for (int c = 0; c < 16; ++c) __builtin_nontemporal_store((f32x4){S[4 * c], S[4 * c + 1], S[4 * c + 2], S[4 * c + 3]}, (f32x4*)(sout + 4 * c));
}
__device__ __forceinline__ void scan_phase(Frame& F) {
    unsigned char* ws = F.ws;
    ScanPtrs P{(const h16*)(ws + WS_SCR), (const h16*)(ws + WS_SCK), (const h16*)(ws + WS_SCV), (const h16*)(ws + WS_SCKK), (const h16*)(ws + WS_SCB), (const h16*)(ws + WS_SCW), (h16*)(ws + WS_O)};
    for (int task = F.vcu; task < 256; task += F.G) {
        if (F.tid < 8) ((volatile LAS unsigned*)(F.lds + FLAG_OFF))[F.tid] = 0u;
        __syncthreads();
        const int pair = task >> 2, q = task & 3, n = pair >> 3, h = pair & 7;
        if (F.wave < 4) scan_prompt_consumer(F, n * LP, h, q * 16 + F.wave * 4, F.out + O_WKV_P + (size_t)pair * 4096);
        else scan_prompt_loader(F, n * LP, h);
        __syncthreads();
    }
    if (F.wave < 4) { for (int pair = F.wave * F.G + F.vcu; pair < NSB * 8; pair += 4 * F.G) scan_sample_pair(F, pair); }
}

struct P6In { v4u o, r, k, v, g; };
__device__ __forceinline__ void p6_load(P6In& X, const unsigned char* ws, int m, int lane) {
    const size_t off = ((size_t)m * HW + lane * 8) * 2;
    X.o = __builtin_nontemporal_load((const v4u*)(ws + WS_O + off)); X.r = __builtin_nontemporal_load((const v4u*)(ws + WS_SCR + off)); X.k = __builtin_nontemporal_load((const v4u*)(ws + WS_SCK + off));
    X.v = __builtin_nontemporal_load((const v4u*)(ws + WS_SCV + off)); X.g = __builtin_nontemporal_load((const v4u*)(ws + WS_G + off));
}
__device__ __forceinline__ void p6_finish(const P6In& X, bf16* CAT, int m, int lane, const float (&rk)[8], const float (&lg)[8], const float (&lb)[8]) {
    float o[8], r[8], k[8], v[8], g[8];
    unpack_h8(X.o, o); unpack_h8(X.r, r); unpack_h8(X.k, k); unpack_h8(X.v, v); unpack_h8(X.g, g);
    float s = 0.f, bs = 0.f;
#pragma unroll
    for (int i = 0; i < 8; ++i) { s += o[i]; bs += r[i] * k[i] * rk[i]; }
    const float mean = sum8(s) * (1.f / 64.f); bs = sum8(bs); float q = 0.f;
#pragma unroll
    for (int i = 0; i < 8; ++i) { o[i] -= mean; q += o[i] * o[i]; }
    const float rstd = rsqrtf(sum8(q) * (1.f / 64.f) + GN_EPS);
    float res[8];
#pragma unroll
    for (int i = 0; i < 8; ++i) res[i] = (o[i] * rstd * lg[i] + lb[i] + bs * v[i]) * g[i];
    *(v4u*)(CAT + (size_t)m * 1024 + 512 + lane * 8) = pack_bf8(res);
}
__device__ __forceinline__ void p6_rows(Frame& F) {
    const int gw = F.vcu * NWAVES + F.wave, NGW = F.G * NWAVES, lane = F.lane;
    const unsigned char* ws = F.ws; bf16* CAT = (bf16*)(F.ws + WS_CAT);
    float rk[8], lg[8], lb[8]; load_f8(F.in[19] + lane * 8, rk); load_f8(F.in[20] + lane * 8, lg); load_f8(F.in[21] + lane * 8, lb);
    for (int m = gw; m < T; m += 4 * NGW) {
        P6In X[4];
#pragma unroll
        for (int u = 0; u < 4; ++u) { const int mm = m + u * NGW; if (mm < T) p6_load(X[u], ws, mm, lane); }
#pragma unroll
        for (int u = 0; u < 4; ++u) { const int mm = m + u * NGW; if (mm < T) p6_finish(X[u], CAT, mm, lane, rk, lg, lb); }
    }
}

template <int MODE> __device__ __forceinline__ void ln_finish(Frame& F, int m, f32x4 (&v)[4], const f32x4 (&gv)[4], const f32x4 (&bv)[4], int nparts, const h16* pa, const h16* pb) {
    const int lane = F.lane;
    bf16* zr = (bf16*)(F.ws + WS_Z) + (size_t)m * D; bf16* XB = (bf16*)(F.ws + WS_XB);
    float s = 0.f;
    if (m >= TP) {
#pragma unroll 2
        for (int sp = 0; sp < nparts; ++sp) { const h16* pr = (sp < 8 ? pa + (size_t)sp * (1u << 20) : pb + (size_t)(sp - 8) * (1u << 20)) + (size_t)(m - TP) * D;
#pragma unroll
            for (int j = 0; j < 4; ++j) { float f[4]; h4(*(const v2u*)(pr + 4 * (lane + 64 * j)), f); v[j] = v[j] + (f32x4){f[0], f[1], f[2], f[3]}; } }
    }
#pragma unroll
    for (int j = 0; j < 4; ++j) s += (v[j].x + v[j].y) + (v[j].z + v[j].w);
    const float mean = wave_sum(s) * (1.f / D); float s2 = 0.f;
#pragma unroll
    for (int j = 0; j < 4; ++j) { v[j] = v[j] - mean; s2 += (v[j].x * v[j].x + v[j].y * v[j].y) + (v[j].z * v[j].z + v[j].w * v[j].w); }
    const float rstd = rsqrtf(wave_sum(s2) * (1.f / D) + LN_EPS);
#pragma unroll
    for (int j = 0; j < 4; ++j) v[j] = v[j] * rstd * gv[j] + bv[j];
    if (MODE == 2) {
#pragma unroll
        for (int j = 0; j < 4; ++j) __builtin_nontemporal_store(v[j], (f32x4*)(F.out + O_Y + (size_t)m * D + 4 * (lane + 64 * j)));
    } else {
        if ((MODE == 0 || MODE == 1) && m >= TP) {
#pragma unroll
            for (int j = 0; j < 4; ++j) { v2u w; w.x = pkbf(v[j].x * ALPHA, v[j].y * ALPHA); w.y = pkbf(v[j].z * ALPHA, v[j].w * ALPHA); *(v2u*)(zr + 4 * (lane + 64 * j)) = w; }
        }
#pragma unroll
        for (int j = 0; j < 4; ++j) { v2u w; w.x = pkbf(v[j].x, v[j].y); w.y = pkbf(v[j].z, v[j].w); *(v2u*)(XB + (size_t)m * D + 4 * (lane + 64 * j)) = w; }
    }
    if (MODE == 1) {
        const bool sample = m >= TP; const int seq = sample ? (m - TP) >> 3 : m >> 11, t = sample ? (m - TP) & 7 : m & 2047;
        if (sample) {
            float* op = F.out + O_POOL_S + ((size_t)seq * 15 + 7 + t) * D;
#pragma unroll
            for (int j = 0; j < 4; ++j) *(f32x4*)(op + 4 * (lane + 64 * j)) = v[j];
            if (t == 0) { const float* sp = F.in[5] + ((size_t)seq * 15 + 8) * D; float* o0 = F.out + O_POOL_S + (size_t)seq * 15 * D;
                for (int i = lane; i < 7 * D / 4; i += 64) *(f32x4*)(o0 + 4 * i) = *(const f32x4*)(sp + 4 * i); }
        } else if (t >= LP - 15) {
            float* op = F.out + O_POOL_P + ((size_t)seq * 15 + (t - (LP - 15))) * D;
#pragma unroll
            for (int j = 0; j < 4; ++j) *(f32x4*)(op + 4 * (lane + 64 * j)) = v[j];
        }
    }
}
template <int MODE> __device__ __forceinline__ void ln_rows(Frame& F, const float* g, const float* b, int nparts, const h16* pa, const h16* pb, int TL = T) {
    const int gw = F.vcu * NWAVES + F.wave, NGW = F.G * NWAVES, lane = F.lane;
    const bf16* Z = (const bf16*)(F.ws + WS_Z);
    f32x4 gv[4], bv[4];
#pragma unroll
    for (int j = 0; j < 4; ++j) { gv[j] = *(const f32x4*)(g + 4 * (lane + 64 * j)); bv[j] = *(const f32x4*)(b + 4 * (lane + 64 * j)); }
    constexpr int LU = 4;
    for (int m = gw; m < TL; m += LU * NGW) {
        f32x4 v[LU][4];
#pragma unroll
        for (int u = 0; u < LU; ++u) { const int mm = m + u * NGW; if (mm < TL) {
#pragma unroll
                for (int j = 0; j < 4; ++j) { const v2u w = __builtin_nontemporal_load((const v2u*)(Z + (size_t)mm * D + 4 * (lane + 64 * j))); const unsigned w0 = w.x, w1 = w.y;
                    v[u][j] = (f32x4){__uint_as_float(w0 << 16), __uint_as_float(w0 & 0xffff0000u), __uint_as_float(w1 << 16), __uint_as_float(w1 & 0xffff0000u)}; } } }
#pragma unroll
        for (int u = 0; u < LU; ++u) { const int mm = m + u * NGW; if (mm < TL) ln_finish<MODE>(F, mm, v[u], gv, bv, nparts, pa, pb); }
    }
}

template <int TT> __device__ __forceinline__ float pool_one(const float (&xs)[TT + 15], int t, int g, int cnt) {
    const float x0 = xs[t + 15];
    const float s2 = x0 + xs[t + 14];
    const float s4 = s2 + (xs[t + 13] + xs[t + 12]);
    const float s8 = s4 + ((xs[t + 11] + xs[t + 10]) + (xs[t + 9] + xs[t + 8]));
    const float s16 = s8 + (((xs[t + 7] + xs[t + 6]) + (xs[t + 5] + xs[t + 4])) + ((xs[t + 3] + xs[t + 2]) + (xs[t + 1] + xs[t + 0])));
    const float sum = g == 0 ? s2 : (g == 1 ? s4 : (g == 2 ? s8 : s16));
    return sum / (float)cnt - x0;
}
template <int TT> __device__ __forceinline__ void pool_tile(Frame& F, int m0, int t0, int seq, bool sample) {
    const bf16* XR = (const bf16*)(F.ws + WS_XR); bf16* PL = (bf16*)(F.ws + WS_PL); const float* spool = F.in[5];
    const int c = 2 * F.tid, g = c >> 8;
    float xa[TT + 15], xb[TT + 15];
    const bf16* zp = XR + ((size_t)m0 - 15) * D + c; const float* sp = spool + ((size_t)seq * 15 + t0) * D + c;
#pragma unroll
    for (int s = -15; s < TT; ++s) {
        asm volatile("" : "+v"(zp), "+v"(sp));
        if (t0 + s >= 0) { const unsigned w = *(const unsigned*)zp; xa[s + 15] = __uint_as_float(w << 16); xb[s + 15] = __uint_as_float(w & 0xffff0000u); }
        else if (sample) { xa[s + 15] = sp[0]; xb[s + 15] = sp[1]; }
        else { xa[s + 15] = 0.f; xb[s + 15] = 0.f; }
        zp += D; sp += D;
    }
    const int wdw = 2 << g;
#pragma unroll
    for (int t = 0; t < TT; ++t) {
        const int cnt = sample ? wdw : min(wdw, t0 + t + 1);
        const float p0 = pool_one<TT>(xa, t, g, cnt), p1 = pool_one<TT>(xb, t, g, cnt);
        *(unsigned*)(PL + (size_t)(m0 + t) * D + c) = pkbf(p0, p1);
    }
}
__device__ __forceinline__ void pool_phase(Frame& F) {
    for (int it = F.vcu; it < 512 + 128; it += F.G) {
        if (it < 512) { const int m0 = it * 32; pool_tile<32>(F, m0, m0 & 2047, m0 >> 11, false); }
        else { const int seq = it - 512; pool_tile<8>(F, TP + seq * 8, 0, seq, true); }
    }
}


#ifndef DIAG_AT
#define DIAG_AT -1
#endif
__device__ __forceinline__ bool dbad(float got, float want) { return !(fabsf(got - want) <= 0.03f * fabsf(want) + 0.02f); }
__device__ __forceinline__ float h2f(h16 x) { return (float)x; }
__device__ __forceinline__ void diag_checks(Frame& F, int at) {
    if (blockIdx.x != 0 || F.wave != 0) return;
    const int lane = F.lane; unsigned char* ws = F.ws;
    unsigned mask = 0;
    const bf16* PA = (const bf16*)(ws + WS_PROJA); const bf16* PB = (const bf16*)(ws + WS_PROJB);
    const h16* SCR = (const h16*)(ws + WS_SCR); const h16* SCK = (const h16*)(ws + WS_SCK); const h16* SCV = (const h16*)(ws + WS_SCV); const h16* SCKK = (const h16*)(ws + WS_SCKK);
    const h16* SCB = (const h16*)(ws + WS_SCB); const h16* SCW = (const h16*)(ws + WS_SCW);
    const int m = 1 + (lane * 131 + 7) % 9000;
    const int t = m & 2047;
    if (at == 3) {
        const int c = (lane * 29 + 5) % 512, h0 = c & ~63;
        auto xm = [&](int col) { const float p = bf2f(PB[(size_t)m * BP + col]); const float pv = t > 0 ? bf2f(PB[(size_t)(m - 1) * BP + col]) : 0.f; return p + F.in[11][col] * (pv - p); };
        float ss = 0.f; for (int j = 0; j < 64; ++j) { const float kx = xm(512 + h0 + j) * F.in[17][h0 + j]; ss += kx * kx; }
        const float kkn = xm(512 + c) * F.in[17][c] / fmaxf(sqrtf(ss), 1e-12f);
        float al = F.in[14][c]; for (int j = 0; j < 64; ++j) al += xm(1600 + j) * F.in[15][(size_t)j * 512 + c];
        const float a = 1.f / (1.f + expf(-al)); const float f = (1.f + (a - 1.f) * F.in[18][c]); const float k0 = xm(512 + c); const float b = kkn * a;
        const float gotk = h2f(SCK[(size_t)m * HW + c]);
        if (__ballot(dbad(gotk, k0 * f))) mask |= 1;
        if (__ballot(dbad(h2f(SCB[(size_t)m * HW + c]) * 10.f, b * 10.f))) mask |= 2;
        { const bf16* LA = (const bf16*)(ws + WS_LA); bool bad = false; for (int j = 0; j < 64; ++j) bad = bad || dbad(bf2f(LA[(size_t)m * 256 + 64 + j]), xm(1600 + j)); if (__ballot(bad)) mask |= 4; }
        { float g = 0.f; for (int j = 0; j < 128; ++j) g += (1.f / (1.f + expf(-xm(1664 + j)))) * F.in[16][(size_t)j * 512 + c];
          const h16* G = (const h16*)(ws + WS_G); if (__ballot(dbad(h2f(G[(size_t)m * HW + c]), g))) mask |= 8; }
        if (__ballot(dbad(gotk, k0 * f * f))) mask |= 16;
        if (__ballot(dbad(gotk, k0))) mask |= 32;
    }
    if (lane == 0) *(unsigned*)(ws + 0) = mask;
}
__device__ __forceinline__ void diag_fill(Frame& F) {
    const unsigned mask = *(const unsigned*)(F.ws + 0);
    const float C = sqrtf(exp2f(1.f + (float)mask));
    const int gt = blockIdx.x * NTHREADS + F.tid, NGT = F.G * NTHREADS;
    for (int i = gt; i < TS * D; i += NGT) F.out[O_Y + (size_t)TP * D + i] = C;
}

#define XB_TMO      128
#define XB_XCNT(j)  (256  + 64 * (j))
#define XB_XSUB(j)  (1280 + 64 * (j))
#define XB_XGEN(j)  (2304 + 64 * (j))
#define XB_TOP      3328
#define XB_TOPGEN   3392
#define XCD_BAR_WORDS 3456
#define XB_SPIN_CAP (1u << 18)

__device__ __forceinline__ unsigned xb_ld(unsigned* p)              { return __hip_atomic_load(p, __ATOMIC_RELAXED, __HIP_MEMORY_SCOPE_AGENT); }
__device__ __forceinline__ unsigned xb_add(unsigned* p, unsigned v) { return __hip_atomic_fetch_add(p, v, __ATOMIC_RELAXED, __HIP_MEMORY_SCOPE_AGENT); }
__device__ __forceinline__ unsigned xb_xcc_id() { return (unsigned)__builtin_amdgcn_s_getreg((3 << 11) | 20) & 0xFu; }
#define XB_SPIN(cond, bar) do { unsigned _sp = 0; while (cond) { __builtin_amdgcn_s_sleep(1); \
    if ((++_sp & 255u) == 0u) { if (xb_ld(&(bar)[XB_TMO])) break; if (_sp > XB_SPIN_CAP) { atomicAdd(&(bar)[XB_TMO], 1u); break; } } } } while (0)

struct XcdBarrier {
    unsigned* bar; unsigned x;
    volatile LAS unsigned* st;
};

__device__ __forceinline__ XcdBarrier xcd_barrier_post(unsigned* bar, volatile LAS unsigned* st) {
    XcdBarrier b; b.bar = bar; b.x = xb_xcc_id(); b.st = st;
    if (threadIdx.x == 0) (void)xb_add(&bar[XB_XCNT(b.x)], 1u);
    return b;
}
__device__ __forceinline__ void xcd_barrier_complete(unsigned* bar, unsigned x, unsigned& nloc, unsigned& nx) {
    const unsigned G = gridDim.x * gridDim.y * gridDim.z;
    unsigned sum, cnt, mine, sp = 0u;
    for (;;) {
        sum = 0u; cnt = 0u; mine = 0u;
#pragma unroll
        for (unsigned j = 0; j < 16; ++j) { const unsigned c = xb_ld(&bar[XB_XCNT(j)]); sum += c; cnt += (c > 0u) ? 1u : 0u; mine = (j == x) ? c : mine; }
        if (sum == G) break;
        __builtin_amdgcn_s_sleep(1);
        if ((++sp & 255u) == 0u) { if (xb_ld(&bar[XB_TMO])) break; if (sp > XB_SPIN_CAP) { atomicAdd(&bar[XB_TMO], 1u); break; } }
    }
    nloc = mine > 0u ? mine : 1u; nx = cnt > 0u ? cnt : 1u;
}

__device__ __forceinline__ void xcd_barrier(const XcdBarrier& b) {
    asm volatile("s_waitcnt vmcnt(0)" ::: "memory");
    __syncthreads();
    if (threadIdx.x == 0) {
        unsigned* bar = b.bar;
        __builtin_amdgcn_s_waitcnt(0);
        unsigned nloc = b.st[0], nx = b.st[1];
        if (nloc == 0u) { xcd_barrier_complete(bar, b.x, nloc, nx); b.st[0] = nloc; b.st[1] = nx; }
        const unsigned old = xb_add(&bar[XB_XSUB(b.x)], 1u);
        const unsigned gen = old / nloc;
        if (old + 1u == (gen + 1u) * nloc) {
            __builtin_amdgcn_fence(__ATOMIC_RELEASE, "agent");
            asm volatile("s_waitcnt vmcnt(0)" ::: "memory");
            const unsigned og = xb_add(&bar[XB_TOP], 1u);
            const unsigned tg = og / nx;
            if (og + 1u == (tg + 1u) * nx) xb_add(&bar[XB_TOPGEN], 1u);
            else XB_SPIN(xb_ld(&bar[XB_TOPGEN]) == tg, bar);
            __builtin_amdgcn_fence(__ATOMIC_ACQUIRE, "agent");
            xb_add(&bar[XB_XGEN(b.x)], 1u);
            asm volatile("s_waitcnt vmcnt(0)" ::: "memory");
        } else {
            XB_SPIN(xb_ld(&bar[XB_XGEN(b.x)]) == gen, bar);
            __builtin_amdgcn_fence(__ATOMIC_ACQUIRE, "agent");
            asm volatile("s_waitcnt vmcnt(0)" ::: "memory");
        }
    }
    __syncthreads();
}

struct Args { const float* in[32]; float* out; unsigned char* ws; int ph_lo, ph_hi, coop, pad; };

__global__ void __launch_bounds__(NTHREADS, 2) mk_fwd(Args args) {
    extern __shared__ __attribute__((aligned(16))) unsigned char lds_raw[];
    Frame F;
    F.lds = (LAS unsigned char*)lds_raw;
    F.tid = threadIdx.x; F.lane = F.tid & 63; F.wave = __builtin_amdgcn_readfirstlane(F.tid >> 6);
    F.G = gridDim.x; { const int bx = blockIdx.x; F.vcu = (F.G % 8 == 0) ? (bx % 8) * (F.G / 8) + bx / 8 : bx; }
    F.in = args.in;
    F.out = args.out; F.ws = args.ws;
    unsigned char* ws = args.ws;
    const int lo = args.ph_lo, hi = args.ph_hi;
    volatile LAS unsigned* MISC = (volatile LAS unsigned*)(F.lds + 131072 + 512);
    if (F.tid < 32) MISC[F.tid] = 0u;
    __syncthreads();
    XcdBarrier bar = xcd_barrier_post((unsigned*)ws, MISC + 8);
#ifndef PHMASK
#define PHMASK 0x3ffff
#endif
#define IN(k) ((((PHMASK) >> (k)) & 1) && lo <= (k) && (k) < hi)
#ifndef PROF
#define PROF 0
#endif
    unsigned long long* tsbuf = (unsigned long long*)(ws + 65536);
#define STAMP(k) do { if (PROF && blockIdx.x == 0 && F.tid == 0) tsbuf[k] = __builtin_amdgcn_s_memrealtime(); } while (0)
#define SEAM(k) do { if (IN(k) && IN((k) + 1)) { xcd_barrier(bar); } STAMP((k) + 1); } while (0)
    STAMP(0);
    typedef pg8::bf16_t gb;

#ifndef DUP0
#define DUP0 0
#endif
#ifndef DUP9
#define DUP9 0
#endif
#ifndef DUP2
#define DUP2 0
#endif
#ifndef DUP6
#define DUP6 0
#endif
#ifndef DUP7
#define DUP7 0
#endif
#ifndef DUP13
#define DUP13 0
#endif
#ifndef DUP12
#define DUP12 0
#endif
#ifndef DUPLN
#define DUPLN 0
#endif
#ifndef DUP10
#define DUP10 0
#endif
#ifndef DUP1
#define DUP1 0
#endif
    if (DUP0) { p0_prologue(F); }
    if (IN(0)) { p0_prologue(F); } SEAM(0);
    if (DUP1) { pg8::Gemm g{(const gb*)(ws + WS_XB), (const gb*)(ws + WS_WIN), T, INP, D, D, D, 0}; pg8::StaticOrder S; S.init(T, INP, F.G, (int)blockIdx.x, D);
        EpiProj E{(bf16*)(ws + WS_PROJA), (bf16*)(ws + WS_PROJB)};
        pg8::gemm_phase<EpiProj, pg8::StaticOrder, true, true>(F.lds, g, S, E); xcd_barrier(bar); }
    if (IN(1)) {
        pg8::Gemm g{(const gb*)(ws + WS_XB), (const gb*)(ws + WS_WIN), T, INP, D, D, D, 0}; pg8::StaticOrder S; S.init(T, INP, F.G, (int)blockIdx.x, D);
        EpiProj E{(bf16*)(ws + WS_PROJA), (bf16*)(ws + WS_PROJB)};
        pg8::gemm_phase<EpiProj, pg8::StaticOrder, true, true>(F.lds, g, S, E);
    } SEAM(1);
    if (DUP2) { p2_rows(F); }
    if (IN(2)) { p2_rows(F); } SEAM(2);
    if (IN(3)) {
        pg8::Gemm g{(const gb*)(ws + WS_LA), (const gb*)(ws + WS_LORAT), T, 1536, 256, 256, 256, 0}; pg8::StaticOrder S; S.init(T, 1536, F.G, (int)blockIdx.x, 256);
        EpiLora E{F.in[12], F.in[14], F.in[18], (h16*)(ws + WS_SCW), (h16*)(ws + WS_SCK), (h16*)(ws + WS_SCKK), (h16*)(ws + WS_SCB), (h16*)(ws + WS_G)};
        pg8::gemm_phase<EpiLora, pg8::StaticOrder, true, true>(F.lds, g, S, E);
    } SEAM(3);
    if (IN(4)) { conv_phase(F); }
    STAMP(5);
#ifndef DUP5
#define DUP5 0
#endif
#ifndef DUP4
#define DUP4 0
#endif
    if (DUP4) { conv_phase(F); }
    if (IN(5)) { scan_phase(F); } SEAM(5);
    if (DUP5) { scan_phase(F); xcd_barrier(bar); }
    if (DUP6) { p6_rows(F); }
    if (IN(6)) { p6_rows(F); } SEAM(6);
    if (DUP7) { pg8::Gemm g{(const gb*)(ws + WS_CAT), (const gb*)(ws + WS_WOUT), T, D, D, D, D, 0}; SplitOrder S; S.init(D, F.G, (int)blockIdx.x, D, 4);
        EpiResid E{F.in[0], F.in[1], (bf16*)(ws + WS_Z), nullptr, nullptr, (h16*)(ws + WS_PART7), nullptr};
        pg8::gemm_phase<EpiResid, SplitOrder, true, true>(F.lds, g, S, E); xcd_barrier(bar); }
    if (IN(7)) {
        pg8::Gemm g{(const gb*)(ws + WS_CAT), (const gb*)(ws + WS_WOUT), T, D, D, D, D, 0}; SplitOrder S; S.init(D, F.G, (int)blockIdx.x, D, 4);
        EpiResid E{F.in[0], F.in[1], (bf16*)(ws + WS_Z), nullptr, nullptr, (h16*)(ws + WS_PART7), nullptr};
        pg8::gemm_phase<EpiResid, SplitOrder, true, true>(F.lds, g, S, E);
    } SEAM(7);
    if (DUPLN) { ln_rows<0>(F, F.in[25], F.in[26], 4, (const h16*)(ws + WS_PART7), nullptr, TP); xcd_barrier(bar); }
    if (IN(8)) { ln_rows<0>(F, F.in[25], F.in[26], 4, (const h16*)(ws + WS_PART7), nullptr); } SEAM(8);
#define FFN_PHASES(layer, pgu, pdn) \
    if (IN(pgu)) { \
        pg8::Gemm g{(const gb*)(ws + WS_XB), (const gb*)(ws + ((layer) ? WS_WGU1 : WS_WGU0)), T, 2 * FF, D, D, D, 0}; pg8::StaticOrder S; S.init(T, 2 * FF, F.G, (int)blockIdx.x, D); \
        EpiGateUp E{(bf16*)(ws + WS_H)}; \
        pg8::gemm_phase<EpiGateUp, pg8::StaticOrder, true, true>(F.lds, g, S, E); \
    } SEAM(pgu); \
    if (IN(pdn)) { \
        pg8::Gemm g{(const gb*)(ws + WS_H), (const gb*)(ws + ((layer) ? WS_WD1 : WS_WD0)), T, D, FF, FF, FF, 0}; SplitOrder S; S.init(D, F.G, (int)blockIdx.x, FF, 11); \
        EpiResid E{nullptr, nullptr, (bf16*)(ws + WS_Z), nullptr, (const bf16*)(ws + WS_XR), (h16*)(ws + WS_PARTA), (h16*)(ws + WS_PARTB)}; \
        pg8::gemm_phase<EpiResid, SplitOrder, true, true>(F.lds, g, S, E); \
    } SEAM(pdn);
    if (DUP9) { pg8::Gemm g{(const gb*)(ws + WS_XB), (const gb*)(ws + WS_WGU0), T, 2 * FF, D, D, D, 0}; pg8::StaticOrder S; S.init(T, 2 * FF, F.G, (int)blockIdx.x, D);
        EpiGateUp E{(bf16*)(ws + WS_H)}; pg8::gemm_phase<EpiGateUp, pg8::StaticOrder, true, true>(F.lds, g, S, E); xcd_barrier(bar); }
    FFN_PHASES(0, 9, 10)
    if (DUP10) { pg8::Gemm g{(const gb*)(ws + WS_H), (const gb*)(ws + WS_WD0), T, D, FF, FF, FF, 0}; SplitOrder S; S.init(D, F.G, (int)blockIdx.x, FF, 11);
        EpiResid E{nullptr, nullptr, (bf16*)(ws + WS_Z), nullptr, (const bf16*)(ws + WS_XR), (h16*)(ws + WS_PARTA), (h16*)(ws + WS_PARTB)};
        pg8::gemm_phase<EpiResid, SplitOrder, true, true>(F.lds, g, S, E); xcd_barrier(bar); }
    if (IN(11)) { ln_rows<1>(F, F.in[30], F.in[31], 11, (const h16*)(ws + WS_PARTA), (const h16*)(ws + WS_PARTB)); } SEAM(11);
    if (DUP12) { pool_phase(F); }
    if (IN(12)) { pool_phase(F); } SEAM(12);
    if (DUP13) { pg8::Gemm g{(const gb*)(ws + WS_PL), (const gb*)(ws + WS_POOLT), T, D, 256, D, 256, 256}; pg8::StaticOrder S; S.init(T, D, F.G, (int)blockIdx.x, 256);
        EpiResid E{nullptr, nullptr, (bf16*)(ws + WS_Z), F.in[24], (const bf16*)(ws + WS_XR), nullptr, nullptr};
        pg8::gemm_phase<EpiResid, pg8::StaticOrder, true, true>(F.lds, g, S, E); xcd_barrier(bar); }
    if (IN(13)) {
        pg8::Gemm g{(const gb*)(ws + WS_PL), (const gb*)(ws + WS_POOLT), T, D, 256, D, 256, 256}; SplitOrder S; S.init(D, F.G, (int)blockIdx.x, 256, 2);
        EpiResid E{nullptr, nullptr, (bf16*)(ws + WS_Z), F.in[24], (const bf16*)(ws + WS_XR), (h16*)(ws + WS_PART7), nullptr};
        pg8::gemm_phase<EpiResid, SplitOrder, true, true>(F.lds, g, S, E);
    } SEAM(13);
    if (IN(14)) { ln_rows<0>(F, F.in[25] + D, F.in[26] + D, 2, (const h16*)(ws + WS_PART7), nullptr); } SEAM(14);
    FFN_PHASES(1, 15, 16)
    if (IN(17)) { ln_rows<2>(F, F.in[30] + D, F.in[31] + D, 11, (const h16*)(ws + WS_PARTA), (const h16*)(ws + WS_PARTB)); }
    if (PROF) {
        STAMP(18);
        xcd_barrier(bar);
        if (blockIdx.x == 0) {
            const size_t obase[10] = {O_Y, O_Y + (size_t)TP * D, O_CONV_P, O_SHIFT_P, O_WKV_P, O_POOL_P, O_CONV_S, O_SHIFT_S, O_WKV_S, O_POOL_S};
#pragma unroll
            for (int k = 0; k < 10; ++k) {
                const int a = PROF == 1 ? k : 10 + k; unsigned long long d;
                if (a < 18) d = (tsbuf[a + 1] - tsbuf[a]) / 10ull; else if (a == 18) d = (tsbuf[18] - tsbuf[0]) / 100ull; else d = 1000ull;
                unsigned n = (unsigned)d; if (n > 14000u) n = 14000u; if (n < 1u) n = 1u;
                for (unsigned i = F.tid; i < n; i += NTHREADS) ((unsigned*)F.out)[obase[k] + i] = 0xAAAAAAAAu;
            }
        }
    }
    if (lo == 100) diag_checks(F, args.pad);
    if (lo == 101) diag_fill(F);
#undef IN
#undef SEAM
}

extern "C" void kernel_launch(void* const* d_in, const int* in_sizes, int n_in, void* d_out, int out_size, void* d_ws, size_t ws_size, hipStream_t stream) {
    static int grid = 0;
    if (grid == 0) {
        if (n_in != 32 || out_size != (int)O_TOTAL || ws_size < WS_END) { fprintf(stderr, "kernel_launch: unexpected shapes: n_in %d out %d ws %zu\n", n_in, out_size, ws_size); grid = -1; return; }
        int dev = 0, cus = 0, per_cu = 0;
        if (hipGetDevice(&dev) != hipSuccess || hipDeviceGetAttribute(&cus, hipDeviceAttributeMultiprocessorCount, dev) != hipSuccess) { grid = -1; return; }
        if (hipFuncSetAttribute((const void*)mk_fwd, hipFuncAttributeMaxDynamicSharedMemorySize, LDS_BYTES) != hipSuccess) { fprintf(stderr, "kernel_launch: hipFuncSetAttribute failed\n"); grid = -1; return; }
        if (hipOccupancyMaxActiveBlocksPerMultiprocessor(&per_cu, (const void*)mk_fwd, NTHREADS, LDS_BYTES) != hipSuccess || per_cu < 1) { fprintf(stderr, "kernel_launch: occupancy query says %d\n", per_cu); (void)hipGetLastError(); per_cu = 1; }
        grid = cus * 1;
        if (per_cu < 1) grid = -1;
    }
    if (grid < 0) return;
    Args a{};
    for (int i = 0; i < 32; ++i) a.in[i] = (const float*)d_in[i];
    a.out = (float*)d_out; a.ws = (unsigned char*)d_ws;
#if MK_SINGLE
    if (hipMemsetAsync(d_ws, 0, 16384, stream) != hipSuccess) { fprintf(stderr, "kernel_launch: memset failed\n"); return; }
    a.ph_lo = 0; a.ph_hi = NPHASE; a.coop = 1;
    void* params[] = {&a};
    hipError_t e = hipLaunchCooperativeKernel((const void*)mk_fwd, dim3(grid), dim3(NTHREADS), params, LDS_BYTES, stream);
    if (e != hipSuccess) fprintf(stderr, "kernel_launch: cooperative launch failed: %s (grid %d)\n", hipGetErrorString(e), grid);
#else
    for (int p = 0; p < NPHASE; ++p) {
        if (DIAG_AT >= 0 && p > DIAG_AT) break;
        a.ph_lo = p; a.ph_hi = p + 1; a.coop = 0;
        hipLaunchKernelGGL(mk_fwd, dim3(grid), dim3(NTHREADS), LDS_BYTES, stream, a);
    }
    if (DIAG_AT >= 0) { a.pad = DIAG_AT; a.ph_lo = 100; a.ph_hi = 101; hipLaunchKernelGGL(mk_fwd, dim3(grid), dim3(NTHREADS), LDS_BYTES, stream, a);
                        a.ph_lo = 101; a.ph_hi = 102; hipLaunchKernelGGL(mk_fwd, dim3(grid), dim3(NTHREADS), LDS_BYTES, stream, a); }
#endif
}
```
